# Optimizing an MI355X kernel written in HIP

```python
import jax, jax.numpy as jnp
from jax import lax
import numpy as np

D_MODEL = 2048
BATCH = 1
SEQ = 8192
DEPTH = 4

N_MIXERS = 3
EPS = 1e-6
ROPE_THETA = 10000.0
N_HEADS = 16
HEAD_DIM = 128
N_KV_HEADS = 4
IDX_HEADS = 16
IDX_DIM = 128
IDX_ROPE_DIM = 64
TOPK_MAX = 256
Q_BLOCK = 128
A_SPLITS = [N_HEADS * HEAD_DIM, N_KV_HEADS * HEAD_DIM, N_KV_HEADS * HEAD_DIM, IDX_HEADS * IDX_DIM, IDX_DIM]
A_IN = sum(A_SPLITS) + IDX_HEADS
A_CUTS = [int(c) for c in np.cumsum(A_SPLITS)]
LRU_WIDTH = D_MODEL
LRU_BLOCKS = 8
LRU_BLOCK = LRU_WIDTH // LRU_BLOCKS
CONV_WIDTH = 4
LRU_C = 8.0
POOL_WINDOWS = (2, 4, 8, 16)
POOL_GROUPS = len(POOL_WINDOWS)
POOL_GROUP = D_MODEL // POOL_GROUPS
D_FF = 4 * D_MODEL

kernel_name = 'hybrid_dsa_rglru_pool_trunk'

F32 = jnp.float32


def rms_norm(x, g):
    xf = x.astype(F32)
    y = xf * lax.rsqrt(jnp.mean(xf * xf, axis=-1, keepdims=True) + EPS)
    return (y * g.astype(F32)).astype(x.dtype)


def rope_tables(pos, dim):
    inv = 1.0 / (ROPE_THETA ** (jnp.arange(0, dim, 2, dtype=F32) / dim))
    ang = pos.astype(F32)[..., None] * inv
    return jnp.cos(ang), jnp.sin(ang)


def apply_rope(x, cos, sin):
    xf = x.astype(F32)
    x1, x2 = jnp.split(xf, 2, axis=-1)
    c = cos[:, :, None, :]
    s = sin[:, :, None, :]
    return jnp.concatenate([x1 * c - x2 * s, x2 * c + x1 * s], axis=-1).astype(x.dtype)


def partial_rope(x, cos, sin):
    return jnp.concatenate([apply_rope(x[..., :IDX_ROPE_DIM], cos, sin), x[..., IDX_ROPE_DIM:]], axis=-1)


def dsa_mixer(h, pos, w_in, q_norm, k_norm, w_out):
    B, T, _ = h.shape
    topk = min(TOPK_MAX, T // 4)
    proj = h @ w_in
    q, k, v, iq, ik, iw = jnp.split(proj, A_CUTS, axis=-1)
    q = rms_norm(q.reshape(B, T, N_HEADS, HEAD_DIM), q_norm)
    k = rms_norm(k.reshape(B, T, N_KV_HEADS, HEAD_DIM), k_norm)
    v = v.reshape(B, T, N_KV_HEADS, HEAD_DIM)
    cos, sin = rope_tables(pos, HEAD_DIM)
    q = apply_rope(q, cos, sin)
    k = apply_rope(k, cos, sin)
    icos, isin = rope_tables(pos, IDX_ROPE_DIM)
    iq = partial_rope(iq.reshape(B, T, IDX_HEADS, IDX_DIM), icos, isin)
    ik = partial_rope(ik.reshape(B, T, 1, IDX_DIM), icos, isin)[:, :, 0]
    iw = iw * IDX_HEADS ** -0.5
    n_blk = T // Q_BLOCK
    key_idx = jnp.arange(T, dtype=jnp.int32)
    ik_f = ik.astype(F32)
    group = N_HEADS // N_KV_HEADS

    def to_blocks(a):
        return jnp.moveaxis(a.reshape((B, n_blk, Q_BLOCK) + a.shape[2:]), 1, 0)

    def block_fn(args):
        qb, iqb, iwb, tb = args
        logits = jnp.einsum('bqhd,bsd->bqhs', iqb.astype(F32), ik_f) * IDX_DIM ** -0.5
        score = jnp.einsum('bqh,bqhs->bqs', iwb.astype(F32), jax.nn.relu(logits))
        causal = key_idx[None, None, :] <= tb[None, :, None]
        score = jnp.where(causal, score, -jnp.inf)
        _, sel = lax.top_k(score, topk)
        valid = sel <= tb[None, :, None]
        kg = jax.vmap(lambda kk, ii: kk[ii])(k, sel)
        vg = jax.vmap(lambda vv, ii: vv[ii])(v, sel)
        qg = qb.reshape(B, Q_BLOCK, N_KV_HEADS, group, HEAD_DIM)
        s = jnp.einsum('bqgrd,bqkgd->bqgrk', qg, kg).astype(F32) * HEAD_DIM ** -0.5
        s = jnp.where(valid[:, :, None, None, :], s, -jnp.inf)
        p = jax.nn.softmax(s, axis=-1).astype(vg.dtype)
        o = jnp.einsum('bqgrk,bqkgd->bqgrd', p, vg)
        return o.reshape(B, Q_BLOCK, N_HEADS * HEAD_DIM)

    out = lax.map(block_fn, (to_blocks(q), to_blocks(iq), to_blocks(iw), key_idx.reshape(n_blk, Q_BLOCK)))
    out = jnp.moveaxis(out, 0, 1).reshape(B, T, N_HEADS * HEAD_DIM)
    return out @ w_out


def rglru_mixer(h, w_in, conv_w, conv_b, gate_a_w, gate_a_b, gate_x_w, gate_x_b, lam, w_out):
    B, T, _ = h.shape
    proj = h @ w_in
    gate, xr = jnp.split(proj, 2, axis=-1)
    xp = jnp.pad(xr, ((0, 0), (CONV_WIDTH - 1, 0), (0, 0)))
    xc = conv_b + xp[:, 0:T] * conv_w[0]
    for j in range(1, CONV_WIDTH):
        xc = xc + xp[:, j:j + T] * conv_w[j]
    xb = xc.reshape(B, T, LRU_BLOCKS, LRU_BLOCK)
    r = jax.nn.sigmoid(jnp.einsum('btnc,ncd->btnd', xb, gate_a_w).reshape(B, T, LRU_WIDTH) + gate_a_b)
    i = jax.nn.sigmoid(jnp.einsum('btnc,ncd->btnd', xb, gate_x_w).reshape(B, T, LRU_WIDTH) + gate_x_b)
    log_a = -LRU_C * r.astype(F32) * jax.nn.softplus(-lam.astype(F32))
    a = jnp.exp(log_a)
    mult = jnp.sqrt(-jnp.expm1(2.0 * log_a))
    b = xc.astype(F32) * i.astype(F32) * mult

    def combine(left, right):
        a1, b1 = left
        a2, b2 = right
        return a1 * a2, a2 * b1 + b2

    _, hs = lax.associative_scan(combine, (a, b), axis=1)
    y = hs.astype(h.dtype) * jax.nn.gelu(gate)
    return y @ w_out


def pool_mixer(h, w_group, b_group, scale):
    B, T, D = h.shape
    hf = h.astype(F32)
    csum = jnp.concatenate([jnp.zeros((B, 1, D), F32), jnp.cumsum(hf, axis=1)], axis=1)
    t1 = jnp.arange(1, T + 1, dtype=F32)[None, :, None]
    outs = []
    for g, w in enumerate(POOL_WINDOWS):
        sl = slice(g * POOL_GROUP, (g + 1) * POOL_GROUP)
        c = csum[:, :, sl]
        lag = jnp.concatenate([jnp.zeros((B, w - 1, POOL_GROUP), F32), c[:, :T + 1 - w]], axis=1)
        mean = (c[:, 1:] - lag) / jnp.minimum(t1, float(w))
        outs.append(mean - hf[:, :, sl])
    y = jnp.stack(outs, axis=2).astype(h.dtype)
    y = jnp.einsum('btgc,gcd->btgd', y, w_group) + b_group
    return y.reshape(B, T, D) * scale


def channel_mlp(h, w_up, w_down):
    return jnp.square(jax.nn.relu(h @ w_up)) @ w_down


def setup_inputs(seed: int = 0) -> dict:
    key = jax.random.key(seed)
    ks = jax.random.split(key, 32)
    n_a = (DEPTH + 2) // 3
    n_b = (DEPTH + 1) // 3
    n_c = DEPTH // 3
    nrm = jax.random.normal

    def gain(k, n, d):
        return 1.0 + 0.02 * nrm(k, (n, d), F32)

    x = nrm(ks[0], (BATCH, SEQ, D_MODEL), F32)
    positions = jnp.broadcast_to(jnp.arange(SEQ, dtype=jnp.int32)[None, :], (BATCH, SEQ))
    u = jax.random.uniform(ks[14], (n_b, LRU_WIDTH), F32, 0.9, 0.999)
    a0 = u ** (1.0 / LRU_C)
    lam = jnp.log(a0) - jnp.log1p(-a0)
    return {
        'x': x,
        'positions': positions,
        'attn_norm': gain(ks[1], n_a, D_MODEL),
        'attn_w_in': nrm(ks[2], (n_a, D_MODEL, A_IN), F32) * D_MODEL ** -0.5,
        'attn_q_norm': gain(ks[3], n_a, HEAD_DIM),
        'attn_k_norm': gain(ks[4], n_a, HEAD_DIM),
        'attn_w_out': nrm(ks[5], (n_a, N_HEADS * HEAD_DIM, D_MODEL), F32) * (N_HEADS * HEAD_DIM) ** -0.5,
        'rnn_norm': gain(ks[6], n_b, D_MODEL),
        'rnn_w_in': nrm(ks[7], (n_b, D_MODEL, 2 * LRU_WIDTH), F32) * D_MODEL ** -0.5,
        'rnn_conv_w': nrm(ks[8], (n_b, CONV_WIDTH, LRU_WIDTH), F32) * CONV_WIDTH ** -0.5,
        'rnn_conv_b': 0.02 * nrm(ks[9], (n_b, LRU_WIDTH), F32),
        'rnn_gate_a_w': nrm(ks[10], (n_b, LRU_BLOCKS, LRU_BLOCK, LRU_BLOCK), F32) * LRU_BLOCK ** -0.5,
        'rnn_gate_a_b': 0.02 * nrm(ks[11], (n_b, LRU_WIDTH), F32),
        'rnn_gate_x_w': nrm(ks[12], (n_b, LRU_BLOCKS, LRU_BLOCK, LRU_BLOCK), F32) * LRU_BLOCK ** -0.5,
        'rnn_gate_x_b': 0.02 * nrm(ks[13], (n_b, LRU_WIDTH), F32),
        'rnn_lambda': lam,
        'rnn_w_out': nrm(ks[15], (n_b, LRU_WIDTH, D_MODEL), F32) * LRU_WIDTH ** -0.5,
        'pool_norm': gain(ks[16], n_c, D_MODEL),
        'pool_w': nrm(ks[17], (n_c, POOL_GROUPS, POOL_GROUP, POOL_GROUP), F32) * POOL_GROUP ** -0.5,
        'pool_b': 0.02 * nrm(ks[18], (n_c, POOL_GROUPS, POOL_GROUP), F32),
        'pool_scale': 1.0 + 0.1 * nrm(ks[19], (n_c, D_MODEL), F32),
        'mlp_norm': gain(ks[20], DEPTH, D_MODEL),
        'mlp_w_up': nrm(ks[21], (DEPTH, D_MODEL, D_FF), F32) * D_MODEL ** -0.5,
        'mlp_w_down': nrm(ks[22], (DEPTH, D_FF, D_MODEL), F32) * D_FF ** -0.5,
    }


def reference(x, positions, attn_norm, attn_w_in, attn_q_norm, attn_k_norm, attn_w_out,
              rnn_norm, rnn_w_in, rnn_conv_w, rnn_conv_b, rnn_gate_a_w, rnn_gate_a_b,
              rnn_gate_x_w, rnn_gate_x_b, rnn_lambda, rnn_w_out,
              pool_norm, pool_w, pool_b, pool_scale,
              mlp_norm, mlp_w_up, mlp_w_down):
    for i in range(DEPTH):
        kind, j = i % N_MIXERS, i // N_MIXERS
        if kind == 0:
            x = x + dsa_mixer(rms_norm(x, attn_norm[j]), positions, attn_w_in[j],
                              attn_q_norm[j], attn_k_norm[j], attn_w_out[j])
        elif kind == 1:
            x = x + rglru_mixer(rms_norm(x, rnn_norm[j]), rnn_w_in[j], rnn_conv_w[j], rnn_conv_b[j],
                                rnn_gate_a_w[j], rnn_gate_a_b[j], rnn_gate_x_w[j], rnn_gate_x_b[j],
                                rnn_lambda[j], rnn_w_out[j])
        else:
            x = x + pool_mixer(rms_norm(x, pool_norm[j]), pool_w[j], pool_b[j], pool_scale[j])
        x = x + channel_mlp(rms_norm(x, mlp_norm[i]), mlp_w_up[i], mlp_w_down[i])
    return x
```

```cpp
#include <hip/hip_runtime.h>
#include <cstdio>
#include <cstdint>

#ifndef REP_MASK
#define REP_MASK 0u
#endif
#ifndef MK_SPLIT
#define MK_SPLIT 0
#endif

namespace pg8 {
#define PG8_LAS __attribute__((address_space(3)))
typedef _Float16 bf16_t;
typedef _Float16 bf16x8 __attribute__((ext_vector_type(8)));
typedef float f32x4 __attribute__((ext_vector_type(4)));
typedef unsigned u32x4 __attribute__((ext_vector_type(4)));
typedef unsigned u32x2 __attribute__((ext_vector_type(2)));
typedef _Float16 h16x2 __attribute__((ext_vector_type(2)));
typedef _Float16 h16x4 __attribute__((ext_vector_type(4)));
constexpr int BM = 256, BK = 64, HALF = 128, HTB = HALF * BK * 2  , STAGE_BYTES = 8 * HTB, NXCD = 8, WGM = 8;

__host__ __device__ __forceinline__ int lds_byte(int r, int c) { const int st = (r >> 4) * 2 + (c >> 5), rr = r & 15, cc = c & 31, ob = rr * 64 + cc * 2; return st * 1024 + (ob ^ (((ob >> 9) & 1) << 5)); }
__host__ __device__ __forceinline__ void stage_rc(int b, int& R, int& C) { const int st = b / 1024, sb = b % 1024, swz = sb ^ (((sb >> 9) & 1) << 5); R = (st >> 1) * 16 + swz / 64; C = (st & 1) * 32 + (swz % 64) / 2; }
__host__ __device__ __forceinline__ int perm32(int rho) { const int n = rho >> 4, i = rho & 15; return 8 * (i >> 2) + 4 * n + (i & 3); }

struct Unit { int pm, pn; };
struct Gemm { const bf16_t* A; const bf16_t* Bt; int M, N, K, lda, npg, ldb; size_t kstepA, kstepB; };

struct StaticOrder {
    int nM, nN, nwg, G, c;
    __host__ __device__ void init(int M, int N, int G_, int c_) { nM = M / BM; nN = N / BM; nwg = nM * nN; G = G_; c = c_; }
    __host__ __device__ bool next(int i, Unit& u) const {
        const long L = (long)i * G + c; if (L >= nwg) return false;
        int wgid = (int)L; { const int q = nwg / NXCD, r = nwg % NXCD, xcd = wgid % NXCD, off = wgid / NXCD; wgid = (xcd < r ? xcd * (q + 1) : r * (q + 1) + (xcd - r) * q) + off; }
        const int nig = WGM * nN, gid = wgid / nig, fm = gid * WGM, gsz = (nM - fm) < WGM ? (nM - fm) : WGM;
        u.pm = fm + ((wgid % nig) % gsz); u.pn = (wgid % nig) / gsz; return true;
    }
    __device__ __forceinline__ void a_ready(const Unit&) const {}
    __device__ __forceinline__ void done(const Unit&) const {}
};

__device__ __forceinline__ unsigned pk_h2(float lo, float hi) { h16x2 v = {(_Float16)lo, (_Float16)hi}; return __builtin_bit_cast(unsigned, v); }

template <int ACT> struct EpiF16 {
    static constexpr bool PERM = true, AFTER_DRAIN = false;
    bf16_t* O; int ldc; const float* rowsq; int kblk_rows; int npart;
    __device__ __forceinline__ void operator()(const f32x4 (&acc)[2][2][4][2], const Unit& u, int wr, int wc, int fr, int fq) const {
        const int row0 = u.pm * BM + wr * 64 + fr, col0 = u.pn * BM + wc * 32 + 8 * fq;
#pragma unroll
        for (int ai = 0; ai < 2; ++ai)
#pragma unroll
            for (int m = 0; m < 4; ++m) { const int row = row0 + ai * HALF + m * 16;
                bf16_t* rowp = kblk_rows ? O + ((size_t)(col0 >> 6) * kblk_rows + row) * 64 + (col0 & 63) : O + (size_t)row * ldc + col0;
                const size_t bjstep = kblk_rows ? (size_t)2 * kblk_rows * 64 : (size_t)HALF;
                float rs = 1.0f; if (rowsq) { float ssq;
                    if (npart) { const f32x4* pp = (const f32x4*)(rowsq + (size_t)row * 32); f32x4 a4 = pp[0];
#pragma unroll
                        for (int q = 1; q < 8; ++q) a4 += pp[q];
                        ssq = (a4[0] + a4[1]) + (a4[2] + a4[3]); }
                    else ssq = rowsq[row];
                    rs = 1.0f / sqrtf(ssq * (1.0f / 2048.0f) + 1e-6f); if (ACT == 1) rs = rs * rs; }
#pragma unroll
                for (int bj = 0; bj < 2; ++bj) { f32x4 v0 = acc[ai][bj][m][0], v1 = acc[ai][bj][m][1];
                    if (ACT == 1) {
#pragma unroll
                        for (int j = 0; j < 4; ++j) { const float a = fmaxf(v0[j], 0.f), b = fmaxf(v1[j], 0.f); v0[j] = a * a; v1[j] = b * b; } }
                    v0 = v0 * rs; v1 = v1 * rs;
                    u32x4 w; w.x = pk_h2(v0[0], v0[1]); w.y = pk_h2(v0[2], v0[3]); w.z = pk_h2(v1[0], v1[1]); w.w = pk_h2(v1[2], v1[3]);
                    *(u32x4*)(rowp + bj * bjstep) = w; } }
    }
};
typedef int i32x4e __attribute__((ext_vector_type(4)));
template <class AccV> struct EpiQRelu2;
template <class AccV> struct EpiQRelu2 {
    static constexpr bool PERM = true, AFTER_DRAIN = false;
    bf16_t* O; const float* rs; const float* cs; int kblk_rows;
    __device__ __forceinline__ void operator()(const AccV (&acc)[2][2][4][2], const Unit& u, int wr, int wc, int fr, int fq) const {
        const int row0 = u.pm * BM + wr * 64 + fr, col0 = u.pn * BM + wc * 32 + 8 * fq;
        f32x4 cv[2][2];
#pragma unroll
        for (int bj = 0; bj < 2; ++bj)
#pragma unroll
            for (int n = 0; n < 2; ++n) cv[bj][n] = *(const f32x4*)(cs + col0 + bj * HALF + 4 * n);
#pragma unroll
        for (int ai = 0; ai < 2; ++ai)
#pragma unroll
            for (int m = 0; m < 4; ++m) { const int row = row0 + ai * HALF + m * 16; const float r = rs[row];
                bf16_t* rowp = O + ((size_t)(col0 >> 6) * kblk_rows + row) * 64 + (col0 & 63); const size_t bjstep = (size_t)2 * kblk_rows * 64;
#pragma unroll
                for (int bj = 0; bj < 2; ++bj) { f32x4 v0, v1;
#pragma unroll
                    for (int j = 0; j < 4; ++j) { const float a = fmaxf((float)acc[ai][bj][m][0][j] * (r * cv[bj][0][j]), 0.f), b = fmaxf((float)acc[ai][bj][m][1][j] * (r * cv[bj][1][j]), 0.f); v0[j] = a * a; v1[j] = b * b; }
                    u32x4 w; w.x = pk_h2(v0[0], v0[1]); w.y = pk_h2(v0[2], v0[3]); w.z = pk_h2(v1[0], v1[1]); w.w = pk_h2(v1[2], v1[3]);
                    *(u32x4*)(rowp + bj * bjstep) = w; } }
    }
};
struct EpiResid {
    static constexpr bool PERM = false, AFTER_DRAIN = false;
    const float* res; float* out; int ldc; const float* bias; const float* scale; bf16_t* xg; const float* gnext; float* rowsq;
    __device__ __forceinline__ void operator()(const f32x4 (&acc)[2][2][4][2], const Unit& u, int wr, int wc, int fr, int fq) const {
        const int row0 = u.pm * BM + wr * 64 + fr, col0 = u.pn * BM + wc * 32 + 4 * fq;
#pragma unroll
        for (int ai = 0; ai < 2; ++ai)
#pragma unroll
            for (int m = 0; m < 4; ++m) { const int row = row0 + ai * HALF + m * 16; const size_t off = (size_t)row * ldc + col0; float sq = 0.f;
#pragma unroll
                for (int bj = 0; bj < 2; ++bj)
#pragma unroll
                    for (int n = 0; n < 2; ++n) { const int cc = bj * HALF + n * 16; const f32x4 r = *(const f32x4*)(res + off + cc);
                        const f32x4 bv = bias ? *(const f32x4*)(bias + col0 + cc) : (f32x4){0.f, 0.f, 0.f, 0.f}, sv = scale ? *(const f32x4*)(scale + col0 + cc) : (f32x4){1.f, 1.f, 1.f, 1.f};
                        const f32x4 o = r + (acc[ai][bj][m][n] + bv) * sv;
                        *(f32x4*)(out + off + cc) = o;
                        if (xg) { const f32x4 gv = *(const f32x4*)(gnext + col0 + cc); u32x2 w; w.x = pk_h2(o[0] * gv[0], o[1] * gv[1]); w.y = pk_h2(o[2] * gv[2], o[3] * gv[3]); *(u32x2*)(xg + off + cc) = w;
                                  sq += (o[0] * o[0] + o[1] * o[1]) + (o[2] * o[2] + o[3] * o[3]); } }
                if (xg) { sq += __shfl_xor(sq, 16); sq += __shfl_xor(sq, 32); if (fq == 0) rowsq[(size_t)row * 32 + u.pn * 4 + wc] = sq; }
                asm volatile("" ::: "memory"); }
    }
};
struct EpiResidQ {
    static constexpr bool PERM = false, AFTER_DRAIN = false;
    const float* res; float* out; int ldc; const float* rs; const float* cs; const float* csum; bf16_t* xg; const float* gnext; float* rowsq;
    __device__ __forceinline__ void operator()(const i32x4e (&acc)[2][2][4][2], const Unit& u, int wr, int wc, int fr, int fq) const {
        const int row0 = u.pm * BM + wr * 64 + fr, col0 = u.pn * BM + wc * 32 + 4 * fq;
#pragma unroll
        for (int ai = 0; ai < 2; ++ai)
#pragma unroll
            for (int m = 0; m < 4; ++m) { const int row = row0 + ai * HALF + m * 16; const size_t off = (size_t)row * ldc + col0; float sq = 0.f; const float rsv = rs[row];
#pragma unroll
                for (int bj = 0; bj < 2; ++bj)
#pragma unroll
                    for (int n = 0; n < 2; ++n) { const int cc = bj * HALF + n * 16; const f32x4 r = *(const f32x4*)(res + off + cc);
                        const f32x4 cv = *(const f32x4*)(cs + col0 + cc), zv = *(const f32x4*)(csum + col0 + cc); f32x4 o;
#pragma unroll
                        for (int j = 0; j < 4; ++j) o[j] = r[j] + (rsv * cv[j]) * ((float)acc[ai][bj][m][n][j] + 128.0f * zv[j]);
                        *(f32x4*)(out + off + cc) = o;
                        if (xg) { const f32x4 gv = *(const f32x4*)(gnext + col0 + cc); u32x2 w; w.x = pk_h2(o[0] * gv[0], o[1] * gv[1]); w.y = pk_h2(o[2] * gv[2], o[3] * gv[3]); *(u32x2*)(xg + off + cc) = w;
                                  sq += (o[0] * o[0] + o[1] * o[1]) + (o[2] * o[2] + o[3] * o[3]); } }
                if (xg) { sq += __shfl_xor(sq, 16); sq += __shfl_xor(sq, 32); if (fq == 0) rowsq[(size_t)row * 32 + u.pn * 4 + wc] = sq; }
                asm volatile("" ::: "memory"); }
    }
};
struct EpiGates {
    static constexpr bool PERM = false, AFTER_DRAIN = false;
    const bf16_t* XC; const float* ba; const float* bx; const float* lam; bf16_t* AF; bf16_t* BF;
    __device__ __forceinline__ void operator()(const f32x4 (&acc)[2][2][4][2], const Unit& u, int wr, int wc, int fr, int fq) const {
        const int row0 = u.pm * BM + wr * 64 + fr, ch0 = (u.pn >> 1) * 256 + (u.pn & 1) * 128 + wc * 32 + 4 * fq;
#pragma unroll
        for (int n = 0; n < 2; ++n) {
            const f32x4 bav = *(const f32x4*)(ba + ch0 + n * 16), bxv = *(const f32x4*)(bx + ch0 + n * 16), l = *(const f32x4*)(lam + ch0 + n * 16); f32x4 spv;
#pragma unroll
            for (int j = 0; j < 4; ++j) spv[j] = -8.0f * log1pf(__expf(-l[j]));
#pragma unroll
            for (int ai = 0; ai < 2; ++ai)
#pragma unroll
                for (int m = 0; m < 4; ++m) { const size_t off = (size_t)(row0 + ai * HALF + m * 16) * 2048 + ch0 + n * 16;
                    const h16x4 xh = *(const h16x4*)(XC + off); f32x4 av, bv;
#pragma unroll
                    for (int j = 0; j < 4; ++j) { const float r = __builtin_amdgcn_rcpf(1.0f + __expf(-(acc[ai][0][m][n][j] + bav[j]))), ig = __builtin_amdgcn_rcpf(1.0f + __expf(-(acc[ai][1][m][n][j] + bxv[j])));
                        const float la = r * spv[j]; av[j] = la;
                        const float y = 2.0f * la;
                        const float em = y * (1.0f + y * 0.5f * (1.0f + y * (1.0f / 3.0f) * (1.0f + y * 0.25f * (1.0f + y * 0.2f * (1.0f + y * (1.0f / 6.0f) * (1.0f + y * (1.0f / 7.0f)))))));
                        const float om = (y > -0.5f) ? -em : 1.0f - __expf(y);
                        bv[j] = (float)xh[j] * ig * __builtin_amdgcn_sqrtf(fmaxf(om, 0.f)); }
                    { u32x2 w; w.x = pk_h2(av[0], av[1]); w.y = pk_h2(av[2], av[3]); *(u32x2*)(AF + off) = w; w.x = pk_h2(bv[0], bv[1]); w.y = pk_h2(bv[2], bv[3]); *(u32x2*)(BF + off) = w; }
                    asm volatile("" ::: "memory"); }
        }
    }
};

template <class Epi, class Sched, bool ALIGN_EPI = false, bool SP2 = false>
__device__ __forceinline__ void gemm_phase(PG8_LAS unsigned char* lds, const Gemm g, const Sched& S, const Epi& E, const int tid) {
    const int wid = __builtin_amdgcn_readfirstlane(tid >> 6), lane = tid & 63, wr = wid >> 2, wc = wid & 3, fr = lane & 15, fq = lane >> 4;
    const int K = g.K, nt = K / BK;
    unsigned voffA[2], voffB[2];
#pragma unroll
    for (int i = 0; i < 2; ++i) { int R, C; stage_rc(tid * 16 + i * 8192, R, C); const int Rb = Epi::PERM ? ((R & ~31) + perm32(R & 31)) : R;
        voffA[i] = (unsigned)(R * g.lda + C) * 2u; voffB[i] = (unsigned)(Rb * g.ldb + C) * 2u; }
    const size_t kstepA = g.kstepA, kstepB = g.kstepB;
    const size_t hstepA = (size_t)HALF * g.lda * 2, hstepB = (size_t)HALF * g.ldb * 2;
#define PG8_ABASE(u) ((const char*)g.A + ((size_t)(u).pm * BM * g.lda + (size_t)((u).pn / g.npg) * K) * 2)
#define PG8_BBASE(u) ((const char*)g.Bt + (size_t)(u).pn * BM * g.ldb * 2)
    const unsigned ldsw = (unsigned)wid * 1024u;
    const int aoff = lds_byte(wr * 64 + fr, fq * 8), boff = lds_byte(wc * 32 + fr, fq * 8);
#define PG8_SA(b, h) (((b) * 2 + (h)) * HTB)
#define PG8_SB(b, h) ((4 + (b) * 2 + (h)) * HTB)
#define PG8_STAGE(bufoff, gbase, voff) do { _Pragma("unroll") for (int _i = 0; _i < 2; ++_i) \
        __builtin_amdgcn_global_load_lds((const unsigned*)((const char*)(gbase) + (voff)[_i]), (PG8_LAS unsigned*)(lds + (bufoff) + ldsw + _i * 8192), 16, 0, 0); } while (0)
#define PG8_LDA(dst, b, h) do { _Pragma("unroll") for (int m = 0; m < 4; ++m) _Pragma("unroll") for (int k = 0; k < 2; ++k) dst[m][k] = *(const PG8_LAS bf16x8*)(lds + PG8_SA(b, h) + aoff + m * 2048 + k * 1024); } while (0)
#define PG8_LDB(dst, b, h) do { _Pragma("unroll") for (int n = 0; n < 2; ++n) _Pragma("unroll") for (int k = 0; k < 2; ++k) dst[n][k] = *(const PG8_LAS bf16x8*)(lds + PG8_SB(b, h) + boff + n * 2048 + k * 1024); } while (0)
#define PG8_MMA(ai, bj, At, Bt) do { __builtin_amdgcn_s_setprio(1); _Pragma("unroll") for (int m = 0; m < 4; ++m) _Pragma("unroll") for (int n = 0; n < 2; ++n) _Pragma("unroll") for (int k = 0; k < 2; ++k) \
        acc[ai][bj][m][n] = __builtin_amdgcn_mfma_f32_16x16x32_f16(Bt[n][k], At[m][k], acc[ai][bj][m][n], 0, 0, 0); __builtin_amdgcn_s_setprio(0); } while (0)
#define PG8_WAIT_V(n) asm volatile("s_waitcnt vmcnt(" #n ")" ::: "memory")
#define PG8_WAIT_L(n) asm volatile("s_waitcnt lgkmcnt(" #n ")" ::: "memory")
#define PG8_BAR __builtin_amdgcn_s_barrier()
#define PG8_SCHED __builtin_amdgcn_sched_barrier(0)
    Unit cur, nxt; int ui = 0;
    if (!S.next(0, cur)) return;
    f32x4 acc[2][2][4][2];
#pragma unroll
    for (int a = 0; a < 2; ++a)
#pragma unroll
        for (int b = 0; b < 2; ++b)
#pragma unroll
            for (int m = 0; m < 4; ++m)
#pragma unroll
                for (int n = 0; n < 2; ++n) acc[a][b][m][n] = (f32x4){0.f, 0.f, 0.f, 0.f};
    bf16x8 At[4][2], B0[2][2], B1[2][2];
    const char* cA = PG8_ABASE(cur); const char* cB = PG8_BBASE(cur);
    S.a_ready(cur);
    if constexpr (SP2) {
        PG8_STAGE(PG8_SB(0, 0), cB, voffB); PG8_STAGE(PG8_SB(0, 1), cB + hstepB, voffB); PG8_STAGE(PG8_SA(0, 0), cA, voffA); PG8_STAGE(PG8_SA(0, 1), cA + hstepA, voffA);
        if (wr == 1) PG8_BAR;
        PG8_WAIT_V(2); PG8_BAR;
        PG8_STAGE(PG8_SB(1, 0), cB + kstepB, voffB); PG8_STAGE(PG8_SA(1, 0), cA + kstepA, voffA); PG8_STAGE(PG8_SB(1, 1), cB + hstepB + kstepB, voffB);
        PG8_WAIT_V(6); PG8_BAR;
    } else {
        PG8_STAGE(PG8_SB(0, 0), cB, voffB); PG8_STAGE(PG8_SA(0, 0), cA, voffA); PG8_STAGE(PG8_SB(0, 1), cB + hstepB, voffB); PG8_STAGE(PG8_SA(0, 1), cA + hstepA, voffA);
        if (wr == 1) PG8_BAR;
        PG8_WAIT_V(4); PG8_BAR;
        PG8_STAGE(PG8_SB(1, 0), cB + kstepB, voffB); PG8_STAGE(PG8_SA(1, 0), cA + kstepA, voffA); PG8_STAGE(PG8_SB(1, 1), cB + hstepB + kstepB, voffB);
        PG8_WAIT_V(6); PG8_BAR;
    }
    for (;;) {
        const bool has_next = S.next(ui + 1, nxt);
        const char* nA = has_next ? PG8_ABASE(nxt) : cA; const char* nB = has_next ? PG8_BBASE(nxt) : cB;
        for (int t = 0; t < nt; t += 2) {
            const bool last = (t == nt - 2);
            const char* a1 = cA + (size_t)(t + 1) * kstepA;
            const char* a2 = last ? nA : cA + (size_t)(t + 2) * kstepA; const char* b2 = last ? nB : cB + (size_t)(t + 2) * kstepB;
            const char* a3 = a2 + kstepA; const char* b3 = b2 + kstepB;
            if (last && has_next) S.a_ready(nxt);
            if constexpr (SP2) {
            PG8_LDB(B0, 0, 0); PG8_LDB(B1, 0, 1); PG8_SCHED; PG8_LDA(At, 0, 0); PG8_STAGE(PG8_SA(1, 1), a1 + hstepA, voffA);
            PG8_WAIT_V(8); PG8_WAIT_L(0); PG8_BAR; PG8_MMA(0, 0, At, B0); PG8_MMA(0, 1, At, B1); PG8_BAR; PG8_SCHED;
            PG8_LDA(At, 0, 1); PG8_STAGE(PG8_SB(0, 0), b2, voffB); PG8_STAGE(PG8_SB(0, 1), b2 + hstepB, voffB); PG8_STAGE(PG8_SA(0, 0), a2, voffA);
            PG8_WAIT_V(8); PG8_WAIT_L(0); PG8_BAR; PG8_MMA(1, 0, At, B0); PG8_MMA(1, 1, At, B1); PG8_BAR; PG8_SCHED;
            PG8_LDB(B0, 1, 0); PG8_LDB(B1, 1, 1); PG8_SCHED; PG8_LDA(At, 1, 0); PG8_STAGE(PG8_SA(0, 1), a2 + hstepA, voffA);
            PG8_WAIT_V(8); PG8_WAIT_L(0); PG8_BAR; PG8_MMA(0, 0, At, B0); PG8_MMA(0, 1, At, B1); PG8_BAR; PG8_SCHED;
            PG8_LDA(At, 1, 1); PG8_STAGE(PG8_SB(1, 0), b3, voffB); PG8_STAGE(PG8_SB(1, 1), b3 + hstepB, voffB); PG8_STAGE(PG8_SA(1, 0), a3, voffA);
            PG8_WAIT_V(8); PG8_WAIT_L(0); PG8_BAR; PG8_MMA(1, 0, At, B0); PG8_MMA(1, 1, At, B1); PG8_BAR; PG8_SCHED;
            } else {
            PG8_LDB(B0, 0, 0); PG8_SCHED; PG8_LDA(At, 0, 0); PG8_STAGE(PG8_SA(1, 1), a1 + hstepA, voffA);
            PG8_WAIT_L(8); PG8_BAR; PG8_WAIT_L(0); PG8_MMA(0, 0, At, B0); PG8_BAR; PG8_SCHED;
            PG8_LDB(B1, 0, 1); PG8_STAGE(PG8_SB(0, 0), b2, voffB);
            PG8_BAR; PG8_WAIT_L(0); PG8_MMA(0, 1, At, B1); PG8_BAR;
            PG8_LDA(At, 0, 1); PG8_STAGE(PG8_SA(0, 0), a2, voffA);
            PG8_BAR; PG8_WAIT_L(0); PG8_MMA(1, 0, At, B0); PG8_BAR; PG8_SCHED;
            PG8_STAGE(PG8_SB(0, 1), b2 + hstepB, voffB);
            PG8_WAIT_V(6); PG8_BAR; PG8_MMA(1, 1, At, B1); PG8_BAR;
            PG8_LDB(B0, 1, 0); PG8_SCHED; PG8_LDA(At, 1, 0); PG8_STAGE(PG8_SA(0, 1), a2 + hstepA, voffA);
            PG8_WAIT_L(8); PG8_BAR; PG8_WAIT_L(0); PG8_MMA(0, 0, At, B0); PG8_BAR; PG8_SCHED;
            PG8_LDB(B1, 1, 1); PG8_STAGE(PG8_SB(1, 0), b3, voffB);
            PG8_BAR; PG8_WAIT_L(0); PG8_MMA(0, 1, At, B1); PG8_BAR;
            PG8_LDA(At, 1, 1); PG8_STAGE(PG8_SA(1, 0), a3, voffA);
            PG8_BAR; PG8_WAIT_L(0); PG8_MMA(1, 0, At, B0); PG8_BAR; PG8_SCHED;
            PG8_STAGE(PG8_SB(1, 1), b3 + hstepB, voffB);
            PG8_WAIT_V(6); PG8_BAR; PG8_MMA(1, 1, At, B1); PG8_BAR;
            }
        }
        if constexpr (ALIGN_EPI) { if (wr == 0) PG8_BAR; }
        if constexpr (!Epi::AFTER_DRAIN) { E(acc, cur, wr, wc, fr, fq); S.done(cur); }
        if (!has_next) break;
#pragma unroll
        for (int a = 0; a < 2; ++a)
#pragma unroll
            for (int b = 0; b < 2; ++b)
#pragma unroll
                for (int m = 0; m < 4; ++m)
#pragma unroll
                    for (int n = 0; n < 2; ++n) acc[a][b][m][n] = (f32x4){0.f, 0.f, 0.f, 0.f};
        cur = nxt; cA = nA; cB = nB; ++ui;
        if constexpr (ALIGN_EPI) { if (wr == 1) PG8_BAR; }
    }
    PG8_WAIT_V(0);
    if constexpr (!ALIGN_EPI) { if (wr == 0) PG8_BAR; }
    PG8_BAR;
    if constexpr (Epi::AFTER_DRAIN) { E.fused(acc, cur, wr, wc, fr, fq, lds, wid, lane); S.done(cur); }
#undef PG8_ABASE
#undef PG8_BBASE
#undef PG8_SA
#undef PG8_SB
#undef PG8_STAGE
#undef PG8_LDA
#undef PG8_LDB
#undef PG8_MMA
#undef PG8_WAIT_V
#undef PG8_WAIT_L
#undef PG8_BAR
#undef PG8_SCHED
}
typedef int i32x4 __attribute__((ext_vector_type(4)));
template <class Epi, class Sched, bool ALIGN_EPI = false, bool SP2 = false>
__device__ __forceinline__ void gemm_phase_i8(PG8_LAS unsigned char* lds, const Gemm g, const Sched& S, const Epi& E, const int tid) {
    const int wid = __builtin_amdgcn_readfirstlane(tid >> 6), lane = tid & 63, wr = wid >> 2, wc = wid & 3, fr = lane & 15, fq = lane >> 4;
    const int K = g.K, nt = K / BK;
    unsigned voffA[2], voffB[2];
#pragma unroll
    for (int i = 0; i < 2; ++i) { int R, C; stage_rc(tid * 16 + i * 8192, R, C); const int Rb = Epi::PERM ? ((R & ~31) + perm32(R & 31)) : R;
        voffA[i] = (unsigned)(R * g.lda + C) * 2u; voffB[i] = (unsigned)(Rb * g.ldb + C) * 2u; }
    const size_t kstepA = g.kstepA, kstepB = g.kstepB;
    const size_t hstepA = (size_t)HALF * g.lda * 2, hstepB = (size_t)HALF * g.ldb * 2;
#define PG8_ABASE(u) ((const char*)g.A + ((size_t)(u).pm * BM * g.lda + (size_t)((u).pn / g.npg) * K) * 2)
#define PG8_BBASE(u) ((const char*)g.Bt + (size_t)(u).pn * BM * g.ldb * 2)
    const unsigned ldsw = (unsigned)wid * 1024u;
    const int aoff = lds_byte(wr * 64 + fr, fq * 8), boff = lds_byte(wc * 32 + fr, fq * 8);
#define PG8_SA(b, h) (((b) * 2 + (h)) * HTB)
#define PG8_SB(b, h) ((4 + (b) * 2 + (h)) * HTB)
#define PG8_STAGE(bufoff, gbase, voff) do { _Pragma("unroll") for (int _i = 0; _i < 2; ++_i) \
        __builtin_amdgcn_global_load_lds((const unsigned*)((const char*)(gbase) + (voff)[_i]), (PG8_LAS unsigned*)(lds + (bufoff) + ldsw + _i * 8192), 16, 0, 0); } while (0)
#define PG8_LDA(dst, b, h) do { _Pragma("unroll") for (int m = 0; m < 4; ++m) _Pragma("unroll") for (int k = 0; k < 2; ++k) dst[m][k] = *(const PG8_LAS bf16x8*)(lds + PG8_SA(b, h) + aoff + m * 2048 + k * 1024); } while (0)
#define PG8_LDB(dst, b, h) do { _Pragma("unroll") for (int n = 0; n < 2; ++n) _Pragma("unroll") for (int k = 0; k < 2; ++k) dst[n][k] = *(const PG8_LAS bf16x8*)(lds + PG8_SB(b, h) + boff + n * 2048 + k * 1024); } while (0)
#define PG8_MMA(ai, bj, At, Bt) do { __builtin_amdgcn_s_setprio(1); _Pragma("unroll") for (int m = 0; m < 4; ++m) _Pragma("unroll") for (int n = 0; n < 2; ++n) _Pragma("unroll") for (int k = 0; k < 2; ++k) \
        acc[ai][bj][m][n] = __builtin_amdgcn_mfma_i32_16x16x64_i8(__builtin_bit_cast(i32x4, Bt[n][k]), __builtin_bit_cast(i32x4, At[m][k]), acc[ai][bj][m][n], 0, 0, 0); __builtin_amdgcn_s_setprio(0); } while (0)
#define PG8_WAIT_V(n) asm volatile("s_waitcnt vmcnt(" #n ")" ::: "memory")
#define PG8_WAIT_L(n) asm volatile("s_waitcnt lgkmcnt(" #n ")" ::: "memory")
#define PG8_BAR __builtin_amdgcn_s_barrier()
#define PG8_SCHED __builtin_amdgcn_sched_barrier(0)
    Unit cur, nxt; int ui = 0;
    if (!S.next(0, cur)) return;
    i32x4 acc[2][2][4][2];
#pragma unroll
    for (int a = 0; a < 2; ++a)
#pragma unroll
        for (int b = 0; b < 2; ++b)
#pragma unroll
            for (int m = 0; m < 4; ++m)
#pragma unroll
                for (int n = 0; n < 2; ++n) acc[a][b][m][n] = (i32x4){0, 0, 0, 0};
    bf16x8 At[4][2], B0[2][2], B1[2][2];
    const char* cA = PG8_ABASE(cur); const char* cB = PG8_BBASE(cur);
    S.a_ready(cur);
    if constexpr (SP2) {
        PG8_STAGE(PG8_SB(0, 0), cB, voffB); PG8_STAGE(PG8_SB(0, 1), cB + hstepB, voffB); PG8_STAGE(PG8_SA(0, 0), cA, voffA); PG8_STAGE(PG8_SA(0, 1), cA + hstepA, voffA);
        if (wr == 1) PG8_BAR;
        PG8_WAIT_V(2); PG8_BAR;
        PG8_STAGE(PG8_SB(1, 0), cB + kstepB, voffB); PG8_STAGE(PG8_SA(1, 0), cA + kstepA, voffA); PG8_STAGE(PG8_SB(1, 1), cB + hstepB + kstepB, voffB);
        PG8_WAIT_V(6); PG8_BAR;
    } else {
        PG8_STAGE(PG8_SB(0, 0), cB, voffB); PG8_STAGE(PG8_SA(0, 0), cA, voffA); PG8_STAGE(PG8_SB(0, 1), cB + hstepB, voffB); PG8_STAGE(PG8_SA(0, 1), cA + hstepA, voffA);
        if (wr == 1) PG8_BAR;
        PG8_WAIT_V(4); PG8_BAR;
        PG8_STAGE(PG8_SB(1, 0), cB + kstepB, voffB); PG8_STAGE(PG8_SA(1, 0), cA + kstepA, voffA); PG8_STAGE(PG8_SB(1, 1), cB + hstepB + kstepB, voffB);
        PG8_WAIT_V(6); PG8_BAR;
    }
    for (;;) {
        const bool has_next = S.next(ui + 1, nxt);
        const char* nA = has_next ? PG8_ABASE(nxt) : cA; const char* nB = has_next ? PG8_BBASE(nxt) : cB;
        for (int t = 0; t < nt; t += 2) {
            const bool last = (t == nt - 2);
            const char* a1 = cA + (size_t)(t + 1) * kstepA;
            const char* a2 = last ? nA : cA + (size_t)(t + 2) * kstepA; const char* b2 = last ? nB : cB + (size_t)(t + 2) * kstepB;
            const char* a3 = a2 + kstepA; const char* b3 = b2 + kstepB;
            if (last && has_next) S.a_ready(nxt);
            if constexpr (SP2) {
            PG8_LDB(B0, 0, 0); PG8_LDB(B1, 0, 1); PG8_SCHED; PG8_LDA(At, 0, 0); PG8_STAGE(PG8_SA(1, 1), a1 + hstepA, voffA);
            PG8_WAIT_V(8); PG8_WAIT_L(0); PG8_BAR; PG8_MMA(0, 0, At, B0); PG8_MMA(0, 1, At, B1); PG8_BAR; PG8_SCHED;
            PG8_LDA(At, 0, 1); PG8_STAGE(PG8_SB(0, 0), b2, voffB); PG8_STAGE(PG8_SB(0, 1), b2 + hstepB, voffB); PG8_STAGE(PG8_SA(0, 0), a2, voffA);
            PG8_WAIT_V(8); PG8_WAIT_L(0); PG8_BAR; PG8_MMA(1, 0, At, B0); PG8_MMA(1, 1, At, B1); PG8_BAR; PG8_SCHED;
            PG8_LDB(B0, 1, 0); PG8_LDB(B1, 1, 1); PG8_SCHED; PG8_LDA(At, 1, 0); PG8_STAGE(PG8_SA(0, 1), a2 + hstepA, voffA);
            PG8_WAIT_V(8); PG8_WAIT_L(0); PG8_BAR; PG8_MMA(0, 0, At, B0); PG8_MMA(0, 1, At, B1); PG8_BAR; PG8_SCHED;
            PG8_LDA(At, 1, 1); PG8_STAGE(PG8_SB(1, 0), b3, voffB); PG8_STAGE(PG8_SB(1, 1), b3 + hstepB, voffB); PG8_STAGE(PG8_SA(1, 0), a3, voffA);
            PG8_WAIT_V(8); PG8_WAIT_L(0); PG8_BAR; PG8_MMA(1, 0, At, B0); PG8_MMA(1, 1, At, B1); PG8_BAR; PG8_SCHED;
            } else {
            PG8_LDB(B0, 0, 0); PG8_SCHED; PG8_LDA(At, 0, 0); PG8_STAGE(PG8_SA(1, 1), a1 + hstepA, voffA);
            PG8_WAIT_L(8); PG8_BAR; PG8_WAIT_L(0); PG8_MMA(0, 0, At, B0); PG8_BAR; PG8_SCHED;
            PG8_LDB(B1, 0, 1); PG8_STAGE(PG8_SB(0, 0), b2, voffB);
            PG8_BAR; PG8_WAIT_L(0); PG8_MMA(0, 1, At, B1); PG8_BAR;
            PG8_LDA(At, 0, 1); PG8_STAGE(PG8_SA(0, 0), a2, voffA);
            PG8_BAR; PG8_WAIT_L(0); PG8_MMA(1, 0, At, B0); PG8_BAR; PG8_SCHED;
            PG8_STAGE(PG8_SB(0, 1), b2 + hstepB, voffB);
            PG8_WAIT_V(6); PG8_BAR; PG8_MMA(1, 1, At, B1); PG8_BAR;
            PG8_LDB(B0, 1, 0); PG8_SCHED; PG8_LDA(At, 1, 0); PG8_STAGE(PG8_SA(0, 1), a2 + hstepA, voffA);
            PG8_WAIT_L(8); PG8_BAR; PG8_WAIT_L(0); PG8_MMA(0, 0, At, B0); PG8_BAR; PG8_SCHED;
            PG8_LDB(B1, 1, 1); PG8_STAGE(PG8_SB(1, 0), b3, voffB);
            PG8_BAR; PG8_WAIT_L(0); PG8_MMA(0, 1, At, B1); PG8_BAR;
            PG8_LDA(At, 1, 1); PG8_STAGE(PG8_SA(1, 0), a3, voffA);
            PG8_BAR; PG8_WAIT_L(0); PG8_MMA(1, 0, At, B0); PG8_BAR; PG8_SCHED;
            PG8_STAGE(PG8_SB(1, 1), b3 + hstepB, voffB);
            PG8_WAIT_V(6); PG8_BAR; PG8_MMA(1, 1, At, B1); PG8_BAR;
            }
        }
        if constexpr (ALIGN_EPI) { if (wr == 0) PG8_BAR; }
        if constexpr (!Epi::AFTER_DRAIN) { E(acc, cur, wr, wc, fr, fq); S.done(cur); }
        if (!has_next) break;
#pragma unroll
        for (int a = 0; a < 2; ++a)
#pragma unroll
            for (int b = 0; b < 2; ++b)
#pragma unroll
                for (int m = 0; m < 4; ++m)
#pragma unroll
                    for (int n = 0; n < 2; ++n) acc[a][b][m][n] = (i32x4){0, 0, 0, 0};
        cur = nxt; cA = nA; cB = nB; ++ui;
        if constexpr (ALIGN_EPI) { if (wr == 1) PG8_BAR; }
    }
    PG8_WAIT_V(0);
    if constexpr (!ALIGN_EPI) { if (wr == 0) PG8_BAR; }
    PG8_BAR;
    if constexpr (Epi::AFTER_DRAIN) { E.fused(acc, cur, wr, wc, fr, fq, lds, wid, lane); S.done(cur); }
#undef PG8_ABASE
#undef PG8_BBASE
#undef PG8_SA
#undef PG8_SB
#undef PG8_STAGE
#undef PG8_LDA
#undef PG8_LDB
#undef PG8_MMA
#undef PG8_WAIT_V
#undef PG8_WAIT_L
#undef PG8_BAR
#undef PG8_SCHED
}
}

constexpr int T = 8192, D = 2048, FF = 8192, DEPTH = 4;
constexpr int NH = 16, HD = 128, NKV = 4, TOPK = 256;
constexpr int A_IN = 5264, A_INP = 5376;
constexpr int C_Q = 0, C_K = 2048, C_V = 2560, C_IQ = 3072, C_IK = 5120, C_IW = 5248;
constexpr float EPS = 1e-6f;
constexpr int NWAVES = 8, NTHR = NWAVES * 64;

constexpr size_t MiB = 1u << 20;
constexpr size_t WS_CTL = 0, CTL_ZERO_BYTES = 1 * MiB;
constexpr size_t WS_COS128 = 1 * MiB, WS_SIN128 = 3 * MiB, WS_COS64 = 5 * MiB, WS_SIN64 = 6 * MiB;
constexpr size_t WS_IW = 7 * MiB;
constexpr size_t WS_AGGA = 8 * MiB, WS_AGGB = 9 * MiB;
constexpr size_t WS_WINA = 10 * MiB;
constexpr size_t WS_WOUTA = 52 * MiB;
constexpr size_t WS_WINR = 68 * MiB;
constexpr size_t WS_WGR = 84 * MiB;
constexpr size_t WS_WOUTR = 86 * MiB;
constexpr size_t WS_WPOOL = 94 * MiB;
constexpr size_t WS_WUP = 96 * MiB;
constexpr size_t WS_WDOWN = 224 * MiB;
constexpr size_t WS_BA = 352 * MiB;
constexpr size_t BA_SC = 0;
constexpr int SC_LD = T + 64;
constexpr size_t BA_O16 = 0;
constexpr size_t BA_U = 0;
constexpr size_t BA_AF = 0, BA_BF = 64 * MiB;
constexpr size_t BA_H16 = 128 * MiB;
constexpr size_t BA_PROJ = 160 * MiB;
constexpr size_t BA_XC = 224 * MiB;
constexpr size_t WS_QH = 616 * MiB, WS_IQ = 648 * MiB, WS_KH = 680 * MiB, WS_VH = 688 * MiB, WS_IK = 696 * MiB, WS_SEL = 698 * MiB, WS_PARTA = 710 * MiB, WS_PARTB = 711 * MiB, WS_BLKMAXD = 712 * MiB, WS_END = 716 * MiB;
constexpr int CW_BAR = 4096;
constexpr size_t WS_BLKMAX = 706 * MiB;
constexpr size_t WS_RS = 7 * MiB + 512 * 1024, WS_CS = WS_RS + 64 * 1024;
constexpr size_t WS_RS2 = WS_RS + 128 * 1024, WS_CS2 = WS_RS + 192 * 1024, WS_CSUM = WS_RS + 208 * 1024;
constexpr size_t BA_U8 = 192 * MiB, BA_W8D = 176 * MiB;
constexpr size_t BA_A8 = 160 * MiB, BA_W8 = 176 * MiB;
constexpr size_t WS_ROWSQ = 256 * 1024;

constexpr int RING_BYTES = 131072;
constexpr int LDSCTL_OFF = RING_BYTES, MISC_OFF = LDSCTL_OFF + 320;
constexpr int LDS_BYTES = 155648;

#define GAS __attribute__((address_space(1)))
#define LAS __attribute__((address_space(3)))
typedef _Float16 h16;
typedef _Float16 h16x2 __attribute__((ext_vector_type(2)));
typedef _Float16 h16x4 __attribute__((ext_vector_type(4)));
typedef _Float16 h16x8 __attribute__((ext_vector_type(8)));
typedef unsigned v4u __attribute__((ext_vector_type(4)));
typedef unsigned v2u __attribute__((ext_vector_type(2)));
typedef float f32x4 __attribute__((ext_vector_type(4)));
#define LDS_WAIT() asm volatile("s_waitcnt lgkmcnt(0)" ::: "memory")
#define VM_WAIT() asm volatile("s_waitcnt vmcnt(0)" ::: "memory")
__device__ __forceinline__ unsigned pkh(float lo, float hi) { h16x2 v = {(h16)lo, (h16)hi}; return __builtin_bit_cast(unsigned, v); }
__device__ __forceinline__ float wave_sum(float v) {
#pragma unroll
    for (int o = 1; o < 64; o <<= 1) v += __shfl_xor(v, o);
    return v;
}
__device__ __forceinline__ float wave_max(float v) {
#pragma unroll
    for (int o = 1; o < 64; o <<= 1) v = fmaxf(v, __shfl_xor(v, o));
    return v;
}

#define XB_TMO      128
#define XB_XCNT(j)  (256  + 64 * (j))
#define XB_XSUB(j)  (1280 + 64 * (j))
#define XB_XGEN(j)  (2304 + 64 * (j))
#define XB_TOP      3328
#define XB_TOPGEN   3392
#define XCD_BAR_WORDS 3456
#define XB_SPIN_CAP (1u << 18)

__device__ __forceinline__ unsigned xb_ld(unsigned* p)              { return __hip_atomic_load(p, __ATOMIC_RELAXED, __HIP_MEMORY_SCOPE_AGENT); }
__device__ __forceinline__ unsigned xb_add(unsigned* p, unsigned v) { return __hip_atomic_fetch_add(p, v, __ATOMIC_RELAXED, __HIP_MEMORY_SCOPE_AGENT); }
__device__ __forceinline__ unsigned xb_xcc_id() { return (unsigned)__builtin_amdgcn_s_getreg((3 << 11) | 20) & 0xFu; }
#define XB_SPIN(cond, bar) do { unsigned _sp = 0; while (cond) { __builtin_amdgcn_s_sleep(1); \
    if ((++_sp & 255u) == 0u) { if (xb_ld(&(bar)[XB_TMO])) break; if (_sp > XB_SPIN_CAP) { atomicAdd(&(bar)[XB_TMO], 1u); break; } } } } while (0)

struct XcdBarrier { unsigned* bar; unsigned x; volatile LAS unsigned* st; };

__device__ __forceinline__ XcdBarrier xcd_barrier_post(unsigned* bar, volatile LAS unsigned* st) {
    XcdBarrier b; b.bar = bar; b.x = xb_xcc_id(); b.st = st;
    if (threadIdx.x == 0) (void)xb_add(&bar[XB_XCNT(b.x)], 1u);
    return b;
}
__device__ __forceinline__ void xcd_barrier_complete(unsigned* bar, unsigned x, unsigned& nloc, unsigned& nx) {
    const unsigned G = gridDim.x * gridDim.y * gridDim.z;
    unsigned sum, cnt, mine, sp = 0u;
    for (;;) {
        sum = 0u; cnt = 0u; mine = 0u;
#pragma unroll
        for (unsigned j = 0; j < 16; ++j) { const unsigned c = xb_ld(&bar[XB_XCNT(j)]); sum += c; cnt += (c > 0u) ? 1u : 0u; mine = (j == x) ? c : mine; }
        if (sum == G) break;
        __builtin_amdgcn_s_sleep(1);
        if ((++sp & 255u) == 0u) { if (xb_ld(&bar[XB_TMO])) break; if (sp > XB_SPIN_CAP) { atomicAdd(&bar[XB_TMO], 1u); break; } }
    }
    nloc = mine > 0u ? mine : 1u; nx = cnt > 0u ? cnt : 1u;
}
__device__ __forceinline__ void xcd_barrier(const XcdBarrier& b) {
    asm volatile("s_waitcnt vmcnt(0)" ::: "memory");
    __syncthreads();
    if (threadIdx.x == 0) {
        unsigned* bar = b.bar;
        __builtin_amdgcn_s_waitcnt(0);
        unsigned nloc = b.st[0], nx = b.st[1];
        if (nloc == 0u) { xcd_barrier_complete(bar, b.x, nloc, nx); b.st[0] = nloc; b.st[1] = nx; }
        const unsigned old = xb_add(&bar[XB_XSUB(b.x)], 1u);
        const unsigned gen = old / nloc;
        if (old + 1u == (gen + 1u) * nloc) {
            __builtin_amdgcn_fence(__ATOMIC_RELEASE, "agent");
            asm volatile("s_waitcnt vmcnt(0)" ::: "memory");
            const unsigned og = xb_add(&bar[XB_TOP], 1u);
            const unsigned tg = og / nx;
            if (og + 1u == (tg + 1u) * nx) xb_add(&bar[XB_TOPGEN], 1u);
            else XB_SPIN(xb_ld(&bar[XB_TOPGEN]) == tg, bar);
            __builtin_amdgcn_fence(__ATOMIC_ACQUIRE, "agent");
            xb_add(&bar[XB_XGEN(b.x)], 1u);
            asm volatile("s_waitcnt vmcnt(0)" ::: "memory");
        } else {
            XB_SPIN(xb_ld(&bar[XB_XGEN(b.x)]) == gen, bar);
            __builtin_amdgcn_fence(__ATOMIC_ACQUIRE, "agent");
            asm volatile("s_waitcnt vmcnt(0)" ::: "memory");
        }
    }
    __syncthreads();
}

__device__ __forceinline__ void tr_item(const float* src, int ldw, int nvalid, h16* dst, int ldd, LAS float* scr, int lane, unsigned* colmax = nullptr) {
    const int nn = lane & 31; float v[32];
#pragma unroll
    for (int i = 0; i < 32; ++i) { const int kk = 2 * i + (lane >> 5); v[i] = (nn < nvalid) ? src[(size_t)kk * ldw + nn] : 0.f; }
    __builtin_amdgcn_sched_barrier(0);
#pragma unroll
    for (int i = 0; i < 32; ++i) { const int kk = 2 * i + (lane >> 5); scr[kk * 33 + nn] = v[i]; }
    LDS_WAIT();
    const int c = lane & 7;
#pragma unroll
    for (int j = 0; j < 4; ++j) { const int n = (lane >> 3) + 8 * j; const LAS float* s = scr + (8 * c) * 33 + n;
        v4u o; o.x = pkh(s[0 * 33], s[1 * 33]); o.y = pkh(s[2 * 33], s[3 * 33]); o.z = pkh(s[4 * 33], s[5 * 33]); o.w = pkh(s[6 * 33], s[7 * 33]);
        *(v4u*)(dst + (size_t)n * ldd + 8 * c) = o;
        if (colmax) {
            float mx = fmaxf(fmaxf(fmaxf(fabsf(s[0 * 33]), fabsf(s[1 * 33])), fmaxf(fabsf(s[2 * 33]), fabsf(s[3 * 33]))), fmaxf(fmaxf(fabsf(s[4 * 33]), fabsf(s[5 * 33])), fmaxf(fabsf(s[6 * 33]), fabsf(s[7 * 33]))));
            mx = fmaxf(mx, __shfl_xor(mx, 1)); mx = fmaxf(mx, __shfl_xor(mx, 2)); mx = fmaxf(mx, __shfl_xor(mx, 4));
            if (c == 0) colmax[n] = __float_as_uint(mx); } }
    LDS_WAIT();
}

struct Ptrs {
    const float* x; const int* pos;
    const float *attn_norm, *attn_w_in, *attn_qn, *attn_kn, *attn_w_out;
    const float *rnn_norm, *rnn_w_in, *conv_w, *conv_b, *ga_w, *ga_b, *gx_w, *gx_b, *lam, *rnn_w_out;
    const float *pool_norm, *pool_w, *pool_b, *pool_scale;
    const float *mlp_norm, *mlp_w_up, *mlp_w_down;
    float* out; unsigned char* ws;
    int ph_lo, ph_hi;
};

#define CAS __attribute__((address_space(4)))
__device__ __forceinline__ const CAS Ptrs* kargs() { const CAS Ptrs* p = (const CAS Ptrs*)__builtin_amdgcn_kernarg_segment_ptr(); asm volatile("" : "+s"(p)); return p; }
__device__ __forceinline__ void p0_prologue(const CAS Ptrs* PP, LAS unsigned char* lds, int gw, int NGW, int wave, int lane, int gtid, int NGT) {
    LAS float* scr = (LAS float*)(lds + wave * 16384);
    unsigned char* ws = PP->ws;
    constexpr int I_WINA = 32 * 165, I_WOUTA = 32 * 64, I_WINR = 32 * 128, I_G = 4 * 8, I_WOUTR = 32 * 64, I_POOL = 8 * 16, I_UP = 32 * 256, I_DN = 128 * 64, I_Z = 384;
    constexpr int NITEMS = 2 * I_WINA + 2 * I_WOUTA + I_WINR + 16 * I_G + I_WOUTR + 4 * I_POOL + 4 * I_UP + 4 * I_DN + 2 * I_Z;
    for (int it = gw; it < NITEMS; it += NGW) {
        int r = it;
        if (r < 2 * I_WINA) { const int j = r / I_WINA; r -= j * I_WINA; const int kb = r / 165, nb = r % 165, n0 = 32 * nb; const int nv = (A_IN - n0) < 32 ? (A_IN - n0) : 32;
            tr_item(PP->attn_w_in + (size_t)j * D * A_IN + (size_t)(64 * kb) * A_IN + n0, A_IN, nv, (h16*)(ws + WS_WINA) + (size_t)j * A_INP * D + (size_t)n0 * D + 64 * kb, D, scr, lane); continue; }
        r -= 2 * I_WINA;
        if (r < 2 * I_WOUTA) { const int j = r / I_WOUTA; r -= j * I_WOUTA; const int kb = r / 64, nb = r % 64;
            tr_item(PP->attn_w_out + (size_t)j * D * D + (size_t)(64 * kb) * D + 32 * nb, D, 32, (h16*)(ws + WS_WOUTA) + (size_t)j * D * D + (size_t)(32 * nb) * D + 64 * kb, D, scr, lane); continue; }
        r -= 2 * I_WOUTA;
        if (r < I_WINR) { const int kb = r / 128, nb = r % 128;
            tr_item(PP->rnn_w_in + (size_t)(64 * kb) * 4096 + 32 * nb, 4096, 32, (h16*)(ws + WS_WINR) + (size_t)(32 * nb) * D + 64 * kb, D, scr, lane); continue; }
        r -= I_WINR;
        if (r < 16 * I_G) { const int mi = r / I_G; r -= mi * I_G; const int which = mi >> 3, blk = mi & 7, kb = r / 8, nb = r % 8, d0 = 32 * nb;
            const float* src = (which ? PP->gx_w : PP->ga_w) + (size_t)blk * 65536 + (size_t)(64 * kb) * 256 + d0;
            const int drow = 256 * (2 * blk + (d0 >> 7)) + 128 * which + (d0 & 127);
            tr_item(src, 256, 32, (h16*)(ws + WS_WGR) + (size_t)drow * 256 + 64 * kb, 256, scr, lane); continue; }
        r -= 16 * I_G;
        if (r < I_WOUTR) { const int kb = r / 64, nb = r % 64;
            tr_item(PP->rnn_w_out + (size_t)(64 * kb) * D + 32 * nb, D, 32, (h16*)(ws + WS_WOUTR) + (size_t)(32 * nb) * D + 64 * kb, D, scr, lane); continue; }
        r -= I_WOUTR;
        if (r < 4 * I_POOL) { const int g = r / I_POOL; r -= g * I_POOL; const int kb = r / 16, nb = r % 16;
            tr_item(PP->pool_w + (size_t)g * 262144 + (size_t)(64 * kb) * 512 + 32 * nb, 512, 32, (h16*)(ws + WS_WPOOL) + (size_t)(512 * g + 32 * nb) * 512 + 64 * kb, 512, scr, lane); continue; }
        r -= 4 * I_POOL;
        if (r < 4 * I_UP) { const int i = r / I_UP; r -= i * I_UP; const int kb = r / 256, nb = r % 256;
            tr_item(PP->mlp_w_up + (size_t)i * D * FF + (size_t)(64 * kb) * FF + 32 * nb, FF, 32, (h16*)(ws + WS_WUP) + (size_t)i * D * FF + (size_t)(32 * nb) * D + 64 * kb, D, scr, lane, (unsigned*)(ws + WS_BLKMAX) + ((size_t)i * 32 + kb) * FF + 32 * nb); continue; }
        r -= 4 * I_UP;
        if (r < 4 * I_DN) { const int i = r / I_DN; r -= i * I_DN; const int kb = r / 64, nb = r % 64;
            tr_item(PP->mlp_w_down + (size_t)i * D * FF + (size_t)(64 * kb) * D + 32 * nb, D, 32, (h16*)(ws + WS_WDOWN) + (size_t)i * D * FF + ((size_t)kb * D + 32 * nb) * 64, 64, scr, lane, (unsigned*)(ws + WS_BLKMAXD) + ((size_t)i * 128 + kb) * D + 32 * nb); continue; }
        r -= 4 * I_DN;
        { const int j = r / I_Z; r -= j * I_Z;
            v4u* z = (v4u*)((h16*)(ws + WS_WINA) + (size_t)j * A_INP * D + (size_t)5280 * D); z[(size_t)r * 64 + lane] = (v4u){0u, 0u, 0u, 0u}; }
    }
    for (int e = gtid; e < T * 96; e += NGT) {
        const int t = e / 96, i = e % 96; const bool big = i < 64; const int fi = big ? i : i - 64;
        const double base = big ? 0.8659643233600653 : 0.7498942093324559;
        double inv = 1.0; for (int k = 0; k < fi; ++k) inv *= base;
        const double ang = (double)PP->pos[t] * inv;
        const double n = __builtin_rint(ang * 0.15915494309189535); const double rr = ang - n * 6.283185307179586 - n * 2.4492935982947064e-16;
        const double r2 = rr * rr; double sn = 1.0, cs = 1.0;
#pragma unroll
        for (int k = 14; k >= 1; --k) { sn = 1.0 - sn * r2 * (1.0 / (double)((2 * k) * (2 * k + 1))); cs = 1.0 - cs * r2 * (1.0 / (double)((2 * k - 1) * (2 * k))); }
        sn *= rr;
        if (big) { ((float*)(ws + WS_COS128))[t * 64 + fi] = (float)cs; ((float*)(ws + WS_SIN128))[t * 64 + fi] = (float)sn; }
        else { ((float*)(ws + WS_COS64))[t * 32 + fi] = (float)cs; ((float*)(ws + WS_SIN64))[t * 32 + fi] = (float)sn; }
    }
}

__device__ __forceinline__ void quant_rows(const h16* src, int nrows, signed char* dst, float* scale_out, const float* rowsq, const unsigned* colmax, int gw, int NGW, int lane) {
    h16x8 vn[4]; float cmn = 0.f;
    if (gw < nrows) {
#pragma unroll
        for (int j = 0; j < 4; ++j) vn[j] = *(const h16x8*)(src + (size_t)gw * D + 512 * j + 8 * lane);
        if (colmax) cmn = lane < 32 ? __uint_as_float(colmax[(size_t)lane * FF + gw]) : 0.f; }
    for (int r = gw; r < nrows; r += NGW) {
        h16x8 v[4]; const float cm = cmn;
#pragma unroll
        for (int j = 0; j < 4; ++j) v[j] = vn[j];
        const int rn = r + NGW;
        if (rn < nrows) {
#pragma unroll
            for (int j = 0; j < 4; ++j) vn[j] = *(const h16x8*)(src + (size_t)rn * D + 512 * j + 8 * lane);
            if (colmax) cmn = lane < 32 ? __uint_as_float(colmax[(size_t)lane * FF + rn]) : 0.f; }
        float mx;
        if (colmax) mx = wave_max(cm);
        else { mx = 0.f;
#pragma unroll
            for (int j = 0; j < 4; ++j)
#pragma unroll
                for (int e = 0; e < 8; ++e) mx = fmaxf(mx, fabsf((float)v[j][e]));
            mx = wave_max(mx); }
        const float step = mx > 0.f ? mx * (1.0f / 127.0f) : 1.0f, inv = 1.0f / step;
        if (lane == 0) { float sc = step;
            if (rowsq) { const f32x4* pp = (const f32x4*)(rowsq + (size_t)r * 32); f32x4 a4 = pp[0];
#pragma unroll
                for (int q = 1; q < 8; ++q) a4 += pp[q];
                sc = step / sqrtf(((a4[0] + a4[1]) + (a4[2] + a4[3])) * (1.0f / D) + EPS); }
            scale_out[r] = sc; }
#pragma unroll
        for (int j = 0; j < 4; ++j) { unsigned w[2];
#pragma unroll
            for (int hh = 0; hh < 2; ++hh) { unsigned p = 0u;
#pragma unroll
                for (int e = 0; e < 4; ++e) { int qv = (int)rintf((float)v[j][4 * hh + e] * inv); qv = qv > 127 ? 127 : (qv < -127 ? -127 : qv); p |= ((unsigned)qv & 255u) << (8 * e); }
                w[hh] = p; }
            *(v2u*)(dst + (size_t)r * D + 512 * j + 8 * lane) = (v2u){w[0], w[1]}; }
    }
}
template <bool UNSIGNED>
__device__ __forceinline__ void quant_kblk(const h16* src, int R, signed char* dst, float* scale_out, float* csum, const unsigned* blkmax, int gw, int NGW, int lane) {
    const int bsub = lane >> 3, c8 = (lane & 7) * 8;
    h16x8 vn[16]; float cmn = 0.f;
#define QK_LOAD(r_) do { _Pragma("unroll") for (int i = 0; i < 16; ++i) vn[i] = *(const h16x8*)(src + ((size_t)(8 * i + bsub) * R + (r_)) * 64 + c8); \
        if (!UNSIGNED) cmn = fmaxf(__uint_as_float(blkmax[(size_t)lane * R + (r_)]), __uint_as_float(blkmax[(size_t)(64 + lane) * R + (r_)])); } while (0)
    if (gw < R) QK_LOAD(gw);
    for (int r = gw; r < R; r += NGW) {
        h16x8 v[16]; const float cm = cmn;
#pragma unroll
        for (int i = 0; i < 16; ++i) v[i] = vn[i];
        if (r + NGW < R) QK_LOAD(r + NGW);
        float mx;
        if (UNSIGNED) { mx = 0.f;
#pragma unroll
            for (int i = 0; i < 16; ++i)
#pragma unroll
                for (int e = 0; e < 8; ++e) mx = fmaxf(mx, (float)v[i][e]);
            mx = wave_max(mx); }
        else mx = wave_max(cm);
        const float step = mx > 0.f ? mx * (UNSIGNED ? 1.0f / 255.0f : 1.0f / 127.0f) : 1.0f, inv = 1.0f / step;
        int ssum = 0;
#pragma unroll
        for (int i = 0; i < 16; ++i) { unsigned w[2];
#pragma unroll
            for (int hh = 0; hh < 2; ++hh) { unsigned p = 0u;
#pragma unroll
                for (int e = 0; e < 4; ++e) { int qv = (int)rintf((float)v[i][4 * hh + e] * inv);
                    if (UNSIGNED) { qv = qv > 255 ? 255 : (qv < 0 ? 0 : qv); qv -= 128; } else { qv = qv > 127 ? 127 : (qv < -127 ? -127 : qv); ssum += qv; }
                    p |= ((unsigned)qv & 255u) << (8 * e); }
                w[hh] = p; }
            const int b = 8 * i + bsub;
            *(v2u*)(dst + ((size_t)(b >> 1) * R + r) * 128 + 64 * (b & 1) + c8) = (v2u){w[0], w[1]}; }
        if (!UNSIGNED) { float fs = (float)ssum; fs = wave_sum(fs); if (lane == 0) csum[r] = fs; }
        if (lane == 0) scale_out[r] = step;
    }
#undef QK_LOAD
}
__device__ __forceinline__ void norm0_phase(const float* src, const float* gain, h16* dst, float* rowsq, int gw, int NGW, int lane) {
    for (int m = gw; m < T; m += NGW) {
        const f32x4* xr = (const f32x4*)(src + (size_t)m * D) + lane; const f32x4* gr = (const f32x4*)gain + lane;
        f32x4 v[8]; float s = 0.f;
#pragma unroll
        for (int j = 0; j < 8; ++j) { v[j] = xr[64 * j]; s += (v[j].x * v[j].x + v[j].y * v[j].y) + (v[j].z * v[j].z + v[j].w * v[j].w); }
        s = wave_sum(s); if (lane == 0) rowsq[m] = s;
        v2u* o = (v2u*)(dst + (size_t)m * D) + lane;
#pragma unroll
        for (int j = 0; j < 8; ++j) { const f32x4 g = gr[64 * j]; v2u w; w.x = pkh(v[j].x * g.x, v[j].y * g.y); w.y = pkh(v[j].z * g.z, v[j].w * g.w); o[64 * j] = w; }
    }
}

__device__ __forceinline__ unsigned char f8(float x) { return (unsigned char)(__builtin_amdgcn_cvt_pk_fp8_f32(x, x, 0, false) & 0xFF); }
__device__ __forceinline__ float sum16(float v) { v += __shfl_xor(v, 1); v += __shfl_xor(v, 2); v += __shfl_xor(v, 4); v += __shfl_xor(v, 8); return v; }
__device__ __forceinline__ unsigned f8x4(float a, float b, float c, float d) { int p = __builtin_amdgcn_cvt_pk_fp8_f32(a, b, 0, false); p = __builtin_amdgcn_cvt_pk_fp8_f32(c, d, p, true); return (unsigned)p; }
__device__ __forceinline__ void dsa_post_phase(const h16* PROJ, const float* qn, const float* kn, const float* c128, const float* s128, const float* c64, const float* s64,
                                               unsigned char* Q8, unsigned char* K8, unsigned char* V8, h16* IQ, h16* IK, float* IW, int gw, int NGW, int lane) {
    const int hh = lane >> 4, m = lane & 15;
    const f32x4 gqa = *(const f32x4*)(qn + 4 * m), gqb = *(const f32x4*)(qn + 64 + 4 * m), gka = *(const f32x4*)(kn + 4 * m), gkb = *(const f32x4*)(kn + 64 + 4 * m);
    const bool rot = m < 8; const int ioa = rot ? 4 * m : 32 + 4 * m, iob = ioa + 32;
    for (int t = gw; t < T; t += NGW) {
        const h16* pr = PROJ + (size_t)t * A_INP;
        const f32x4 c = *(const f32x4*)(c128 + t * 64 + 4 * m), s = *(const f32x4*)(s128 + t * 64 + 4 * m);
        f32x4 ci = {1.f, 1.f, 1.f, 1.f}, si = {0.f, 0.f, 0.f, 0.f};
        if (rot) { ci = *(const f32x4*)(c64 + t * 32 + 4 * m); si = *(const f32x4*)(s64 + t * 32 + 4 * m); }
#pragma unroll
        for (int p = 0; p < 5; ++p) {
            const int cb = (p < 4 ? C_Q + (4 * p + hh) * HD : C_K + hh * HD) + 4 * m;
            const h16x4 a4 = *(const h16x4*)(pr + cb), b4 = *(const h16x4*)(pr + cb + 64);
            float a[4], b[4], ss = 0.f;
#pragma unroll
            for (int e = 0; e < 4; ++e) { a[e] = (float)a4[e]; b[e] = (float)b4[e]; ss += a[e] * a[e] + b[e] * b[e]; }
            const float rstd = 1.0f / sqrtf(sum16(ss) * (1.0f / HD) + EPS);
            float oa[4], ob[4];
#pragma unroll
            for (int e = 0; e < 4; ++e) { const float ya = a[e] * rstd * (p < 4 ? gqa[e] : gka[e]), yb = b[e] * rstd * (p < 4 ? gqb[e] : gkb[e]); oa[e] = ya * c[e] - yb * s[e]; ob[e] = yb * c[e] + ya * s[e]; }
            unsigned char* o8 = (p < 4 ? Q8 + (size_t)t * D + (4 * p + hh) * HD : K8 + (size_t)t * 512 + hh * HD) + 4 * m;
            *(unsigned*)o8 = f8x4(oa[0], oa[1], oa[2], oa[3]); *(unsigned*)(o8 + 64) = f8x4(ob[0], ob[1], ob[2], ob[3]);
        }
        { const h16x8 vv = *(const h16x8*)(pr + C_V + lane * 8);
          *(v2u*)(V8 + (size_t)t * 512 + lane * 8) = (v2u){f8x4((float)vv[0], (float)vv[1], (float)vv[2], (float)vv[3]), f8x4((float)vv[4], (float)vv[5], (float)vv[6], (float)vv[7])}; }
#pragma unroll
        for (int p = 0; p < 5; ++p) {
            const int hd = p < 4 ? 4 * p + hh : 0; const int cb = p < 4 ? C_IQ + hd * HD : C_IK;
            const h16x4 a4 = *(const h16x4*)(pr + cb + ioa), b4 = *(const h16x4*)(pr + cb + iob);
            h16x4 oa, ob;
#pragma unroll
            for (int e = 0; e < 4; ++e) { const float av = (float)a4[e], bv = (float)b4[e]; oa[e] = (h16)(av * ci[e] - bv * si[e]); ob[e] = (h16)(bv * ci[e] + av * si[e]); }
            if (p < 4) { *(h16x4*)(IQ + (size_t)t * D + hd * HD + ioa) = oa; *(h16x4*)(IQ + (size_t)t * D + hd * HD + iob) = ob; }
            else if (hh == 0) { *(h16x4*)(IK + (size_t)t * HD + ioa) = oa; *(h16x4*)(IK + (size_t)t * HD + iob) = ob; }
        }
        if (lane < 16) IW[t * 16 + lane] = (float)pr[C_IW + lane] * 0.02209708691207961f;
    }
}

__device__ __forceinline__ float relu_i(float x) { const int b = __float_as_int(x); return __int_as_float(b > 0 ? b : 0); }
constexpr int IDX_ITEMS = 8320, IDX_ROWB = 272, IDX_TILEB = 128 * IDX_ROWB;
__device__ __forceinline__ void idx_decode(int L, int& qb, int& kc) {
    int m = (int)((sqrtf(1.0f + 2.0f * (float)L) - 1.0f) * 0.5f);
    while (2 * (m + 1) * (m + 2) <= L) ++m;
    while (2 * m * (m + 1) > L) --m;
    const int rem = L - 2 * m * (m + 1); qb = 4 * m + rem / (m + 1); kc = rem % (m + 1);
}
__device__ __forceinline__ void idx_scores_phase(const h16* IQ, const h16* IK, const float* IW, float* SC, LAS unsigned char* lds, int wg, int G, int tid, int wave, int lane) {
    const int L0 = (int)(((long)IDX_ITEMS * wg) / G), L1 = (int)(((long)IDX_ITEMS * (wg + 1)) / G);
    if (L0 >= L1) return;
    int qb, kc; idx_decode(L0, qb, kc);
    const int fr = lane & 15, fq = lane >> 4;
    h16x8 st[4];
#define IDX_LOAD(kc_) do { _Pragma("unroll") for (int i = 0; i < 4; ++i) { const int p = tid + 512 * i; st[i] = *(const h16x8*)(IK + (size_t)((kc_) * 128 + (p >> 4)) * HD + (p & 15) * 8); } } while (0)
#define IDX_WRITE(buf_) do { _Pragma("unroll") for (int i = 0; i < 4; ++i) { const int p = tid + 512 * i; *(LAS h16x8*)(lds + (buf_) * IDX_TILEB + (p >> 4) * IDX_ROWB + (p & 15) * 16) = st[i]; } } while (0)
    IDX_LOAD(kc); IDX_WRITE(0);
    __syncthreads();
    h16x8 a[4][4]; f32x4 w4[4]; int cur_qb = -1; int par = 0;
    for (int L = L0; L < L1; ++L) {
        int qbn = qb, kcn = kc + 1; if (kcn > (qb >> 2)) { kcn = 0; qbn = qb + 1; }
        const bool more = (L + 1 < L1);
        if (qb != cur_qb) { cur_qb = qb; const int tq = 32 * qb + 4 * wave;
#pragma unroll
            for (int q = 0; q < 4; ++q) {
#pragma unroll
                for (int ks = 0; ks < 4; ++ks) a[q][ks] = *(const h16x8*)(IQ + (size_t)(tq + q) * D + fr * HD + ks * 32 + fq * 8);
                w4[q] = *(const f32x4*)(IW + (size_t)(tq + q) * 16 + 4 * fq); } }
        { const int kcp = more ? kcn : kc; IDX_LOAD(kcp); }
        const LAS unsigned char* bb = lds + par * IDX_TILEB + fr * IDX_ROWB + fq * 16;
        float pq[4][4];
#ifdef IDX_REP
#pragma unroll 1
        for (int irep = 0; irep < IDX_REP; ++irep)
#endif
        h16x8 bq[2][4];
#pragma unroll
        for (int ks = 0; ks < 4; ++ks) bq[0][ks] = *(const LAS h16x8*)(bb + ks * 64);
#pragma unroll
        for (int kt = 0; kt < 8; ++kt) {
            if (kt + 1 < 8) {
#pragma unroll
                for (int ks = 0; ks < 4; ++ks) bq[(kt + 1) & 1][ks] = *(const LAS h16x8*)(bb + (kt + 1) * 16 * IDX_ROWB + ks * 64);
                __builtin_amdgcn_sched_barrier(0); }
            const h16x8 (&b)[4] = bq[kt & 1];
#pragma unroll
            for (int q = 0; q < 4; ++q) { f32x4 acc = {0.f, 0.f, 0.f, 0.f};
#pragma unroll
                for (int ks = 0; ks < 4; ++ks) acc = __builtin_amdgcn_mfma_f32_16x16x32_f16(a[q][ks], b[ks], acc, 0, 0, 0);
                pq[q][kt & 3] = w4[q][0] * relu_i(acc[0]) + w4[q][1] * relu_i(acc[1]) + w4[q][2] * relu_i(acc[2]) + w4[q][3] * relu_i(acc[3]); }
            if ((kt & 3) == 3) { const int tq = 32 * qb + 4 * wave;
#pragma unroll
                for (int q = 0; q < 4; ++q) {
                    const auto r02 = __builtin_amdgcn_permlane32_swap(__float_as_uint(pq[q][0]), __float_as_uint(pq[q][2]), false, false);
                    const auto r13 = __builtin_amdgcn_permlane32_swap(__float_as_uint(pq[q][1]), __float_as_uint(pq[q][3]), false, false);
                    const float a02 = __uint_as_float(r02[0]) + __uint_as_float(r02[1]), a13 = __uint_as_float(r13[0]) + __uint_as_float(r13[1]);
                    const float keep = (fq & 1) ? a13 : a02, send = (fq & 1) ? a02 : a13;
                    SC[(size_t)(tq + q) * SC_LD + kc * 128 + 64 * (kt >> 2) + lane] = keep + __shfl_xor(send, 16); } }
        }
        IDX_WRITE(par ^ 1);
        asm volatile("s_waitcnt lgkmcnt(0)" ::: "memory"); __builtin_amdgcn_s_barrier(); asm volatile("" ::: "memory");
        par ^= 1; qb = qbn; kc = kcn;
    }
#undef IDX_LOAD
#undef IDX_WRITE
}

template <int NR>
__device__ __forceinline__ unsigned kth_largest(const unsigned (&u)[NR], int K) {
    unsigned prefix = 0u;
#pragma unroll 1
    for (int bit = 31; bit >= 0; --bit) { const unsigned cand = prefix | (1u << bit); int cnt = 0;
#pragma unroll
        for (int i = 0; i < NR; ++i) { cnt += __builtin_popcountll(__ballot(u[i] >= cand)); if ((i & 31) == 31) __builtin_amdgcn_sched_barrier(0); }
        if (cnt >= K) prefix = cand; }
    return prefix;
}
template <int NR, bool ARR>
__device__ __forceinline__ void emit_topk(const unsigned (&u)[NR], unsigned thr_in, int* sel, const int (&keys)[ARR ? NR : 1], int lane) {
    unsigned thr = thr_in; int cgt = 0;
#pragma unroll
    for (int i = 0; i < NR; ++i) { cgt += __builtin_popcountll(__ballot(u[i] > thr)); if ((i & 7) == 7) __builtin_amdgcn_sched_barrier(0); }
    const int need = TOPK - cgt;
    asm volatile("" : "+s"(thr));
    int base = 0, eqseen = 0;
#pragma unroll
    for (int i = 0; i < NR; ++i) {
        const bool gt = u[i] > thr, eq = u[i] == thr;
        const unsigned long long eb = __ballot(eq);
        const int erank = eqseen + (int)__builtin_amdgcn_mbcnt_hi((unsigned)(eb >> 32), __builtin_amdgcn_mbcnt_lo((unsigned)eb, 0u));
        const bool take = gt || (eq && erank < need);
        const unsigned long long tb = __ballot(take);
        const int pos = base + (int)__builtin_amdgcn_mbcnt_hi((unsigned)(tb >> 32), __builtin_amdgcn_mbcnt_lo((unsigned)tb, 0u));
        if (take) sel[pos] = ARR ? keys[ARR ? i : 0] : 64 * i + lane;
        base += __builtin_popcountll(tb); eqseen += __builtin_popcountll(eb);
        __builtin_amdgcn_sched_barrier(0);
    }
}
constexpr int TK_CAP = 768, TK_TARGET = 448;
template <int NREG>
__device__ __forceinline__ void topk_load_row(unsigned (&u)[NREG], const float* sc_in, int t_in, int lane) {
    static_assert(NREG % 16 == 0, "chunks of 16 registers");
#pragma unroll
    for (int c = 0; c < NREG / 16; ++c) {
        const GAS float* pc = (const GAS float*)(sc_in + 1024 * c); asm volatile("" : "+s"(pc));
#pragma unroll
        for (int k = 0; k < 16; ++k) u[16 * c + k] = __float_as_uint(pc[64 * k + lane]);
    }
#pragma unroll
    for (int c = 0; c < NREG / 16; ++c) {
        int tl = t_in - 1024 * c; asm volatile("" : "+s"(tl));
#pragma unroll
        for (int k = 0; k < 16; ++k) { const unsigned b = u[16 * c + k]; const unsigned mk = (b >> 31) ? 0xFFFFFFFFu : 0x80000000u; u[16 * c + k] = (lane <= tl - 64 * k) ? (b ^ mk) : 0u; }
        __builtin_amdgcn_sched_barrier(0);
    }
}
template <int NREG>
__device__ __forceinline__ void topk_row(const float* sc_in, int t_in, int* sel, int lane_in, LAS unsigned long long* cand) {
    int lane = lane_in; asm volatile("" : "+v"(lane));
    if constexpr (NREG >= 64) {
        int cn = 0;
        {   unsigned u[NREG];
            topk_load_row<NREG>(u, sc_in, t_in, lane);
            constexpr int NS = NREG / 8;
            unsigned us[NS]; int nsv = 0;
#pragma unroll
            for (int s = 0; s < NS; ++s) { us[s] = u[8 * s]; const int rem = t_in + 1 - 512 * s; nsv += rem < 0 ? 0 : (rem > 64 ? 64 : rem); }
            int Ks = (TK_TARGET * nsv) / (t_in + 1); Ks = Ks < 1 ? 1 : Ks;
            unsigned tau = kth_largest<NS>(us, Ks);
            asm volatile("" : "+s"(tau));
#pragma unroll
            for (int c = 0; c < NREG / 16; ++c) {
                int kb = 1024 * c + lane; asm volatile("" : "+v"(kb));
#pragma unroll
                for (int k = 0; k < 16; ++k) { const int i = 16 * c + k; const bool m = u[i] >= tau && tau != 0u; const unsigned long long mb = __ballot(m);
                    const int pos = cn + (int)__builtin_amdgcn_mbcnt_hi((unsigned)(mb >> 32), __builtin_amdgcn_mbcnt_lo((unsigned)mb, 0u));
                    if (m && pos < TK_CAP) cand[pos] = ((unsigned long long)u[i] << 32) | (unsigned)(kb + 64 * k);
                    cn += __builtin_popcountll(mb); if ((k & 3) == 3) __builtin_amdgcn_sched_barrier(0); }
            }
        }
        asm volatile("" : "+s"(cn));
        if (cn >= TOPK && cn <= TK_CAP) {
            LDS_WAIT();
            unsigned cu[TK_CAP / 64]; int ck[TK_CAP / 64];
#pragma unroll
            for (int k = 0; k < TK_CAP / 64; ++k) { const int ix = 64 * k + lane; const unsigned long long v = cand[ix]; cu[k] = ix < cn ? (unsigned)(v >> 32) : 0u; ck[k] = (int)(unsigned)v; }
            const unsigned thr = kth_largest<TK_CAP / 64>(cu, TOPK);
            emit_topk<TK_CAP / 64, true>(cu, thr, sel, ck, lane);
            LDS_WAIT();
            return;
        }
    }
    {   unsigned u[NREG];
        topk_load_row<NREG>(u, sc_in, t_in, lane);
        const unsigned thr = kth_largest<NREG>(u, TOPK);
        const int nokeys[1] = {0}; emit_topk<NREG, false>(u, thr, sel, nokeys, lane); }
}
__device__ __forceinline__ void topk_phase(const float* SC, int* SEL, LAS unsigned char* lds, int gw, int NGW, int wave, int lane) {
    LAS unsigned long long* cand = (LAS unsigned long long*)(lds + wave * (TK_CAP * 8));
    for (int t = gw; t < T; t += NGW) {
        const float* sc = SC + (size_t)t * SC_LD; int* sel = SEL + (size_t)t * TOPK;
        if (t < TOPK) {
#pragma unroll
            for (int j = 0; j < 4; ++j) { const int k = lane + 64 * j; sel[k] = (k <= t) ? k : -1; }
        } else if (t < 2048) topk_row<32>(sc, t, sel, lane, cand);
        else if (t < 4096) topk_row<64>(sc, t, sel, lane, cand);
        else if (t < 6144) topk_row<96>(sc, t, sel, lane, cand);
        else topk_row<128>(sc, t, sel, lane, cand);
    }
}

__device__ __forceinline__ float dot8(h16x8 a, h16x8 b, float c) {
#if __has_builtin(__builtin_amdgcn_fdot2)
    c = __builtin_amdgcn_fdot2((h16x2){a[0], a[1]}, (h16x2){b[0], b[1]}, c, false); c = __builtin_amdgcn_fdot2((h16x2){a[2], a[3]}, (h16x2){b[2], b[3]}, c, false);
    c = __builtin_amdgcn_fdot2((h16x2){a[4], a[5]}, (h16x2){b[4], b[5]}, c, false); c = __builtin_amdgcn_fdot2((h16x2){a[6], a[7]}, (h16x2){b[6], b[7]}, c, false);
#else
#pragma unroll
    for (int e = 0; e < 8; ++e) c += (float)a[e] * (float)b[e];
#endif
    return c;
}
__device__ __forceinline__ void attn_phase(const h16* QH, const h16* KH, const h16* VH, const int* SEL, h16* O, LAS unsigned char* lds, int wg, int G, int wave, int lane) {
    LAS h16* qs = (LAS h16*)(lds + wave * 6144);
    LAS float* ps = (LAS float*)(lds + wave * 6144 + 1024);
    LAS int* is = (LAS int*)(lds + wave * 6144 + 5120);
    const int grp = lane >> 4, c = lane & 15;
    for (int L = wg; L < (T / 8) * NKV; L += G) {
        const int g = L & 3, t = 8 * (L >> 2) + wave;
        int idx[4];
#pragma unroll
        for (int j = 0; j < 4; ++j) idx[j] = SEL[(size_t)t * TOPK + lane + 64 * j];
        *(LAS h16x8*)(qs + lane * 8) = *(const h16x8*)(QH + (size_t)t * D + g * 512 + lane * 8);
#pragma unroll
        for (int j = 0; j < 4; ++j) is[lane + 64 * j] = idx[j] < 0 ? 0 : idx[j];
        LDS_WAIT();
        float sc[4][4];
#pragma unroll
        for (int j = 0; j < 4; ++j) { const h16* krow = KH + (size_t)(idx[j] < 0 ? 0 : idx[j]) * 512 + g * HD; h16x8 kf[16];
#pragma unroll
            for (int cc = 0; cc < 16; ++cc) kf[cc] = *(const h16x8*)(krow + 8 * cc);
#pragma unroll
            for (int hh = 0; hh < 4; ++hh) { float s = 0.f;
#pragma unroll
                for (int cc = 0; cc < 16; ++cc) s = dot8(kf[cc], *(const LAS h16x8*)(qs + hh * HD + 8 * cc), s);
                sc[j][hh] = (idx[j] < 0) ? -__builtin_inff() : s * 0.08838834764831845f; }
            __builtin_amdgcn_sched_barrier(0); }
#pragma unroll
        for (int hh = 0; hh < 4; ++hh) {
            const float mx = wave_max(fmaxf(fmaxf(sc[0][hh], sc[1][hh]), fmaxf(sc[2][hh], sc[3][hh])));
            float e0 = __expf(sc[0][hh] - mx), e1 = __expf(sc[1][hh] - mx), e2 = __expf(sc[2][hh] - mx), e3 = __expf(sc[3][hh] - mx);
            const float inv = 1.0f / wave_sum((e0 + e1) + (e2 + e3));
            sc[0][hh] = e0 * inv; sc[1][hh] = e1 * inv; sc[2][hh] = e2 * inv; sc[3][hh] = e3 * inv; }
#pragma unroll
        for (int j = 0; j < 4; ++j) *(LAS f32x4*)(ps + 4 * (lane + 64 * j)) = (f32x4){sc[j][0], sc[j][1], sc[j][2], sc[j][3]};
        LDS_WAIT();
        float acc[4][8];
#pragma unroll
        for (int hh = 0; hh < 4; ++hh)
#pragma unroll
            for (int e = 0; e < 8; ++e) acc[hh][e] = 0.f;
#pragma unroll 4
        for (int it = 0; it < 64; ++it) { const int kk = 4 * it + grp; const int ik = is[kk]; const f32x4 p4 = *(const LAS f32x4*)(ps + 4 * kk);
            const h16x8 v8 = *(const h16x8*)(VH + (size_t)ik * 512 + g * HD + 8 * c);
#pragma unroll
            for (int hh = 0; hh < 4; ++hh)
#pragma unroll
                for (int e = 0; e < 8; ++e) acc[hh][e] += p4[hh] * (float)v8[e];
            if ((it & 3) == 3) __builtin_amdgcn_sched_barrier(0); }
#pragma unroll
        for (int hh = 0; hh < 4; ++hh)
#pragma unroll
            for (int e = 0; e < 8; ++e) { float v = acc[hh][e]; v += __shfl_xor(v, 16); v += __shfl_xor(v, 32); acc[hh][e] = v; }
        float o8[8];
#pragma unroll
        for (int e = 0; e < 8; ++e) o8[e] = grp == 0 ? acc[0][e] : grp == 1 ? acc[1][e] : grp == 2 ? acc[2][e] : acc[3][e];
        v4u w; w.x = pkh(o8[0], o8[1]); w.y = pkh(o8[2], o8[3]); w.z = pkh(o8[4], o8[5]); w.w = pkh(o8[6], o8[7]);
        *(v4u*)(O + (size_t)t * D + (4 * g + grp) * HD + 8 * c) = w;
        LDS_WAIT();
    }
}

__device__ __forceinline__ void conv_phase(const h16* PROJ, const float* cw, const float* cb, h16* XC, int gtid, int NGT) {
    h16x8 xn[4];
#define CONV_LOAD(i_) do { const int c8_ = ((i_) & 255) * 8, t_ = (i_) >> 8; _Pragma("unroll") for (int j = 0; j < 4; ++j) { const int tt = t_ - 3 + j; xn[j] = *(const h16x8*)(PROJ + (size_t)(tt < 0 ? 0 : tt) * 4096 + 2048 + c8_); } } while (0)
    if (gtid < T * 256) CONV_LOAD(gtid);
    for (int i = gtid; i < T * 256; i += NGT) { const int c8 = (i & 255) * 8, t = i >> 8;
        h16x8 xv[4];
#pragma unroll
        for (int j = 0; j < 4; ++j) xv[j] = xn[j];
        if (i + NGT < T * 256) CONV_LOAD(i + NGT);
        float acc[8];
#pragma unroll
        for (int e = 0; e < 8; ++e) acc[e] = cb[c8 + e];
#pragma unroll
        for (int j = 0; j < 4; ++j) { const int tt = t - 3 + j; if (tt >= 0) {
            const f32x4 w0 = *(const f32x4*)(cw + j * 2048 + c8), w1 = *(const f32x4*)(cw + j * 2048 + c8 + 4);
#pragma unroll
            for (int e = 0; e < 4; ++e) { acc[e] += (float)xv[j][e] * w0[e]; acc[4 + e] += (float)xv[j][4 + e] * w1[e]; } } }
        v4u w; w.x = pkh(acc[0], acc[1]); w.y = pkh(acc[2], acc[3]); w.z = pkh(acc[4], acc[5]); w.w = pkh(acc[6], acc[7]);
        *(v4u*)(XC + (size_t)t * 2048 + c8) = w; }
#undef CONV_LOAD
}
constexpr int SCAN_LC = 64, SCAN_NCH = T / SCAN_LC;
__device__ __forceinline__ f32x4 ld_a4(const h16* LA, size_t o) { const h16x4 v = *(const h16x4*)(LA + o); return (f32x4){__expf((float)v[0]), __expf((float)v[1]), __expf((float)v[2]), __expf((float)v[3])}; }
__device__ __forceinline__ f32x4 ld_b4(const h16* BF, size_t o) { const h16x4 v = *(const h16x4*)(BF + o); return (f32x4){(float)v[0], (float)v[1], (float)v[2], (float)v[3]}; }
__device__ __forceinline__ void scan_agg_phase(const h16* AF, const h16* BF, float* AGGA, float* AGGB, int gtid, int NGT) {
    for (int i = gtid; i < SCAN_NCH * 512; i += NGT) { const int cg = (i & 511) * 4, k = i >> 9;
        f32x4 Pr = {1.f, 1.f, 1.f, 1.f}, H = {0.f, 0.f, 0.f, 0.f};
#pragma unroll 16
        for (int r = 0; r < SCAN_LC; ++r) { const size_t o = (size_t)(k * SCAN_LC + r) * 2048 + cg; const f32x4 a = ld_a4(AF, o), b = ld_b4(BF, o); H = a * H + b; Pr = Pr * a; }
        *(f32x4*)(AGGA + (size_t)k * 2048 + cg) = Pr; *(f32x4*)(AGGB + (size_t)k * 2048 + cg) = H; }
}
__device__ __forceinline__ float gelu_tanh(float x) { const float u = 0.7978845608028654f * (x + 0.044715f * x * x * x); const float e = __expf(2.0f * u); const float th = 1.0f - 2.0f / (e + 1.0f); return 0.5f * x * (1.0f + th); }
__device__ __forceinline__ void scan_final_phase(const h16* AF, const h16* BF, const float* AGGA, const float* AGGB, const h16* PROJ, h16* Y, int gtid, int NGT) {
    for (int i = gtid; i < SCAN_NCH * 512; i += NGT) { const int cg = (i & 511) * 4, k = i >> 9;
        f32x4 H = {0.f, 0.f, 0.f, 0.f};
#pragma unroll 8
        for (int j = 0; j < k; ++j) { const f32x4 a = *(const f32x4*)(AGGA + (size_t)j * 2048 + cg), b = *(const f32x4*)(AGGB + (size_t)j * 2048 + cg); H = a * H + b; }
#pragma unroll 8
        for (int r = 0; r < SCAN_LC; ++r) { const int t = k * SCAN_LC + r; const size_t o = (size_t)t * 2048 + cg; const f32x4 a = ld_a4(AF, o), b = ld_b4(BF, o); H = a * H + b;
            const h16x4 gt = *(const h16x4*)(PROJ + (size_t)t * 4096 + cg);
            v2u w; w.x = pkh(H[0] * gelu_tanh((float)gt[0]), H[1] * gelu_tanh((float)gt[1])); w.y = pkh(H[2] * gelu_tanh((float)gt[2]), H[3] * gelu_tanh((float)gt[3]));
            *(v2u*)(Y + o) = w; } }
}
__device__ __forceinline__ void pool_phase(const float* X, const float* gain, h16* Y, LAS unsigned char* lds, int wg, int G, int tid, int wave, int lane) {
    LAS float* rs = (LAS float*)lds;
    const int c4 = tid * 4; const int w = 2 << (tid >> 7);
    const f32x4 gn = *(const f32x4*)(gain + c4);
    for (int u = wg; u < T / 32; u += G) { const int t0 = 32 * u;
        __syncthreads();
        for (int r = wave; r < 47; r += NWAVES) { const int t = t0 - 15 + r;
            if (t >= 0) { const f32x4* xr = (const f32x4*)(X + (size_t)t * D) + lane; float s = 0.f;
#pragma unroll
                for (int j = 0; j < 8; ++j) { const f32x4 v = xr[64 * j]; s += (v.x * v.x + v.y * v.y) + (v.z * v.z + v.w * v.w); }
                s = wave_sum(s); if (lane == 0) rs[r] = 1.0f / sqrtf(s * (1.0f / D) + EPS); } }
        __syncthreads();
        f32x4 sum = {0.f, 0.f, 0.f, 0.f};
        { const int n0 = (t0 + 1) < w ? (t0 + 1) : w;
          for (int j = 1; j < n0; ++j) sum += *(const f32x4*)(X + (size_t)(t0 - j) * D + c4) * rs[15 - j]; }
#pragma unroll 8
        for (int r = 0; r < 32; ++r) { const int t = t0 + r; const int n = (t + 1) < w ? (t + 1) : w;
            const f32x4 h0 = *(const f32x4*)(X + (size_t)t * D + c4) * rs[15 + r];
            sum += h0;
            const float invn = 1.0f / (float)n;
            const f32x4 y = (sum * invn - h0) * gn;
            v2u o; o.x = pkh(y.x, y.y); o.y = pkh(y.z, y.w); *(v2u*)(Y + (size_t)t * D + c4) = o;
            if (t + 1 >= w) sum -= *(const f32x4*)(X + (size_t)(t + 1 - w) * D + c4) * rs[15 + r + 1 - w]; }
    }
}

__device__ __forceinline__ h16x8 f8x8_to_h(unsigned d0, unsigned d1) {
    const h16x2 a = __builtin_amdgcn_cvt_scalef32_pk_f16_fp8((int)d0, 1.0f, false), b = __builtin_amdgcn_cvt_scalef32_pk_f16_fp8((int)d0, 1.0f, true);
    const h16x2 c = __builtin_amdgcn_cvt_scalef32_pk_f16_fp8((int)d1, 1.0f, false), d = __builtin_amdgcn_cvt_scalef32_pk_f16_fp8((int)d1, 1.0f, true);
    return (h16x8){a[0], a[1], b[0], b[1], c[0], c[1], d[0], d[1]};
}
__device__ __forceinline__ unsigned attn_off_b(unsigned row, unsigned ch) { return 256u * row + 16u * (ch ^ (((row & 3u) << 2) | ((row >> 2) & 3u))); }
__device__ __forceinline__ void attn_mfma_phase(const unsigned char* Q8, const unsigned char* K8, const unsigned char* V8, const int* SEL, h16* O, LAS unsigned char* lds, int wg, int G, int wave, int lane_in) {
    typedef int i32x4 __attribute__((ext_vector_type(4)));
    typedef int i32x2 __attribute__((ext_vector_type(2)));
    typedef long i64x2 __attribute__((ext_vector_type(2)));
    i32x4 svn = {0, 0, 0, 0}; i64x2 qfn[2] = {{0, 0}, {0, 0}};
#define AT_PREF(L_) do { const int g_ = (L_) & 3, t_ = 8 * ((L_) >> 2) + wave; svn = *(const i32x4*)(SEL + (size_t)t_ * TOPK + 4 * lane_in); \
        _Pragma("unroll") for (int pp = 0; pp < 2; ++pp) qfn[pp] = *(const i64x2*)(Q8 + (size_t)t_ * D + (4 * g_ + (lane_in & 3)) * HD + 64 * pp + 16 * (lane_in >> 4)); } while (0)
    v4u kga[4], kgb[4];
#define AT_LOADK2(buf, G_, selk_, kbase_) do { const i32x2 i0 = *(const LAS i32x2*)((selk_) + 2 * (G_)), i1 = *(const LAS i32x2*)((selk_) + 128 + 2 * (G_)); \
            buf[0] = *(const v4u*)((kbase_) + (size_t)(i0.x < 0 ? 0 : i0.x) * 512); buf[1] = *(const v4u*)((kbase_) + (size_t)(i1.x < 0 ? 0 : i1.x) * 512); \
            buf[2] = *(const v4u*)((kbase_) + (size_t)(i0.y < 0 ? 0 : i0.y) * 512); buf[3] = *(const v4u*)((kbase_) + (size_t)(i1.y < 0 ? 0 : i1.y) * 512); } while (0)
#define AT_PREP(L_, par_) do { LAS int* sst_ = (LAS int*)(lds + LDSCTL_OFF + 1024 + wave * 2048 + (par_) * 1024); *(LAS i32x4*)(sst_ + 4 * lane_in) = svn; \
        asm volatile("s_waitcnt lgkmcnt(0)" ::: "memory"); \
        const LAS int* selk_ = sst_ + 16 * (lane_in >> 3); const unsigned char* kbase_ = K8 + ((L_) & 3) * HD + 16 * (lane_in & 7); \
        AT_LOADK2(kga, 0, selk_, kbase_); AT_LOADK2(kgb, 1, selk_, kbase_); } while (0)
    if (wg < (T / 8) * NKV) { AT_PREF(wg); AT_PREP(wg, 0); }
    int itpar = 0;
    for (int L = wg; L < (T / 8) * NKV; L += G, itpar ^= 1) {
        int lane = lane_in; asm volatile("" : "+v"(lane));
        const int jl = lane & 15, gi = lane >> 4;
        const int g = L & 3, t = 8 * (L >> 2) + wave;
        const int* sel = SEL + (size_t)t * TOPK; (void)sel;
        const int nvalid = (t + 1) < TOPK ? (t + 1) : TOPK;
        LAS int* sst = (LAS int*)(lds + LDSCTL_OFF + 1024 + wave * 2048 + itpar * 1024);
        i64x2 qf[2];
#pragma unroll
        for (int pp = 0; pp < 2; ++pp) qf[pp] = qfn[pp];
        LAS unsigned char* vimg = lds + wave * 16384;
        const LAS int* selk = sst + 16 * (lane >> 3);
        const unsigned char* kbase = K8 + g * HD + 16 * (lane & 7);
        const unsigned kwr = 136u * (unsigned)(lane >> 3) + 16u * (unsigned)(lane & 7), krd = 136u * (unsigned)jl + 16u * (unsigned)gi;
        f32x4 s[16];
#define AT_LOADK(buf, G_) AT_LOADK2(buf, G_, selk, kbase)
#define AT_KSTEP(buf, G_) do { LAS unsigned char* kb_ = vimg + ((G_) & 1) * 8192; \
            _Pragma("unroll") for (int j = 0; j < 4; ++j) { *(LAS v2u*)(kb_ + kwr + 1088 * j) = (v2u){buf[j].x, buf[j].y}; *(LAS v2u*)(kb_ + kwr + 1088 * j + 8) = (v2u){buf[j].z, buf[j].w}; } \
            if ((G_) + 2 < 8) AT_LOADK(buf, (G_) + 2); \
            _Pragma("unroll") for (int tt = 0; tt < 2; ++tt) { f32x4 acc = {0.f, 0.f, 0.f, 0.f}; \
                _Pragma("unroll") for (int pp = 0; pp < 2; ++pp) { const long a0 = *(const LAS long*)(kb_ + krd + 2176 * tt + 64 * pp), a1 = *(const LAS long*)(kb_ + krd + 2176 * tt + 64 * pp + 8); \
                    acc = __builtin_amdgcn_mfma_f32_16x16x32_fp8_fp8(a0, qf[pp].x, acc, 0, 0, 0); acc = __builtin_amdgcn_mfma_f32_16x16x32_fp8_fp8(a1, qf[pp].y, acc, 0, 0, 0); } \
                s[2 * (G_) + tt] = acc; } } while (0)
        if (L + G < (T / 8) * NKV) AT_PREF(L + G);
        AT_KSTEP(kga, 0); AT_KSTEP(kgb, 1); AT_KSTEP(kga, 2); AT_KSTEP(kgb, 3); AT_KSTEP(kga, 4); AT_KSTEP(kgb, 5); AT_KSTEP(kga, 6); AT_KSTEP(kgb, 7);
#undef AT_LOADK
#undef AT_KSTEP
        const LAS int* selv = sst + ((lane >> 5) & 1) + 16 * ((lane >> 3) & 3);
        const unsigned char* vbase = V8 + g * HD + 16 * (lane & 7);
        v4u vsa[4], vsb[4];
#define AT_LOADV(vst, Tt) do { _Pragma("unroll") for (int i = 0; i < 4; ++i) { const int ix = selv[2 * (Tt) + 64 * i]; vst[i] = *(const v4u*)(vbase + (size_t)(ix < 0 ? 0 : ix) * 512); } } while (0)
        AT_LOADV(vsa, 0); AT_LOADV(vsb, 1);
        __builtin_amdgcn_sched_barrier(0);
        if (nvalid < TOPK) {
#pragma unroll
            for (int kt = 0; kt < 16; ++kt)
#pragma unroll
                for (int r = 0; r < 4; ++r) if (kt + 64 * gi + 16 * r >= nvalid) s[kt][r] = -__builtin_inff();
        }
        float mx = -__builtin_inff();
#pragma unroll
        for (int kt = 0; kt < 16; ++kt) mx = fmaxf(mx, fmaxf(fmaxf(s[kt][0], s[kt][1]), fmaxf(s[kt][2], s[kt][3])));
        mx = fmaxf(mx, __shfl_xor(mx, 16)); mx = fmaxf(mx, __shfl_xor(mx, 32));
        constexpr float C2 = 0.08838834764831845f * 1.4426950408889634f;
        const float mb = -mx * C2; float sum = 0.f;
        h16x8 pf[8];
#pragma unroll
        for (int Tt = 0; Tt < 8; ++Tt) { float p[8];
#pragma unroll
            for (int r = 0; r < 4; ++r) { p[r] = __builtin_amdgcn_exp2f(fmaf(s[2 * Tt][r], C2, mb)); p[4 + r] = __builtin_amdgcn_exp2f(fmaf(s[2 * Tt + 1][r], C2, mb)); }
            sum += ((p[0] + p[1]) + (p[2] + p[3])) + ((p[4] + p[5]) + (p[6] + p[7]));
            pf[Tt] = (h16x8){(h16)p[0], (h16)p[1], (h16)p[2], (h16)p[3], (h16)p[4], (h16)p[5], (h16)p[6], (h16)p[7]}; }
        sum += __shfl_xor(sum, 16); sum += __shfl_xor(sum, 32);
        const float linv = 1.0f / sum;
        const unsigned q4 = (unsigned)jl >> 2, p4 = (unsigned)jl & 3u;
        unsigned wr_off[8], rd_off[2];
#pragma unroll
        for (int i = 0; i < 4; ++i) { wr_off[2 * i] = attn_off_b((unsigned)((lane >> 3) + 8 * i), 2u * (lane & 7)); wr_off[2 * i + 1] = attn_off_b((unsigned)((lane >> 3) + 8 * i), 2u * (lane & 7) + 1u); }
#pragma unroll
        for (int tt = 0; tt < 2; ++tt) { const unsigned row = 8u * gi + 4u * tt + q4; const unsigned x = ((row & 3u) << 2) | ((row >> 2) & 3u);
            rd_off[tt] = 256u * row + 16u * ((p4 >> 1) ^ (x & 1u)) + 8u * (p4 & 1u) + 32u * (x >> 1); }
        f32x4 o[8];
#pragma unroll
        for (int c = 0; c < 8; ++c) o[c] = (f32x4){0.f, 0.f, 0.f, 0.f};
#define AT_STEP(vst, Tt) do { \
            _Pragma("unroll") for (int i = 0; i < 4; ++i) {     \
                *(LAS h16x8*)(vimg + ((Tt) & 1) * 8192 + wr_off[2 * i]) = f8x8_to_h(vst[i].x, vst[i].y); *(LAS h16x8*)(vimg + ((Tt) & 1) * 8192 + wr_off[2 * i + 1]) = f8x8_to_h(vst[i].z, vst[i].w); } \
            if ((Tt) + 2 < 8) AT_LOADV(vst, (Tt) + 2); \
            const unsigned ib = (unsigned)(size_t)(vimg + ((Tt) & 1) * 8192); \
            h16x4 lo[8], hi[8]; \
            asm volatile("s_waitcnt lgkmcnt(0)" ::: "memory"); \
            _Pragma("unroll") for (int c = 0; c < 8; ++c) { \
                asm volatile("ds_read_b64_tr_b16 %0, %1" : "=&v"(lo[c]) : "v"(ib + (rd_off[0] ^ ((unsigned)c << 5))) : "memory"); \
                asm volatile("ds_read_b64_tr_b16 %0, %1" : "=&v"(hi[c]) : "v"(ib + (rd_off[1] ^ ((unsigned)c << 5))) : "memory"); } \
            asm volatile("s_waitcnt lgkmcnt(0)" ::: "memory"); __builtin_amdgcn_sched_barrier(0); \
            _Pragma("unroll") for (int c = 0; c < 8; ++c) o[c] = __builtin_amdgcn_mfma_f32_16x16x32_f16(pf[Tt], (h16x8){lo[c][0], lo[c][1], lo[c][2], lo[c][3], hi[c][0], hi[c][1], hi[c][2], hi[c][3]}, o[c], 0, 0, 0); \
        } while (0)
        AT_STEP(vsa, 0); AT_STEP(vsb, 1); AT_STEP(vsa, 2); AT_STEP(vsb, 3); AT_STEP(vsa, 4); AT_STEP(vsb, 5); AT_STEP(vsa, 6); AT_STEP(vsb, 7);
#undef AT_STEP
#undef AT_LOADV
        const float li = __shfl(linv, gi);
        h16* orow = O + (size_t)t * D + (4 * g + gi) * HD + jl;
#pragma unroll
        for (int c = 0; c < 8; ++c) { const float v = gi == 0 ? o[c][0] : gi == 1 ? o[c][1] : gi == 2 ? o[c][2] : o[c][3]; orow[16 * c] = (h16)(v * li); }
        asm volatile("s_waitcnt lgkmcnt(0)" ::: "memory");
        if (L + G < (T / 8) * NKV) AT_PREP(L + G, itpar ^ 1);
    }
#undef AT_PREF
#undef AT_PREP
#undef AT_LOADK2
}

constexpr int NPH = 37;
__global__ void __launch_bounds__(NTHR, 2) fwd_kernel(Ptrs P_unused) {
    extern __shared__ __attribute__((aligned(16))) unsigned char lds_raw[];
    LAS unsigned char* lds = (LAS unsigned char*)lds_raw;
    volatile LAS unsigned* MISC = (volatile LAS unsigned*)(lds + MISC_OFF);
    for (int u = threadIdx.x; u < (LDS_BYTES - LDSCTL_OFF) / 4; u += NTHR) ((LAS unsigned*)(lds + LDSCTL_OFF))[u] = 0u;
    __syncthreads();
    int lo, hi;
    XcdBarrier bar;
    { const CAS Ptrs* PP = kargs(); lo = PP->ph_lo; hi = PP->ph_hi; unsigned* bw = (unsigned*)(PP->ws + WS_CTL) + CW_BAR;
      bar.bar = bw; bar.x = 0; bar.st = nullptr; if (hi - lo > 1) bar = xcd_barrier_post(bw, MISC + 8); }
    int seq = 0;
#define PH_BEGIN(S_) if (seq >= lo && seq < hi) { const CAS Ptrs* PP = kargs(); unsigned char* const ws = PP->ws; float* const X = PP->out; (void)X; \
        int tid = threadIdx.x, bx = blockIdx.x, G = gridDim.x; asm volatile("" : "+v"(tid), "+s"(bx), "+s"(G)); \
        const int lane = tid & 63, wave = __builtin_amdgcn_readfirstlane(tid >> 6); const int vcu = (G % 8 == 0) ? (bx % 8) * (G / 8) + bx / 8 : bx; \
        const int gw = vcu * NWAVES + wave, NGW = G * NWAVES, gtid = vcu * NTHR + tid, NGT = G * NTHR; (void)lane; (void)gw; (void)NGW; (void)gtid; (void)NGT; \
        for (int rep_ = 0; rep_ < 1 + (int)((REP_MASK >> (S_)) & 1u); ++rep_) { if (rep_) __syncthreads(); \
        h16* const H16 = (h16*)(ws + WS_BA + BA_H16); h16* const PROJ = (h16*)(ws + WS_BA + BA_PROJ); h16* const U16 = (h16*)(ws + WS_BA + BA_U); (void)H16; (void)PROJ; (void)U16;
#define PH_END   } if (seq + 1 < hi) xcd_barrier(bar); } ++seq;
#define RSQ(i_) ((float*)(ws + WS_CTL + WS_ROWSQ) + (size_t)(i_) * T)
#define PARTA ((float*)(ws + WS_PARTA))
#define PARTB ((float*)(ws + WS_PARTB))
#define XIN ((layer == 0) ? PP->x : (const float*)X)

    PH_BEGIN(0) p0_prologue(PP, lds, gw, NGW, wave, lane, gtid, NGT); norm0_phase(PP->x, PP->attn_norm, H16, RSQ(0), gw, NGW, lane); PH_END

#pragma unroll 1
    for (int layer = 0; layer < DEPTH; ++layer) {
        const int kind = layer % 3, j = layer / 3;
        if (kind == 0) {
            PH_BEGIN(2) { pg8::Gemm g{H16, (const h16*)(ws + WS_WINA) + (size_t)j * A_INP * D, T, A_INP, D, D, 1 << 20, D, 128, 128}; pg8::StaticOrder S; S.init(T, A_INP, G, bx);
                       pg8::EpiF16<0> E{PROJ, A_INP, layer == 0 ? RSQ(0) : PARTB, 0, layer == 0 ? 0 : 32}; pg8::gemm_phase<pg8::EpiF16<0>, pg8::StaticOrder, true, true>(lds, g, S, E, tid); } PH_END
            PH_BEGIN(3) dsa_post_phase(PROJ, PP->attn_qn + j * HD, PP->attn_kn + j * HD, (const float*)(ws + WS_COS128), (const float*)(ws + WS_SIN128), (const float*)(ws + WS_COS64), (const float*)(ws + WS_SIN64),
                                    (unsigned char*)(ws + WS_QH), (unsigned char*)(ws + WS_KH), (unsigned char*)(ws + WS_VH), (h16*)(ws + WS_IQ), (h16*)(ws + WS_IK), (float*)(ws + WS_IW), gw, NGW, lane); PH_END
            PH_BEGIN(4) idx_scores_phase((const h16*)(ws + WS_IQ), (const h16*)(ws + WS_IK), (const float*)(ws + WS_IW), (float*)(ws + WS_BA + BA_SC), lds, vcu, G, tid, wave, lane); PH_END
            PH_BEGIN(5) topk_phase((const float*)(ws + WS_BA + BA_SC), (int*)(ws + WS_SEL), lds, gw, NGW, wave, lane); PH_END
            PH_BEGIN(6) attn_mfma_phase((const unsigned char*)(ws + WS_QH), (const unsigned char*)(ws + WS_KH), (const unsigned char*)(ws + WS_VH), (const int*)(ws + WS_SEL), (h16*)(ws + WS_BA + BA_O16), lds, bx, G, wave, lane); PH_END
            PH_BEGIN(7) { pg8::Gemm g{(const h16*)(ws + WS_BA + BA_O16), (const h16*)(ws + WS_WOUTA) + (size_t)j * D * D, T, D, D, D, 1 << 20, D, 128, 128}; pg8::StaticOrder S; S.init(T, D, G, bx);
                       pg8::EpiResid E{XIN, X, D, nullptr, nullptr, H16, PP->mlp_norm + (size_t)layer * D, PARTA}; pg8::gemm_phase<pg8::EpiResid, pg8::StaticOrder, true, true>(lds, g, S, E, tid); } PH_END
        } else if (kind == 1) {
            PH_BEGIN(9) { pg8::Gemm g{H16, (const h16*)(ws + WS_WINR), T, 4096, D, D, 1 << 20, D, 128, 128}; pg8::StaticOrder S; S.init(T, 4096, G, bx);
                       pg8::EpiF16<0> E{PROJ, 4096, layer == 0 ? RSQ(0) : PARTB, 0, layer == 0 ? 0 : 32}; pg8::gemm_phase<pg8::EpiF16<0>, pg8::StaticOrder, true, true>(lds, g, S, E, tid); } PH_END
            PH_BEGIN(10) conv_phase(PROJ, PP->conv_w, PP->conv_b, (h16*)(ws + WS_BA + BA_XC), gtid, NGT); PH_END
            PH_BEGIN(11) { int kg = 256; asm volatile("" : "+s"(kg));
                       pg8::Gemm g{(const h16*)(ws + WS_BA + BA_XC), (const h16*)(ws + WS_WGR), T, 4096, kg, D, 2, kg, 128, 128}; pg8::StaticOrder S; S.init(T, 4096, G, bx);
                       pg8::EpiGates E{(const h16*)(ws + WS_BA + BA_XC), PP->ga_b, PP->gx_b, PP->lam, (h16*)(ws + WS_BA + BA_AF), (h16*)(ws + WS_BA + BA_BF)};
                       pg8::gemm_phase<pg8::EpiGates, pg8::StaticOrder, true, true>(lds, g, S, E, tid); } PH_END
            PH_BEGIN(12) scan_agg_phase((const h16*)(ws + WS_BA + BA_AF), (const h16*)(ws + WS_BA + BA_BF), (float*)(ws + WS_AGGA), (float*)(ws + WS_AGGB), gtid, NGT); PH_END
            PH_BEGIN(13) scan_final_phase((const h16*)(ws + WS_BA + BA_AF), (const h16*)(ws + WS_BA + BA_BF), (const float*)(ws + WS_AGGA), (const float*)(ws + WS_AGGB), PROJ, (h16*)(ws + WS_BA + BA_XC), gtid, NGT); PH_END
            PH_BEGIN(14) { pg8::Gemm g{(const h16*)(ws + WS_BA + BA_XC), (const h16*)(ws + WS_WOUTR), T, D, D, D, 1 << 20, D, 128, 128}; pg8::StaticOrder S; S.init(T, D, G, bx);
                       pg8::EpiResid E{XIN, X, D, nullptr, nullptr, H16, PP->mlp_norm + (size_t)layer * D, PARTA}; pg8::gemm_phase<pg8::EpiResid, pg8::StaticOrder, true, true>(lds, g, S, E, tid); } PH_END
        } else {
            PH_BEGIN(15) pool_phase(XIN, PP->pool_norm, (h16*)(ws + WS_BA + BA_XC), lds, vcu, G, tid, wave, lane); PH_END
            PH_BEGIN(16) { pg8::Gemm g{(const h16*)(ws + WS_BA + BA_XC), (const h16*)(ws + WS_WPOOL), T, D, 512, D, 2, 512, 128, 128}; pg8::StaticOrder S; S.init(T, D, G, bx);
                       pg8::EpiResid E{XIN, X, D, PP->pool_b, PP->pool_scale, H16, PP->mlp_norm + (size_t)layer * D, PARTA}; pg8::gemm_phase<pg8::EpiResid, pg8::StaticOrder, true, true>(lds, g, S, E, tid); } PH_END
        }
        PH_BEGIN(17) quant_rows(H16, T, (signed char*)(ws + WS_BA + BA_A8), (float*)(ws + WS_RS), PARTA, nullptr, gw, NGW, lane);
                     quant_rows((const h16*)(ws + WS_WUP) + (size_t)layer * D * FF, FF, (signed char*)(ws + WS_BA + BA_W8), (float*)(ws + WS_CS), nullptr, (const unsigned*)(ws + WS_BLKMAX) + (size_t)layer * 32 * FF, gw, NGW, lane); PH_END
        PH_BEGIN(18) { pg8::Gemm g{(const h16*)(ws + WS_BA + BA_A8), (const h16*)(ws + WS_BA + BA_W8), T, FF, D / 2, D / 2, 1 << 20, D / 2, 128, 128}; pg8::StaticOrder S; S.init(T, FF, G, bx);
                   pg8::EpiQRelu2<pg8::i32x4> E{U16, (const float*)(ws + WS_RS), (const float*)(ws + WS_CS), T}; pg8::gemm_phase_i8<pg8::EpiQRelu2<pg8::i32x4>, pg8::StaticOrder, true, true>(lds, g, S, E, tid); } PH_END
        PH_BEGIN(19) quant_kblk<true>(U16, T, (signed char*)(ws + WS_BA + BA_U8), (float*)(ws + WS_RS2), nullptr, nullptr, gw, NGW, lane);
                     quant_kblk<false>((const h16*)(ws + WS_WDOWN) + (size_t)layer * D * FF, D, (signed char*)(ws + WS_BA + BA_W8D), (float*)(ws + WS_CS2), (float*)(ws + WS_CSUM), (const unsigned*)(ws + WS_BLKMAXD) + (size_t)layer * 128 * D, gw, NGW, lane); PH_END
        PH_BEGIN(20) { pg8::Gemm g{(const h16*)(ws + WS_BA + BA_U8), (const h16*)(ws + WS_BA + BA_W8D), T, D, FF / 2, 64, 1 << 20, 64, (size_t)T * 128, (size_t)D * 128}; pg8::StaticOrder S; S.init(T, D, G, bx);
                   const int nk = (layer + 1) % 3, nj = (layer + 1) / 3; const float* gn = (layer + 1 >= DEPTH || nk == 2) ? nullptr : (nk == 0 ? PP->attn_norm + (size_t)nj * D : PP->rnn_norm);
                   pg8::EpiResidQ E{X, X, D, (const float*)(ws + WS_RS2), (const float*)(ws + WS_CS2), (const float*)(ws + WS_CSUM), gn ? H16 : nullptr, gn, PARTB};
                   pg8::gemm_phase_i8<pg8::EpiResidQ, pg8::StaticOrder, true, true>(lds, g, S, E, tid); } PH_END
    }
#undef PH_BEGIN
#undef PH_END
#undef XIN
#undef RSQ
#undef PARTA
#undef PARTB
}

extern "C" void kernel_launch(void* const* d_in, const int* in_sizes, int n_in, void* d_out, int out_size, void* d_ws, size_t ws_size, hipStream_t stream) {
    static int grid = 0;
    if (grid == 0) {
        if (n_in != 24 || in_sizes[0] != T * D || out_size != T * D || ws_size < WS_END) { fprintf(stderr, "kernel_launch: unexpected shapes / workspace (n_in %d, in0 %d, out %d, ws %zu, need %zu); nothing launched\n", n_in, n_in > 0 ? in_sizes[0] : -1, out_size, ws_size, (size_t)WS_END); grid = -1; return; }
        int dev = 0, cus = 0, per_cu = 0;
        if (hipGetDevice(&dev) != hipSuccess || hipDeviceGetAttribute(&cus, hipDeviceAttributeMultiprocessorCount, dev) != hipSuccess) { grid = -1; return; }
        if (hipFuncSetAttribute((const void*)fwd_kernel, hipFuncAttributeMaxDynamicSharedMemorySize, LDS_BYTES) != hipSuccess) { fprintf(stderr, "kernel_launch: hipFuncSetAttribute failed\n"); grid = -1; return; }
        if (hipOccupancyMaxActiveBlocksPerMultiprocessor(&per_cu, (const void*)fwd_kernel, NTHR, LDS_BYTES) != hipSuccess || per_cu < 1) { fprintf(stderr, "kernel_launch: occupancy query reports %d workgroups per CU\n", per_cu); }
        (void)hipGetLastError();
        grid = cus;
    }
    if (grid < 0) return;
    if (hipMemsetAsync((char*)d_ws + WS_CTL, 0, CTL_ZERO_BYTES, stream) != hipSuccess) return;
    Ptrs p{};
    p.x = (const float*)d_in[0]; p.pos = (const int*)d_in[1];
    p.attn_norm = (const float*)d_in[2]; p.attn_w_in = (const float*)d_in[3]; p.attn_qn = (const float*)d_in[4]; p.attn_kn = (const float*)d_in[5]; p.attn_w_out = (const float*)d_in[6];
    p.rnn_norm = (const float*)d_in[7]; p.rnn_w_in = (const float*)d_in[8]; p.conv_w = (const float*)d_in[9]; p.conv_b = (const float*)d_in[10]; p.ga_w = (const float*)d_in[11]; p.ga_b = (const float*)d_in[12];
    p.gx_w = (const float*)d_in[13]; p.gx_b = (const float*)d_in[14]; p.lam = (const float*)d_in[15]; p.rnn_w_out = (const float*)d_in[16];
    p.pool_norm = (const float*)d_in[17]; p.pool_w = (const float*)d_in[18]; p.pool_b = (const float*)d_in[19]; p.pool_scale = (const float*)d_in[20];
    p.mlp_norm = (const float*)d_in[21]; p.mlp_w_up = (const float*)d_in[22]; p.mlp_w_down = (const float*)d_in[23];
    p.out = (float*)d_out; p.ws = (unsigned char*)d_ws;
#if MK_SPLIT
    for (int ph = 0; ph < NPH; ++ph) { p.ph_lo = ph; p.ph_hi = ph + 1; hipLaunchKernelGGL(fwd_kernel, dim3(grid), dim3(NTHR), LDS_BYTES, stream, p); }
#else
    p.ph_lo = 0; p.ph_hi = NPH; hipLaunchKernelGGL(fwd_kernel, dim3(grid), dim3(NTHR), LDS_BYTES, stream, p);
#endif
}
```

```cpp
#include <hip/hip_runtime.h>
#include <cstdio>
#include <cstdint>

#ifndef REP_MASK
#define REP_MASK 0u
#endif
#ifndef MK_SPLIT
#define MK_SPLIT 0
#endif

namespace pg8 {
#define PG8_LAS __attribute__((address_space(3)))
typedef _Float16 bf16_t;
typedef _Float16 bf16x8 __attribute__((ext_vector_type(8)));
typedef float f32x4 __attribute__((ext_vector_type(4)));
typedef unsigned u32x4 __attribute__((ext_vector_type(4)));
typedef unsigned u32x2 __attribute__((ext_vector_type(2)));
typedef _Float16 h16x2 __attribute__((ext_vector_type(2)));
typedef _Float16 h16x4 __attribute__((ext_vector_type(4)));
constexpr int BM = 256, BK = 64, HALF = 128, HTB = HALF * BK * 2  , STAGE_BYTES = 8 * HTB, NXCD = 8, WGM = 8;

__host__ __device__ __forceinline__ int lds_byte(int r, int c) { const int st = (r >> 4) * 2 + (c >> 5), rr = r & 15, cc = c & 31, ob = rr * 64 + cc * 2; return st * 1024 + (ob ^ (((ob >> 9) & 1) << 5)); }
__host__ __device__ __forceinline__ void stage_rc(int b, int& R, int& C) { const int st = b / 1024, sb = b % 1024, swz = sb ^ (((sb >> 9) & 1) << 5); R = (st >> 1) * 16 + swz / 64; C = (st & 1) * 32 + (swz % 64) / 2; }
__host__ __device__ __forceinline__ int perm32(int rho) { const int n = rho >> 4, i = rho & 15; return 8 * (i >> 2) + 4 * n + (i & 3); }

struct Unit { int pm, pn; };
struct Gemm { const bf16_t* A; const bf16_t* Bt; int M, N, K, lda, npg, ldb; size_t kstepA, kstepB; };

struct StaticOrder {
    int nM, nN, nwg, G, c;
    __host__ __device__ void init(int M, int N, int G_, int c_) { nM = M / BM; nN = N / BM; nwg = nM * nN; G = G_; c = c_; }
    __host__ __device__ bool next(int i, Unit& u) const {
        const long L = (long)i * G + c; if (L >= nwg) return false;
        int wgid = (int)L; { const int q = nwg / NXCD, r = nwg % NXCD, xcd = wgid % NXCD, off = wgid / NXCD; wgid = (xcd < r ? xcd * (q + 1) : r * (q + 1) + (xcd - r) * q) + off; }
        const int nig = WGM * nN, gid = wgid / nig, fm = gid * WGM, gsz = (nM - fm) < WGM ? (nM - fm) : WGM;
        u.pm = fm + ((wgid % nig) % gsz); u.pn = (wgid % nig) / gsz; return true;
    }
    __device__ __forceinline__ void a_ready(const Unit&) const {}
    __device__ __forceinline__ void done(const Unit&) const {}
};

__device__ __forceinline__ unsigned pk_h2(float lo, float hi) { h16x2 v = {(_Float16)lo, (_Float16)hi}; return __builtin_bit_cast(unsigned, v); }

template <int ACT> struct EpiF16 {
    static constexpr bool PERM = true, AFTER_DRAIN = false;
    bf16_t* O; int ldc; const float* rowsq; int kblk_rows; int npart;
    __device__ __forceinline__ void operator()(const f32x4 (&acc)[2][2][4][2], const Unit& u, int wr, int wc, int fr, int fq) const {
        const int row0 = u.pm * BM + wr * 64 + fr, col0 = u.pn * BM + wc * 32 + 8 * fq;
#pragma unroll
        for (int ai = 0; ai < 2; ++ai)
#pragma unroll
            for (int m = 0; m < 4; ++m) { const int row = row0 + ai * HALF + m * 16;
                bf16_t* rowp = kblk_rows ? O + ((size_t)(col0 >> 6) * kblk_rows + row) * 64 + (col0 & 63) : O + (size_t)row * ldc + col0;
                const size_t bjstep = kblk_rows ? (size_t)2 * kblk_rows * 64 : (size_t)HALF;
                float rs = 1.0f; if (rowsq) { float ssq;
                    if (npart) { const f32x4* pp = (const f32x4*)(rowsq + (size_t)row * 32); f32x4 a4 = pp[0];
#pragma unroll
                        for (int q = 1; q < 8; ++q) a4 += pp[q];
                        ssq = (a4[0] + a4[1]) + (a4[2] + a4[3]); }
                    else ssq = rowsq[row];
                    rs = 1.0f / sqrtf(ssq * (1.0f / 2048.0f) + 1e-6f); if (ACT == 1) rs = rs * rs; }
#pragma unroll
                for (int bj = 0; bj < 2; ++bj) { f32x4 v0 = acc[ai][bj][m][0], v1 = acc[ai][bj][m][1];
                    if (ACT == 1) {
#pragma unroll
                        for (int j = 0; j < 4; ++j) { const float a = fmaxf(v0[j], 0.f), b = fmaxf(v1[j], 0.f); v0[j] = a * a; v1[j] = b * b; } }
                    v0 = v0 * rs; v1 = v1 * rs;
                    u32x4 w; w.x = pk_h2(v0[0], v0[1]); w.y = pk_h2(v0[2], v0[3]); w.z = pk_h2(v1[0], v1[1]); w.w = pk_h2(v1[2], v1[3]);
                    *(u32x4*)(rowp + bj * bjstep) = w; } }
    }
};
typedef int i32x4e __attribute__((ext_vector_type(4)));
template <class AccV> struct EpiQRelu2;
template <class AccV> struct EpiQRelu2 {
    static constexpr bool PERM = true, AFTER_DRAIN = false;
    bf16_t* O; const float* rs; const float* cs; int kblk_rows;
    __device__ __forceinline__ void operator()(const AccV (&acc)[2][2][4][2], const Unit& u, int wr, int wc, int fr, int fq) const {
        const int row0 = u.pm * BM + wr * 64 + fr, col0 = u.pn * BM + wc * 32 + 8 * fq;
        f32x4 cv[2][2];
#pragma unroll
        for (int bj = 0; bj < 2; ++bj)
#pragma unroll
            for (int n = 0; n < 2; ++n) cv[bj][n] = *(const f32x4*)(cs + col0 + bj * HALF + 4 * n);
#pragma unroll
        for (int ai = 0; ai < 2; ++ai)
#pragma unroll
            for (int m = 0; m < 4; ++m) { const int row = row0 + ai * HALF + m * 16; const float r = rs[row];
                bf16_t* rowp = O + ((size_t)(col0 >> 6) * kblk_rows + row) * 64 + (col0 & 63); const size_t bjstep = (size_t)2 * kblk_rows * 64;
#pragma unroll
                for (int bj = 0; bj < 2; ++bj) { f32x4 v0, v1;
#pragma unroll
                    for (int j = 0; j < 4; ++j) { const float a = fmaxf((float)acc[ai][bj][m][0][j] * (r * cv[bj][0][j]), 0.f), b = fmaxf((float)acc[ai][bj][m][1][j] * (r * cv[bj][1][j]), 0.f); v0[j] = a * a; v1[j] = b * b; }
                    u32x4 w; w.x = pk_h2(v0[0], v0[1]); w.y = pk_h2(v0[2], v0[3]); w.z = pk_h2(v1[0], v1[1]); w.w = pk_h2(v1[2], v1[3]);
                    *(u32x4*)(rowp + bj * bjstep) = w; } }
    }
};
struct EpiResid {
    static constexpr bool PERM = false, AFTER_DRAIN = false;
    const bf16_t* res; bf16_t* out; float* out32; int ldc; const float* bias; const float* scale; float* rowsq;
    __device__ __forceinline__ void operator()(const f32x4 (&acc)[2][2][4][2], const Unit& u, int wr, int wc, int fr, int fq) const {
        const int row0 = u.pm * BM + wr * 64 + fr, col0 = u.pn * BM + wc * 32 + 4 * fq;
#pragma unroll
        for (int ai = 0; ai < 2; ++ai)
#pragma unroll
            for (int m = 0; m < 4; ++m) { const int row = row0 + ai * HALF + m * 16; const size_t off = (size_t)row * ldc + col0; float sq = 0.f;
#pragma unroll
                for (int bj = 0; bj < 2; ++bj)
#pragma unroll
                    for (int n = 0; n < 2; ++n) { const int cc = bj * HALF + n * 16; const h16x4 rh = *(const h16x4*)(res + off + cc); const f32x4 r = {(float)rh[0], (float)rh[1], (float)rh[2], (float)rh[3]};
                        const f32x4 bv = bias ? *(const f32x4*)(bias + col0 + cc) : (f32x4){0.f, 0.f, 0.f, 0.f}, sv = scale ? *(const f32x4*)(scale + col0 + cc) : (f32x4){1.f, 1.f, 1.f, 1.f};
                        const f32x4 o = r + (acc[ai][bj][m][n] + bv) * sv;
                        if (out32) *(f32x4*)(out32 + off + cc) = o; else { u32x2 w; w.x = pk_h2(o[0], o[1]); w.y = pk_h2(o[2], o[3]); *(u32x2*)(out + off + cc) = w; }
                        sq += (o[0] * o[0] + o[1] * o[1]) + (o[2] * o[2] + o[3] * o[3]); }
                if (rowsq) { sq += __shfl_xor(sq, 16); sq += __shfl_xor(sq, 32); if (fq == 0) rowsq[(size_t)row * 32 + u.pn * 4 + wc] = sq; }
                asm volatile("" ::: "memory"); }
    }
};
struct EpiResidQ {
    static constexpr bool PERM = false, AFTER_DRAIN = false;
    const bf16_t* res; bf16_t* out; float* out32; int ldc; const float* rs; const float* cs; const float* csum; float* rowsq;
    __device__ __forceinline__ void operator()(const i32x4e (&acc)[2][2][4][2], const Unit& u, int wr, int wc, int fr, int fq) const {
        const int row0 = u.pm * BM + wr * 64 + fr, col0 = u.pn * BM + wc * 32 + 4 * fq;
#pragma unroll
        for (int ai = 0; ai < 2; ++ai)
#pragma unroll
            for (int m = 0; m < 4; ++m) { const int row = row0 + ai * HALF + m * 16; const size_t off = (size_t)row * ldc + col0; float sq = 0.f; const float rsv = rs[row];
#pragma unroll
                for (int bj = 0; bj < 2; ++bj)
#pragma unroll
                    for (int n = 0; n < 2; ++n) { const int cc = bj * HALF + n * 16; const h16x4 rh = *(const h16x4*)(res + off + cc);
                        const f32x4 cv = *(const f32x4*)(cs + col0 + cc), zv = *(const f32x4*)(csum + col0 + cc); f32x4 o;
#pragma unroll
                        for (int j = 0; j < 4; ++j) o[j] = (float)rh[j] + (rsv * cv[j]) * ((float)acc[ai][bj][m][n][j] + 128.0f * zv[j]);
                        if (out32) *(f32x4*)(out32 + off + cc) = o; else { u32x2 w; w.x = pk_h2(o[0], o[1]); w.y = pk_h2(o[2], o[3]); *(u32x2*)(out + off + cc) = w; }
                        sq += (o[0] * o[0] + o[1] * o[1]) + (o[2] * o[2] + o[3] * o[3]); }
                if (rowsq) { sq += __shfl_xor(sq, 16); sq += __shfl_xor(sq, 32); if (fq == 0) rowsq[(size_t)row * 32 + u.pn * 4 + wc] = sq; }
                asm volatile("" ::: "memory"); }
    }
};
struct EpiGates {
    static constexpr bool PERM = false, AFTER_DRAIN = false;
    const bf16_t* XC; const float* ba; const float* bx; const float* lam; bf16_t* AF; bf16_t* BF;
    __device__ __forceinline__ void operator()(const f32x4 (&acc)[2][2][4][2], const Unit& u, int wr, int wc, int fr, int fq) const {
        const int row0 = u.pm * BM + wr * 64 + fr, ch0 = (u.pn >> 1) * 256 + (u.pn & 1) * 128 + wc * 32 + 4 * fq;
#pragma unroll
        for (int n = 0; n < 2; ++n) {
            const f32x4 bav = *(const f32x4*)(ba + ch0 + n * 16), bxv = *(const f32x4*)(bx + ch0 + n * 16), l = *(const f32x4*)(lam + ch0 + n * 16); f32x4 spv;
#pragma unroll
            for (int j = 0; j < 4; ++j) spv[j] = -8.0f * log1pf(__expf(-l[j]));
#pragma unroll
            for (int ai = 0; ai < 2; ++ai)
#pragma unroll
                for (int m = 0; m < 4; ++m) { const size_t off = (size_t)(row0 + ai * HALF + m * 16) * 2048 + ch0 + n * 16;
                    const h16x4 xh = *(const h16x4*)(XC + off); f32x4 av, bv;
#pragma unroll
                    for (int j = 0; j < 4; ++j) { const float r = __builtin_amdgcn_rcpf(1.0f + __expf(-(acc[ai][0][m][n][j] + bav[j]))), ig = __builtin_amdgcn_rcpf(1.0f + __expf(-(acc[ai][1][m][n][j] + bxv[j])));
                        const float la = r * spv[j]; av[j] = la;
                        const float y = 2.0f * la;
                        const float em = y * (1.0f + y * 0.5f * (1.0f + y * (1.0f / 3.0f) * (1.0f + y * 0.25f * (1.0f + y * 0.2f * (1.0f + y * (1.0f / 6.0f) * (1.0f + y * (1.0f / 7.0f)))))));
                        const float om = (y > -0.5f) ? -em : 1.0f - __expf(y);
                        bv[j] = (float)xh[j] * ig * __builtin_amdgcn_sqrtf(fmaxf(om, 0.f)); }
                    { u32x2 w; w.x = pk_h2(av[0], av[1]); w.y = pk_h2(av[2], av[3]); *(u32x2*)(AF + off) = w; w.x = pk_h2(bv[0], bv[1]); w.y = pk_h2(bv[2], bv[3]); *(u32x2*)(BF + off) = w; }
                    asm volatile("" ::: "memory"); }
        }
    }
};

template <class Epi, class Sched, bool ALIGN_EPI = false, bool SP2 = false>
__device__ __forceinline__ void gemm_phase(PG8_LAS unsigned char* lds, const Gemm g, const Sched& S, const Epi& E, const int tid) {
    const int wid = __builtin_amdgcn_readfirstlane(tid >> 6), lane = tid & 63, wr = wid >> 2, wc = wid & 3, fr = lane & 15, fq = lane >> 4;
    const int K = g.K, nt = K / BK;
    unsigned voffA[2], voffB[2];
#pragma unroll
    for (int i = 0; i < 2; ++i) { int R, C; stage_rc(tid * 16 + i * 8192, R, C); const int Rb = Epi::PERM ? ((R & ~31) + perm32(R & 31)) : R;
        voffA[i] = (unsigned)(R * g.lda + C) * 2u; voffB[i] = (unsigned)(Rb * g.ldb + C) * 2u; }
    const size_t kstepA = g.kstepA, kstepB = g.kstepB;
    const size_t hstepA = (size_t)HALF * g.lda * 2, hstepB = (size_t)HALF * g.ldb * 2;
#define PG8_ABASE(u) ((const char*)g.A + ((size_t)(u).pm * BM * g.lda + (size_t)((u).pn / g.npg) * K) * 2)
#define PG8_BBASE(u) ((const char*)g.Bt + (size_t)(u).pn * BM * g.ldb * 2)
    const unsigned ldsw = (unsigned)wid * 1024u;
    const int aoff = lds_byte(wr * 64 + fr, fq * 8), boff = lds_byte(wc * 32 + fr, fq * 8);
#define PG8_SA(b, h) (((b) * 2 + (h)) * HTB)
#define PG8_SB(b, h) ((4 + (b) * 2 + (h)) * HTB)
#define PG8_STAGE(bufoff, gbase, voff) do { _Pragma("unroll") for (int _i = 0; _i < 2; ++_i) \
        __builtin_amdgcn_global_load_lds((const unsigned*)((const char*)(gbase) + (voff)[_i]), (PG8_LAS unsigned*)(lds + (bufoff) + ldsw + _i * 8192), 16, 0, 0); } while (0)
#define PG8_LDA(dst, b, h) do { _Pragma("unroll") for (int m = 0; m < 4; ++m) _Pragma("unroll") for (int k = 0; k < 2; ++k) dst[m][k] = *(const PG8_LAS bf16x8*)(lds + PG8_SA(b, h) + aoff + m * 2048 + k * 1024); } while (0)
#define PG8_LDB(dst, b, h) do { _Pragma("unroll") for (int n = 0; n < 2; ++n) _Pragma("unroll") for (int k = 0; k < 2; ++k) dst[n][k] = *(const PG8_LAS bf16x8*)(lds + PG8_SB(b, h) + boff + n * 2048 + k * 1024); } while (0)
#define PG8_MMA(ai, bj, At, Bt) do { __builtin_amdgcn_s_setprio(1); _Pragma("unroll") for (int m = 0; m < 4; ++m) _Pragma("unroll") for (int n = 0; n < 2; ++n) _Pragma("unroll") for (int k = 0; k < 2; ++k) \
        acc[ai][bj][m][n] = __builtin_amdgcn_mfma_f32_16x16x32_f16(Bt[n][k], At[m][k], acc[ai][bj][m][n], 0, 0, 0); __builtin_amdgcn_s_setprio(0); } while (0)
#define PG8_WAIT_V(n) asm volatile("s_waitcnt vmcnt(" #n ")" ::: "memory")
#define PG8_WAIT_L(n) asm volatile("s_waitcnt lgkmcnt(" #n ")" ::: "memory")
#define PG8_BAR __builtin_amdgcn_s_barrier()
#define PG8_SCHED __builtin_amdgcn_sched_barrier(0)
    Unit cur, nxt; int ui = 0;
    if (!S.next(0, cur)) return;
    f32x4 acc[2][2][4][2];
#pragma unroll
    for (int a = 0; a < 2; ++a)
#pragma unroll
        for (int b = 0; b < 2; ++b)
#pragma unroll
            for (int m = 0; m < 4; ++m)
#pragma unroll
                for (int n = 0; n < 2; ++n) acc[a][b][m][n] = (f32x4){0.f, 0.f, 0.f, 0.f};
    bf16x8 At[4][2], B0[2][2], B1[2][2];
    const char* cA = PG8_ABASE(cur); const char* cB = PG8_BBASE(cur);
    S.a_ready(cur);
    if constexpr (SP2) {
        PG8_STAGE(PG8_SB(0, 0), cB, voffB); PG8_STAGE(PG8_SB(0, 1), cB + hstepB, voffB); PG8_STAGE(PG8_SA(0, 0), cA, voffA); PG8_STAGE(PG8_SA(0, 1), cA + hstepA, voffA);
        if (wr == 1) PG8_BAR;
        PG8_WAIT_V(2); PG8_BAR;
        PG8_STAGE(PG8_SB(1, 0), cB + kstepB, voffB); PG8_STAGE(PG8_SA(1, 0), cA + kstepA, voffA); PG8_STAGE(PG8_SB(1, 1), cB + hstepB + kstepB, voffB);
        PG8_WAIT_V(6); PG8_BAR;
    } else {
        PG8_STAGE(PG8_SB(0, 0), cB, voffB); PG8_STAGE(PG8_SA(0, 0), cA, voffA); PG8_STAGE(PG8_SB(0, 1), cB + hstepB, voffB); PG8_STAGE(PG8_SA(0, 1), cA + hstepA, voffA);
        if (wr == 1) PG8_BAR;
        PG8_WAIT_V(4); PG8_BAR;
        PG8_STAGE(PG8_SB(1, 0), cB + kstepB, voffB); PG8_STAGE(PG8_SA(1, 0), cA + kstepA, voffA); PG8_STAGE(PG8_SB(1, 1), cB + hstepB + kstepB, voffB);
        PG8_WAIT_V(6); PG8_BAR;
    }
    for (;;) {
        const bool has_next = S.next(ui + 1, nxt);
        const char* nA = has_next ? PG8_ABASE(nxt) : cA; const char* nB = has_next ? PG8_BBASE(nxt) : cB;
        for (int t = 0; t < nt; t += 2) {
            const bool last = (t == nt - 2);
            const char* a1 = cA + (size_t)(t + 1) * kstepA;
            const char* a2 = last ? nA : cA + (size_t)(t + 2) * kstepA; const char* b2 = last ? nB : cB + (size_t)(t + 2) * kstepB;
            const char* a3 = a2 + kstepA; const char* b3 = b2 + kstepB;
            if (last && has_next) S.a_ready(nxt);
            if constexpr (SP2) {
            PG8_LDB(B0, 0, 0); PG8_LDB(B1, 0, 1); PG8_SCHED; PG8_LDA(At, 0, 0); PG8_STAGE(PG8_SA(1, 1), a1 + hstepA, voffA);
            PG8_WAIT_V(8); PG8_WAIT_L(0); PG8_BAR; PG8_MMA(0, 0, At, B0); PG8_MMA(0, 1, At, B1); PG8_BAR; PG8_SCHED;
            PG8_LDA(At, 0, 1); PG8_STAGE(PG8_SB(0, 0), b2, voffB); PG8_STAGE(PG8_SB(0, 1), b2 + hstepB, voffB); PG8_STAGE(PG8_SA(0, 0), a2, voffA);
            PG8_WAIT_V(8); PG8_WAIT_L(0); PG8_BAR; PG8_MMA(1, 0, At, B0); PG8_MMA(1, 1, At, B1); PG8_BAR; PG8_SCHED;
            PG8_LDB(B0, 1, 0); PG8_LDB(B1, 1, 1); PG8_SCHED; PG8_LDA(At, 1, 0); PG8_STAGE(PG8_SA(0, 1), a2 + hstepA, voffA);
            PG8_WAIT_V(8); PG8_WAIT_L(0); PG8_BAR; PG8_MMA(0, 0, At, B0); PG8_MMA(0, 1, At, B1); PG8_BAR; PG8_SCHED;
            PG8_LDA(At, 1, 1); PG8_STAGE(PG8_SB(1, 0), b3, voffB); PG8_STAGE(PG8_SB(1, 1), b3 + hstepB, voffB); PG8_STAGE(PG8_SA(1, 0), a3, voffA);
            PG8_WAIT_V(8); PG8_WAIT_L(0); PG8_BAR; PG8_MMA(1, 0, At, B0); PG8_MMA(1, 1, At, B1); PG8_BAR; PG8_SCHED;
            } else {
            PG8_LDB(B0, 0, 0); PG8_SCHED; PG8_LDA(At, 0, 0); PG8_STAGE(PG8_SA(1, 1), a1 + hstepA, voffA);
            PG8_WAIT_L(8); PG8_BAR; PG8_WAIT_L(0); PG8_MMA(0, 0, At, B0); PG8_BAR; PG8_SCHED;
            PG8_LDB(B1, 0, 1); PG8_STAGE(PG8_SB(0, 0), b2, voffB);
            PG8_BAR; PG8_WAIT_L(0); PG8_MMA(0, 1, At, B1); PG8_BAR;
            PG8_LDA(At, 0, 1); PG8_STAGE(PG8_SA(0, 0), a2, voffA);
            PG8_BAR; PG8_WAIT_L(0); PG8_MMA(1, 0, At, B0); PG8_BAR; PG8_SCHED;
            PG8_STAGE(PG8_SB(0, 1), b2 + hstepB, voffB);
            PG8_WAIT_V(6); PG8_BAR; PG8_MMA(1, 1, At, B1); PG8_BAR;
            PG8_LDB(B0, 1, 0); PG8_SCHED; PG8_LDA(At, 1, 0); PG8_STAGE(PG8_SA(0, 1), a2 + hstepA, voffA);
            PG8_WAIT_L(8); PG8_BAR; PG8_WAIT_L(0); PG8_MMA(0, 0, At, B0); PG8_BAR; PG8_SCHED;
            PG8_LDB(B1, 1, 1); PG8_STAGE(PG8_SB(1, 0), b3, voffB);
            PG8_BAR; PG8_WAIT_L(0); PG8_MMA(0, 1, At, B1); PG8_BAR;
            PG8_LDA(At, 1, 1); PG8_STAGE(PG8_SA(1, 0), a3, voffA);
            PG8_BAR; PG8_WAIT_L(0); PG8_MMA(1, 0, At, B0); PG8_BAR; PG8_SCHED;
            PG8_STAGE(PG8_SB(1, 1), b3 + hstepB, voffB);
            PG8_WAIT_V(6); PG8_BAR; PG8_MMA(1, 1, At, B1); PG8_BAR;
            }
        }
        if constexpr (ALIGN_EPI) { if (wr == 0) PG8_BAR; }
        if constexpr (!Epi::AFTER_DRAIN) { E(acc, cur, wr, wc, fr, fq); S.done(cur); }
        if (!has_next) break;
#pragma unroll
        for (int a = 0; a < 2; ++a)
#pragma unroll
            for (int b = 0; b < 2; ++b)
#pragma unroll
                for (int m = 0; m < 4; ++m)
#pragma unroll
                    for (int n = 0; n < 2; ++n) acc[a][b][m][n] = (f32x4){0.f, 0.f, 0.f, 0.f};
        cur = nxt; cA = nA; cB = nB; ++ui;
        if constexpr (ALIGN_EPI) { if (wr == 1) PG8_BAR; }
    }
    PG8_WAIT_V(0);
    if constexpr (!ALIGN_EPI) { if (wr == 0) PG8_BAR; }
    PG8_BAR;
    if constexpr (Epi::AFTER_DRAIN) { E.fused(acc, cur, wr, wc, fr, fq, lds, wid, lane); S.done(cur); }
#undef PG8_ABASE
#undef PG8_BBASE
#undef PG8_SA
#undef PG8_SB
#undef PG8_STAGE
#undef PG8_LDA
#undef PG8_LDB
#undef PG8_MMA
#undef PG8_WAIT_V
#undef PG8_WAIT_L
#undef PG8_BAR
#undef PG8_SCHED
}
typedef int i32x4 __attribute__((ext_vector_type(4)));
template <class Epi, class Sched, bool ALIGN_EPI = false, bool SP2 = false>
__device__ __forceinline__ void gemm_phase_i8(PG8_LAS unsigned char* lds, const Gemm g, const Sched& S, const Epi& E, const int tid) {
    const int wid = __builtin_amdgcn_readfirstlane(tid >> 6), lane = tid & 63, wr = wid >> 2, wc = wid & 3, fr = lane & 15, fq = lane >> 4;
    const int K = g.K, nt = K / BK;
    unsigned voffA[2], voffB[2];
#pragma unroll
    for (int i = 0; i < 2; ++i) { int R, C; stage_rc(tid * 16 + i * 8192, R, C); const int Rb = Epi::PERM ? ((R & ~31) + perm32(R & 31)) : R;
        voffA[i] = (unsigned)(R * g.lda + C) * 2u; voffB[i] = (unsigned)(Rb * g.ldb + C) * 2u; }
    const size_t kstepA = g.kstepA, kstepB = g.kstepB;
    const size_t hstepA = (size_t)HALF * g.lda * 2, hstepB = (size_t)HALF * g.ldb * 2;
#define PG8_ABASE(u) ((const char*)g.A + ((size_t)(u).pm * BM * g.lda + (size_t)((u).pn / g.npg) * K) * 2)
#define PG8_BBASE(u) ((const char*)g.Bt + (size_t)(u).pn * BM * g.ldb * 2)
    const unsigned ldsw = (unsigned)wid * 1024u;
    const int aoff = lds_byte(wr * 64 + fr, fq * 8), boff = lds_byte(wc * 32 + fr, fq * 8);
#define PG8_SA(b, h) (((b) * 2 + (h)) * HTB)
#define PG8_SB(b, h) ((4 + (b) * 2 + (h)) * HTB)
#define PG8_STAGE(bufoff, gbase, voff) do { _Pragma("unroll") for (int _i = 0; _i < 2; ++_i) \
        __builtin_amdgcn_global_load_lds((const unsigned*)((const char*)(gbase) + (voff)[_i]), (PG8_LAS unsigned*)(lds + (bufoff) + ldsw + _i * 8192), 16, 0, 0); } while (0)
#define PG8_LDA(dst, b, h) do { _Pragma("unroll") for (int m = 0; m < 4; ++m) _Pragma("unroll") for (int k = 0; k < 2; ++k) dst[m][k] = *(const PG8_LAS bf16x8*)(lds + PG8_SA(b, h) + aoff + m * 2048 + k * 1024); } while (0)
#define PG8_LDB(dst, b, h) do { _Pragma("unroll") for (int n = 0; n < 2; ++n) _Pragma("unroll") for (int k = 0; k < 2; ++k) dst[n][k] = *(const PG8_LAS bf16x8*)(lds + PG8_SB(b, h) + boff + n * 2048 + k * 1024); } while (0)
#define PG8_MMA(ai, bj, At, Bt) do { __builtin_amdgcn_s_setprio(1); _Pragma("unroll") for (int m = 0; m < 4; ++m) _Pragma("unroll") for (int n = 0; n < 2; ++n) _Pragma("unroll") for (int k = 0; k < 2; ++k) \
        acc[ai][bj][m][n] = __builtin_amdgcn_mfma_i32_16x16x64_i8(__builtin_bit_cast(i32x4, Bt[n][k]), __builtin_bit_cast(i32x4, At[m][k]), acc[ai][bj][m][n], 0, 0, 0); __builtin_amdgcn_s_setprio(0); } while (0)
#define PG8_WAIT_V(n) asm volatile("s_waitcnt vmcnt(" #n ")" ::: "memory")
#define PG8_WAIT_L(n) asm volatile("s_waitcnt lgkmcnt(" #n ")" ::: "memory")
#define PG8_BAR __builtin_amdgcn_s_barrier()
#define PG8_SCHED __builtin_amdgcn_sched_barrier(0)
    Unit cur, nxt; int ui = 0;
    if (!S.next(0, cur)) return;
    i32x4 acc[2][2][4][2];
#pragma unroll
    for (int a = 0; a < 2; ++a)
#pragma unroll
        for (int b = 0; b < 2; ++b)
#pragma unroll
            for (int m = 0; m < 4; ++m)
#pragma unroll
                for (int n = 0; n < 2; ++n) acc[a][b][m][n] = (i32x4){0, 0, 0, 0};
    bf16x8 At[4][2], B0[2][2], B1[2][2];
    const char* cA = PG8_ABASE(cur); const char* cB = PG8_BBASE(cur);
    S.a_ready(cur);
    if constexpr (SP2) {
        PG8_STAGE(PG8_SB(0, 0), cB, voffB); PG8_STAGE(PG8_SB(0, 1), cB + hstepB, voffB); PG8_STAGE(PG8_SA(0, 0), cA, voffA); PG8_STAGE(PG8_SA(0, 1), cA + hstepA, voffA);
        if (wr == 1) PG8_BAR;
        PG8_WAIT_V(2); PG8_BAR;
        PG8_STAGE(PG8_SB(1, 0), cB + kstepB, voffB); PG8_STAGE(PG8_SA(1, 0), cA + kstepA, voffA); PG8_STAGE(PG8_SB(1, 1), cB + hstepB + kstepB, voffB);
        PG8_WAIT_V(6); PG8_BAR;
    } else {
        PG8_STAGE(PG8_SB(0, 0), cB, voffB); PG8_STAGE(PG8_SA(0, 0), cA, voffA); PG8_STAGE(PG8_SB(0, 1), cB + hstepB, voffB); PG8_STAGE(PG8_SA(0, 1), cA + hstepA, voffA);
        if (wr == 1) PG8_BAR;
        PG8_WAIT_V(4); PG8_BAR;
        PG8_STAGE(PG8_SB(1, 0), cB + kstepB, voffB); PG8_STAGE(PG8_SA(1, 0), cA + kstepA, voffA); PG8_STAGE(PG8_SB(1, 1), cB + hstepB + kstepB, voffB);
        PG8_WAIT_V(6); PG8_BAR;
    }
    for (;;) {
        const bool has_next = S.next(ui + 1, nxt);
        const char* nA = has_next ? PG8_ABASE(nxt) : cA; const char* nB = has_next ? PG8_BBASE(nxt) : cB;
        for (int t = 0; t < nt; t += 2) {
            const bool last = (t == nt - 2);
            const char* a1 = cA + (size_t)(t + 1) * kstepA;
            const char* a2 = last ? nA : cA + (size_t)(t + 2) * kstepA; const char* b2 = last ? nB : cB + (size_t)(t + 2) * kstepB;
            const char* a3 = a2 + kstepA; const char* b3 = b2 + kstepB;
            if (last && has_next) S.a_ready(nxt);
            if constexpr (SP2) {
            PG8_LDB(B0, 0, 0); PG8_LDB(B1, 0, 1); PG8_SCHED; PG8_LDA(At, 0, 0); PG8_STAGE(PG8_SA(1, 1), a1 + hstepA, voffA);
            PG8_WAIT_V(8); PG8_WAIT_L(0); PG8_BAR; PG8_MMA(0, 0, At, B0); PG8_MMA(0, 1, At, B1); PG8_BAR; PG8_SCHED;
            PG8_LDA(At, 0, 1); PG8_STAGE(PG8_SB(0, 0), b2, voffB); PG8_STAGE(PG8_SB(0, 1), b2 + hstepB, voffB); PG8_STAGE(PG8_SA(0, 0), a2, voffA);
            PG8_WAIT_V(8); PG8_WAIT_L(0); PG8_BAR; PG8_MMA(1, 0, At, B0); PG8_MMA(1, 1, At, B1); PG8_BAR; PG8_SCHED;
            PG8_LDB(B0, 1, 0); PG8_LDB(B1, 1, 1); PG8_SCHED; PG8_LDA(At, 1, 0); PG8_STAGE(PG8_SA(0, 1), a2 + hstepA, voffA);
            PG8_WAIT_V(8); PG8_WAIT_L(0); PG8_BAR; PG8_MMA(0, 0, At, B0); PG8_MMA(0, 1, At, B1); PG8_BAR; PG8_SCHED;
            PG8_LDA(At, 1, 1); PG8_STAGE(PG8_SB(1, 0), b3, voffB); PG8_STAGE(PG8_SB(1, 1), b3 + hstepB, voffB); PG8_STAGE(PG8_SA(1, 0), a3, voffA);
            PG8_WAIT_V(8); PG8_WAIT_L(0); PG8_BAR; PG8_MMA(1, 0, At, B0); PG8_MMA(1, 1, At, B1); PG8_BAR; PG8_SCHED;
            } else {
            PG8_LDB(B0, 0, 0); PG8_SCHED; PG8_LDA(At, 0, 0); PG8_STAGE(PG8_SA(1, 1), a1 + hstepA, voffA);
            PG8_WAIT_L(8); PG8_BAR; PG8_WAIT_L(0); PG8_MMA(0, 0, At, B0); PG8_BAR; PG8_SCHED;
            PG8_LDB(B1, 0, 1); PG8_STAGE(PG8_SB(0, 0), b2, voffB);
            PG8_BAR; PG8_WAIT_L(0); PG8_MMA(0, 1, At, B1); PG8_BAR;
            PG8_LDA(At, 0, 1); PG8_STAGE(PG8_SA(0, 0), a2, voffA);
            PG8_BAR; PG8_WAIT_L(0); PG8_MMA(1, 0, At, B0); PG8_BAR; PG8_SCHED;
            PG8_STAGE(PG8_SB(0, 1), b2 + hstepB, voffB);
            PG8_WAIT_V(6); PG8_BAR; PG8_MMA(1, 1, At, B1); PG8_BAR;
            PG8_LDB(B0, 1, 0); PG8_SCHED; PG8_LDA(At, 1, 0); PG8_STAGE(PG8_SA(0, 1), a2 + hstepA, voffA);
            PG8_WAIT_L(8); PG8_BAR; PG8_WAIT_L(0); PG8_MMA(0, 0, At, B0); PG8_BAR; PG8_SCHED;
            PG8_LDB(B1, 1, 1); PG8_STAGE(PG8_SB(1, 0), b3, voffB);
            PG8_BAR; PG8_WAIT_L(0); PG8_MMA(0, 1, At, B1); PG8_BAR;
            PG8_LDA(At, 1, 1); PG8_STAGE(PG8_SA(1, 0), a3, voffA);
            PG8_BAR; PG8_WAIT_L(0); PG8_MMA(1, 0, At, B0); PG8_BAR; PG8_SCHED;
            PG8_STAGE(PG8_SB(1, 1), b3 + hstepB, voffB);
            PG8_WAIT_V(6); PG8_BAR; PG8_MMA(1, 1, At, B1); PG8_BAR;
            }
        }
        if constexpr (ALIGN_EPI) { if (wr == 0) PG8_BAR; }
        if constexpr (!Epi::AFTER_DRAIN) { E(acc, cur, wr, wc, fr, fq); S.done(cur); }
        if (!has_next) break;
#pragma unroll
        for (int a = 0; a < 2; ++a)
#pragma unroll
            for (int b = 0; b < 2; ++b)
#pragma unroll
                for (int m = 0; m < 4; ++m)
#pragma unroll
                    for (int n = 0; n < 2; ++n) acc[a][b][m][n] = (i32x4){0, 0, 0, 0};
        cur = nxt; cA = nA; cB = nB; ++ui;
        if constexpr (ALIGN_EPI) { if (wr == 1) PG8_BAR; }
    }
    PG8_WAIT_V(0);
    if constexpr (!ALIGN_EPI) { if (wr == 0) PG8_BAR; }
    PG8_BAR;
    if constexpr (Epi::AFTER_DRAIN) { E.fused(acc, cur, wr, wc, fr, fq, lds, wid, lane); S.done(cur); }
#undef PG8_ABASE
#undef PG8_BBASE
#undef PG8_SA
#undef PG8_SB
#undef PG8_STAGE
#undef PG8_LDA
#undef PG8_LDB
#undef PG8_MMA
#undef PG8_WAIT_V
#undef PG8_WAIT_L
#undef PG8_BAR
#undef PG8_SCHED
}
}

constexpr int T = 8192, D = 2048, FF = 8192, DEPTH = 4;
constexpr int NH = 16, HD = 128, NKV = 4, TOPK = 256;
constexpr int A_IN = 5264, A_INP = 5376;
constexpr int C_Q = 0, C_K = 2048, C_V = 2560, C_IQ = 3072, C_IK = 5120, C_IW = 5248;
constexpr float EPS = 1e-6f;
constexpr int NWAVES = 8, NTHR = NWAVES * 64;

constexpr size_t MiB = 1u << 20;
constexpr size_t WS_CTL = 0, CTL_ZERO_BYTES = 1 * MiB;
constexpr size_t WS_COS128 = 1 * MiB, WS_SIN128 = 3 * MiB, WS_COS64 = 5 * MiB, WS_SIN64 = 6 * MiB;
constexpr size_t WS_IW = 7 * MiB;
constexpr size_t WS_AGGA = 8 * MiB, WS_AGGB = 9 * MiB;
constexpr size_t WS_WINA = 10 * MiB;
constexpr size_t WS_WOUTA = 52 * MiB;
constexpr size_t WS_WINR = 68 * MiB;
constexpr size_t WS_WGR = 84 * MiB;
constexpr size_t WS_WOUTR = 86 * MiB;
constexpr size_t WS_WPOOL = 94 * MiB;
constexpr size_t WS_WUP = 96 * MiB;
constexpr size_t WS_WDOWN = 224 * MiB;
constexpr size_t WS_BA = 352 * MiB;
constexpr size_t BA_SC = 0;
constexpr int SC_LD = T + 64;
constexpr size_t BA_O16 = 0;
constexpr size_t BA_U = 0;
constexpr size_t BA_AF = 0, BA_BF = 64 * MiB;
constexpr size_t BA_H16 = 128 * MiB;
constexpr size_t BA_PROJ = 160 * MiB;
constexpr size_t BA_XC = 224 * MiB;
constexpr size_t WS_QH = 616 * MiB, WS_KH = 632 * MiB, WS_VH = 636 * MiB, WS_IK = 640 * MiB, WS_SEL = 642 * MiB, WS_IQ = 650 * MiB, WS_PARTA = 686 * MiB, WS_PARTB = 687 * MiB, WS_BLKMAXD = 688 * MiB, WS_X16 = 692 * MiB, WS_END = 724 * MiB;
constexpr int CW_BAR = 4096;
constexpr size_t WS_BLKMAX = 682 * MiB;
constexpr size_t WS_RS = 7 * MiB + 512 * 1024, WS_CS = WS_RS + 64 * 1024;
constexpr size_t WS_RS2 = WS_RS + 128 * 1024, WS_CS2 = WS_RS + 192 * 1024, WS_CSUM = WS_RS + 208 * 1024;
constexpr size_t BA_U8 = 192 * MiB, BA_W8D = 176 * MiB;
constexpr size_t BA_A8 = 160 * MiB, BA_W8 = 176 * MiB;
constexpr size_t WS_ROWSQ = 256 * 1024;

constexpr int RING_BYTES = 131072;
constexpr int LDSCTL_OFF = RING_BYTES, MISC_OFF = LDSCTL_OFF + 320;
constexpr int LDS_BYTES = 155648;

#define GAS __attribute__((address_space(1)))
#define LAS __attribute__((address_space(3)))
typedef _Float16 h16;
typedef _Float16 h16x2 __attribute__((ext_vector_type(2)));
typedef _Float16 h16x4 __attribute__((ext_vector_type(4)));
typedef _Float16 h16x8 __attribute__((ext_vector_type(8)));
typedef unsigned v4u __attribute__((ext_vector_type(4)));
typedef unsigned v2u __attribute__((ext_vector_type(2)));
typedef float f32x4 __attribute__((ext_vector_type(4)));
#define LDS_WAIT() asm volatile("s_waitcnt lgkmcnt(0)" ::: "memory")
#define VM_WAIT() asm volatile("s_waitcnt vmcnt(0)" ::: "memory")
__device__ __forceinline__ unsigned pkh(float lo, float hi) { h16x2 v = {(h16)lo, (h16)hi}; return __builtin_bit_cast(unsigned, v); }
__device__ __forceinline__ float wave_sum(float v) {
#pragma unroll
    for (int o = 1; o < 64; o <<= 1) v += __shfl_xor(v, o);
    return v;
}
__device__ __forceinline__ float wave_max(float v) {
#pragma unroll
    for (int o = 1; o < 64; o <<= 1) v = fmaxf(v, __shfl_xor(v, o));
    return v;
}

#define XB_TMO      128
#define XB_XCNT(j)  (256  + 64 * (j))
#define XB_XSUB(j)  (1280 + 64 * (j))
#define XB_XGEN(j)  (2304 + 64 * (j))
#define XB_TOP      3328
#define XB_TOPGEN   3392
#define XCD_BAR_WORDS 3456
#define XB_SPIN_CAP (1u << 18)

__device__ __forceinline__ unsigned xb_ld(unsigned* p)              { return __hip_atomic_load(p, __ATOMIC_RELAXED, __HIP_MEMORY_SCOPE_AGENT); }
__device__ __forceinline__ unsigned xb_add(unsigned* p, unsigned v) { return __hip_atomic_fetch_add(p, v, __ATOMIC_RELAXED, __HIP_MEMORY_SCOPE_AGENT); }
__device__ __forceinline__ unsigned xb_xcc_id() { return (unsigned)__builtin_amdgcn_s_getreg((3 << 11) | 20) & 0xFu; }
#define XB_SPIN(cond, bar) do { unsigned _sp = 0; while (cond) { __builtin_amdgcn_s_sleep(1); \
    if ((++_sp & 255u) == 0u) { if (xb_ld(&(bar)[XB_TMO])) break; if (_sp > XB_SPIN_CAP) { atomicAdd(&(bar)[XB_TMO], 1u); break; } } } } while (0)

struct XcdBarrier { unsigned* bar; unsigned x; volatile LAS unsigned* st; };

__device__ __forceinline__ XcdBarrier xcd_barrier_post(unsigned* bar, volatile LAS unsigned* st) {
    XcdBarrier b; b.bar = bar; b.x = xb_xcc_id(); b.st = st;
    if (threadIdx.x == 0) (void)xb_add(&bar[XB_XCNT(b.x)], 1u);
    return b;
}
__device__ __forceinline__ void xcd_barrier_complete(unsigned* bar, unsigned x, unsigned& nloc, unsigned& nx) {
    const unsigned G = gridDim.x * gridDim.y * gridDim.z;
    unsigned sum, cnt, mine, sp = 0u;
    for (;;) {
        sum = 0u; cnt = 0u; mine = 0u;
#pragma unroll
        for (unsigned j = 0; j < 16; ++j) { const unsigned c = xb_ld(&bar[XB_XCNT(j)]); sum += c; cnt += (c > 0u) ? 1u : 0u; mine = (j == x) ? c : mine; }
        if (sum == G) break;
        __builtin_amdgcn_s_sleep(1);
        if ((++sp & 255u) == 0u) { if (xb_ld(&bar[XB_TMO])) break; if (sp > XB_SPIN_CAP) { atomicAdd(&bar[XB_TMO], 1u); break; } }
    }
    nloc = mine > 0u ? mine : 1u; nx = cnt > 0u ? cnt : 1u;
}
__device__ __forceinline__ void xcd_barrier(const XcdBarrier& b) {
    asm volatile("s_waitcnt vmcnt(0)" ::: "memory");
    __syncthreads();
    if (threadIdx.x == 0) {
        unsigned* bar = b.bar;
        __builtin_amdgcn_s_waitcnt(0);
        unsigned nloc = b.st[0], nx = b.st[1];
        if (nloc == 0u) { xcd_barrier_complete(bar, b.x, nloc, nx); b.st[0] = nloc; b.st[1] = nx; }
        const unsigned old = xb_add(&bar[XB_XSUB(b.x)], 1u);
        const unsigned gen = old / nloc;
        if (old + 1u == (gen + 1u) * nloc) {
            __builtin_amdgcn_fence(__ATOMIC_RELEASE, "agent");
            asm volatile("s_waitcnt vmcnt(0)" ::: "memory");
            const unsigned og = xb_add(&bar[XB_TOP], 1u);
            const unsigned tg = og / nx;
            if (og + 1u == (tg + 1u) * nx) xb_add(&bar[XB_TOPGEN], 1u);
            else XB_SPIN(xb_ld(&bar[XB_TOPGEN]) == tg, bar);
            __builtin_amdgcn_fence(__ATOMIC_ACQUIRE, "agent");
            xb_add(&bar[XB_XGEN(b.x)], 1u);
            asm volatile("s_waitcnt vmcnt(0)" ::: "memory");
        } else {
            XB_SPIN(xb_ld(&bar[XB_XGEN(b.x)]) == gen, bar);
            __builtin_amdgcn_fence(__ATOMIC_ACQUIRE, "agent");
            asm volatile("s_waitcnt vmcnt(0)" ::: "memory");
        }
    }
    __syncthreads();
}

__device__ __forceinline__ void tr_item(const float* src, int ldw, int nvalid, h16* dst, int ldd, LAS float* scr, int lane, unsigned* colmax = nullptr, const float* gk = nullptr) {
    const int nn = lane & 31; float v[32];
#pragma unroll
    for (int i = 0; i < 32; ++i) { const int kk = 2 * i + (lane >> 5); v[i] = (nn < nvalid) ? src[(size_t)kk * ldw + nn] * (gk ? gk[kk] : 1.0f) : 0.f; }
    __builtin_amdgcn_sched_barrier(0);
#pragma unroll
    for (int i = 0; i < 32; ++i) { const int kk = 2 * i + (lane >> 5); scr[kk * 33 + nn] = v[i]; }
    LDS_WAIT();
    const int c = lane & 7;
#pragma unroll
    for (int j = 0; j < 4; ++j) { const int n = (lane >> 3) + 8 * j; const LAS float* s = scr + (8 * c) * 33 + n;
        v4u o; o.x = pkh(s[0 * 33], s[1 * 33]); o.y = pkh(s[2 * 33], s[3 * 33]); o.z = pkh(s[4 * 33], s[5 * 33]); o.w = pkh(s[6 * 33], s[7 * 33]);
        *(v4u*)(dst + (size_t)n * ldd + 8 * c) = o;
        if (colmax) {
            float mx = fmaxf(fmaxf(fmaxf(fabsf(s[0 * 33]), fabsf(s[1 * 33])), fmaxf(fabsf(s[2 * 33]), fabsf(s[3 * 33]))), fmaxf(fmaxf(fabsf(s[4 * 33]), fabsf(s[5 * 33])), fmaxf(fabsf(s[6 * 33]), fabsf(s[7 * 33]))));
            mx = fmaxf(mx, __shfl_xor(mx, 1)); mx = fmaxf(mx, __shfl_xor(mx, 2)); mx = fmaxf(mx, __shfl_xor(mx, 4));
            if (c == 0) colmax[n] = __float_as_uint(mx); } }
    LDS_WAIT();
}

struct Ptrs {
    const float* x; const int* pos;
    const float *attn_norm, *attn_w_in, *attn_qn, *attn_kn, *attn_w_out;
    const float *rnn_norm, *rnn_w_in, *conv_w, *conv_b, *ga_w, *ga_b, *gx_w, *gx_b, *lam, *rnn_w_out;
    const float *pool_norm, *pool_w, *pool_b, *pool_scale;
    const float *mlp_norm, *mlp_w_up, *mlp_w_down;
    float* out; unsigned char* ws;
    int ph_lo, ph_hi;
};

#define CAS __attribute__((address_space(4)))
__device__ __forceinline__ const CAS Ptrs* kargs() { const CAS Ptrs* p = (const CAS Ptrs*)__builtin_amdgcn_kernarg_segment_ptr(); asm volatile("" : "+s"(p)); return p; }
__device__ __forceinline__ void p0_prologue(const CAS Ptrs* PP, LAS unsigned char* lds, int gw, int NGW, int wave, int lane, int gtid, int NGT) {
    LAS float* scr = (LAS float*)(lds + wave * 16384);
    unsigned char* ws = PP->ws;
    constexpr int I_WINA = 32 * 165, I_WOUTA = 32 * 64, I_WINR = 32 * 128, I_G = 4 * 8, I_WOUTR = 32 * 64, I_POOL = 8 * 16, I_UP = 32 * 256, I_DN = 128 * 64, I_Z = 384;
    constexpr int NITEMS = 2 * I_WINA + 2 * I_WOUTA + I_WINR + 16 * I_G + I_WOUTR + 4 * I_POOL + 4 * I_UP + 4 * I_DN + 2 * I_Z;
    for (int it = gw; it < NITEMS; it += NGW) {
        int r = it;
        if (r < 2 * I_WINA) { const int j = r / I_WINA; r -= j * I_WINA; const int kb = r / 165, nb = r % 165, n0 = 32 * nb; const int nv = (A_IN - n0) < 32 ? (A_IN - n0) : 32;
            tr_item(PP->attn_w_in + (size_t)j * D * A_IN + (size_t)(64 * kb) * A_IN + n0, A_IN, nv, (h16*)(ws + WS_WINA) + (size_t)j * A_INP * D + (size_t)n0 * D + 64 * kb, D, scr, lane, nullptr, PP->attn_norm + (size_t)j * D + 64 * kb); continue; }
        r -= 2 * I_WINA;
        if (r < 2 * I_WOUTA) { const int j = r / I_WOUTA; r -= j * I_WOUTA; const int kb = r / 64, nb = r % 64;
            tr_item(PP->attn_w_out + (size_t)j * D * D + (size_t)(64 * kb) * D + 32 * nb, D, 32, (h16*)(ws + WS_WOUTA) + (size_t)j * D * D + (size_t)(32 * nb) * D + 64 * kb, D, scr, lane); continue; }
        r -= 2 * I_WOUTA;
        if (r < I_WINR) { const int kb = r / 128, nb = r % 128;
            tr_item(PP->rnn_w_in + (size_t)(64 * kb) * 4096 + 32 * nb, 4096, 32, (h16*)(ws + WS_WINR) + (size_t)(32 * nb) * D + 64 * kb, D, scr, lane, nullptr, PP->rnn_norm + 64 * kb); continue; }
        r -= I_WINR;
        if (r < 16 * I_G) { const int mi = r / I_G; r -= mi * I_G; const int which = mi >> 3, blk = mi & 7, kb = r / 8, nb = r % 8, d0 = 32 * nb;
            const float* src = (which ? PP->gx_w : PP->ga_w) + (size_t)blk * 65536 + (size_t)(64 * kb) * 256 + d0;
            const int drow = 256 * (2 * blk + (d0 >> 7)) + 128 * which + (d0 & 127);
            tr_item(src, 256, 32, (h16*)(ws + WS_WGR) + (size_t)drow * 256 + 64 * kb, 256, scr, lane); continue; }
        r -= 16 * I_G;
        if (r < I_WOUTR) { const int kb = r / 64, nb = r % 64;
            tr_item(PP->rnn_w_out + (size_t)(64 * kb) * D + 32 * nb, D, 32, (h16*)(ws + WS_WOUTR) + (size_t)(32 * nb) * D + 64 * kb, D, scr, lane); continue; }
        r -= I_WOUTR;
        if (r < 4 * I_POOL) { const int g = r / I_POOL; r -= g * I_POOL; const int kb = r / 16, nb = r % 16;
            tr_item(PP->pool_w + (size_t)g * 262144 + (size_t)(64 * kb) * 512 + 32 * nb, 512, 32, (h16*)(ws + WS_WPOOL) + (size_t)(512 * g + 32 * nb) * 512 + 64 * kb, 512, scr, lane); continue; }
        r -= 4 * I_POOL;
        if (r < 4 * I_UP) { const int i = r / I_UP; r -= i * I_UP; const int kb = r / 256, nb = r % 256;
            tr_item(PP->mlp_w_up + (size_t)i * D * FF + (size_t)(64 * kb) * FF + 32 * nb, FF, 32, (h16*)(ws + WS_WUP) + (size_t)i * D * FF + (size_t)(32 * nb) * D + 64 * kb, D, scr, lane, (unsigned*)(ws + WS_BLKMAX) + ((size_t)i * 32 + kb) * FF + 32 * nb, PP->mlp_norm + (size_t)i * D + 64 * kb); continue; }
        r -= 4 * I_UP;
        if (r < 4 * I_DN) { const int i = r / I_DN; r -= i * I_DN; const int kb = r / 64, nb = r % 64;
            tr_item(PP->mlp_w_down + (size_t)i * D * FF + (size_t)(64 * kb) * D + 32 * nb, D, 32, (h16*)(ws + WS_WDOWN) + (size_t)i * D * FF + ((size_t)kb * D + 32 * nb) * 64, 64, scr, lane, (unsigned*)(ws + WS_BLKMAXD) + ((size_t)i * 128 + kb) * D + 32 * nb); continue; }
        r -= 4 * I_DN;
        { const int j = r / I_Z; r -= j * I_Z;
            v4u* z = (v4u*)((h16*)(ws + WS_WINA) + (size_t)j * A_INP * D + (size_t)5280 * D); z[(size_t)r * 64 + lane] = (v4u){0u, 0u, 0u, 0u}; }
    }
    for (int e = gtid; e < T * 96; e += NGT) {
        const int t = e / 96, i = e % 96; const bool big = i < 64; const int fi = big ? i : i - 64;
        const double base = big ? 0.8659643233600653 : 0.7498942093324559;
        double inv = 1.0; for (int k = 0; k < fi; ++k) inv *= base;
        const double ang = (double)PP->pos[t] * inv;
        const double n = __builtin_rint(ang * 0.15915494309189535); const double rr = ang - n * 6.283185307179586 - n * 2.4492935982947064e-16;
        const double r2 = rr * rr; double sn = 1.0, cs = 1.0;
#pragma unroll
        for (int k = 14; k >= 1; --k) { sn = 1.0 - sn * r2 * (1.0 / (double)((2 * k) * (2 * k + 1))); cs = 1.0 - cs * r2 * (1.0 / (double)((2 * k - 1) * (2 * k))); }
        sn *= rr;
        if (big) { ((float*)(ws + WS_COS128))[t * 64 + fi] = (float)cs; ((float*)(ws + WS_SIN128))[t * 64 + fi] = (float)sn; }
        else { ((float*)(ws + WS_COS64))[t * 32 + fi] = (float)cs; ((float*)(ws + WS_SIN64))[t * 32 + fi] = (float)sn; }
    }
}

__device__ __forceinline__ void quant_rows(const h16* src, int nrows, signed char* dst, float* scale_out, const float* rowsq, const unsigned* colmax, int gw, int NGW, int lane) {
    h16x8 vn[4]; float cmn = 0.f;
    if (gw < nrows) {
#pragma unroll
        for (int j = 0; j < 4; ++j) vn[j] = *(const h16x8*)(src + (size_t)gw * D + 512 * j + 8 * lane);
        if (colmax) cmn = lane < 32 ? __uint_as_float(colmax[(size_t)lane * FF + gw]) : 0.f; }
    for (int r = gw; r < nrows; r += NGW) {
        h16x8 v[4]; const float cm = cmn;
#pragma unroll
        for (int j = 0; j < 4; ++j) v[j] = vn[j];
        const int rn = r + NGW;
        if (rn < nrows) {
#pragma unroll
            for (int j = 0; j < 4; ++j) vn[j] = *(const h16x8*)(src + (size_t)rn * D + 512 * j + 8 * lane);
            if (colmax) cmn = lane < 32 ? __uint_as_float(colmax[(size_t)lane * FF + rn]) : 0.f; }
        float mx;
        if (colmax) mx = wave_max(cm);
        else { mx = 0.f;
#pragma unroll
            for (int j = 0; j < 4; ++j)
#pragma unroll
                for (int e = 0; e < 8; ++e) mx = fmaxf(mx, fabsf((float)v[j][e]));
            mx = wave_max(mx); }
        const float step = mx > 0.f ? mx * (1.0f / 127.0f) : 1.0f, inv = 1.0f / step;
        if (lane == 0) { float sc = step;
            if (rowsq) { const f32x4* pp = (const f32x4*)(rowsq + (size_t)r * 32); f32x4 a4 = pp[0];
#pragma unroll
                for (int q = 1; q < 8; ++q) a4 += pp[q];
                sc = step / sqrtf(((a4[0] + a4[1]) + (a4[2] + a4[3])) * (1.0f / D) + EPS); }
            scale_out[r] = sc; }
#pragma unroll
        for (int j = 0; j < 4; ++j) { unsigned w[2];
#pragma unroll
            for (int hh = 0; hh < 2; ++hh) { unsigned p = 0u;
#pragma unroll
                for (int e = 0; e < 4; ++e) { int qv = (int)rintf((float)v[j][4 * hh + e] * inv); qv = qv > 127 ? 127 : (qv < -127 ? -127 : qv); p |= ((unsigned)qv & 255u) << (8 * e); }
                w[hh] = p; }
            *(v2u*)(dst + (size_t)r * D + 512 * j + 8 * lane) = (v2u){w[0], w[1]}; }
    }
}
template <bool UNSIGNED>
__device__ __forceinline__ void quant_kblk(const h16* src, int R, signed char* dst, float* scale_out, float* csum, const unsigned* blkmax, int gw, int NGW, int lane) {
    const int bsub = lane >> 3, c8 = (lane & 7) * 8;
    h16x8 vn[16]; float cmn = 0.f;
#define QK_LOAD(r_) do { _Pragma("unroll") for (int i = 0; i < 16; ++i) vn[i] = *(const h16x8*)(src + ((size_t)(8 * i + bsub) * R + (r_)) * 64 + c8); \
        if (!UNSIGNED) cmn = fmaxf(__uint_as_float(blkmax[(size_t)lane * R + (r_)]), __uint_as_float(blkmax[(size_t)(64 + lane) * R + (r_)])); } while (0)
    if (gw < R) QK_LOAD(gw);
    for (int r = gw; r < R; r += NGW) {
        h16x8 v[16]; const float cm = cmn;
#pragma unroll
        for (int i = 0; i < 16; ++i) v[i] = vn[i];
        if (r + NGW < R) QK_LOAD(r + NGW);
        float mx;
        if (UNSIGNED) { mx = 0.f;
#pragma unroll
            for (int i = 0; i < 16; ++i)
#pragma unroll
                for (int e = 0; e < 8; ++e) mx = fmaxf(mx, (float)v[i][e]);
            mx = wave_max(mx); }
        else mx = wave_max(cm);
        const float step = mx > 0.f ? mx * (UNSIGNED ? 1.0f / 255.0f : 1.0f / 127.0f) : 1.0f, inv = 1.0f / step;
        int ssum = 0;
#pragma unroll
        for (int i = 0; i < 16; ++i) { unsigned w[2];
#pragma unroll
            for (int hh = 0; hh < 2; ++hh) { unsigned p = 0u;
#pragma unroll
                for (int e = 0; e < 4; ++e) { int qv = (int)rintf((float)v[i][4 * hh + e] * inv);
                    if (UNSIGNED) { qv = qv > 255 ? 255 : (qv < 0 ? 0 : qv); qv -= 128; } else { qv = qv > 127 ? 127 : (qv < -127 ? -127 : qv); ssum += qv; }
                    p |= ((unsigned)qv & 255u) << (8 * e); }
                w[hh] = p; }
            const int b = 8 * i + bsub;
            *(v2u*)(dst + ((size_t)(b >> 1) * R + r) * 128 + 64 * (b & 1) + c8) = (v2u){w[0], w[1]}; }
        if (!UNSIGNED) { float fs = (float)ssum; fs = wave_sum(fs); if (lane == 0) csum[r] = fs; }
        if (lane == 0) scale_out[r] = step;
    }
#undef QK_LOAD
}
__device__ __forceinline__ void norm0_phase(const float* src, h16* dst, float* rowsq, int gw, int NGW, int lane) {
    for (int m = gw; m < T; m += NGW) {
        const f32x4* xr = (const f32x4*)(src + (size_t)m * D) + lane;
        f32x4 v[8]; float s = 0.f;
#pragma unroll
        for (int j = 0; j < 8; ++j) { v[j] = xr[64 * j]; s += (v[j].x * v[j].x + v[j].y * v[j].y) + (v[j].z * v[j].z + v[j].w * v[j].w); }
        s = wave_sum(s); if (lane == 0) rowsq[m] = s;
        v2u* o = (v2u*)(dst + (size_t)m * D) + lane;
#pragma unroll
        for (int j = 0; j < 8; ++j) { v2u w; w.x = pkh(v[j].x, v[j].y); w.y = pkh(v[j].z, v[j].w); o[64 * j] = w; }
    }
}

__device__ __forceinline__ unsigned char f8(float x) { return (unsigned char)(__builtin_amdgcn_cvt_pk_fp8_f32(x, x, 0, false) & 0xFF); }
__device__ __forceinline__ float sum16(float v) { v += __shfl_xor(v, 1); v += __shfl_xor(v, 2); v += __shfl_xor(v, 4); v += __shfl_xor(v, 8); return v; }
__device__ __forceinline__ unsigned f8x4(float a, float b, float c, float d) { int p = __builtin_amdgcn_cvt_pk_fp8_f32(a, b, 0, false); p = __builtin_amdgcn_cvt_pk_fp8_f32(c, d, p, true); return (unsigned)p; }
__device__ __forceinline__ void dsa_post_phase(const h16* PROJ, const float* qn, const float* kn, const float* c128, const float* s128, const float* c64, const float* s64,
                                               unsigned char* Q8, unsigned char* K8, unsigned char* V8, h16* IQ, h16* IK, float* IW, int gw, int NGW, int lane) {
    const int hh = lane >> 4, m = lane & 15;
    const f32x4 gqa = *(const f32x4*)(qn + 4 * m), gqb = *(const f32x4*)(qn + 64 + 4 * m), gka = *(const f32x4*)(kn + 4 * m), gkb = *(const f32x4*)(kn + 64 + 4 * m);
    const bool rot = m < 8; const int ioa = rot ? 4 * m : 32 + 4 * m, iob = ioa + 32;
    for (int t = gw; t < T; t += NGW) {
        const h16* pr = PROJ + (size_t)t * A_INP;
        const f32x4 c = *(const f32x4*)(c128 + t * 64 + 4 * m), s = *(const f32x4*)(s128 + t * 64 + 4 * m);
        f32x4 ci = {1.f, 1.f, 1.f, 1.f}, si = {0.f, 0.f, 0.f, 0.f};
        if (rot) { ci = *(const f32x4*)(c64 + t * 32 + 4 * m); si = *(const f32x4*)(s64 + t * 32 + 4 * m); }
#pragma unroll
        for (int p = 0; p < 5; ++p) {
            const int cb = (p < 4 ? C_Q + (4 * p + hh) * HD : C_K + hh * HD) + 4 * m;
            const h16x4 a4 = *(const h16x4*)(pr + cb), b4 = *(const h16x4*)(pr + cb + 64);
            float a[4], b[4], ss = 0.f;
#pragma unroll
            for (int e = 0; e < 4; ++e) { a[e] = (float)a4[e]; b[e] = (float)b4[e]; ss += a[e] * a[e] + b[e] * b[e]; }
            const float rstd = 1.0f / sqrtf(sum16(ss) * (1.0f / HD) + EPS);
            float oa[4], ob[4];
#pragma unroll
            for (int e = 0; e < 4; ++e) { const float ya = a[e] * rstd * (p < 4 ? gqa[e] : gka[e]), yb = b[e] * rstd * (p < 4 ? gqb[e] : gkb[e]); oa[e] = ya * c[e] - yb * s[e]; ob[e] = yb * c[e] + ya * s[e]; }
            unsigned char* o8 = (p < 4 ? Q8 + (size_t)t * D + (4 * p + hh) * HD : K8 + (size_t)t * 512 + hh * HD) + 4 * m;
            *(unsigned*)o8 = f8x4(oa[0], oa[1], oa[2], oa[3]); *(unsigned*)(o8 + 64) = f8x4(ob[0], ob[1], ob[2], ob[3]);
        }
        { const h16x8 vv = *(const h16x8*)(pr + C_V + lane * 8);
          *(v2u*)(V8 + (size_t)t * 512 + lane * 8) = (v2u){f8x4((float)vv[0], (float)vv[1], (float)vv[2], (float)vv[3]), f8x4((float)vv[4], (float)vv[5], (float)vv[6], (float)vv[7])}; }
#pragma unroll
        for (int p = 0; p < 5; ++p) {
            const int hd = p < 4 ? 4 * p + hh : 0; const int cb = p < 4 ? C_IQ + hd * HD : C_IK;
            const h16x4 a4 = *(const h16x4*)(pr + cb + ioa), b4 = *(const h16x4*)(pr + cb + iob);
            h16x4 oa, ob;
#pragma unroll
            for (int e = 0; e < 4; ++e) { const float av = (float)a4[e], bv = (float)b4[e]; oa[e] = (h16)(av * ci[e] - bv * si[e]); ob[e] = (h16)(bv * ci[e] + av * si[e]); }
            if (p < 4) { *(h16x4*)(IQ + (size_t)t * D + hd * HD + ioa) = oa; *(h16x4*)(IQ + (size_t)t * D + hd * HD + iob) = ob; }
            else if (hh == 0) { *(h16x4*)(IK + (size_t)t * HD + ioa) = oa; *(h16x4*)(IK + (size_t)t * HD + iob) = ob; }
        }
        if (lane < 16) IW[t * 16 + lane] = (float)pr[C_IW + lane] * 0.02209708691207961f;
    }
}

__device__ __forceinline__ float relu_i(float x) { const int b = __float_as_int(x); return __int_as_float(b > 0 ? b : 0); }
constexpr int IDX_ITEMS = 8320, IDX_ROWB = 272, IDX_TILEB = 128 * IDX_ROWB;
__device__ __forceinline__ void idx_decode(int L, int& qb, int& kc) {
    int m = (int)((sqrtf(1.0f + 2.0f * (float)L) - 1.0f) * 0.5f);
    while (2 * (m + 1) * (m + 2) <= L) ++m;
    while (2 * m * (m + 1) > L) --m;
    const int rem = L - 2 * m * (m + 1); qb = 4 * m + rem / (m + 1); kc = rem % (m + 1);
}
__device__ __forceinline__ void idx_scores_phase(const h16* IQ, const h16* IK, const float* IW, float* SC, LAS unsigned char* lds, int wg, int G, int tid, int wave, int lane) {
    const int L0 = (int)(((long)IDX_ITEMS * wg) / G), L1 = (int)(((long)IDX_ITEMS * (wg + 1)) / G);
    if (L0 >= L1) return;
    int qb, kc; idx_decode(L0, qb, kc);
    const int fr = lane & 15, fq = lane >> 4;
    h16x8 st[4];
#define IDX_LOAD(kc_) do { _Pragma("unroll") for (int i = 0; i < 4; ++i) { const int p = tid + 512 * i; st[i] = *(const h16x8*)(IK + (size_t)((kc_) * 128 + (p >> 4)) * HD + (p & 15) * 8); } } while (0)
#define IDX_WRITE(buf_) do { _Pragma("unroll") for (int i = 0; i < 4; ++i) { const int p = tid + 512 * i; *(LAS h16x8*)(lds + (buf_) * IDX_TILEB + (p >> 4) * IDX_ROWB + (p & 15) * 16) = st[i]; } } while (0)
    IDX_LOAD(kc); IDX_WRITE(0);
    __syncthreads();
    h16x8 a[4][4]; f32x4 w4[4]; int cur_qb = -1; int par = 0;
    for (int L = L0; L < L1; ++L) {
        int qbn = qb, kcn = kc + 1; if (kcn > (qb >> 2)) { kcn = 0; qbn = qb + 1; }
        const bool more = (L + 1 < L1);
        if (qb != cur_qb) { cur_qb = qb; const int tq = 32 * qb + 4 * wave;
#pragma unroll
            for (int q = 0; q < 4; ++q) {
#pragma unroll
                for (int ks = 0; ks < 4; ++ks) a[q][ks] = *(const h16x8*)(IQ + (size_t)(tq + q) * D + fr * HD + ks * 32 + fq * 8);
                w4[q] = *(const f32x4*)(IW + (size_t)(tq + q) * 16 + 4 * fq); } }
        { const int kcp = more ? kcn : kc; IDX_LOAD(kcp); }
        const LAS unsigned char* bb = lds + par * IDX_TILEB + fr * IDX_ROWB + fq * 16;
        float pq[4][4];
#ifdef IDX_REP
#pragma unroll 1
        for (int irep = 0; irep < IDX_REP; ++irep)
#endif
        h16x8 bq[2][4];
#pragma unroll
        for (int ks = 0; ks < 4; ++ks) bq[0][ks] = *(const LAS h16x8*)(bb + ks * 64);
#pragma unroll
        for (int kt = 0; kt < 8; ++kt) {
            if (kt + 1 < 8) {
#pragma unroll
                for (int ks = 0; ks < 4; ++ks) bq[(kt + 1) & 1][ks] = *(const LAS h16x8*)(bb + (kt + 1) * 16 * IDX_ROWB + ks * 64);
                __builtin_amdgcn_sched_barrier(0); }
            const h16x8 (&b)[4] = bq[kt & 1];
#pragma unroll
            for (int q = 0; q < 4; ++q) { f32x4 acc = {0.f, 0.f, 0.f, 0.f};
#pragma unroll
                for (int ks = 0; ks < 4; ++ks) acc = __builtin_amdgcn_mfma_f32_16x16x32_f16(a[q][ks], b[ks], acc, 0, 0, 0);
                pq[q][kt & 3] = w4[q][0] * relu_i(acc[0]) + w4[q][1] * relu_i(acc[1]) + w4[q][2] * relu_i(acc[2]) + w4[q][3] * relu_i(acc[3]); }
            if ((kt & 3) == 3) { const int tq = 32 * qb + 4 * wave;
#pragma unroll
                for (int q = 0; q < 4; ++q) {
                    const auto r02 = __builtin_amdgcn_permlane32_swap(__float_as_uint(pq[q][0]), __float_as_uint(pq[q][2]), false, false);
                    const auto r13 = __builtin_amdgcn_permlane32_swap(__float_as_uint(pq[q][1]), __float_as_uint(pq[q][3]), false, false);
                    const float a02 = __uint_as_float(r02[0]) + __uint_as_float(r02[1]), a13 = __uint_as_float(r13[0]) + __uint_as_float(r13[1]);
                    const float keep = (fq & 1) ? a13 : a02, send = (fq & 1) ? a02 : a13;
                    SC[(size_t)(tq + q) * SC_LD + kc * 128 + 64 * (kt >> 2) + lane] = keep + __shfl_xor(send, 16); } }
        }
        IDX_WRITE(par ^ 1);
        asm volatile("s_waitcnt lgkmcnt(0)" ::: "memory"); __builtin_amdgcn_s_barrier(); asm volatile("" ::: "memory");
        par ^= 1; qb = qbn; kc = kcn;
    }
#undef IDX_LOAD
#undef IDX_WRITE
}

template <int NR>
__device__ __forceinline__ unsigned kth_largest(const unsigned (&u)[NR], int K) {
    unsigned prefix = 0u;
#pragma unroll 1
    for (int bit = 31; bit >= 0; --bit) { const unsigned cand = prefix | (1u << bit); int cnt = 0;
#pragma unroll
        for (int i = 0; i < NR; ++i) { cnt += __builtin_popcountll(__ballot(u[i] >= cand)); if ((i & 31) == 31) __builtin_amdgcn_sched_barrier(0); }
        if (cnt >= K) prefix = cand; }
    return prefix;
}
template <int NR, bool ARR>
__device__ __forceinline__ void emit_topk(const unsigned (&u)[NR], unsigned thr_in, int* sel, const int (&keys)[ARR ? NR : 1], int lane) {
    unsigned thr = thr_in; int cgt = 0;
#pragma unroll
    for (int i = 0; i < NR; ++i) { cgt += __builtin_popcountll(__ballot(u[i] > thr)); if ((i & 7) == 7) __builtin_amdgcn_sched_barrier(0); }
    const int need = TOPK - cgt;
    asm volatile("" : "+s"(thr));
    int base = 0, eqseen = 0;
#pragma unroll
    for (int i = 0; i < NR; ++i) {
        const bool gt = u[i] > thr, eq = u[i] == thr;
        const unsigned long long eb = __ballot(eq);
        const int erank = eqseen + (int)__builtin_amdgcn_mbcnt_hi((unsigned)(eb >> 32), __builtin_amdgcn_mbcnt_lo((unsigned)eb, 0u));
        const bool take = gt || (eq && erank < need);
        const unsigned long long tb = __ballot(take);
        const int pos = base + (int)__builtin_amdgcn_mbcnt_hi((unsigned)(tb >> 32), __builtin_amdgcn_mbcnt_lo((unsigned)tb, 0u));
        if (take) sel[pos] = ARR ? keys[ARR ? i : 0] : 64 * i + lane;
        base += __builtin_popcountll(tb); eqseen += __builtin_popcountll(eb);
        __builtin_amdgcn_sched_barrier(0);
    }
}
constexpr int TK_CAP = 768, TK_TARGET = 448;
template <int NREG>
__device__ __forceinline__ void topk_load_row(unsigned (&u)[NREG], const float* sc_in, int t_in, int lane) {
    static_assert(NREG % 16 == 0, "chunks of 16 registers");
#pragma unroll
    for (int c = 0; c < NREG / 16; ++c) {
        const GAS float* pc = (const GAS float*)(sc_in + 1024 * c); asm volatile("" : "+s"(pc));
#pragma unroll
        for (int k = 0; k < 16; ++k) u[16 * c + k] = __float_as_uint(pc[64 * k + lane]);
    }
#pragma unroll
    for (int c = 0; c < NREG / 16; ++c) {
        int tl = t_in - 1024 * c; asm volatile("" : "+s"(tl));
#pragma unroll
        for (int k = 0; k < 16; ++k) { const unsigned b = u[16 * c + k]; const unsigned mk = (b >> 31) ? 0xFFFFFFFFu : 0x80000000u; u[16 * c + k] = (lane <= tl - 64 * k) ? (b ^ mk) : 0u; }
        __builtin_amdgcn_sched_barrier(0);
    }
}
template <int NREG>
__device__ __forceinline__ void topk_row(const float* sc_in, int t_in, int* sel, int lane_in, LAS unsigned long long* cand) {
    int lane = lane_in; asm volatile("" : "+v"(lane));
    if constexpr (NREG >= 64) {
        int cn = 0;
        {   unsigned u[NREG];
            topk_load_row<NREG>(u, sc_in, t_in, lane);
            constexpr int NS = NREG / 8;
            unsigned us[NS]; int nsv = 0;
#pragma unroll
            for (int s = 0; s < NS; ++s) { us[s] = u[8 * s]; const int rem = t_in + 1 - 512 * s; nsv += rem < 0 ? 0 : (rem > 64 ? 64 : rem); }
            int Ks = (TK_TARGET * nsv) / (t_in + 1); Ks = Ks < 1 ? 1 : Ks;
            unsigned tau = kth_largest<NS>(us, Ks);
            asm volatile("" : "+s"(tau));
#pragma unroll
            for (int c = 0; c < NREG / 16; ++c) {
                int kb = 1024 * c + lane; asm volatile("" : "+v"(kb));
#pragma unroll
                for (int k = 0; k < 16; ++k) { const int i = 16 * c + k; const bool m = u[i] >= tau && tau != 0u; const unsigned long long mb = __ballot(m);
                    const int pos = cn + (int)__builtin_amdgcn_mbcnt_hi((unsigned)(mb >> 32), __builtin_amdgcn_mbcnt_lo((unsigned)mb, 0u));
                    if (m && pos < TK_CAP) cand[pos] = ((unsigned long long)u[i] << 32) | (unsigned)(kb + 64 * k);
                    cn += __builtin_popcountll(mb); if ((k & 3) == 3) __builtin_amdgcn_sched_barrier(0); }
            }
        }
        asm volatile("" : "+s"(cn));
        if (cn >= TOPK && cn <= TK_CAP) {
            LDS_WAIT();
            unsigned cu[TK_CAP / 64]; int ck[TK_CAP / 64];
#pragma unroll
            for (int k = 0; k < TK_CAP / 64; ++k) { const int ix = 64 * k + lane; const unsigned long long v = cand[ix]; cu[k] = ix < cn ? (unsigned)(v >> 32) : 0u; ck[k] = (int)(unsigned)v; }
            const unsigned thr = kth_largest<TK_CAP / 64>(cu, TOPK);
            emit_topk<TK_CAP / 64, true>(cu, thr, sel, ck, lane);
            LDS_WAIT();
            return;
        }
    }
    {   unsigned u[NREG];
        topk_load_row<NREG>(u, sc_in, t_in, lane);
        const unsigned thr = kth_largest<NREG>(u, TOPK);
        const int nokeys[1] = {0}; emit_topk<NREG, false>(u, thr, sel, nokeys, lane); }
}
__device__ __forceinline__ void topk_phase(const float* SC, int* SEL, LAS unsigned char* lds, int gw, int NGW, int wave, int lane) {
    LAS unsigned long long* cand = (LAS unsigned long long*)(lds + wave * (TK_CAP * 8));
    for (int t = gw; t < T; t += NGW) {
        const float* sc = SC + (size_t)t * SC_LD; int* sel = SEL + (size_t)t * TOPK;
        if (t < TOPK) {
#pragma unroll
            for (int j = 0; j < 4; ++j) { const int k = lane + 64 * j; sel[k] = (k <= t) ? k : -1; }
        } else if (t < 2048) topk_row<32>(sc, t, sel, lane, cand);
        else if (t < 4096) topk_row<64>(sc, t, sel, lane, cand);
        else if (t < 6144) topk_row<96>(sc, t, sel, lane, cand);
        else topk_row<128>(sc, t, sel, lane, cand);
    }
}

__device__ __forceinline__ float dot8(h16x8 a, h16x8 b, float c) {
#if __has_builtin(__builtin_amdgcn_fdot2)
    c = __builtin_amdgcn_fdot2((h16x2){a[0], a[1]}, (h16x2){b[0], b[1]}, c, false); c = __builtin_amdgcn_fdot2((h16x2){a[2], a[3]}, (h16x2){b[2], b[3]}, c, false);
    c = __builtin_amdgcn_fdot2((h16x2){a[4], a[5]}, (h16x2){b[4], b[5]}, c, false); c = __builtin_amdgcn_fdot2((h16x2){a[6], a[7]}, (h16x2){b[6], b[7]}, c, false);
#else
#pragma unroll
    for (int e = 0; e < 8; ++e) c += (float)a[e] * (float)b[e];
#endif
    return c;
}
__device__ __forceinline__ void attn_phase(const h16* QH, const h16* KH, const h16* VH, const int* SEL, h16* O, LAS unsigned char* lds, int wg, int G, int wave, int lane) {
    LAS h16* qs = (LAS h16*)(lds + wave * 6144);
    LAS float* ps = (LAS float*)(lds + wave * 6144 + 1024);
    LAS int* is = (LAS int*)(lds + wave * 6144 + 5120);
    const int grp = lane >> 4, c = lane & 15;
    for (int L = wg; L < (T / 8) * NKV; L += G) {
        const int g = L & 3, t = 8 * (L >> 2) + wave;
        int idx[4];
#pragma unroll
        for (int j = 0; j < 4; ++j) idx[j] = SEL[(size_t)t * TOPK + lane + 64 * j];
        *(LAS h16x8*)(qs + lane * 8) = *(const h16x8*)(QH + (size_t)t * D + g * 512 + lane * 8);
#pragma unroll
        for (int j = 0; j < 4; ++j) is[lane + 64 * j] = idx[j] < 0 ? 0 : idx[j];
        LDS_WAIT();
        float sc[4][4];
#pragma unroll
        for (int j = 0; j < 4; ++j) { const h16* krow = KH + (size_t)(idx[j] < 0 ? 0 : idx[j]) * 512 + g * HD; h16x8 kf[16];
#pragma unroll
            for (int cc = 0; cc < 16; ++cc) kf[cc] = *(const h16x8*)(krow + 8 * cc);
#pragma unroll
            for (int hh = 0; hh < 4; ++hh) { float s = 0.f;
#pragma unroll
                for (int cc = 0; cc < 16; ++cc) s = dot8(kf[cc], *(const LAS h16x8*)(qs + hh * HD + 8 * cc), s);
                sc[j][hh] = (idx[j] < 0) ? -__builtin_inff() : s * 0.08838834764831845f; }
            __builtin_amdgcn_sched_barrier(0); }
#pragma unroll
        for (int hh = 0; hh < 4; ++hh) {
            const float mx = wave_max(fmaxf(fmaxf(sc[0][hh], sc[1][hh]), fmaxf(sc[2][hh], sc[3][hh])));
            float e0 = __expf(sc[0][hh] - mx), e1 = __expf(sc[1][hh] - mx), e2 = __expf(sc[2][hh] - mx), e3 = __expf(sc[3][hh] - mx);
            const float inv = 1.0f / wave_sum((e0 + e1) + (e2 + e3));
            sc[0][hh] = e0 * inv; sc[1][hh] = e1 * inv; sc[2][hh] = e2 * inv; sc[3][hh] = e3 * inv; }
#pragma unroll
        for (int j = 0; j < 4; ++j) *(LAS f32x4*)(ps + 4 * (lane + 64 * j)) = (f32x4){sc[j][0], sc[j][1], sc[j][2], sc[j][3]};
        LDS_WAIT();
        float acc[4][8];
#pragma unroll
        for (int hh = 0; hh < 4; ++hh)
#pragma unroll
            for (int e = 0; e < 8; ++e) acc[hh][e] = 0.f;
#pragma unroll 4
        for (int it = 0; it < 64; ++it) { const int kk = 4 * it + grp; const int ik = is[kk]; const f32x4 p4 = *(const LAS f32x4*)(ps + 4 * kk);
            const h16x8 v8 = *(const h16x8*)(VH + (size_t)ik * 512 + g * HD + 8 * c);
#pragma unroll
            for (int hh = 0; hh < 4; ++hh)
#pragma unroll
                for (int e = 0; e < 8; ++e) acc[hh][e] += p4[hh] * (float)v8[e];
            if ((it & 3) == 3) __builtin_amdgcn_sched_barrier(0); }
#pragma unroll
        for (int hh = 0; hh < 4; ++hh)
#pragma unroll
            for (int e = 0; e < 8; ++e) { float v = acc[hh][e]; v += __shfl_xor(v, 16); v += __shfl_xor(v, 32); acc[hh][e] = v; }
        float o8[8];
#pragma unroll
        for (int e = 0; e < 8; ++e) o8[e] = grp == 0 ? acc[0][e] : grp == 1 ? acc[1][e] : grp == 2 ? acc[2][e] : acc[3][e];
        v4u w; w.x = pkh(o8[0], o8[1]); w.y = pkh(o8[2], o8[3]); w.z = pkh(o8[4], o8[5]); w.w = pkh(o8[6], o8[7]);
        *(v4u*)(O + (size_t)t * D + (4 * g + grp) * HD + 8 * c) = w;
        LDS_WAIT();
    }
}

__device__ __forceinline__ void conv_phase(const h16* PROJ, const float* cw, const float* cb, h16* XC, int gtid, int NGT) {
    h16x8 xn[4];
#define CONV_LOAD(i_) do { const int c8_ = ((i_) & 255) * 8, t_ = (i_) >> 8; _Pragma("unroll") for (int j = 0; j < 4; ++j) { const int tt = t_ - 3 + j; xn[j] = *(const h16x8*)(PROJ + (size_t)(tt < 0 ? 0 : tt) * 4096 + 2048 + c8_); } } while (0)
    if (gtid < T * 256) CONV_LOAD(gtid);
    for (int i = gtid; i < T * 256; i += NGT) { const int c8 = (i & 255) * 8, t = i >> 8;
        h16x8 xv[4];
#pragma unroll
        for (int j = 0; j < 4; ++j) xv[j] = xn[j];
        if (i + NGT < T * 256) CONV_LOAD(i + NGT);
        float acc[8];
#pragma unroll
        for (int e = 0; e < 8; ++e) acc[e] = cb[c8 + e];
#pragma unroll
        for (int j = 0; j < 4; ++j) { const int tt = t - 3 + j; if (tt >= 0) {
            const f32x4 w0 = *(const f32x4*)(cw + j * 2048 + c8), w1 = *(const f32x4*)(cw + j * 2048 + c8 + 4);
#pragma unroll
            for (int e = 0; e < 4; ++e) { acc[e] += (float)xv[j][e] * w0[e]; acc[4 + e] += (float)xv[j][4 + e] * w1[e]; } } }
        v4u w; w.x = pkh(acc[0], acc[1]); w.y = pkh(acc[2], acc[3]); w.z = pkh(acc[4], acc[5]); w.w = pkh(acc[6], acc[7]);
        *(v4u*)(XC + (size_t)t * 2048 + c8) = w; }
#undef CONV_LOAD
}
constexpr int SCAN_LC = 64, SCAN_NCH = T / SCAN_LC;
__device__ __forceinline__ f32x4 ld_a4(const h16* LA, size_t o) { const h16x4 v = *(const h16x4*)(LA + o); return (f32x4){__expf((float)v[0]), __expf((float)v[1]), __expf((float)v[2]), __expf((float)v[3])}; }
__device__ __forceinline__ f32x4 ld_b4(const h16* BF, size_t o) { const h16x4 v = *(const h16x4*)(BF + o); return (f32x4){(float)v[0], (float)v[1], (float)v[2], (float)v[3]}; }
__device__ __forceinline__ void scan_agg_phase(const h16* AF, const h16* BF, float* AGGA, float* AGGB, int gtid, int NGT) {
    for (int i = gtid; i < SCAN_NCH * 512; i += NGT) { const int cg = (i & 511) * 4, k = i >> 9;
        f32x4 Pr = {1.f, 1.f, 1.f, 1.f}, H = {0.f, 0.f, 0.f, 0.f};
#pragma unroll 16
        for (int r = 0; r < SCAN_LC; ++r) { const size_t o = (size_t)(k * SCAN_LC + r) * 2048 + cg; const f32x4 a = ld_a4(AF, o), b = ld_b4(BF, o); H = a * H + b; Pr = Pr * a; }
        *(f32x4*)(AGGA + (size_t)k * 2048 + cg) = Pr; *(f32x4*)(AGGB + (size_t)k * 2048 + cg) = H; }
}
__device__ __forceinline__ float gelu_tanh(float x) { const float u = 0.7978845608028654f * (x + 0.044715f * x * x * x); const float e = __expf(2.0f * u); const float th = 1.0f - 2.0f / (e + 1.0f); return 0.5f * x * (1.0f + th); }
__device__ __forceinline__ void scan_final_phase(const h16* AF, const h16* BF, const float* AGGA, const float* AGGB, const h16* PROJ, h16* Y, int gtid, int NGT) {
    for (int i = gtid; i < SCAN_NCH * 512; i += NGT) { const int cg = (i & 511) * 4, k = i >> 9;
        f32x4 H = {0.f, 0.f, 0.f, 0.f};
#pragma unroll 8
        for (int j = 0; j < k; ++j) { const f32x4 a = *(const f32x4*)(AGGA + (size_t)j * 2048 + cg), b = *(const f32x4*)(AGGB + (size_t)j * 2048 + cg); H = a * H + b; }
#pragma unroll 8
        for (int r = 0; r < SCAN_LC; ++r) { const int t = k * SCAN_LC + r; const size_t o = (size_t)t * 2048 + cg; const f32x4 a = ld_a4(AF, o), b = ld_b4(BF, o); H = a * H + b;
            const h16x4 gt = *(const h16x4*)(PROJ + (size_t)t * 4096 + cg);
            v2u w; w.x = pkh(H[0] * gelu_tanh((float)gt[0]), H[1] * gelu_tanh((float)gt[1])); w.y = pkh(H[2] * gelu_tanh((float)gt[2]), H[3] * gelu_tanh((float)gt[3]));
            *(v2u*)(Y + o) = w; } }
}
__device__ __forceinline__ f32x4 ldx4(const h16* p) { const h16x4 v = *(const h16x4*)p; return (f32x4){(float)v[0], (float)v[1], (float)v[2], (float)v[3]}; }
__device__ __forceinline__ void pool_phase(const h16* X, const float* gain, h16* Y, LAS unsigned char* lds, int wg, int G, int tid, int wave, int lane) {
    LAS float* rs = (LAS float*)lds;
    const int c4 = tid * 4; const int w = 2 << (tid >> 7);
    const f32x4 gn = *(const f32x4*)(gain + c4);
    for (int u = wg; u < T / 32; u += G) { const int t0 = 32 * u;
        __syncthreads();
        for (int r = wave; r < 47; r += NWAVES) { const int t = t0 - 15 + r;
            if (t >= 0) { const h16* xr = X + (size_t)t * D + 4 * lane; float s = 0.f;
#pragma unroll
                for (int j = 0; j < 8; ++j) { const f32x4 v = ldx4(xr + 256 * j); s += (v.x * v.x + v.y * v.y) + (v.z * v.z + v.w * v.w); }
                s = wave_sum(s); if (lane == 0) rs[r] = 1.0f / sqrtf(s * (1.0f / D) + EPS); } }
        __syncthreads();
        f32x4 sum = {0.f, 0.f, 0.f, 0.f};
        { const int n0 = (t0 + 1) < w ? (t0 + 1) : w;
          for (int j = 1; j < n0; ++j) sum += ldx4(X + (size_t)(t0 - j) * D + c4) * rs[15 - j]; }
#pragma unroll 8
        for (int r = 0; r < 32; ++r) { const int t = t0 + r; const int n = (t + 1) < w ? (t + 1) : w;
            const f32x4 h0 = ldx4(X + (size_t)t * D + c4) * rs[15 + r];
            sum += h0;
            const float invn = 1.0f / (float)n;
            const f32x4 y = (sum * invn - h0) * gn;
            v2u o; o.x = pkh(y.x, y.y); o.y = pkh(y.z, y.w); *(v2u*)(Y + (size_t)t * D + c4) = o;
            if (t + 1 >= w) sum -= ldx4(X + (size_t)(t + 1 - w) * D + c4) * rs[15 + r + 1 - w]; }
    }
}

__device__ __forceinline__ h16x8 f8x8_to_h(unsigned d0, unsigned d1) {
    const h16x2 a = __builtin_amdgcn_cvt_scalef32_pk_f16_fp8((int)d0, 1.0f, false), b = __builtin_amdgcn_cvt_scalef32_pk_f16_fp8((int)d0, 1.0f, true);
    const h16x2 c = __builtin_amdgcn_cvt_scalef32_pk_f16_fp8((int)d1, 1.0f, false), d = __builtin_amdgcn_cvt_scalef32_pk_f16_fp8((int)d1, 1.0f, true);
    return (h16x8){a[0], a[1], b[0], b[1], c[0], c[1], d[0], d[1]};
}
__device__ __forceinline__ unsigned attn_off_b(unsigned row, unsigned ch) { return 256u * row + 16u * (ch ^ (((row & 3u) << 2) | ((row >> 2) & 3u))); }
__device__ __forceinline__ void attn_mfma_phase(const unsigned char* Q8, const unsigned char* K8, const unsigned char* V8, const int* SEL, h16* O, LAS unsigned char* lds, int wg, int G, int wave, int lane_in) {
    typedef int i32x4 __attribute__((ext_vector_type(4)));
    typedef int i32x2 __attribute__((ext_vector_type(2)));
    typedef long i64x2 __attribute__((ext_vector_type(2)));
    i32x4 svn = {0, 0, 0, 0}; i64x2 qfn[2] = {{0, 0}, {0, 0}};
#define AT_PREF(L_) do { const int g_ = (L_) & 3, t_ = 8 * ((L_) >> 2) + wave; svn = *(const i32x4*)(SEL + (size_t)t_ * TOPK + 4 * lane_in); \
        _Pragma("unroll") for (int pp = 0; pp < 2; ++pp) qfn[pp] = *(const i64x2*)(Q8 + (size_t)t_ * D + (4 * g_ + (lane_in & 3)) * HD + 64 * pp + 16 * (lane_in >> 4)); } while (0)
    v4u kga[4], kgb[4];
#define AT_LOADK2(buf, G_, selk_, kbase_) do { const i32x2 i0 = *(const LAS i32x2*)((selk_) + 2 * (G_)), i1 = *(const LAS i32x2*)((selk_) + 128 + 2 * (G_)); \
            buf[0] = *(const v4u*)((kbase_) + (size_t)(i0.x < 0 ? 0 : i0.x) * 512); buf[1] = *(const v4u*)((kbase_) + (size_t)(i1.x < 0 ? 0 : i1.x) * 512); \
            buf[2] = *(const v4u*)((kbase_) + (size_t)(i0.y < 0 ? 0 : i0.y) * 512); buf[3] = *(const v4u*)((kbase_) + (size_t)(i1.y < 0 ? 0 : i1.y) * 512); } while (0)
#define AT_PREP(L_, par_) do { LAS int* sst_ = (LAS int*)(lds + LDSCTL_OFF + 1024 + wave * 2048 + (par_) * 1024); *(LAS i32x4*)(sst_ + 4 * lane_in) = svn; \
        asm volatile("s_waitcnt lgkmcnt(0)" ::: "memory"); \
        const LAS int* selk_ = sst_ + 16 * (lane_in >> 3); const unsigned char* kbase_ = K8 + ((L_) & 3) * HD + 16 * (lane_in & 7); \
        AT_LOADK2(kga, 0, selk_, kbase_); AT_LOADK2(kgb, 1, selk_, kbase_); } while (0)
    if (wg < (T / 8) * NKV) { AT_PREF(wg); AT_PREP(wg, 0); }
    int itpar = 0;
    for (int L = wg; L < (T / 8) * NKV; L += G, itpar ^= 1) {
        int lane = lane_in; asm volatile("" : "+v"(lane));
        const int jl = lane & 15, gi = lane >> 4;
        const int g = L & 3, t = 8 * (L >> 2) + wave;
        const int* sel = SEL + (size_t)t * TOPK; (void)sel;
        const int nvalid = (t + 1) < TOPK ? (t + 1) : TOPK;
        LAS int* sst = (LAS int*)(lds + LDSCTL_OFF + 1024 + wave * 2048 + itpar * 1024);
        i64x2 qf[2];
#pragma unroll
        for (int pp = 0; pp < 2; ++pp) qf[pp] = qfn[pp];
        LAS unsigned char* vimg = lds + wave * 16384;
        const LAS int* selk = sst + 16 * (lane >> 3);
        const unsigned char* kbase = K8 + g * HD + 16 * (lane & 7);
        const unsigned kwr = 136u * (unsigned)(lane >> 3) + 16u * (unsigned)(lane & 7), krd = 136u * (unsigned)jl + 16u * (unsigned)gi;
        f32x4 s[16];
#define AT_LOADK(buf, G_) AT_LOADK2(buf, G_, selk, kbase)
#define AT_KSTEP(buf, G_) do { LAS unsigned char* kb_ = vimg + ((G_) & 1) * 8192; \
            _Pragma("unroll") for (int j = 0; j < 4; ++j) { *(LAS v2u*)(kb_ + kwr + 1088 * j) = (v2u){buf[j].x, buf[j].y}; *(LAS v2u*)(kb_ + kwr + 1088 * j + 8) = (v2u){buf[j].z, buf[j].w}; } \
            if ((G_) + 2 < 8) AT_LOADK(buf, (G_) + 2); \
            _Pragma("unroll") for (int tt = 0; tt < 2; ++tt) { f32x4 acc = {0.f, 0.f, 0.f, 0.f}; \
                _Pragma("unroll") for (int pp = 0; pp < 2; ++pp) { const long a0 = *(const LAS long*)(kb_ + krd + 2176 * tt + 64 * pp), a1 = *(const LAS long*)(kb_ + krd + 2176 * tt + 64 * pp + 8); \
                    acc = __builtin_amdgcn_mfma_f32_16x16x32_fp8_fp8(a0, qf[pp].x, acc, 0, 0, 0); acc = __builtin_amdgcn_mfma_f32_16x16x32_fp8_fp8(a1, qf[pp].y, acc, 0, 0, 0); } \
                s[2 * (G_) + tt] = acc; } } while (0)
        if (L + G < (T / 8) * NKV) AT_PREF(L + G);
        AT_KSTEP(kga, 0); AT_KSTEP(kgb, 1); AT_KSTEP(kga, 2); AT_KSTEP(kgb, 3); AT_KSTEP(kga, 4); AT_KSTEP(kgb, 5); AT_KSTEP(kga, 6); AT_KSTEP(kgb, 7);
#undef AT_LOADK
#undef AT_KSTEP
        const LAS int* selv = sst + ((lane >> 5) & 1) + 16 * ((lane >> 3) & 3);
        const unsigned char* vbase = V8 + g * HD + 16 * (lane & 7);
        v4u vsa[4], vsb[4];
#define AT_LOADV(vst, Tt) do { _Pragma("unroll") for (int i = 0; i < 4; ++i) { const int ix = selv[2 * (Tt) + 64 * i]; vst[i] = *(const v4u*)(vbase + (size_t)(ix < 0 ? 0 : ix) * 512); } } while (0)
        AT_LOADV(vsa, 0); AT_LOADV(vsb, 1);
        __builtin_amdgcn_sched_barrier(0);
        if (nvalid < TOPK) {
#pragma unroll
            for (int kt = 0; kt < 16; ++kt)
#pragma unroll
                for (int r = 0; r < 4; ++r) if (kt + 64 * gi + 16 * r >= nvalid) s[kt][r] = -__builtin_inff();
        }
        float mx = -__builtin_inff();
#pragma unroll
        for (int kt = 0; kt < 16; ++kt) mx = fmaxf(mx, fmaxf(fmaxf(s[kt][0], s[kt][1]), fmaxf(s[kt][2], s[kt][3])));
        mx = fmaxf(mx, __shfl_xor(mx, 16)); mx = fmaxf(mx, __shfl_xor(mx, 32));
        constexpr float C2 = 0.08838834764831845f * 1.4426950408889634f;
        const float mb = -mx * C2; float sum = 0.f;
        h16x8 pf[8];
#pragma unroll
        for (int Tt = 0; Tt < 8; ++Tt) { float p[8];
#pragma unroll
            for (int r = 0; r < 4; ++r) { p[r] = __builtin_amdgcn_exp2f(fmaf(s[2 * Tt][r], C2, mb)); p[4 + r] = __builtin_amdgcn_exp2f(fmaf(s[2 * Tt + 1][r], C2, mb)); }
            sum += ((p[0] + p[1]) + (p[2] + p[3])) + ((p[4] + p[5]) + (p[6] + p[7]));
            pf[Tt] = (h16x8){(h16)p[0], (h16)p[1], (h16)p[2], (h16)p[3], (h16)p[4], (h16)p[5], (h16)p[6], (h16)p[7]}; }
        sum += __shfl_xor(sum, 16); sum += __shfl_xor(sum, 32);
        const float linv = 1.0f / sum;
        const unsigned q4 = (unsigned)jl >> 2, p4 = (unsigned)jl & 3u;
        unsigned wr_off[8], rd_off[2];
#pragma unroll
        for (int i = 0; i < 4; ++i) { wr_off[2 * i] = attn_off_b((unsigned)((lane >> 3) + 8 * i), 2u * (lane & 7)); wr_off[2 * i + 1] = attn_off_b((unsigned)((lane >> 3) + 8 * i), 2u * (lane & 7) + 1u); }
#pragma unroll
        for (int tt = 0; tt < 2; ++tt) { const unsigned row = 8u * gi + 4u * tt + q4; const unsigned x = ((row & 3u) << 2) | ((row >> 2) & 3u);
            rd_off[tt] = 256u * row + 16u * ((p4 >> 1) ^ (x & 1u)) + 8u * (p4 & 1u) + 32u * (x >> 1); }
        f32x4 o[8];
#pragma unroll
        for (int c = 0; c < 8; ++c) o[c] = (f32x4){0.f, 0.f, 0.f, 0.f};
#define AT_STEP(vst, Tt) do { \
            _Pragma("unroll") for (int i = 0; i < 4; ++i) {     \
                *(LAS h16x8*)(vimg + ((Tt) & 1) * 8192 + wr_off[2 * i]) = f8x8_to_h(vst[i].x, vst[i].y); *(LAS h16x8*)(vimg + ((Tt) & 1) * 8192 + wr_off[2 * i + 1]) = f8x8_to_h(vst[i].z, vst[i].w); } \
            if ((Tt) + 2 < 8) AT_LOADV(vst, (Tt) + 2); \
            const unsigned ib = (unsigned)(size_t)(vimg + ((Tt) & 1) * 8192); \
            h16x4 lo[8], hi[8]; \
            asm volatile("s_waitcnt lgkmcnt(0)" ::: "memory"); \
            _Pragma("unroll") for (int c = 0; c < 8; ++c) { \
                asm volatile("ds_read_b64_tr_b16 %0, %1" : "=&v"(lo[c]) : "v"(ib + (rd_off[0] ^ ((unsigned)c << 5))) : "memory"); \
                asm volatile("ds_read_b64_tr_b16 %0, %1" : "=&v"(hi[c]) : "v"(ib + (rd_off[1] ^ ((unsigned)c << 5))) : "memory"); } \
            asm volatile("s_waitcnt lgkmcnt(0)" ::: "memory"); __builtin_amdgcn_sched_barrier(0); \
            _Pragma("unroll") for (int c = 0; c < 8; ++c) o[c] = __builtin_amdgcn_mfma_f32_16x16x32_f16(pf[Tt], (h16x8){lo[c][0], lo[c][1], lo[c][2], lo[c][3], hi[c][0], hi[c][1], hi[c][2], hi[c][3]}, o[c], 0, 0, 0); \
        } while (0)
        AT_STEP(vsa, 0); AT_STEP(vsb, 1); AT_STEP(vsa, 2); AT_STEP(vsb, 3); AT_STEP(vsa, 4); AT_STEP(vsb, 5); AT_STEP(vsa, 6); AT_STEP(vsb, 7);
#undef AT_STEP
#undef AT_LOADV
        const float li = __shfl(linv, gi);
        h16* orow = O + (size_t)t * D + (4 * g + gi) * HD + jl;
#pragma unroll
        for (int c = 0; c < 8; ++c) { const float v = gi == 0 ? o[c][0] : gi == 1 ? o[c][1] : gi == 2 ? o[c][2] : o[c][3]; orow[16 * c] = (h16)(v * li); }
        asm volatile("s_waitcnt lgkmcnt(0)" ::: "memory");
        if (L + G < (T / 8) * NKV) AT_PREP(L + G, itpar ^ 1);
    }
#undef AT_PREF
#undef AT_PREP
#undef AT_LOADK2
}

constexpr int NPH = 37;
__global__ void __launch_bounds__(NTHR, 2) fwd_kernel(Ptrs P_unused) {
    extern __shared__ __attribute__((aligned(16))) unsigned char lds_raw[];
    LAS unsigned char* lds = (LAS unsigned char*)lds_raw;
    volatile LAS unsigned* MISC = (volatile LAS unsigned*)(lds + MISC_OFF);
    for (int u = threadIdx.x; u < (LDS_BYTES - LDSCTL_OFF) / 4; u += NTHR) ((LAS unsigned*)(lds + LDSCTL_OFF))[u] = 0u;
    __syncthreads();
    int lo, hi;
    XcdBarrier bar;
    { const CAS Ptrs* PP = kargs(); lo = PP->ph_lo; hi = PP->ph_hi; unsigned* bw = (unsigned*)(PP->ws + WS_CTL) + CW_BAR;
      bar.bar = bw; bar.x = 0; bar.st = nullptr; if (hi - lo > 1) bar = xcd_barrier_post(bw, MISC + 8); }
    int seq = 0;
#define PH_BEGIN(S_) if (seq >= lo && seq < hi) { const CAS Ptrs* PP = kargs(); unsigned char* const ws = PP->ws; float* const X = PP->out; (void)X; \
        int tid = threadIdx.x, bx = blockIdx.x, G = gridDim.x; asm volatile("" : "+v"(tid), "+s"(bx), "+s"(G)); \
        const int lane = tid & 63, wave = __builtin_amdgcn_readfirstlane(tid >> 6); const int vcu = (G % 8 == 0) ? (bx % 8) * (G / 8) + bx / 8 : bx; \
        const int gw = vcu * NWAVES + wave, NGW = G * NWAVES, gtid = vcu * NTHR + tid, NGT = G * NTHR; (void)lane; (void)gw; (void)NGW; (void)gtid; (void)NGT; \
        for (int rep_ = 0; rep_ < 1 + (int)((REP_MASK >> (S_)) & 1u); ++rep_) { if (rep_) __syncthreads(); \
        h16* const X16 = (h16*)(ws + WS_X16); h16* const PROJ = (h16*)(ws + WS_BA + BA_PROJ); h16* const U16 = (h16*)(ws + WS_BA + BA_U); (void)X16; (void)PROJ; (void)U16;
#define PH_END   } if (seq + 1 < hi) xcd_barrier(bar); } ++seq;
#define RSQ(i_) ((float*)(ws + WS_CTL + WS_ROWSQ) + (size_t)(i_) * T)
#define PARTA ((float*)(ws + WS_PARTA))
#define PARTB ((float*)(ws + WS_PARTB))

    PH_BEGIN(0) p0_prologue(PP, lds, gw, NGW, wave, lane, gtid, NGT); norm0_phase(PP->x, X16, RSQ(0), gw, NGW, lane); PH_END

#pragma unroll 1
    for (int layer = 0; layer < DEPTH; ++layer) {
        const int kind = layer % 3, j = layer / 3;
        if (kind == 0) {
            PH_BEGIN(2) { pg8::Gemm g{X16, (const h16*)(ws + WS_WINA) + (size_t)j * A_INP * D, T, A_INP, D, D, 1 << 20, D, 128, 128}; pg8::StaticOrder S; S.init(T, A_INP, G, bx);
                       pg8::EpiF16<0> E{PROJ, A_INP, layer == 0 ? RSQ(0) : PARTB, 0, layer == 0 ? 0 : 32}; pg8::gemm_phase<pg8::EpiF16<0>, pg8::StaticOrder, true, true>(lds, g, S, E, tid); } PH_END
            PH_BEGIN(3) dsa_post_phase(PROJ, PP->attn_qn + j * HD, PP->attn_kn + j * HD, (const float*)(ws + WS_COS128), (const float*)(ws + WS_SIN128), (const float*)(ws + WS_COS64), (const float*)(ws + WS_SIN64),
                                    (unsigned char*)(ws + WS_QH), (unsigned char*)(ws + WS_KH), (unsigned char*)(ws + WS_VH), (h16*)(ws + WS_IQ), (h16*)(ws + WS_IK), (float*)(ws + WS_IW), gw, NGW, lane); PH_END
            PH_BEGIN(4) idx_scores_phase((const h16*)(ws + WS_IQ), (const h16*)(ws + WS_IK), (const float*)(ws + WS_IW), (float*)(ws + WS_BA + BA_SC), lds, vcu, G, tid, wave, lane); PH_END
            PH_BEGIN(5) topk_phase((const float*)(ws + WS_BA + BA_SC), (int*)(ws + WS_SEL), lds, gw, NGW, wave, lane); PH_END
            PH_BEGIN(6) attn_mfma_phase((const unsigned char*)(ws + WS_QH), (const unsigned char*)(ws + WS_KH), (const unsigned char*)(ws + WS_VH), (const int*)(ws + WS_SEL), (h16*)(ws + WS_BA + BA_O16), lds, bx, G, wave, lane); PH_END
            PH_BEGIN(7) { pg8::Gemm g{(const h16*)(ws + WS_BA + BA_O16), (const h16*)(ws + WS_WOUTA) + (size_t)j * D * D, T, D, D, D, 1 << 20, D, 128, 128}; pg8::StaticOrder S; S.init(T, D, G, bx);
                       pg8::EpiResid E{X16, X16, nullptr, D, nullptr, nullptr, PARTA}; pg8::gemm_phase<pg8::EpiResid, pg8::StaticOrder, true, true>(lds, g, S, E, tid); } PH_END
        } else if (kind == 1) {
            PH_BEGIN(9) { pg8::Gemm g{X16, (const h16*)(ws + WS_WINR), T, 4096, D, D, 1 << 20, D, 128, 128}; pg8::StaticOrder S; S.init(T, 4096, G, bx);
                       pg8::EpiF16<0> E{PROJ, 4096, layer == 0 ? RSQ(0) : PARTB, 0, layer == 0 ? 0 : 32}; pg8::gemm_phase<pg8::EpiF16<0>, pg8::StaticOrder, true, true>(lds, g, S, E, tid); } PH_END
            PH_BEGIN(10) conv_phase(PROJ, PP->conv_w, PP->conv_b, (h16*)(ws + WS_BA + BA_XC), gtid, NGT); PH_END
            PH_BEGIN(11) { int kg = 256; asm volatile("" : "+s"(kg));
                       pg8::Gemm g{(const h16*)(ws + WS_BA + BA_XC), (const h16*)(ws + WS_WGR), T, 4096, kg, D, 2, kg, 128, 128}; pg8::StaticOrder S; S.init(T, 4096, G, bx);
                       pg8::EpiGates E{(const h16*)(ws + WS_BA + BA_XC), PP->ga_b, PP->gx_b, PP->lam, (h16*)(ws + WS_BA + BA_AF), (h16*)(ws + WS_BA + BA_BF)};
                       pg8::gemm_phase<pg8::EpiGates, pg8::StaticOrder, true, true>(lds, g, S, E, tid); } PH_END
            PH_BEGIN(12) scan_agg_phase((const h16*)(ws + WS_BA + BA_AF), (const h16*)(ws + WS_BA + BA_BF), (float*)(ws + WS_AGGA), (float*)(ws + WS_AGGB), gtid, NGT); PH_END
            PH_BEGIN(13) scan_final_phase((const h16*)(ws + WS_BA + BA_AF), (const h16*)(ws + WS_BA + BA_BF), (const float*)(ws + WS_AGGA), (const float*)(ws + WS_AGGB), PROJ, (h16*)(ws + WS_BA + BA_XC), gtid, NGT); PH_END
            PH_BEGIN(14) { pg8::Gemm g{(const h16*)(ws + WS_BA + BA_XC), (const h16*)(ws + WS_WOUTR), T, D, D, D, 1 << 20, D, 128, 128}; pg8::StaticOrder S; S.init(T, D, G, bx);
                       pg8::EpiResid E{X16, X16, nullptr, D, nullptr, nullptr, PARTA}; pg8::gemm_phase<pg8::EpiResid, pg8::StaticOrder, true, true>(lds, g, S, E, tid); } PH_END
        } else {
            PH_BEGIN(15) pool_phase(X16, PP->pool_norm, (h16*)(ws + WS_BA + BA_XC), lds, vcu, G, tid, wave, lane); PH_END
            PH_BEGIN(16) { pg8::Gemm g{(const h16*)(ws + WS_BA + BA_XC), (const h16*)(ws + WS_WPOOL), T, D, 512, D, 2, 512, 128, 128}; pg8::StaticOrder S; S.init(T, D, G, bx);
                       pg8::EpiResid E{X16, X16, nullptr, D, PP->pool_b, PP->pool_scale, PARTA}; pg8::gemm_phase<pg8::EpiResid, pg8::StaticOrder, true, true>(lds, g, S, E, tid); } PH_END
        }
        PH_BEGIN(17) quant_rows(X16, T, (signed char*)(ws + WS_BA + BA_A8), (float*)(ws + WS_RS), PARTA, nullptr, gw, NGW, lane);
                     quant_rows((const h16*)(ws + WS_WUP) + (size_t)layer * D * FF, FF, (signed char*)(ws + WS_BA + BA_W8), (float*)(ws + WS_CS), nullptr, (const unsigned*)(ws + WS_BLKMAX) + (size_t)layer * 32 * FF, gw, NGW, lane); PH_END
        PH_BEGIN(18) { pg8::Gemm g{(const h16*)(ws + WS_BA + BA_A8), (const h16*)(ws + WS_BA + BA_W8), T, FF, D / 2, D / 2, 1 << 20, D / 2, 128, 128}; pg8::StaticOrder S; S.init(T, FF, G, bx);
                   pg8::EpiQRelu2<pg8::i32x4> E{U16, (const float*)(ws + WS_RS), (const float*)(ws + WS_CS), T}; pg8::gemm_phase_i8<pg8::EpiQRelu2<pg8::i32x4>, pg8::StaticOrder, true, true>(lds, g, S, E, tid); } PH_END
        PH_BEGIN(19) quant_kblk<true>(U16, T, (signed char*)(ws + WS_BA + BA_U8), (float*)(ws + WS_RS2), nullptr, nullptr, gw, NGW, lane);
                     quant_kblk<false>((const h16*)(ws + WS_WDOWN) + (size_t)layer * D * FF, D, (signed char*)(ws + WS_BA + BA_W8D), (float*)(ws + WS_CS2), (float*)(ws + WS_CSUM), (const unsigned*)(ws + WS_BLKMAXD) + (size_t)layer * 128 * D, gw, NGW, lane); PH_END
        PH_BEGIN(20) { pg8::Gemm g{(const h16*)(ws + WS_BA + BA_U8), (const h16*)(ws + WS_BA + BA_W8D), T, D, FF / 2, 64, 1 << 20, 64, (size_t)T * 128, (size_t)D * 128}; pg8::StaticOrder S; S.init(T, D, G, bx);
                   const bool lastl = layer + 1 >= DEPTH, needsq = !lastl && (layer + 1) % 3 != 2;
                   pg8::EpiResidQ E{X16, X16, lastl ? X : nullptr, D, (const float*)(ws + WS_RS2), (const float*)(ws + WS_CS2), (const float*)(ws + WS_CSUM), needsq ? PARTB : nullptr};
                   pg8::gemm_phase_i8<pg8::EpiResidQ, pg8::StaticOrder, true, true>(lds, g, S, E, tid); } PH_END
    }
#undef PH_BEGIN
#undef PH_END
#undef RSQ
#undef PARTA
#undef PARTB
}

extern "C" void kernel_launch(void* const* d_in, const int* in_sizes, int n_in, void* d_out, int out_size, void* d_ws, size_t ws_size, hipStream_t stream) {
    static int grid = 0;
    if (grid == 0) {
        if (n_in != 24 || in_sizes[0] != T * D || out_size != T * D || ws_size < WS_END) { fprintf(stderr, "kernel_launch: unexpected shapes / workspace (n_in %d, in0 %d, out %d, ws %zu, need %zu); nothing launched\n", n_in, n_in > 0 ? in_sizes[0] : -1, out_size, ws_size, (size_t)WS_END); grid = -1; return; }
        int dev = 0, cus = 0, per_cu = 0;
        if (hipGetDevice(&dev) != hipSuccess || hipDeviceGetAttribute(&cus, hipDeviceAttributeMultiprocessorCount, dev) != hipSuccess) { grid = -1; return; }
        if (hipFuncSetAttribute((const void*)fwd_kernel, hipFuncAttributeMaxDynamicSharedMemorySize, LDS_BYTES) != hipSuccess) { fprintf(stderr, "kernel_launch: hipFuncSetAttribute failed\n"); grid = -1; return; }
        if (hipOccupancyMaxActiveBlocksPerMultiprocessor(&per_cu, (const void*)fwd_kernel, NTHR, LDS_BYTES) != hipSuccess || per_cu < 1) { fprintf(stderr, "kernel_launch: occupancy query reports %d workgroups per CU\n", per_cu); }
        (void)hipGetLastError();
        grid = cus;
    }
    if (grid < 0) return;
    if (hipMemsetAsync((char*)d_ws + WS_CTL, 0, CTL_ZERO_BYTES, stream) != hipSuccess) return;
    Ptrs p{};
    p.x = (const float*)d_in[0]; p.pos = (const int*)d_in[1];
    p.attn_norm = (const float*)d_in[2]; p.attn_w_in = (const float*)d_in[3]; p.attn_qn = (const float*)d_in[4]; p.attn_kn = (const float*)d_in[5]; p.attn_w_out = (const float*)d_in[6];
    p.rnn_norm = (const float*)d_in[7]; p.rnn_w_in = (const float*)d_in[8]; p.conv_w = (const float*)d_in[9]; p.conv_b = (const float*)d_in[10]; p.ga_w = (const float*)d_in[11]; p.ga_b = (const float*)d_in[12];
    p.gx_w = (const float*)d_in[13]; p.gx_b = (const float*)d_in[14]; p.lam = (const float*)d_in[15]; p.rnn_w_out = (const float*)d_in[16];
    p.pool_norm = (const float*)d_in[17]; p.pool_w = (const float*)d_in[18]; p.pool_b = (const float*)d_in[19]; p.pool_scale = (const float*)d_in[20];
    p.mlp_norm = (const float*)d_in[21]; p.mlp_w_up = (const float*)d_in[22]; p.mlp_w_down = (const float*)d_in[23];
    p.out = (float*)d_out; p.ws = (unsigned char*)d_ws;
#if MK_SPLIT
    for (int ph = 0; ph < NPH; ++ph) { p.ph_lo = ph; p.ph_hi = ph + 1; hipLaunchKernelGGL(fwd_kernel, dim3(grid), dim3(NTHR), LDS_BYTES, stream, p); }
#else
    p.ph_lo = 0; p.ph_hi = NPH; hipLaunchKernelGGL(fwd_kernel, dim3(grid), dim3(NTHR), LDS_BYTES, stream, p);
#endif
}
```

```cpp
#include <hip/hip_runtime.h>
#include <cstdio>
#include <cstdint>

#ifndef REP_MASK
#define REP_MASK 0u
#endif
#ifndef MK_SPLIT
#define MK_SPLIT 0
#endif

namespace pg8 {
#define PG8_LAS __attribute__((address_space(3)))
typedef _Float16 bf16_t;
typedef _Float16 bf16x8 __attribute__((ext_vector_type(8)));
typedef float f32x4 __attribute__((ext_vector_type(4)));
typedef unsigned u32x4 __attribute__((ext_vector_type(4)));
typedef unsigned u32x2 __attribute__((ext_vector_type(2)));
typedef _Float16 h16x2 __attribute__((ext_vector_type(2)));
typedef _Float16 h16x4 __attribute__((ext_vector_type(4)));
constexpr int BM = 256, BK = 64, HALF = 128, HTB = HALF * BK * 2  , STAGE_BYTES = 8 * HTB, NXCD = 8, WGM = 8;

__host__ __device__ __forceinline__ int lds_byte(int r, int c) { const int st = (r >> 4) * 2 + (c >> 5), rr = r & 15, cc = c & 31, ob = rr * 64 + cc * 2; return st * 1024 + (ob ^ (((ob >> 9) & 1) << 5)); }
__host__ __device__ __forceinline__ void stage_rc(int b, int& R, int& C) { const int st = b / 1024, sb = b % 1024, swz = sb ^ (((sb >> 9) & 1) << 5); R = (st >> 1) * 16 + swz / 64; C = (st & 1) * 32 + (swz % 64) / 2; }
__host__ __device__ __forceinline__ int perm32(int rho) { const int n = rho >> 4, i = rho & 15; return 8 * (i >> 2) + 4 * n + (i & 3); }

struct Unit { int pm, pn; };
struct Gemm { const bf16_t* A; const bf16_t* Bt; int M, N, K, lda, npg, ldb; size_t kstepA, kstepB; };

struct StaticOrder {
    int nM, nN, nwg, G, c;
    __host__ __device__ void init(int M, int N, int G_, int c_) { nM = M / BM; nN = N / BM; nwg = nM * nN; G = G_; c = c_; }
    __host__ __device__ bool next(int i, Unit& u) const {
        const long L = (long)i * G + c; if (L >= nwg) return false;
        int wgid = (int)L; { const int q = nwg / NXCD, r = nwg % NXCD, xcd = wgid % NXCD, off = wgid / NXCD; wgid = (xcd < r ? xcd * (q + 1) : r * (q + 1) + (xcd - r) * q) + off; }
        const int nig = WGM * nN, gid = wgid / nig, fm = gid * WGM, gsz = (nM - fm) < WGM ? (nM - fm) : WGM;
        u.pm = fm + ((wgid % nig) % gsz); u.pn = (wgid % nig) / gsz; return true;
    }
    __device__ __forceinline__ void a_ready(const Unit&) const {}
    __device__ __forceinline__ void done(const Unit&) const {}
};

__device__ __forceinline__ unsigned pk_h2(float lo, float hi) { h16x2 v = {(_Float16)lo, (_Float16)hi}; return __builtin_bit_cast(unsigned, v); }

template <int ACT> struct EpiF16 {
    static constexpr bool PERM = true, AFTER_DRAIN = false;
    bf16_t* O; int ldc; const float* rowsq; int kblk_rows; int npart;
    __device__ __forceinline__ void operator()(const f32x4 (&acc)[2][2][4][2], const Unit& u, int wr, int wc, int fr, int fq) const {
        const int row0 = u.pm * BM + wr * 64 + fr, col0 = u.pn * BM + wc * 32 + 8 * fq;
#pragma unroll
        for (int ai = 0; ai < 2; ++ai)
#pragma unroll
            for (int m = 0; m < 4; ++m) { const int row = row0 + ai * HALF + m * 16;
                bf16_t* rowp = kblk_rows ? O + ((size_t)(col0 >> 6) * kblk_rows + row) * 64 + (col0 & 63) : O + (size_t)row * ldc + col0;
                const size_t bjstep = kblk_rows ? (size_t)2 * kblk_rows * 64 : (size_t)HALF;
                float rs = 1.0f; if (rowsq) { float ssq;
                    if (npart) { const f32x4* pp = (const f32x4*)(rowsq + (size_t)row * 32); f32x4 a4 = pp[0];
#pragma unroll
                        for (int q = 1; q < 8; ++q) a4 += pp[q];
                        ssq = (a4[0] + a4[1]) + (a4[2] + a4[3]); }
                    else ssq = rowsq[row];
                    rs = 1.0f / sqrtf(ssq * (1.0f / 2048.0f) + 1e-6f); if (ACT == 1) rs = rs * rs; }
#pragma unroll
                for (int bj = 0; bj < 2; ++bj) { f32x4 v0 = acc[ai][bj][m][0], v1 = acc[ai][bj][m][1];
                    if (ACT == 1) {
#pragma unroll
                        for (int j = 0; j < 4; ++j) { const float a = fmaxf(v0[j], 0.f), b = fmaxf(v1[j], 0.f); v0[j] = a * a; v1[j] = b * b; } }
                    v0 = v0 * rs; v1 = v1 * rs;
                    u32x4 w; w.x = pk_h2(v0[0], v0[1]); w.y = pk_h2(v0[2], v0[3]); w.z = pk_h2(v1[0], v1[1]); w.w = pk_h2(v1[2], v1[3]);
                    *(u32x4*)(rowp + bj * bjstep) = w; } }
    }
};
typedef int i32x4e __attribute__((ext_vector_type(4)));
template <class AccV> struct EpiQRelu2;
template <class AccV> struct EpiQRelu2 {
    static constexpr bool PERM = true, AFTER_DRAIN = false;
    bf16_t* O; const float* rs; const float* cs; int kblk_rows;
    __device__ __forceinline__ void operator()(const AccV (&acc)[2][2][4][2], const Unit& u, int wr, int wc, int fr, int fq) const {
        const int row0 = u.pm * BM + wr * 64 + fr, col0 = u.pn * BM + wc * 32 + 8 * fq;
        f32x4 cv[2][2];
#pragma unroll
        for (int bj = 0; bj < 2; ++bj)
#pragma unroll
            for (int n = 0; n < 2; ++n) cv[bj][n] = *(const f32x4*)(cs + col0 + bj * HALF + 4 * n);
#pragma unroll
        for (int ai = 0; ai < 2; ++ai)
#pragma unroll
            for (int m = 0; m < 4; ++m) { const int row = row0 + ai * HALF + m * 16; const float r = rs[row];
                bf16_t* rowp = O + ((size_t)(col0 >> 6) * kblk_rows + row) * 64 + (col0 & 63); const size_t bjstep = (size_t)2 * kblk_rows * 64;
#pragma unroll
                for (int bj = 0; bj < 2; ++bj) { f32x4 v0, v1;
#pragma unroll
                    for (int j = 0; j < 4; ++j) { const float a = fmaxf((float)acc[ai][bj][m][0][j] * (r * cv[bj][0][j]), 0.f), b = fmaxf((float)acc[ai][bj][m][1][j] * (r * cv[bj][1][j]), 0.f); v0[j] = a * a; v1[j] = b * b; }
                    u32x4 w; w.x = pk_h2(v0[0], v0[1]); w.y = pk_h2(v0[2], v0[3]); w.z = pk_h2(v1[0], v1[1]); w.w = pk_h2(v1[2], v1[3]);
                    *(u32x4*)(rowp + bj * bjstep) = w; } }
    }
};
struct EpiResid {
    static constexpr bool PERM = false, AFTER_DRAIN = false;
    const bf16_t* res; bf16_t* out; float* out32; int ldc; const float* bias; const float* scale; float* rowsq;
    __device__ __forceinline__ void operator()(const f32x4 (&acc)[2][2][4][2], const Unit& u, int wr, int wc, int fr, int fq) const {
        const int row0 = u.pm * BM + wr * 64 + fr, col0 = u.pn * BM + wc * 32 + 4 * fq;
#pragma unroll
        for (int ai = 0; ai < 2; ++ai)
#pragma unroll
            for (int m = 0; m < 4; ++m) { const int row = row0 + ai * HALF + m * 16; const size_t off = (size_t)row * ldc + col0; float sq = 0.f;
#pragma unroll
                for (int bj = 0; bj < 2; ++bj)
#pragma unroll
                    for (int n = 0; n < 2; ++n) { const int cc = bj * HALF + n * 16; const h16x4 rh = *(const h16x4*)(res + off + cc); const f32x4 r = {(float)rh[0], (float)rh[1], (float)rh[2], (float)rh[3]};
                        const f32x4 bv = bias ? *(const f32x4*)(bias + col0 + cc) : (f32x4){0.f, 0.f, 0.f, 0.f}, sv = scale ? *(const f32x4*)(scale + col0 + cc) : (f32x4){1.f, 1.f, 1.f, 1.f};
                        const f32x4 o = r + (acc[ai][bj][m][n] + bv) * sv;
                        if (out32) *(f32x4*)(out32 + off + cc) = o; else { u32x2 w; w.x = pk_h2(o[0], o[1]); w.y = pk_h2(o[2], o[3]); *(u32x2*)(out + off + cc) = w; }
                        sq += (o[0] * o[0] + o[1] * o[1]) + (o[2] * o[2] + o[3] * o[3]); }
                if (rowsq) { sq += __shfl_xor(sq, 16); sq += __shfl_xor(sq, 32); if (fq == 0) rowsq[(size_t)row * 32 + u.pn * 4 + wc] = sq; }
                asm volatile("" ::: "memory"); }
    }
};
struct EpiResidQ {
    static constexpr bool PERM = false, AFTER_DRAIN = false;
    const bf16_t* res; bf16_t* out; float* out32; int ldc; const float* rs; const float* cs; const float* csum; float* rowsq;
    __device__ __forceinline__ void operator()(const i32x4e (&acc)[2][2][4][2], const Unit& u, int wr, int wc, int fr, int fq) const {
        const int row0 = u.pm * BM + wr * 64 + fr, col0 = u.pn * BM + wc * 32 + 4 * fq;
#pragma unroll
        for (int ai = 0; ai < 2; ++ai)
#pragma unroll
            for (int m = 0; m < 4; ++m) { const int row = row0 + ai * HALF + m * 16; const size_t off = (size_t)row * ldc + col0; float sq = 0.f; const float rsv = rs[row];
#pragma unroll
                for (int bj = 0; bj < 2; ++bj)
#pragma unroll
                    for (int n = 0; n < 2; ++n) { const int cc = bj * HALF + n * 16; const h16x4 rh = *(const h16x4*)(res + off + cc);
                        const f32x4 cv = *(const f32x4*)(cs + col0 + cc), zv = *(const f32x4*)(csum + col0 + cc); f32x4 o;
#pragma unroll
                        for (int j = 0; j < 4; ++j) o[j] = (float)rh[j] + (rsv * cv[j]) * ((float)acc[ai][bj][m][n][j] + 128.0f * zv[j]);
                        if (out32) *(f32x4*)(out32 + off + cc) = o; else { u32x2 w; w.x = pk_h2(o[0], o[1]); w.y = pk_h2(o[2], o[3]); *(u32x2*)(out + off + cc) = w; }
                        sq += (o[0] * o[0] + o[1] * o[1]) + (o[2] * o[2] + o[3] * o[3]); }
                if (rowsq) { sq += __shfl_xor(sq, 16); sq += __shfl_xor(sq, 32); if (fq == 0) rowsq[(size_t)row * 32 + u.pn * 4 + wc] = sq; }
                asm volatile("" ::: "memory"); }
    }
};
struct EpiGates {
    static constexpr bool PERM = false, AFTER_DRAIN = false;
    const bf16_t* XC; const float* ba; const float* bx; const float* lam; bf16_t* AF; bf16_t* BF;
    __device__ __forceinline__ void operator()(const f32x4 (&acc)[2][2][4][2], const Unit& u, int wr, int wc, int fr, int fq) const {
        const int row0 = u.pm * BM + wr * 64 + fr, ch0 = (u.pn >> 1) * 256 + (u.pn & 1) * 128 + wc * 32 + 4 * fq;
#pragma unroll
        for (int n = 0; n < 2; ++n) {
            const f32x4 bav = *(const f32x4*)(ba + ch0 + n * 16), bxv = *(const f32x4*)(bx + ch0 + n * 16), l = *(const f32x4*)(lam + ch0 + n * 16); f32x4 spv;
#pragma unroll
            for (int j = 0; j < 4; ++j) spv[j] = -8.0f * log1pf(__expf(-l[j]));
#pragma unroll
            for (int ai = 0; ai < 2; ++ai)
#pragma unroll
                for (int m = 0; m < 4; ++m) { const size_t off = (size_t)(row0 + ai * HALF + m * 16) * 2048 + ch0 + n * 16;
                    const h16x4 xh = *(const h16x4*)(XC + off); f32x4 av, bv;
#pragma unroll
                    for (int j = 0; j < 4; ++j) { const float r = __builtin_amdgcn_rcpf(1.0f + __expf(-(acc[ai][0][m][n][j] + bav[j]))), ig = __builtin_amdgcn_rcpf(1.0f + __expf(-(acc[ai][1][m][n][j] + bxv[j])));
                        const float la = r * spv[j]; av[j] = la;
                        const float y = 2.0f * la;
                        const float em = y * (1.0f + y * 0.5f * (1.0f + y * (1.0f / 3.0f) * (1.0f + y * 0.25f * (1.0f + y * 0.2f * (1.0f + y * (1.0f / 6.0f) * (1.0f + y * (1.0f / 7.0f)))))));
                        const float om = (y > -0.5f) ? -em : 1.0f - __expf(y);
                        bv[j] = (float)xh[j] * ig * __builtin_amdgcn_sqrtf(fmaxf(om, 0.f)); }
                    { u32x2 w; w.x = pk_h2(av[0], av[1]); w.y = pk_h2(av[2], av[3]); *(u32x2*)(AF + off) = w; w.x = pk_h2(bv[0], bv[1]); w.y = pk_h2(bv[2], bv[3]); *(u32x2*)(BF + off) = w; }
                    asm volatile("" ::: "memory"); }
        }
    }
};

template <class Epi, class Sched, bool ALIGN_EPI = false, bool SP2 = false>
__device__ __forceinline__ void gemm_phase(PG8_LAS unsigned char* lds, const Gemm g, const Sched& S, const Epi& E, const int tid) {
    const int wid = __builtin_amdgcn_readfirstlane(tid >> 6), lane = tid & 63, wr = wid >> 2, wc = wid & 3, fr = lane & 15, fq = lane >> 4;
    const int K = g.K, nt = K / BK;
    unsigned voffA[2], voffB[2];
#pragma unroll
    for (int i = 0; i < 2; ++i) { int R, C; stage_rc(tid * 16 + i * 8192, R, C); const int Rb = Epi::PERM ? ((R & ~31) + perm32(R & 31)) : R;
        voffA[i] = (unsigned)(R * g.lda + C) * 2u; voffB[i] = (unsigned)(Rb * g.ldb + C) * 2u; }
    const size_t kstepA = g.kstepA, kstepB = g.kstepB;
    const size_t hstepA = (size_t)HALF * g.lda * 2, hstepB = (size_t)HALF * g.ldb * 2;
#define PG8_ABASE(u) ((const char*)g.A + ((size_t)(u).pm * BM * g.lda + (size_t)((u).pn / g.npg) * K) * 2)
#define PG8_BBASE(u) ((const char*)g.Bt + (size_t)(u).pn * BM * g.ldb * 2)
    const unsigned ldsw = (unsigned)wid * 1024u;
    const int aoff = lds_byte(wr * 64 + fr, fq * 8), boff = lds_byte(wc * 32 + fr, fq * 8);
#define PG8_SA(b, h) (((b) * 2 + (h)) * HTB)
#define PG8_SB(b, h) ((4 + (b) * 2 + (h)) * HTB)
#define PG8_STAGE(bufoff, gbase, voff) do { _Pragma("unroll") for (int _i = 0; _i < 2; ++_i) \
        __builtin_amdgcn_global_load_lds((const unsigned*)((const char*)(gbase) + (voff)[_i]), (PG8_LAS unsigned*)(lds + (bufoff) + ldsw + _i * 8192), 16, 0, 0); } while (0)
#define PG8_LDA(dst, b, h) do { _Pragma("unroll") for (int m = 0; m < 4; ++m) _Pragma("unroll") for (int k = 0; k < 2; ++k) dst[m][k] = *(const PG8_LAS bf16x8*)(lds + PG8_SA(b, h) + aoff + m * 2048 + k * 1024); } while (0)
#define PG8_LDB(dst, b, h) do { _Pragma("unroll") for (int n = 0; n < 2; ++n) _Pragma("unroll") for (int k = 0; k < 2; ++k) dst[n][k] = *(const PG8_LAS bf16x8*)(lds + PG8_SB(b, h) + boff + n * 2048 + k * 1024); } while (0)
#define PG8_MMA(ai, bj, At, Bt) do { __builtin_amdgcn_s_setprio(1); _Pragma("unroll") for (int m = 0; m < 4; ++m) _Pragma("unroll") for (int n = 0; n < 2; ++n) _Pragma("unroll") for (int k = 0; k < 2; ++k) \
        acc[ai][bj][m][n] = __builtin_amdgcn_mfma_f32_16x16x32_f16(Bt[n][k], At[m][k], acc[ai][bj][m][n], 0, 0, 0); __builtin_amdgcn_s_setprio(0); } while (0)
#define PG8_WAIT_V(n) asm volatile("s_waitcnt vmcnt(" #n ")" ::: "memory")
#define PG8_WAIT_L(n) asm volatile("s_waitcnt lgkmcnt(" #n ")" ::: "memory")
#define PG8_BAR __builtin_amdgcn_s_barrier()
#define PG8_SCHED __builtin_amdgcn_sched_barrier(0)
    Unit cur, nxt; int ui = 0;
    if (!S.next(0, cur)) return;
    f32x4 acc[2][2][4][2];
#pragma unroll
    for (int a = 0; a < 2; ++a)
#pragma unroll
        for (int b = 0; b < 2; ++b)
#pragma unroll
            for (int m = 0; m < 4; ++m)
#pragma unroll
                for (int n = 0; n < 2; ++n) acc[a][b][m][n] = (f32x4){0.f, 0.f, 0.f, 0.f};
    bf16x8 At[4][2], B0[2][2], B1[2][2];
    const char* cA = PG8_ABASE(cur); const char* cB = PG8_BBASE(cur);
    S.a_ready(cur);
    if constexpr (SP2) {
        PG8_STAGE(PG8_SB(0, 0), cB, voffB); PG8_STAGE(PG8_SB(0, 1), cB + hstepB, voffB); PG8_STAGE(PG8_SA(0, 0), cA, voffA); PG8_STAGE(PG8_SA(0, 1), cA + hstepA, voffA);
        if (wr == 1) PG8_BAR;
        PG8_WAIT_V(2); PG8_BAR;
        PG8_STAGE(PG8_SB(1, 0), cB + kstepB, voffB); PG8_STAGE(PG8_SA(1, 0), cA + kstepA, voffA); PG8_STAGE(PG8_SB(1, 1), cB + hstepB + kstepB, voffB);
        PG8_WAIT_V(6); PG8_BAR;
    } else {
        PG8_STAGE(PG8_SB(0, 0), cB, voffB); PG8_STAGE(PG8_SA(0, 0), cA, voffA); PG8_STAGE(PG8_SB(0, 1), cB + hstepB, voffB); PG8_STAGE(PG8_SA(0, 1), cA + hstepA, voffA);
        if (wr == 1) PG8_BAR;
        PG8_WAIT_V(4); PG8_BAR;
        PG8_STAGE(PG8_SB(1, 0), cB + kstepB, voffB); PG8_STAGE(PG8_SA(1, 0), cA + kstepA, voffA); PG8_STAGE(PG8_SB(1, 1), cB + hstepB + kstepB, voffB);
        PG8_WAIT_V(6); PG8_BAR;
    }
    for (;;) {
        const bool has_next = S.next(ui + 1, nxt);
        const char* nA = has_next ? PG8_ABASE(nxt) : cA; const char* nB = has_next ? PG8_BBASE(nxt) : cB;
        for (int t = 0; t < nt; t += 2) {
            const bool last = (t == nt - 2);
            const char* a1 = cA + (size_t)(t + 1) * kstepA;
            const char* a2 = last ? nA : cA + (size_t)(t + 2) * kstepA; const char* b2 = last ? nB : cB + (size_t)(t + 2) * kstepB;
            const char* a3 = a2 + kstepA; const char* b3 = b2 + kstepB;
            if (last && has_next) S.a_ready(nxt);
            if constexpr (SP2) {
            PG8_LDB(B0, 0, 0); PG8_LDB(B1, 0, 1); PG8_SCHED; PG8_LDA(At, 0, 0); PG8_STAGE(PG8_SA(1, 1), a1 + hstepA, voffA);
            PG8_WAIT_V(8); PG8_WAIT_L(0); PG8_BAR; PG8_MMA(0, 0, At, B0); PG8_MMA(0, 1, At, B1); PG8_BAR; PG8_SCHED;
            PG8_LDA(At, 0, 1); PG8_STAGE(PG8_SB(0, 0), b2, voffB); PG8_STAGE(PG8_SB(0, 1), b2 + hstepB, voffB); PG8_STAGE(PG8_SA(0, 0), a2, voffA);
            PG8_WAIT_V(8); PG8_WAIT_L(0); PG8_BAR; PG8_MMA(1, 0, At, B0); PG8_MMA(1, 1, At, B1); PG8_BAR; PG8_SCHED;
            PG8_LDB(B0, 1, 0); PG8_LDB(B1, 1, 1); PG8_SCHED; PG8_LDA(At, 1, 0); PG8_STAGE(PG8_SA(0, 1), a2 + hstepA, voffA);
            PG8_WAIT_V(8); PG8_WAIT_L(0); PG8_BAR; PG8_MMA(0, 0, At, B0); PG8_MMA(0, 1, At, B1); PG8_BAR; PG8_SCHED;
            PG8_LDA(At, 1, 1); PG8_STAGE(PG8_SB(1, 0), b3, voffB); PG8_STAGE(PG8_SB(1, 1), b3 + hstepB, voffB); PG8_STAGE(PG8_SA(1, 0), a3, voffA);
            PG8_WAIT_V(8); PG8_WAIT_L(0); PG8_BAR; PG8_MMA(1, 0, At, B0); PG8_MMA(1, 1, At, B1); PG8_BAR; PG8_SCHED;
            } else {
            PG8_LDB(B0, 0, 0); PG8_SCHED; PG8_LDA(At, 0, 0); PG8_STAGE(PG8_SA(1, 1), a1 + hstepA, voffA);
            PG8_WAIT_L(8); PG8_BAR; PG8_WAIT_L(0); PG8_MMA(0, 0, At, B0); PG8_BAR; PG8_SCHED;
            PG8_LDB(B1, 0, 1); PG8_STAGE(PG8_SB(0, 0), b2, voffB);
            PG8_BAR; PG8_WAIT_L(0); PG8_MMA(0, 1, At, B1); PG8_BAR;
            PG8_LDA(At, 0, 1); PG8_STAGE(PG8_SA(0, 0), a2, voffA);
            PG8_BAR; PG8_WAIT_L(0); PG8_MMA(1, 0, At, B0); PG8_BAR; PG8_SCHED;
            PG8_STAGE(PG8_SB(0, 1), b2 + hstepB, voffB);
            PG8_WAIT_V(6); PG8_BAR; PG8_MMA(1, 1, At, B1); PG8_BAR;
            PG8_LDB(B0, 1, 0); PG8_SCHED; PG8_LDA(At, 1, 0); PG8_STAGE(PG8_SA(0, 1), a2 + hstepA, voffA);
            PG8_WAIT_L(8); PG8_BAR; PG8_WAIT_L(0); PG8_MMA(0, 0, At, B0); PG8_BAR; PG8_SCHED;
            PG8_LDB(B1, 1, 1); PG8_STAGE(PG8_SB(1, 0), b3, voffB);
            PG8_BAR; PG8_WAIT_L(0); PG8_MMA(0, 1, At, B1); PG8_BAR;
            PG8_LDA(At, 1, 1); PG8_STAGE(PG8_SA(1, 0), a3, voffA);
            PG8_BAR; PG8_WAIT_L(0); PG8_MMA(1, 0, At, B0); PG8_BAR; PG8_SCHED;
            PG8_STAGE(PG8_SB(1, 1), b3 + hstepB, voffB);
            PG8_WAIT_V(6); PG8_BAR; PG8_MMA(1, 1, At, B1); PG8_BAR;
            }
        }
        if constexpr (ALIGN_EPI) { if (wr == 0) PG8_BAR; }
        if constexpr (!Epi::AFTER_DRAIN) { E(acc, cur, wr, wc, fr, fq); S.done(cur); }
        if (!has_next) break;
#pragma unroll
        for (int a = 0; a < 2; ++a)
#pragma unroll
            for (int b = 0; b < 2; ++b)
#pragma unroll
                for (int m = 0; m < 4; ++m)
#pragma unroll
                    for (int n = 0; n < 2; ++n) acc[a][b][m][n] = (f32x4){0.f, 0.f, 0.f, 0.f};
        cur = nxt; cA = nA; cB = nB; ++ui;
        if constexpr (ALIGN_EPI) { if (wr == 1) PG8_BAR; }
    }
    PG8_WAIT_V(0);
    if constexpr (!ALIGN_EPI) { if (wr == 0) PG8_BAR; }
    PG8_BAR;
    if constexpr (Epi::AFTER_DRAIN) { E.fused(acc, cur, wr, wc, fr, fq, lds, wid, lane); S.done(cur); }
#undef PG8_ABASE
#undef PG8_BBASE
#undef PG8_SA
#undef PG8_SB
#undef PG8_STAGE
#undef PG8_LDA
#undef PG8_LDB
#undef PG8_MMA
#undef PG8_WAIT_V
#undef PG8_WAIT_L
#undef PG8_BAR
#undef PG8_SCHED
}
typedef int i32x4 __attribute__((ext_vector_type(4)));
template <class Epi, class Sched, bool ALIGN_EPI = false, bool SP2 = false>
__device__ __forceinline__ void gemm_phase_i8(PG8_LAS unsigned char* lds, const Gemm g, const Sched& S, const Epi& E, const int tid) {
    const int wid = __builtin_amdgcn_readfirstlane(tid >> 6), lane = tid & 63, wr = wid >> 2, wc = wid & 3, fr = lane & 15, fq = lane >> 4;
    const int K = g.K, nt = K / BK;
    unsigned voffA[2], voffB[2];
#pragma unroll
    for (int i = 0; i < 2; ++i) { int R, C; stage_rc(tid * 16 + i * 8192, R, C); const int Rb = Epi::PERM ? ((R & ~31) + perm32(R & 31)) : R;
        voffA[i] = (unsigned)(R * g.lda + C) * 2u; voffB[i] = (unsigned)(Rb * g.ldb + C) * 2u; }
    const size_t kstepA = g.kstepA, kstepB = g.kstepB;
    const size_t hstepA = (size_t)HALF * g.lda * 2, hstepB = (size_t)HALF * g.ldb * 2;
#define PG8_ABASE(u) ((const char*)g.A + ((size_t)(u).pm * BM * g.lda + (size_t)((u).pn / g.npg) * K) * 2)
#define PG8_BBASE(u) ((const char*)g.Bt + (size_t)(u).pn * BM * g.ldb * 2)
    const unsigned ldsw = (unsigned)wid * 1024u;
    const int aoff = lds_byte(wr * 64 + fr, fq * 8), boff = lds_byte(wc * 32 + fr, fq * 8);
#define PG8_SA(b, h) (((b) * 2 + (h)) * HTB)
#define PG8_SB(b, h) ((4 + (b) * 2 + (h)) * HTB)
#define PG8_STAGE(bufoff, gbase, voff) do { _Pragma("unroll") for (int _i = 0; _i < 2; ++_i) \
        __builtin_amdgcn_global_load_lds((const unsigned*)((const char*)(gbase) + (voff)[_i]), (PG8_LAS unsigned*)(lds + (bufoff) + ldsw + _i * 8192), 16, 0, 0); } while (0)
#define PG8_LDA(dst, b, h) do { _Pragma("unroll") for (int m = 0; m < 4; ++m) _Pragma("unroll") for (int k = 0; k < 2; ++k) dst[m][k] = *(const PG8_LAS bf16x8*)(lds + PG8_SA(b, h) + aoff + m * 2048 + k * 1024); } while (0)
#define PG8_LDB(dst, b, h) do { _Pragma("unroll") for (int n = 0; n < 2; ++n) _Pragma("unroll") for (int k = 0; k < 2; ++k) dst[n][k] = *(const PG8_LAS bf16x8*)(lds + PG8_SB(b, h) + boff + n * 2048 + k * 1024); } while (0)
#define PG8_MMA(ai, bj, At, Bt) do { __builtin_amdgcn_s_setprio(1); _Pragma("unroll") for (int m = 0; m < 4; ++m) _Pragma("unroll") for (int n = 0; n < 2; ++n) _Pragma("unroll") for (int k = 0; k < 2; ++k) \
        acc[ai][bj][m][n] = __builtin_amdgcn_mfma_i32_16x16x64_i8(__builtin_bit_cast(i32x4, Bt[n][k]), __builtin_bit_cast(i32x4, At[m][k]), acc[ai][bj][m][n], 0, 0, 0); __builtin_amdgcn_s_setprio(0); } while (0)
#define PG8_WAIT_V(n) asm volatile("s_waitcnt vmcnt(" #n ")" ::: "memory")
#define PG8_WAIT_L(n) asm volatile("s_waitcnt lgkmcnt(" #n ")" ::: "memory")
#define PG8_BAR __builtin_amdgcn_s_barrier()
#define PG8_SCHED __builtin_amdgcn_sched_barrier(0)
    Unit cur, nxt; int ui = 0;
    if (!S.next(0, cur)) return;
    i32x4 acc[2][2][4][2];
#pragma unroll
    for (int a = 0; a < 2; ++a)
#pragma unroll
        for (int b = 0; b < 2; ++b)
#pragma unroll
            for (int m = 0; m < 4; ++m)
#pragma unroll
                for (int n = 0; n < 2; ++n) acc[a][b][m][n] = (i32x4){0, 0, 0, 0};
    bf16x8 At[4][2], B0[2][2], B1[2][2];
    const char* cA = PG8_ABASE(cur); const char* cB = PG8_BBASE(cur);
    S.a_ready(cur);
    if constexpr (SP2) {
        PG8_STAGE(PG8_SB(0, 0), cB, voffB); PG8_STAGE(PG8_SB(0, 1), cB + hstepB, voffB); PG8_STAGE(PG8_SA(0, 0), cA, voffA); PG8_STAGE(PG8_SA(0, 1), cA + hstepA, voffA);
        if (wr == 1) PG8_BAR;
        PG8_WAIT_V(2); PG8_BAR;
        PG8_STAGE(PG8_SB(1, 0), cB + kstepB, voffB); PG8_STAGE(PG8_SA(1, 0), cA + kstepA, voffA); PG8_STAGE(PG8_SB(1, 1), cB + hstepB + kstepB, voffB);
        PG8_WAIT_V(6); PG8_BAR;
    } else {
        PG8_STAGE(PG8_SB(0, 0), cB, voffB); PG8_STAGE(PG8_SA(0, 0), cA, voffA); PG8_STAGE(PG8_SB(0, 1), cB + hstepB, voffB); PG8_STAGE(PG8_SA(0, 1), cA + hstepA, voffA);
        if (wr == 1) PG8_BAR;
        PG8_WAIT_V(4); PG8_BAR;
        PG8_STAGE(PG8_SB(1, 0), cB + kstepB, voffB); PG8_STAGE(PG8_SA(1, 0), cA + kstepA, voffA); PG8_STAGE(PG8_SB(1, 1), cB + hstepB + kstepB, voffB);
        PG8_WAIT_V(6); PG8_BAR;
    }
    for (;;) {
        const bool has_next = S.next(ui + 1, nxt);
        const char* nA = has_next ? PG8_ABASE(nxt) : cA; const char* nB = has_next ? PG8_BBASE(nxt) : cB;
        for (int t = 0; t < nt; t += 2) {
            const bool last = (t == nt - 2);
            const char* a1 = cA + (size_t)(t + 1) * kstepA;
            const char* a2 = last ? nA : cA + (size_t)(t + 2) * kstepA; const char* b2 = last ? nB : cB + (size_t)(t + 2) * kstepB;
            const char* a3 = a2 + kstepA; const char* b3 = b2 + kstepB;
            if (last && has_next) S.a_ready(nxt);
            if constexpr (SP2) {
            PG8_LDB(B0, 0, 0); PG8_LDB(B1, 0, 1); PG8_SCHED; PG8_LDA(At, 0, 0); PG8_STAGE(PG8_SA(1, 1), a1 + hstepA, voffA);
            PG8_WAIT_V(8); PG8_WAIT_L(0); PG8_BAR; PG8_MMA(0, 0, At, B0); PG8_MMA(0, 1, At, B1); PG8_BAR; PG8_SCHED;
            PG8_LDA(At, 0, 1); PG8_STAGE(PG8_SB(0, 0), b2, voffB); PG8_STAGE(PG8_SB(0, 1), b2 + hstepB, voffB); PG8_STAGE(PG8_SA(0, 0), a2, voffA);
            PG8_WAIT_V(8); PG8_WAIT_L(0); PG8_BAR; PG8_MMA(1, 0, At, B0); PG8_MMA(1, 1, At, B1); PG8_BAR; PG8_SCHED;
            PG8_LDB(B0, 1, 0); PG8_LDB(B1, 1, 1); PG8_SCHED; PG8_LDA(At, 1, 0); PG8_STAGE(PG8_SA(0, 1), a2 + hstepA, voffA);
            PG8_WAIT_V(8); PG8_WAIT_L(0); PG8_BAR; PG8_MMA(0, 0, At, B0); PG8_MMA(0, 1, At, B1); PG8_BAR; PG8_SCHED;
            PG8_LDA(At, 1, 1); PG8_STAGE(PG8_SB(1, 0), b3, voffB); PG8_STAGE(PG8_SB(1, 1), b3 + hstepB, voffB); PG8_STAGE(PG8_SA(1, 0), a3, voffA);
            PG8_WAIT_V(8); PG8_WAIT_L(0); PG8_BAR; PG8_MMA(1, 0, At, B0); PG8_MMA(1, 1, At, B1); PG8_BAR; PG8_SCHED;
            } else {
            PG8_LDB(B0, 0, 0); PG8_SCHED; PG8_LDA(At, 0, 0); PG8_STAGE(PG8_SA(1, 1), a1 + hstepA, voffA);
            PG8_WAIT_L(8); PG8_BAR; PG8_WAIT_L(0); PG8_MMA(0, 0, At, B0); PG8_BAR; PG8_SCHED;
            PG8_LDB(B1, 0, 1); PG8_STAGE(PG8_SB(0, 0), b2, voffB);
            PG8_BAR; PG8_WAIT_L(0); PG8_MMA(0, 1, At, B1); PG8_BAR;
            PG8_LDA(At, 0, 1); PG8_STAGE(PG8_SA(0, 0), a2, voffA);
            PG8_BAR; PG8_WAIT_L(0); PG8_MMA(1, 0, At, B0); PG8_BAR; PG8_SCHED;
            PG8_STAGE(PG8_SB(0, 1), b2 + hstepB, voffB);
            PG8_WAIT_V(6); PG8_BAR; PG8_MMA(1, 1, At, B1); PG8_BAR;
            PG8_LDB(B0, 1, 0); PG8_SCHED; PG8_LDA(At, 1, 0); PG8_STAGE(PG8_SA(0, 1), a2 + hstepA, voffA);
            PG8_WAIT_L(8); PG8_BAR; PG8_WAIT_L(0); PG8_MMA(0, 0, At, B0); PG8_BAR; PG8_SCHED;
            PG8_LDB(B1, 1, 1); PG8_STAGE(PG8_SB(1, 0), b3, voffB);
            PG8_BAR; PG8_WAIT_L(0); PG8_MMA(0, 1, At, B1); PG8_BAR;
            PG8_LDA(At, 1, 1); PG8_STAGE(PG8_SA(1, 0), a3, voffA);
            PG8_BAR; PG8_WAIT_L(0); PG8_MMA(1, 0, At, B0); PG8_BAR; PG8_SCHED;
            PG8_STAGE(PG8_SB(1, 1), b3 + hstepB, voffB);
            PG8_WAIT_V(6); PG8_BAR; PG8_MMA(1, 1, At, B1); PG8_BAR;
            }
        }
        if constexpr (ALIGN_EPI) { if (wr == 0) PG8_BAR; }
        if constexpr (!Epi::AFTER_DRAIN) { E(acc, cur, wr, wc, fr, fq); S.done(cur); }
        if (!has_next) break;
#pragma unroll
        for (int a = 0; a < 2; ++a)
#pragma unroll
            for (int b = 0; b < 2; ++b)
#pragma unroll
                for (int m = 0; m < 4; ++m)
#pragma unroll
                    for (int n = 0; n < 2; ++n) acc[a][b][m][n] = (i32x4){0, 0, 0, 0};
        cur = nxt; cA = nA; cB = nB; ++ui;
        if constexpr (ALIGN_EPI) { if (wr == 1) PG8_BAR; }
    }
    PG8_WAIT_V(0);
    if constexpr (!ALIGN_EPI) { if (wr == 0) PG8_BAR; }
    PG8_BAR;
    if constexpr (Epi::AFTER_DRAIN) { E.fused(acc, cur, wr, wc, fr, fq, lds, wid, lane); S.done(cur); }
#undef PG8_ABASE
#undef PG8_BBASE
#undef PG8_SA
#undef PG8_SB
#undef PG8_STAGE
#undef PG8_LDA
#undef PG8_LDB
#undef PG8_MMA
#undef PG8_WAIT_V
#undef PG8_WAIT_L
#undef PG8_BAR
#undef PG8_SCHED
}
}

constexpr int T = 8192, D = 2048, FF = 8192, DEPTH = 4;
constexpr int NH = 16, HD = 128, NKV = 4, TOPK = 256;
constexpr int A_IN = 5264, A_INP = 5376;
constexpr int C_Q = 0, C_K = 2048, C_V = 2560, C_IQ = 3072, C_IK = 5120, C_IW = 5248;
constexpr float EPS = 1e-6f;
constexpr int NWAVES = 8, NTHR = NWAVES * 64;

constexpr size_t MiB = 1u << 20;
constexpr size_t WS_CTL = 0, CTL_ZERO_BYTES = 1 * MiB;
constexpr size_t WS_COS128 = 1 * MiB, WS_SIN128 = 3 * MiB, WS_COS64 = 5 * MiB, WS_SIN64 = 6 * MiB;
constexpr size_t WS_IW = 7 * MiB;
constexpr size_t WS_AGGA = 8 * MiB, WS_AGGB = 9 * MiB;
constexpr size_t WS_WINA = 10 * MiB;
constexpr size_t WS_WOUTA = 52 * MiB;
constexpr size_t WS_WINR = 68 * MiB;
constexpr size_t WS_WGR = 84 * MiB;
constexpr size_t WS_WOUTR = 86 * MiB;
constexpr size_t WS_WPOOL = 94 * MiB;
constexpr size_t WS_WUP = 96 * MiB;
constexpr size_t WS_WDOWN = 224 * MiB;
constexpr size_t WS_BA = 352 * MiB;
constexpr size_t BA_SC = 0;
constexpr int SC_LD = T + 64;
constexpr size_t BA_O16 = 0;
constexpr size_t BA_U = 0;
constexpr size_t BA_AF = 0, BA_BF = 64 * MiB;
constexpr size_t BA_H16 = 128 * MiB;
constexpr size_t BA_PROJ = 160 * MiB;
constexpr size_t BA_XC = 224 * MiB;
constexpr size_t WS_QH = 616 * MiB, WS_KH = 632 * MiB, WS_VH = 636 * MiB, WS_IK = 640 * MiB, WS_SEL = 642 * MiB, WS_IQ = 650 * MiB, WS_PARTA = 686 * MiB, WS_PARTB = 687 * MiB, WS_BLKMAXD = 688 * MiB, WS_X16 = 692 * MiB, WS_END = 724 * MiB;
constexpr int CW_BAR = 4096;
constexpr size_t WS_BLKMAX = 682 * MiB;
constexpr size_t WS_RS = 7 * MiB + 512 * 1024, WS_CS = WS_RS + 64 * 1024;
constexpr size_t WS_RS2 = WS_RS + 128 * 1024, WS_CS2 = WS_RS + 192 * 1024, WS_CSUM = WS_RS + 208 * 1024;
constexpr size_t BA_U8 = 192 * MiB, BA_W8D = 176 * MiB;
constexpr size_t BA_A8 = 160 * MiB, BA_W8 = 176 * MiB;
constexpr size_t WS_ROWSQ = 256 * 1024;

constexpr int RING_BYTES = 131072;
constexpr int LDSCTL_OFF = RING_BYTES, MISC_OFF = LDSCTL_OFF + 320;
constexpr int LDS_BYTES = 155648;

#define GAS __attribute__((address_space(1)))
#define LAS __attribute__((address_space(3)))
typedef _Float16 h16;
typedef _Float16 h16x2 __attribute__((ext_vector_type(2)));
typedef _Float16 h16x4 __attribute__((ext_vector_type(4)));
typedef _Float16 h16x8 __attribute__((ext_vector_type(8)));
typedef unsigned v4u __attribute__((ext_vector_type(4)));
typedef unsigned v2u __attribute__((ext_vector_type(2)));
typedef float f32x4 __attribute__((ext_vector_type(4)));
#define LDS_WAIT() asm volatile("s_waitcnt lgkmcnt(0)" ::: "memory")
#define VM_WAIT() asm volatile("s_waitcnt vmcnt(0)" ::: "memory")
__device__ __forceinline__ unsigned pkh(float lo, float hi) { h16x2 v = {(h16)lo, (h16)hi}; return __builtin_bit_cast(unsigned, v); }
__device__ __forceinline__ float wave_sum(float v) {
#pragma unroll
    for (int o = 1; o < 64; o <<= 1) v += __shfl_xor(v, o);
    return v;
}
__device__ __forceinline__ float wave_max(float v) {
#pragma unroll
    for (int o = 1; o < 64; o <<= 1) v = fmaxf(v, __shfl_xor(v, o));
    return v;
}

#define XB_TMO      128
#define XB_XCNT(j)  (256  + 64 * (j))
#define XB_XSUB(j)  (1280 + 64 * (j))
#define XB_XGEN(j)  (2304 + 64 * (j))
#define XB_TOP      3328
#define XB_TOPGEN   3392
#define XCD_BAR_WORDS 3456
#define XB_SPIN_CAP (1u << 18)

__device__ __forceinline__ unsigned xb_ld(unsigned* p)              { return __hip_atomic_load(p, __ATOMIC_RELAXED, __HIP_MEMORY_SCOPE_AGENT); }
__device__ __forceinline__ unsigned xb_add(unsigned* p, unsigned v) { return __hip_atomic_fetch_add(p, v, __ATOMIC_RELAXED, __HIP_MEMORY_SCOPE_AGENT); }
__device__ __forceinline__ unsigned xb_xcc_id() { return (unsigned)__builtin_amdgcn_s_getreg((3 << 11) | 20) & 0xFu; }
#define XB_SPIN(cond, bar) do { unsigned _sp = 0; while (cond) { __builtin_amdgcn_s_sleep(1); \
    if ((++_sp & 255u) == 0u) { if (xb_ld(&(bar)[XB_TMO])) break; if (_sp > XB_SPIN_CAP) { atomicAdd(&(bar)[XB_TMO], 1u); break; } } } } while (0)

struct XcdBarrier { unsigned* bar; unsigned x; volatile LAS unsigned* st; };

__device__ __forceinline__ XcdBarrier xcd_barrier_post(unsigned* bar, volatile LAS unsigned* st) {
    XcdBarrier b; b.bar = bar; b.x = xb_xcc_id(); b.st = st;
    if (threadIdx.x == 0) (void)xb_add(&bar[XB_XCNT(b.x)], 1u);
    return b;
}
__device__ __forceinline__ void xcd_barrier_complete(unsigned* bar, unsigned x, unsigned& nloc, unsigned& nx) {
    const unsigned G = gridDim.x * gridDim.y * gridDim.z;
    unsigned sum, cnt, mine, sp = 0u;
    for (;;) {
        sum = 0u; cnt = 0u; mine = 0u;
#pragma unroll
        for (unsigned j = 0; j < 16; ++j) { const unsigned c = xb_ld(&bar[XB_XCNT(j)]); sum += c; cnt += (c > 0u) ? 1u : 0u; mine = (j == x) ? c : mine; }
        if (sum == G) break;
        __builtin_amdgcn_s_sleep(1);
        if ((++sp & 255u) == 0u) { if (xb_ld(&bar[XB_TMO])) break; if (sp > XB_SPIN_CAP) { atomicAdd(&bar[XB_TMO], 1u); break; } }
    }
    nloc = mine > 0u ? mine : 1u; nx = cnt > 0u ? cnt : 1u;
}
__device__ __forceinline__ void xcd_barrier(const XcdBarrier& b) {
    asm volatile("s_waitcnt vmcnt(0)" ::: "memory");
    __syncthreads();
    if (threadIdx.x == 0) {
        unsigned* bar = b.bar;
        __builtin_amdgcn_s_waitcnt(0);
        unsigned nloc = b.st[0], nx = b.st[1];
        if (nloc == 0u) { xcd_barrier_complete(bar, b.x, nloc, nx); b.st[0] = nloc; b.st[1] = nx; }
        const unsigned old = xb_add(&bar[XB_XSUB(b.x)], 1u);
        const unsigned gen = old / nloc;
        if (old + 1u == (gen + 1u) * nloc) {
            __builtin_amdgcn_fence(__ATOMIC_RELEASE, "agent");
            asm volatile("s_waitcnt vmcnt(0)" ::: "memory");
            const unsigned og = xb_add(&bar[XB_TOP], 1u);
            const unsigned tg = og / nx;
            if (og + 1u == (tg + 1u) * nx) xb_add(&bar[XB_TOPGEN], 1u);
            else XB_SPIN(xb_ld(&bar[XB_TOPGEN]) == tg, bar);
            __builtin_amdgcn_fence(__ATOMIC_ACQUIRE, "agent");
            xb_add(&bar[XB_XGEN(b.x)], 1u);
            asm volatile("s_waitcnt vmcnt(0)" ::: "memory");
        } else {
            XB_SPIN(xb_ld(&bar[XB_XGEN(b.x)]) == gen, bar);
            __builtin_amdgcn_fence(__ATOMIC_ACQUIRE, "agent");
            asm volatile("s_waitcnt vmcnt(0)" ::: "memory");
        }
    }
    __syncthreads();
}

__device__ __forceinline__ void tr_item(const float* src, int ldw, int nvalid, h16* dst, int ldd, LAS float* scr, int lane, unsigned* colmax = nullptr, const float* gk = nullptr) {
    const int nn = lane & 31; float v[32];
#pragma unroll
    for (int i = 0; i < 32; ++i) { const int kk = 2 * i + (lane >> 5); v[i] = (nn < nvalid) ? src[(size_t)kk * ldw + nn] * (gk ? gk[kk] : 1.0f) : 0.f; }
    __builtin_amdgcn_sched_barrier(0);
#pragma unroll
    for (int i = 0; i < 32; ++i) { const int kk = 2 * i + (lane >> 5); scr[kk * 33 + nn] = v[i]; }
    LDS_WAIT();
    const int c = lane & 7;
#pragma unroll
    for (int j = 0; j < 4; ++j) { const int n = (lane >> 3) + 8 * j; const LAS float* s = scr + (8 * c) * 33 + n;
        v4u o; o.x = pkh(s[0 * 33], s[1 * 33]); o.y = pkh(s[2 * 33], s[3 * 33]); o.z = pkh(s[4 * 33], s[5 * 33]); o.w = pkh(s[6 * 33], s[7 * 33]);
        *(v4u*)(dst + (size_t)n * ldd + 8 * c) = o;
        if (colmax) {
            float mx = fmaxf(fmaxf(fmaxf(fabsf(s[0 * 33]), fabsf(s[1 * 33])), fmaxf(fabsf(s[2 * 33]), fabsf(s[3 * 33]))), fmaxf(fmaxf(fabsf(s[4 * 33]), fabsf(s[5 * 33])), fmaxf(fabsf(s[6 * 33]), fabsf(s[7 * 33]))));
            mx = fmaxf(mx, __shfl_xor(mx, 1)); mx = fmaxf(mx, __shfl_xor(mx, 2)); mx = fmaxf(mx, __shfl_xor(mx, 4));
            if (c == 0) colmax[n] = __float_as_uint(mx); } }
    LDS_WAIT();
}

struct Ptrs {
    const float* x; const int* pos;
    const float *attn_norm, *attn_w_in, *attn_qn, *attn_kn, *attn_w_out;
    const float *rnn_norm, *rnn_w_in, *conv_w, *conv_b, *ga_w, *ga_b, *gx_w, *gx_b, *lam, *rnn_w_out;
    const float *pool_norm, *pool_w, *pool_b, *pool_scale;
    const float *mlp_norm, *mlp_w_up, *mlp_w_down;
    float* out; unsigned char* ws;
    int ph_lo, ph_hi;
};

#define CAS __attribute__((address_space(4)))
__device__ __forceinline__ const CAS Ptrs* kargs() { const CAS Ptrs* p = (const CAS Ptrs*)__builtin_amdgcn_kernarg_segment_ptr(); asm volatile("" : "+s"(p)); return p; }
__device__ __forceinline__ void p0_prologue(const CAS Ptrs* PP, LAS unsigned char* lds, int gw, int NGW, int wave, int lane, int gtid, int NGT) {
    LAS float* scr = (LAS float*)(lds + wave * 16384);
    unsigned char* ws = PP->ws;
    constexpr int I_WINA = 32 * 165, I_WOUTA = 32 * 64, I_WINR = 32 * 128, I_G = 4 * 8, I_WOUTR = 32 * 64, I_POOL = 8 * 16, I_UP = 32 * 256, I_DN = 128 * 64, I_Z = 384;
    constexpr int NITEMS = 2 * I_WINA + 2 * I_WOUTA + I_WINR + 16 * I_G + I_WOUTR + 4 * I_POOL + 4 * I_UP + 4 * I_DN + 2 * I_Z;
    for (int it = gw; it < NITEMS; it += NGW) {
        int r = it;
        if (r < 2 * I_WINA) { const int j = r / I_WINA; r -= j * I_WINA; const int kb = r / 165, nb = r % 165, n0 = 32 * nb; const int nv = (A_IN - n0) < 32 ? (A_IN - n0) : 32;
            tr_item(PP->attn_w_in + (size_t)j * D * A_IN + (size_t)(64 * kb) * A_IN + n0, A_IN, nv, (h16*)(ws + WS_WINA) + (size_t)j * A_INP * D + (size_t)n0 * D + 64 * kb, D, scr, lane, nullptr, PP->attn_norm + (size_t)j * D + 64 * kb); continue; }
        r -= 2 * I_WINA;
        if (r < 2 * I_WOUTA) { const int j = r / I_WOUTA; r -= j * I_WOUTA; const int kb = r / 64, nb = r % 64;
            tr_item(PP->attn_w_out + (size_t)j * D * D + (size_t)(64 * kb) * D + 32 * nb, D, 32, (h16*)(ws + WS_WOUTA) + (size_t)j * D * D + (size_t)(32 * nb) * D + 64 * kb, D, scr, lane); continue; }
        r -= 2 * I_WOUTA;
        if (r < I_WINR) { const int kb = r / 128, nb = r % 128;
            tr_item(PP->rnn_w_in + (size_t)(64 * kb) * 4096 + 32 * nb, 4096, 32, (h16*)(ws + WS_WINR) + (size_t)(32 * nb) * D + 64 * kb, D, scr, lane, nullptr, PP->rnn_norm + 64 * kb); continue; }
        r -= I_WINR;
        if (r < 16 * I_G) { const int mi = r / I_G; r -= mi * I_G; const int which = mi >> 3, blk = mi & 7, kb = r / 8, nb = r % 8, d0 = 32 * nb;
            const float* src = (which ? PP->gx_w : PP->ga_w) + (size_t)blk * 65536 + (size_t)(64 * kb) * 256 + d0;
            const int drow = 256 * (2 * blk + (d0 >> 7)) + 128 * which + (d0 & 127);
            tr_item(src, 256, 32, (h16*)(ws + WS_WGR) + (size_t)drow * 256 + 64 * kb, 256, scr, lane); continue; }
        r -= 16 * I_G;
        if (r < I_WOUTR) { const int kb = r / 64, nb = r % 64;
            tr_item(PP->rnn_w_out + (size_t)(64 * kb) * D + 32 * nb, D, 32, (h16*)(ws + WS_WOUTR) + (size_t)(32 * nb) * D + 64 * kb, D, scr, lane); continue; }
        r -= I_WOUTR;
        if (r < 4 * I_POOL) { const int g = r / I_POOL; r -= g * I_POOL; const int kb = r / 16, nb = r % 16;
            tr_item(PP->pool_w + (size_t)g * 262144 + (size_t)(64 * kb) * 512 + 32 * nb, 512, 32, (h16*)(ws + WS_WPOOL) + (size_t)(512 * g + 32 * nb) * 512 + 64 * kb, 512, scr, lane); continue; }
        r -= 4 * I_POOL;
        if (r < 4 * I_UP) { const int i = r / I_UP; r -= i * I_UP; const int kb = r / 256, nb = r % 256;
            tr_item(PP->mlp_w_up + (size_t)i * D * FF + (size_t)(64 * kb) * FF + 32 * nb, FF, 32, (h16*)(ws + WS_WUP) + (size_t)i * D * FF + (size_t)(32 * nb) * D + 64 * kb, D, scr, lane, (unsigned*)(ws + WS_BLKMAX) + ((size_t)i * 32 + kb) * FF + 32 * nb, PP->mlp_norm + (size_t)i * D + 64 * kb); continue; }
        r -= 4 * I_UP;
        if (r < 4 * I_DN) { const int i = r / I_DN; r -= i * I_DN; const int kb = r / 64, nb = r % 64;
            tr_item(PP->mlp_w_down + (size_t)i * D * FF + (size_t)(64 * kb) * D + 32 * nb, D, 32, (h16*)(ws + WS_WDOWN) + (size_t)i * D * FF + ((size_t)kb * D + 32 * nb) * 64, 64, scr, lane, (unsigned*)(ws + WS_BLKMAXD) + ((size_t)i * 128 + kb) * D + 32 * nb); continue; }
        r -= 4 * I_DN;
        { const int j = r / I_Z; r -= j * I_Z;
            v4u* z = (v4u*)((h16*)(ws + WS_WINA) + (size_t)j * A_INP * D + (size_t)5280 * D); z[(size_t)r * 64 + lane] = (v4u){0u, 0u, 0u, 0u}; }
    }
    for (int e = gtid; e < T * 96; e += NGT) {
        const int t = e / 96, i = e % 96; const bool big = i < 64; const int fi = big ? i : i - 64;
        const double base = big ? 0.8659643233600653 : 0.7498942093324559;
        double inv = 1.0; for (int k = 0; k < fi; ++k) inv *= base;
        const double ang = (double)PP->pos[t] * inv;
        const double n = __builtin_rint(ang * 0.15915494309189535); const double rr = ang - n * 6.283185307179586 - n * 2.4492935982947064e-16;
        const double r2 = rr * rr; double sn = 1.0, cs = 1.0;
#pragma unroll
        for (int k = 14; k >= 1; --k) { sn = 1.0 - sn * r2 * (1.0 / (double)((2 * k) * (2 * k + 1))); cs = 1.0 - cs * r2 * (1.0 / (double)((2 * k - 1) * (2 * k))); }
        sn *= rr;
        if (big) { ((float*)(ws + WS_COS128))[t * 64 + fi] = (float)cs; ((float*)(ws + WS_SIN128))[t * 64 + fi] = (float)sn; }
        else { ((float*)(ws + WS_COS64))[t * 32 + fi] = (float)cs; ((float*)(ws + WS_SIN64))[t * 32 + fi] = (float)sn; }
    }
}

__device__ __forceinline__ void quant_rows(const h16* src, int nrows, signed char* dst, float* scale_out, const float* rowsq, const unsigned* colmax, int gw, int NGW, int lane) {
    h16x8 vn[4]; float cmn = 0.f;
    if (gw < nrows) {
#pragma unroll
        for (int j = 0; j < 4; ++j) vn[j] = *(const h16x8*)(src + (size_t)gw * D + 512 * j + 8 * lane);
        if (colmax) cmn = lane < 32 ? __uint_as_float(colmax[(size_t)lane * FF + gw]) : 0.f; }
    for (int r = gw; r < nrows; r += NGW) {
        h16x8 v[4]; const float cm = cmn;
#pragma unroll
        for (int j = 0; j < 4; ++j) v[j] = vn[j];
        const int rn = r + NGW;
        if (rn < nrows) {
#pragma unroll
            for (int j = 0; j < 4; ++j) vn[j] = *(const h16x8*)(src + (size_t)rn * D + 512 * j + 8 * lane);
            if (colmax) cmn = lane < 32 ? __uint_as_float(colmax[(size_t)lane * FF + rn]) : 0.f; }
        float mx;
        if (colmax) mx = wave_max(cm);
        else { mx = 0.f;
#pragma unroll
            for (int j = 0; j < 4; ++j)
#pragma unroll
                for (int e = 0; e < 8; ++e) mx = fmaxf(mx, fabsf((float)v[j][e]));
            mx = wave_max(mx); }
        const float step = mx > 0.f ? mx * (1.0f / 127.0f) : 1.0f, inv = 1.0f / step;
        if (lane == 0) { float sc = step;
            if (rowsq) { const f32x4* pp = (const f32x4*)(rowsq + (size_t)r * 32); f32x4 a4 = pp[0];
#pragma unroll
                for (int q = 1; q < 8; ++q) a4 += pp[q];
                sc = step / sqrtf(((a4[0] + a4[1]) + (a4[2] + a4[3])) * (1.0f / D) + EPS); }
            scale_out[r] = sc; }
#pragma unroll
        for (int j = 0; j < 4; ++j) { unsigned w[2];
#pragma unroll
            for (int hh = 0; hh < 2; ++hh) { unsigned p = 0u;
#pragma unroll
                for (int e = 0; e < 4; ++e) { int qv = (int)rintf((float)v[j][4 * hh + e] * inv); qv = qv > 127 ? 127 : (qv < -127 ? -127 : qv); p |= ((unsigned)qv & 255u) << (8 * e); }
                w[hh] = p; }
            *(v2u*)(dst + (size_t)r * D + 512 * j + 8 * lane) = (v2u){w[0], w[1]}; }
    }
}
template <bool UNSIGNED>
__device__ __forceinline__ void quant_kblk(const h16* src, int R, signed char* dst, float* scale_out, float* csum, const unsigned* blkmax, int gw, int NGW, int lane) {
    const int bsub = lane >> 3, c8 = (lane & 7) * 8;
    h16x8 vn[16]; float cmn = 0.f;
#define QK_LOAD(r_) do { _Pragma("unroll") for (int i = 0; i < 16; ++i) vn[i] = *(const h16x8*)(src + ((size_t)(8 * i + bsub) * R + (r_)) * 64 + c8); \
        if (!UNSIGNED) cmn = fmaxf(__uint_as_float(blkmax[(size_t)lane * R + (r_)]), __uint_as_float(blkmax[(size_t)(64 + lane) * R + (r_)])); } while (0)
    if (gw < R) QK_LOAD(gw);
    for (int r = gw; r < R; r += NGW) {
        h16x8 v[16]; const float cm = cmn;
#pragma unroll
        for (int i = 0; i < 16; ++i) v[i] = vn[i];
        if (r + NGW < R) QK_LOAD(r + NGW);
        float mx;
        if (UNSIGNED) { mx = 0.f;
#pragma unroll
            for (int i = 0; i < 16; ++i)
#pragma unroll
                for (int e = 0; e < 8; ++e) mx = fmaxf(mx, (float)v[i][e]);
            mx = wave_max(mx); }
        else mx = wave_max(cm);
        const float step = mx > 0.f ? mx * (UNSIGNED ? 1.0f / 255.0f : 1.0f / 127.0f) : 1.0f, inv = 1.0f / step;
        int ssum = 0;
#pragma unroll
        for (int i = 0; i < 16; ++i) { unsigned w[2];
#pragma unroll
            for (int hh = 0; hh < 2; ++hh) { unsigned p = 0u;
#pragma unroll
                for (int e = 0; e < 4; ++e) { int qv = (int)rintf((float)v[i][4 * hh + e] * inv);
                    if (UNSIGNED) { qv = qv > 255 ? 255 : (qv < 0 ? 0 : qv); qv -= 128; } else { qv = qv > 127 ? 127 : (qv < -127 ? -127 : qv); ssum += qv; }
                    p |= ((unsigned)qv & 255u) << (8 * e); }
                w[hh] = p; }
            const int b = 8 * i + bsub;
            *(v2u*)(dst + ((size_t)(b >> 1) * R + r) * 128 + 64 * (b & 1) + c8) = (v2u){w[0], w[1]}; }
        if (!UNSIGNED) { float fs = (float)ssum; fs = wave_sum(fs); if (lane == 0) csum[r] = fs; }
        if (lane == 0) scale_out[r] = step;
    }
#undef QK_LOAD
}
__device__ __forceinline__ void norm0_phase(const float* src, h16* dst, float* rowsq, int gw, int NGW, int lane) {
    for (int m = gw; m < T; m += NGW) {
        const f32x4* xr = (const f32x4*)(src + (size_t)m * D) + lane;
        f32x4 v[8]; float s = 0.f;
#pragma unroll
        for (int j = 0; j < 8; ++j) { v[j] = xr[64 * j]; s += (v[j].x * v[j].x + v[j].y * v[j].y) + (v[j].z * v[j].z + v[j].w * v[j].w); }
        s = wave_sum(s); if (lane == 0) rowsq[m] = s;
        v2u* o = (v2u*)(dst + (size_t)m * D) + lane;
#pragma unroll
        for (int j = 0; j < 8; ++j) { v2u w; w.x = pkh(v[j].x, v[j].y); w.y = pkh(v[j].z, v[j].w); o[64 * j] = w; }
    }
}

__device__ __forceinline__ unsigned char f8(float x) { return (unsigned char)(__builtin_amdgcn_cvt_pk_fp8_f32(x, x, 0, false) & 0xFF); }
__device__ __forceinline__ float sum16(float v) { v += __shfl_xor(v, 1); v += __shfl_xor(v, 2); v += __shfl_xor(v, 4); v += __shfl_xor(v, 8); return v; }
__device__ __forceinline__ unsigned f8x4(float a, float b, float c, float d) { int p = __builtin_amdgcn_cvt_pk_fp8_f32(a, b, 0, false); p = __builtin_amdgcn_cvt_pk_fp8_f32(c, d, p, true); return (unsigned)p; }
__device__ __forceinline__ void dsa_post_phase(const h16* PROJ, const float* qn, const float* kn, const float* c128, const float* s128, const float* c64, const float* s64,
                                               unsigned char* Q8, unsigned char* K8, unsigned char* V8, h16* IQ, h16* IK, float* IW, int gw, int NGW, int lane) {
    const int hh = lane >> 4, m = lane & 15;
    const f32x4 gqa = *(const f32x4*)(qn + 4 * m), gqb = *(const f32x4*)(qn + 64 + 4 * m), gka = *(const f32x4*)(kn + 4 * m), gkb = *(const f32x4*)(kn + 64 + 4 * m);
    const bool rot = m < 8; const int ioa = rot ? 4 * m : 32 + 4 * m, iob = ioa + 32;
    for (int t = gw; t < T; t += NGW) {
        const h16* pr = PROJ + (size_t)t * A_INP;
        const f32x4 c = *(const f32x4*)(c128 + t * 64 + 4 * m), s = *(const f32x4*)(s128 + t * 64 + 4 * m);
        f32x4 ci = {1.f, 1.f, 1.f, 1.f}, si = {0.f, 0.f, 0.f, 0.f};
        if (rot) { ci = *(const f32x4*)(c64 + t * 32 + 4 * m); si = *(const f32x4*)(s64 + t * 32 + 4 * m); }
#pragma unroll
        for (int p = 0; p < 5; ++p) {
            const int cb = (p < 4 ? C_Q + (4 * p + hh) * HD : C_K + hh * HD) + 4 * m;
            const h16x4 a4 = *(const h16x4*)(pr + cb), b4 = *(const h16x4*)(pr + cb + 64);
            float a[4], b[4], ss = 0.f;
#pragma unroll
            for (int e = 0; e < 4; ++e) { a[e] = (float)a4[e]; b[e] = (float)b4[e]; ss += a[e] * a[e] + b[e] * b[e]; }
            const float rstd = 1.0f / sqrtf(sum16(ss) * (1.0f / HD) + EPS);
            float oa[4], ob[4];
#pragma unroll
            for (int e = 0; e < 4; ++e) { const float ya = a[e] * rstd * (p < 4 ? gqa[e] : gka[e]), yb = b[e] * rstd * (p < 4 ? gqb[e] : gkb[e]); oa[e] = ya * c[e] - yb * s[e]; ob[e] = yb * c[e] + ya * s[e]; }
            unsigned char* o8 = (p < 4 ? Q8 + (size_t)t * D + (4 * p + hh) * HD : K8 + (size_t)t * 512 + hh * HD) + 4 * m;
            *(unsigned*)o8 = f8x4(oa[0], oa[1], oa[2], oa[3]); *(unsigned*)(o8 + 64) = f8x4(ob[0], ob[1], ob[2], ob[3]);
        }
        { const h16x8 vv = *(const h16x8*)(pr + C_V + lane * 8);
          *(v2u*)(V8 + (size_t)t * 512 + lane * 8) = (v2u){f8x4((float)vv[0], (float)vv[1], (float)vv[2], (float)vv[3]), f8x4((float)vv[4], (float)vv[5], (float)vv[6], (float)vv[7])}; }
#pragma unroll
        for (int p = 0; p < 5; ++p) {
            const int hd = p < 4 ? 4 * p + hh : 0; const int cb = p < 4 ? C_IQ + hd * HD : C_IK;
            const h16x4 a4 = *(const h16x4*)(pr + cb + ioa), b4 = *(const h16x4*)(pr + cb + iob);
            h16x4 oa, ob;
#pragma unroll
            for (int e = 0; e < 4; ++e) { const float av = (float)a4[e], bv = (float)b4[e]; oa[e] = (h16)(av * ci[e] - bv * si[e]); ob[e] = (h16)(bv * ci[e] + av * si[e]); }
            if (p < 4) { *(h16x4*)(IQ + (size_t)t * D + hd * HD + ioa) = oa; *(h16x4*)(IQ + (size_t)t * D + hd * HD + iob) = ob; }
            else if (hh == 0) { *(h16x4*)(IK + (size_t)t * HD + ioa) = oa; *(h16x4*)(IK + (size_t)t * HD + iob) = ob; }
        }
        if (lane < 16) IW[t * 16 + lane] = (float)pr[C_IW + lane] * 0.02209708691207961f;
    }
}

__device__ __forceinline__ float relu_i(float x) { const int b = __float_as_int(x); return __int_as_float(b > 0 ? b : 0); }
constexpr int IDX_ITEMS = 8320, IDX_ROWB = 272, IDX_TILEB = 128 * IDX_ROWB;
__device__ __forceinline__ void idx_decode(int L, int& qb, int& kc) {
    int m = (int)((sqrtf(1.0f + 2.0f * (float)L) - 1.0f) * 0.5f);
    while (2 * (m + 1) * (m + 2) <= L) ++m;
    while (2 * m * (m + 1) > L) --m;
    const int rem = L - 2 * m * (m + 1); qb = 4 * m + rem / (m + 1); kc = rem % (m + 1);
}
__device__ __forceinline__ void idx_scores_phase(const h16* IQ, const h16* IK, const float* IW, h16* SC, LAS unsigned char* lds, int wg, int G, int tid, int wave, int lane) {
    const int L0 = (int)(((long)IDX_ITEMS * wg) / G), L1 = (int)(((long)IDX_ITEMS * (wg + 1)) / G);
    if (L0 >= L1) return;
    int qb, kc; idx_decode(L0, qb, kc);
    const int fr = lane & 15, fq = lane >> 4;
    h16x8 st[4];
#define IDX_LOAD(kc_) do { _Pragma("unroll") for (int i = 0; i < 4; ++i) { const int p = tid + 512 * i; st[i] = *(const h16x8*)(IK + (size_t)((kc_) * 128 + (p >> 4)) * HD + (p & 15) * 8); } } while (0)
#define IDX_WRITE(buf_) do { _Pragma("unroll") for (int i = 0; i < 4; ++i) { const int p = tid + 512 * i; *(LAS h16x8*)(lds + (buf_) * IDX_TILEB + (p >> 4) * IDX_ROWB + (p & 15) * 16) = st[i]; } } while (0)
    IDX_LOAD(kc); IDX_WRITE(0);
    __syncthreads();
    h16x8 a[4][4]; f32x4 w4[4]; int cur_qb = -1; int par = 0;
    for (int L = L0; L < L1; ++L) {
        int qbn = qb, kcn = kc + 1; if (kcn > (qb >> 2)) { kcn = 0; qbn = qb + 1; }
        const bool more = (L + 1 < L1);
        if (qb != cur_qb) { cur_qb = qb; const int tq = 32 * qb + 4 * wave;
#pragma unroll
            for (int q = 0; q < 4; ++q) {
#pragma unroll
                for (int ks = 0; ks < 4; ++ks) a[q][ks] = *(const h16x8*)(IQ + (size_t)(tq + q) * D + fr * HD + ks * 32 + fq * 8);
                w4[q] = *(const f32x4*)(IW + (size_t)(tq + q) * 16 + 4 * fq); } }
        { const int kcp = more ? kcn : kc; IDX_LOAD(kcp); }
        const LAS unsigned char* bb = lds + par * IDX_TILEB + fr * IDX_ROWB + fq * 16;
        float pq[4][4];
#ifdef IDX_REP
#pragma unroll 1
        for (int irep = 0; irep < IDX_REP; ++irep)
#endif
        h16x8 bq[2][4];
#pragma unroll
        for (int ks = 0; ks < 4; ++ks) bq[0][ks] = *(const LAS h16x8*)(bb + ks * 64);
#pragma unroll
        for (int kt = 0; kt < 8; ++kt) {
            if (kt + 1 < 8) {
#pragma unroll
                for (int ks = 0; ks < 4; ++ks) bq[(kt + 1) & 1][ks] = *(const LAS h16x8*)(bb + (kt + 1) * 16 * IDX_ROWB + ks * 64);
                __builtin_amdgcn_sched_barrier(0); }
            const h16x8 (&b)[4] = bq[kt & 1];
#pragma unroll
            for (int q = 0; q < 4; ++q) { f32x4 acc = {0.f, 0.f, 0.f, 0.f};
#pragma unroll
                for (int ks = 0; ks < 4; ++ks) acc = __builtin_amdgcn_mfma_f32_16x16x32_f16(a[q][ks], b[ks], acc, 0, 0, 0);
                pq[q][kt & 3] = w4[q][0] * relu_i(acc[0]) + w4[q][1] * relu_i(acc[1]) + w4[q][2] * relu_i(acc[2]) + w4[q][3] * relu_i(acc[3]); }
            if ((kt & 3) == 3) { const int tq = 32 * qb + 4 * wave;
#pragma unroll
                for (int q = 0; q < 4; ++q) {
                    const auto r02 = __builtin_amdgcn_permlane32_swap(__float_as_uint(pq[q][0]), __float_as_uint(pq[q][2]), false, false);
                    const auto r13 = __builtin_amdgcn_permlane32_swap(__float_as_uint(pq[q][1]), __float_as_uint(pq[q][3]), false, false);
                    const float a02 = __uint_as_float(r02[0]) + __uint_as_float(r02[1]), a13 = __uint_as_float(r13[0]) + __uint_as_float(r13[1]);
                    const float keep = (fq & 1) ? a13 : a02, send = (fq & 1) ? a02 : a13;
                    SC[(size_t)(tq + q) * SC_LD + kc * 128 + 64 * (kt >> 2) + lane] = (h16)(keep + __shfl_xor(send, 16)); } }
        }
        IDX_WRITE(par ^ 1);
        asm volatile("s_waitcnt lgkmcnt(0)" ::: "memory"); __builtin_amdgcn_s_barrier(); asm volatile("" ::: "memory");
        par ^= 1; qb = qbn; kc = kcn;
    }
#undef IDX_LOAD
#undef IDX_WRITE
}

template <int NR>
__device__ __forceinline__ unsigned kth_largest(const unsigned (&u)[NR], int K) {
    unsigned prefix = 0u;
#pragma unroll 1
    for (int bit = 15; bit >= 0; --bit) { const unsigned cand = prefix | (1u << bit); int cnt = 0;
#pragma unroll
        for (int i = 0; i < NR; ++i) { cnt += __builtin_popcountll(__ballot(u[i] >= cand)); if ((i & 31) == 31) __builtin_amdgcn_sched_barrier(0); }
        if (cnt >= K) prefix = cand; }
    return prefix;
}
template <int NR, bool ARR>
__device__ __forceinline__ void emit_topk(const unsigned (&u)[NR], unsigned thr_in, int* sel, const int (&keys)[ARR ? NR : 1], int lane) {
    unsigned thr = thr_in; int cgt = 0;
#pragma unroll
    for (int i = 0; i < NR; ++i) { cgt += __builtin_popcountll(__ballot(u[i] > thr)); if ((i & 7) == 7) __builtin_amdgcn_sched_barrier(0); }
    const int need = TOPK - cgt;
    asm volatile("" : "+s"(thr));
    int base = 0, eqseen = 0;
#pragma unroll
    for (int i = 0; i < NR; ++i) {
        const bool gt = u[i] > thr, eq = u[i] == thr;
        const unsigned long long eb = __ballot(eq);
        const int erank = eqseen + (int)__builtin_amdgcn_mbcnt_hi((unsigned)(eb >> 32), __builtin_amdgcn_mbcnt_lo((unsigned)eb, 0u));
        const bool take = gt || (eq && erank < need);
        const unsigned long long tb = __ballot(take);
        const int pos = base + (int)__builtin_amdgcn_mbcnt_hi((unsigned)(tb >> 32), __builtin_amdgcn_mbcnt_lo((unsigned)tb, 0u));
        if (take) sel[pos] = ARR ? keys[ARR ? i : 0] : 64 * i + lane;
        base += __builtin_popcountll(tb); eqseen += __builtin_popcountll(eb);
        __builtin_amdgcn_sched_barrier(0);
    }
}
constexpr int TK_CAP = 768, TK_TARGET = 448;
template <int NREG>
__device__ __forceinline__ void topk_load_row(unsigned (&u)[NREG], const h16* sc_in, int t_in, int lane) {
    static_assert(NREG % 16 == 0, "chunks of 16 registers");
#pragma unroll
    for (int c = 0; c < NREG / 16; ++c) {
        const GAS unsigned short* pc = (const GAS unsigned short*)(sc_in + 1024 * c); asm volatile("" : "+s"(pc));
#pragma unroll
        for (int k = 0; k < 16; ++k) u[16 * c + k] = (unsigned)pc[64 * k + lane];
    }
#pragma unroll
    for (int c = 0; c < NREG / 16; ++c) {
        int tl = t_in - 1024 * c; asm volatile("" : "+s"(tl));
#pragma unroll
        for (int k = 0; k < 16; ++k) { const unsigned b = u[16 * c + k]; const unsigned mk = (b >> 15) ? 0xFFFFu : 0x8000u; u[16 * c + k] = (lane <= tl - 64 * k) ? (b ^ mk) : 0u; }
        __builtin_amdgcn_sched_barrier(0);
    }
}
template <int NREG>
__device__ __forceinline__ void topk_row(const h16* sc_in, int t_in, int* sel, int lane_in, LAS unsigned long long* cand) {
    int lane = lane_in; asm volatile("" : "+v"(lane));
    if constexpr (NREG >= 64) {
        int cn = 0;
        {   unsigned u[NREG];
            topk_load_row<NREG>(u, sc_in, t_in, lane);
            constexpr int NS = NREG / 8;
            unsigned us[NS]; int nsv = 0;
#pragma unroll
            for (int s = 0; s < NS; ++s) { us[s] = u[8 * s]; const int rem = t_in + 1 - 512 * s; nsv += rem < 0 ? 0 : (rem > 64 ? 64 : rem); }
            int Ks = (TK_TARGET * nsv) / (t_in + 1); Ks = Ks < 1 ? 1 : Ks;
            unsigned tau = kth_largest<NS>(us, Ks);
            asm volatile("" : "+s"(tau));
#pragma unroll
            for (int c = 0; c < NREG / 16; ++c) {
                int kb = 1024 * c + lane; asm volatile("" : "+v"(kb));
#pragma unroll
                for (int k = 0; k < 16; ++k) { const int i = 16 * c + k; const bool m = u[i] >= tau && tau != 0u; const unsigned long long mb = __ballot(m);
                    const int pos = cn + (int)__builtin_amdgcn_mbcnt_hi((unsigned)(mb >> 32), __builtin_amdgcn_mbcnt_lo((unsigned)mb, 0u));
                    if (m && pos < TK_CAP) cand[pos] = ((unsigned long long)u[i] << 32) | (unsigned)(kb + 64 * k);
                    cn += __builtin_popcountll(mb); if ((k & 3) == 3) __builtin_amdgcn_sched_barrier(0); }
            }
        }
        asm volatile("" : "+s"(cn));
        if (cn >= TOPK && cn <= TK_CAP) {
            LDS_WAIT();
            unsigned cu[TK_CAP / 64]; int ck[TK_CAP / 64];
#pragma unroll
            for (int k = 0; k < TK_CAP / 64; ++k) { const int ix = 64 * k + lane; const unsigned long long v = cand[ix]; cu[k] = ix < cn ? (unsigned)(v >> 32) : 0u; ck[k] = (int)(unsigned)v; }
            const unsigned thr = kth_largest<TK_CAP / 64>(cu, TOPK);
            emit_topk<TK_CAP / 64, true>(cu, thr, sel, ck, lane);
            LDS_WAIT();
            return;
        }
    }
    {   unsigned u[NREG];
        topk_load_row<NREG>(u, sc_in, t_in, lane);
        const unsigned thr = kth_largest<NREG>(u, TOPK);
        const int nokeys[1] = {0}; emit_topk<NREG, false>(u, thr, sel, nokeys, lane); }
}
__device__ __forceinline__ void topk_phase(const h16* SC, int* SEL, LAS unsigned char* lds, int gw, int NGW, int wave, int lane) {
    LAS unsigned long long* cand = (LAS unsigned long long*)(lds + wave * (TK_CAP * 8));
    for (int t = gw; t < T; t += NGW) {
        const h16* sc = SC + (size_t)t * SC_LD; int* sel = SEL + (size_t)t * TOPK;
        if (t < TOPK) {
#pragma unroll
            for (int j = 0; j < 4; ++j) { const int k = lane + 64 * j; sel[k] = (k <= t) ? k : -1; }
        } else if (t < 2048) topk_row<32>(sc, t, sel, lane, cand);
        else if (t < 4096) topk_row<64>(sc, t, sel, lane, cand);
        else if (t < 6144) topk_row<96>(sc, t, sel, lane, cand);
        else topk_row<128>(sc, t, sel, lane, cand);
    }
}

__device__ __forceinline__ float dot8(h16x8 a, h16x8 b, float c) {
#if __has_builtin(__builtin_amdgcn_fdot2)
    c = __builtin_amdgcn_fdot2((h16x2){a[0], a[1]}, (h16x2){b[0], b[1]}, c, false); c = __builtin_amdgcn_fdot2((h16x2){a[2], a[3]}, (h16x2){b[2], b[3]}, c, false);
    c = __builtin_amdgcn_fdot2((h16x2){a[4], a[5]}, (h16x2){b[4], b[5]}, c, false); c = __builtin_amdgcn_fdot2((h16x2){a[6], a[7]}, (h16x2){b[6], b[7]}, c, false);
#else
#pragma unroll
    for (int e = 0; e < 8; ++e) c += (float)a[e] * (float)b[e];
#endif
    return c;
}
__device__ __forceinline__ void attn_phase(const h16* QH, const h16* KH, const h16* VH, const int* SEL, h16* O, LAS unsigned char* lds, int wg, int G, int wave, int lane) {
    LAS h16* qs = (LAS h16*)(lds + wave * 6144);
    LAS float* ps = (LAS float*)(lds + wave * 6144 + 1024);
    LAS int* is = (LAS int*)(lds + wave * 6144 + 5120);
    const int grp = lane >> 4, c = lane & 15;
    for (int L = wg; L < (T / 8) * NKV; L += G) {
        const int g = L & 3, t = 8 * (L >> 2) + wave;
        int idx[4];
#pragma unroll
        for (int j = 0; j < 4; ++j) idx[j] = SEL[(size_t)t * TOPK + lane + 64 * j];
        *(LAS h16x8*)(qs + lane * 8) = *(const h16x8*)(QH + (size_t)t * D + g * 512 + lane * 8);
#pragma unroll
        for (int j = 0; j < 4; ++j) is[lane + 64 * j] = idx[j] < 0 ? 0 : idx[j];
        LDS_WAIT();
        float sc[4][4];
#pragma unroll
        for (int j = 0; j < 4; ++j) { const h16* krow = KH + (size_t)(idx[j] < 0 ? 0 : idx[j]) * 512 + g * HD; h16x8 kf[16];
#pragma unroll
            for (int cc = 0; cc < 16; ++cc) kf[cc] = *(const h16x8*)(krow + 8 * cc);
#pragma unroll
            for (int hh = 0; hh < 4; ++hh) { float s = 0.f;
#pragma unroll
                for (int cc = 0; cc < 16; ++cc) s = dot8(kf[cc], *(const LAS h16x8*)(qs + hh * HD + 8 * cc), s);
                sc[j][hh] = (idx[j] < 0) ? -__builtin_inff() : s * 0.08838834764831845f; }
            __builtin_amdgcn_sched_barrier(0); }
#pragma unroll
        for (int hh = 0; hh < 4; ++hh) {
            const float mx = wave_max(fmaxf(fmaxf(sc[0][hh], sc[1][hh]), fmaxf(sc[2][hh], sc[3][hh])));
            float e0 = __expf(sc[0][hh] - mx), e1 = __expf(sc[1][hh] - mx), e2 = __expf(sc[2][hh] - mx), e3 = __expf(sc[3][hh] - mx);
            const float inv = 1.0f / wave_sum((e0 + e1) + (e2 + e3));
            sc[0][hh] = e0 * inv; sc[1][hh] = e1 * inv; sc[2][hh] = e2 * inv; sc[3][hh] = e3 * inv; }
#pragma unroll
        for (int j = 0; j < 4; ++j) *(LAS f32x4*)(ps + 4 * (lane + 64 * j)) = (f32x4){sc[j][0], sc[j][1], sc[j][2], sc[j][3]};
        LDS_WAIT();
        float acc[4][8];
#pragma unroll
        for (int hh = 0; hh < 4; ++hh)
#pragma unroll
            for (int e = 0; e < 8; ++e) acc[hh][e] = 0.f;
#pragma unroll 4
        for (int it = 0; it < 64; ++it) { const int kk = 4 * it + grp; const int ik = is[kk]; const f32x4 p4 = *(const LAS f32x4*)(ps + 4 * kk);
            const h16x8 v8 = *(const h16x8*)(VH + (size_t)ik * 512 + g * HD + 8 * c);
#pragma unroll
            for (int hh = 0; hh < 4; ++hh)
#pragma unroll
                for (int e = 0; e < 8; ++e) acc[hh][e] += p4[hh] * (float)v8[e];
            if ((it & 3) == 3) __builtin_amdgcn_sched_barrier(0); }
#pragma unroll
        for (int hh = 0; hh < 4; ++hh)
#pragma unroll
            for (int e = 0; e < 8; ++e) { float v = acc[hh][e]; v += __shfl_xor(v, 16); v += __shfl_xor(v, 32); acc[hh][e] = v; }
        float o8[8];
#pragma unroll
        for (int e = 0; e < 8; ++e) o8[e] = grp == 0 ? acc[0][e] : grp == 1 ? acc[1][e] : grp == 2 ? acc[2][e] : acc[3][e];
        v4u w; w.x = pkh(o8[0], o8[1]); w.y = pkh(o8[2], o8[3]); w.z = pkh(o8[4], o8[5]); w.w = pkh(o8[6], o8[7]);
        *(v4u*)(O + (size_t)t * D + (4 * g + grp) * HD + 8 * c) = w;
        LDS_WAIT();
    }
}

__device__ __forceinline__ void conv_phase(const h16* PROJ, const float* cw, const float* cb, h16* XC, int gtid, int NGT) {
    h16x8 xn[4];
#define CONV_LOAD(i_) do { const int c8_ = ((i_) & 255) * 8, t_ = (i_) >> 8; _Pragma("unroll") for (int j = 0; j < 4; ++j) { const int tt = t_ - 3 + j; xn[j] = *(const h16x8*)(PROJ + (size_t)(tt < 0 ? 0 : tt) * 4096 + 2048 + c8_); } } while (0)
    if (gtid < T * 256) CONV_LOAD(gtid);
    for (int i = gtid; i < T * 256; i += NGT) { const int c8 = (i & 255) * 8, t = i >> 8;
        h16x8 xv[4];
#pragma unroll
        for (int j = 0; j < 4; ++j) xv[j] = xn[j];
        if (i + NGT < T * 256) CONV_LOAD(i + NGT);
        float acc[8];
#pragma unroll
        for (int e = 0; e < 8; ++e) acc[e] = cb[c8 + e];
#pragma unroll
        for (int j = 0; j < 4; ++j) { const int tt = t - 3 + j; if (tt >= 0) {
            const f32x4 w0 = *(const f32x4*)(cw + j * 2048 + c8), w1 = *(const f32x4*)(cw + j * 2048 + c8 + 4);
#pragma unroll
            for (int e = 0; e < 4; ++e) { acc[e] += (float)xv[j][e] * w0[e]; acc[4 + e] += (float)xv[j][4 + e] * w1[e]; } } }
        v4u w; w.x = pkh(acc[0], acc[1]); w.y = pkh(acc[2], acc[3]); w.z = pkh(acc[4], acc[5]); w.w = pkh(acc[6], acc[7]);
        *(v4u*)(XC + (size_t)t * 2048 + c8) = w; }
#undef CONV_LOAD
}
constexpr int SCAN_LC = 64, SCAN_NCH = T / SCAN_LC;
__device__ __forceinline__ f32x4 ld_a4(const h16* LA, size_t o) { const h16x4 v = *(const h16x4*)(LA + o); return (f32x4){__expf((float)v[0]), __expf((float)v[1]), __expf((float)v[2]), __expf((float)v[3])}; }
__device__ __forceinline__ f32x4 ld_b4(const h16* BF, size_t o) { const h16x4 v = *(const h16x4*)(BF + o); return (f32x4){(float)v[0], (float)v[1], (float)v[2], (float)v[3]}; }
__device__ __forceinline__ void scan_agg_phase(const h16* AF, const h16* BF, float* AGGA, float* AGGB, int gtid, int NGT) {
    for (int i = gtid; i < SCAN_NCH * 512; i += NGT) { const int cg = (i & 511) * 4, k = i >> 9;
        f32x4 Pr = {1.f, 1.f, 1.f, 1.f}, H = {0.f, 0.f, 0.f, 0.f};
#pragma unroll 16
        for (int r = 0; r < SCAN_LC; ++r) { const size_t o = (size_t)(k * SCAN_LC + r) * 2048 + cg; const f32x4 a = ld_a4(AF, o), b = ld_b4(BF, o); H = a * H + b; Pr = Pr * a; }
        *(f32x4*)(AGGA + (size_t)k * 2048 + cg) = Pr; *(f32x4*)(AGGB + (size_t)k * 2048 + cg) = H; }
}
__device__ __forceinline__ float gelu_tanh(float x) { const float u = 0.7978845608028654f * (x + 0.044715f * x * x * x); const float e = __expf(2.0f * u); const float th = 1.0f - 2.0f / (e + 1.0f); return 0.5f * x * (1.0f + th); }
__device__ __forceinline__ void scan_final_phase(const h16* AF, const h16* BF, const float* AGGA, const float* AGGB, const h16* PROJ, h16* Y, int gtid, int NGT) {
    for (int i = gtid; i < SCAN_NCH * 512; i += NGT) { const int cg = (i & 511) * 4, k = i >> 9;
        f32x4 H = {0.f, 0.f, 0.f, 0.f};
#pragma unroll 8
        for (int j = 0; j < k; ++j) { const f32x4 a = *(const f32x4*)(AGGA + (size_t)j * 2048 + cg), b = *(const f32x4*)(AGGB + (size_t)j * 2048 + cg); H = a * H + b; }
#pragma unroll 8
        for (int r = 0; r < SCAN_LC; ++r) { const int t = k * SCAN_LC + r; const size_t o = (size_t)t * 2048 + cg; const f32x4 a = ld_a4(AF, o), b = ld_b4(BF, o); H = a * H + b;
            const h16x4 gt = *(const h16x4*)(PROJ + (size_t)t * 4096 + cg);
            v2u w; w.x = pkh(H[0] * gelu_tanh((float)gt[0]), H[1] * gelu_tanh((float)gt[1])); w.y = pkh(H[2] * gelu_tanh((float)gt[2]), H[3] * gelu_tanh((float)gt[3]));
            *(v2u*)(Y + o) = w; } }
}
__device__ __forceinline__ f32x4 ldx4(const h16* p) { const h16x4 v = *(const h16x4*)p; return (f32x4){(float)v[0], (float)v[1], (float)v[2], (float)v[3]}; }
__device__ __forceinline__ void pool_phase(const h16* X, const float* gain, h16* Y, LAS unsigned char* lds, int wg, int G, int tid, int wave, int lane) {
    LAS float* rs = (LAS float*)lds;
    const int c4 = tid * 4; const int w = 2 << (tid >> 7);
    const f32x4 gn = *(const f32x4*)(gain + c4);
    for (int u = wg; u < T / 32; u += G) { const int t0 = 32 * u;
        __syncthreads();
        for (int r = wave; r < 47; r += NWAVES) { const int t = t0 - 15 + r;
            if (t >= 0) { const h16* xr = X + (size_t)t * D + 4 * lane; float s = 0.f;
#pragma unroll
                for (int j = 0; j < 8; ++j) { const f32x4 v = ldx4(xr + 256 * j); s += (v.x * v.x + v.y * v.y) + (v.z * v.z + v.w * v.w); }
                s = wave_sum(s); if (lane == 0) rs[r] = 1.0f / sqrtf(s * (1.0f / D) + EPS); } }
        __syncthreads();
        f32x4 sum = {0.f, 0.f, 0.f, 0.f};
        { const int n0 = (t0 + 1) < w ? (t0 + 1) : w;
          for (int j = 1; j < n0; ++j) sum += ldx4(X + (size_t)(t0 - j) * D + c4) * rs[15 - j]; }
#pragma unroll 8
        for (int r = 0; r < 32; ++r) { const int t = t0 + r; const int n = (t + 1) < w ? (t + 1) : w;
            const f32x4 h0 = ldx4(X + (size_t)t * D + c4) * rs[15 + r];
            sum += h0;
            const float invn = 1.0f / (float)n;
            const f32x4 y = (sum * invn - h0) * gn;
            v2u o; o.x = pkh(y.x, y.y); o.y = pkh(y.z, y.w); *(v2u*)(Y + (size_t)t * D + c4) = o;
            if (t + 1 >= w) sum -= ldx4(X + (size_t)(t + 1 - w) * D + c4) * rs[15 + r + 1 - w]; }
    }
}

__device__ __forceinline__ h16x8 f8x8_to_h(unsigned d0, unsigned d1) {
    const h16x2 a = __builtin_amdgcn_cvt_scalef32_pk_f16_fp8((int)d0, 1.0f, false), b = __builtin_amdgcn_cvt_scalef32_pk_f16_fp8((int)d0, 1.0f, true);
    const h16x2 c = __builtin_amdgcn_cvt_scalef32_pk_f16_fp8((int)d1, 1.0f, false), d = __builtin_amdgcn_cvt_scalef32_pk_f16_fp8((int)d1, 1.0f, true);
    return (h16x8){a[0], a[1], b[0], b[1], c[0], c[1], d[0], d[1]};
}
__device__ __forceinline__ unsigned attn_off_b(unsigned row, unsigned ch) { return 256u * row + 16u * (ch ^ (((row & 3u) << 2) | ((row >> 2) & 3u))); }
__device__ __forceinline__ void attn_mfma_phase(const unsigned char* Q8, const unsigned char* K8, const unsigned char* V8, const int* SEL, h16* O, LAS unsigned char* lds, int wg, int G, int wave, int lane_in) {
    typedef int i32x4 __attribute__((ext_vector_type(4)));
    typedef int i32x2 __attribute__((ext_vector_type(2)));
    typedef long i64x2 __attribute__((ext_vector_type(2)));
    i32x4 svn = {0, 0, 0, 0}; i64x2 qfn[2] = {{0, 0}, {0, 0}};
#define AT_PREF(L_) do { const int g_ = (L_) & 3, t_ = 8 * ((L_) >> 2) + wave; svn = *(const i32x4*)(SEL + (size_t)t_ * TOPK + 4 * lane_in); \
        _Pragma("unroll") for (int pp = 0; pp < 2; ++pp) qfn[pp] = *(const i64x2*)(Q8 + (size_t)t_ * D + (4 * g_ + (lane_in & 3)) * HD + 64 * pp + 16 * (lane_in >> 4)); } while (0)
    v4u kga[4], kgb[4];
#define AT_LOADK2(buf, G_, selk_, kbase_) do { const i32x2 i0 = *(const LAS i32x2*)((selk_) + 2 * (G_)), i1 = *(const LAS i32x2*)((selk_) + 128 + 2 * (G_)); \
            buf[0] = *(const v4u*)((kbase_) + (size_t)(i0.x < 0 ? 0 : i0.x) * 512); buf[1] = *(const v4u*)((kbase_) + (size_t)(i1.x < 0 ? 0 : i1.x) * 512); \
            buf[2] = *(const v4u*)((kbase_) + (size_t)(i0.y < 0 ? 0 : i0.y) * 512); buf[3] = *(const v4u*)((kbase_) + (size_t)(i1.y < 0 ? 0 : i1.y) * 512); } while (0)
#define AT_PREP(L_, par_) do { LAS int* sst_ = (LAS int*)(lds + LDSCTL_OFF + 1024 + wave * 2048 + (par_) * 1024); *(LAS i32x4*)(sst_ + 4 * lane_in) = svn; \
        asm volatile("s_waitcnt lgkmcnt(0)" ::: "memory"); \
        const LAS int* selk_ = sst_ + 16 * (lane_in >> 3); const unsigned char* kbase_ = K8 + ((L_) & 3) * HD + 16 * (lane_in & 7); \
        AT_LOADK2(kga, 0, selk_, kbase_); AT_LOADK2(kgb, 1, selk_, kbase_); } while (0)
    if (wg < (T / 8) * NKV) { AT_PREF(wg); AT_PREP(wg, 0); }
    int itpar = 0;
    for (int L = wg; L < (T / 8) * NKV; L += G, itpar ^= 1) {
        int lane = lane_in; asm volatile("" : "+v"(lane));
        const int jl = lane & 15, gi = lane >> 4;
        const int g = L & 3, t = 8 * (L >> 2) + wave;
        const int* sel = SEL + (size_t)t * TOPK; (void)sel;
        const int nvalid = (t + 1) < TOPK ? (t + 1) : TOPK;
        LAS int* sst = (LAS int*)(lds + LDSCTL_OFF + 1024 + wave * 2048 + itpar * 1024);
        i64x2 qf[2];
#pragma unroll
        for (int pp = 0; pp < 2; ++pp) qf[pp] = qfn[pp];
        LAS unsigned char* vimg = lds + wave * 16384;
        const LAS int* selk = sst + 16 * (lane >> 3);
        const unsigned char* kbase = K8 + g * HD + 16 * (lane & 7);
        const unsigned kwr = 136u * (unsigned)(lane >> 3) + 16u * (unsigned)(lane & 7), krd = 136u * (unsigned)jl + 16u * (unsigned)gi;
        f32x4 s[16];
#define AT_LOADK(buf, G_) AT_LOADK2(buf, G_, selk, kbase)
#define AT_KSTEP(buf, G_) do { LAS unsigned char* kb_ = vimg + ((G_) & 1) * 8192; \
            _Pragma("unroll") for (int j = 0; j < 4; ++j) { *(LAS v2u*)(kb_ + kwr + 1088 * j) = (v2u){buf[j].x, buf[j].y}; *(LAS v2u*)(kb_ + kwr + 1088 * j + 8) = (v2u){buf[j].z, buf[j].w}; } \
            if ((G_) + 2 < 8) AT_LOADK(buf, (G_) + 2); \
            _Pragma("unroll") for (int tt = 0; tt < 2; ++tt) { f32x4 acc = {0.f, 0.f, 0.f, 0.f}; \
                _Pragma("unroll") for (int pp = 0; pp < 2; ++pp) { const long a0 = *(const LAS long*)(kb_ + krd + 2176 * tt + 64 * pp), a1 = *(const LAS long*)(kb_ + krd + 2176 * tt + 64 * pp + 8); \
                    acc = __builtin_amdgcn_mfma_f32_16x16x32_fp8_fp8(a0, qf[pp].x, acc, 0, 0, 0); acc = __builtin_amdgcn_mfma_f32_16x16x32_fp8_fp8(a1, qf[pp].y, acc, 0, 0, 0); } \
                s[2 * (G_) + tt] = acc; } } while (0)
        if (L + G < (T / 8) * NKV) AT_PREF(L + G);
        AT_KSTEP(kga, 0); AT_KSTEP(kgb, 1); AT_KSTEP(kga, 2); AT_KSTEP(kgb, 3); AT_KSTEP(kga, 4); AT_KSTEP(kgb, 5); AT_KSTEP(kga, 6); AT_KSTEP(kgb, 7);
#undef AT_LOADK
#undef AT_KSTEP
        const LAS int* selv = sst + ((lane >> 5) & 1) + 16 * ((lane >> 3) & 3);
        const unsigned char* vbase = V8 + g * HD + 16 * (lane & 7);
        v4u vsa[4], vsb[4];
#define AT_LOADV(vst, Tt) do { _Pragma("unroll") for (int i = 0; i < 4; ++i) { const int ix = selv[2 * (Tt) + 64 * i]; vst[i] = *(const v4u*)(vbase + (size_t)(ix < 0 ? 0 : ix) * 512); } } while (0)
        AT_LOADV(vsa, 0); AT_LOADV(vsb, 1);
        __builtin_amdgcn_sched_barrier(0);
        if (nvalid < TOPK) {
#pragma unroll
            for (int kt = 0; kt < 16; ++kt)
#pragma unroll
                for (int r = 0; r < 4; ++r) if (kt + 64 * gi + 16 * r >= nvalid) s[kt][r] = -__builtin_inff();
        }
        float mx = -__builtin_inff();
#pragma unroll
        for (int kt = 0; kt < 16; ++kt) mx = fmaxf(mx, fmaxf(fmaxf(s[kt][0], s[kt][1]), fmaxf(s[kt][2], s[kt][3])));
        mx = fmaxf(mx, __shfl_xor(mx, 16)); mx = fmaxf(mx, __shfl_xor(mx, 32));
        constexpr float C2 = 0.08838834764831845f * 1.4426950408889634f;
        const float mb = -mx * C2; float sum = 0.f;
        h16x8 pf[8];
#pragma unroll
        for (int Tt = 0; Tt < 8; ++Tt) { float p[8];
#pragma unroll
            for (int r = 0; r < 4; ++r) { p[r] = __builtin_amdgcn_exp2f(fmaf(s[2 * Tt][r], C2, mb)); p[4 + r] = __builtin_amdgcn_exp2f(fmaf(s[2 * Tt + 1][r], C2, mb)); }
            sum += ((p[0] + p[1]) + (p[2] + p[3])) + ((p[4] + p[5]) + (p[6] + p[7]));
            pf[Tt] = (h16x8){(h16)p[0], (h16)p[1], (h16)p[2], (h16)p[3], (h16)p[4], (h16)p[5], (h16)p[6], (h16)p[7]}; }
        sum += __shfl_xor(sum, 16); sum += __shfl_xor(sum, 32);
        const float linv = 1.0f / sum;
        const unsigned q4 = (unsigned)jl >> 2, p4 = (unsigned)jl & 3u;
        unsigned wr_off[8], rd_off[2];
#pragma unroll
        for (int i = 0; i < 4; ++i) { wr_off[2 * i] = attn_off_b((unsigned)((lane >> 3) + 8 * i), 2u * (lane & 7)); wr_off[2 * i + 1] = attn_off_b((unsigned)((lane >> 3) + 8 * i), 2u * (lane & 7) + 1u); }
#pragma unroll
        for (int tt = 0; tt < 2; ++tt) { const unsigned row = 8u * gi + 4u * tt + q4; const unsigned x = ((row & 3u) << 2) | ((row >> 2) & 3u);
            rd_off[tt] = 256u * row + 16u * ((p4 >> 1) ^ (x & 1u)) + 8u * (p4 & 1u) + 32u * (x >> 1); }
        f32x4 o[8];
#pragma unroll
        for (int c = 0; c < 8; ++c) o[c] = (f32x4){0.f, 0.f, 0.f, 0.f};
#define AT_STEP(vst, Tt) do { \
            _Pragma("unroll") for (int i = 0; i < 4; ++i) {     \
                *(LAS h16x8*)(vimg + ((Tt) & 1) * 8192 + wr_off[2 * i]) = f8x8_to_h(vst[i].x, vst[i].y); *(LAS h16x8*)(vimg + ((Tt) & 1) * 8192 + wr_off[2 * i + 1]) = f8x8_to_h(vst[i].z, vst[i].w); } \
            if ((Tt) + 2 < 8) AT_LOADV(vst, (Tt) + 2); \
            const unsigned ib = (unsigned)(size_t)(vimg + ((Tt) & 1) * 8192); \
            h16x4 lo[8], hi[8]; \
            asm volatile("s_waitcnt lgkmcnt(0)" ::: "memory"); \
            _Pragma("unroll") for (int c = 0; c < 8; ++c) { \
                asm volatile("ds_read_b64_tr_b16 %0, %1" : "=&v"(lo[c]) : "v"(ib + (rd_off[0] ^ ((unsigned)c << 5))) : "memory"); \
                asm volatile("ds_read_b64_tr_b16 %0, %1" : "=&v"(hi[c]) : "v"(ib + (rd_off[1] ^ ((unsigned)c << 5))) : "memory"); } \
            asm volatile("s_waitcnt lgkmcnt(0)" ::: "memory"); __builtin_amdgcn_sched_barrier(0); \
            _Pragma("unroll") for (int c = 0; c < 8; ++c) o[c] = __builtin_amdgcn_mfma_f32_16x16x32_f16(pf[Tt], (h16x8){lo[c][0], lo[c][1], lo[c][2], lo[c][3], hi[c][0], hi[c][1], hi[c][2], hi[c][3]}, o[c], 0, 0, 0); \
        } while (0)
        AT_STEP(vsa, 0); AT_STEP(vsb, 1); AT_STEP(vsa, 2); AT_STEP(vsb, 3); AT_STEP(vsa, 4); AT_STEP(vsb, 5); AT_STEP(vsa, 6); AT_STEP(vsb, 7);
#undef AT_STEP
#undef AT_LOADV
        const float li = __shfl(linv, gi);
        h16* orow = O + (size_t)t * D + (4 * g + gi) * HD + jl;
#pragma unroll
        for (int c = 0; c < 8; ++c) { const float v = gi == 0 ? o[c][0] : gi == 1 ? o[c][1] : gi == 2 ? o[c][2] : o[c][3]; orow[16 * c] = (h16)(v * li); }
        asm volatile("s_waitcnt lgkmcnt(0)" ::: "memory");
        if (L + G < (T / 8) * NKV) AT_PREP(L + G, itpar ^ 1);
    }
#undef AT_PREF
#undef AT_PREP
#undef AT_LOADK2
}

constexpr int NPH = 37;
__global__ void __launch_bounds__(NTHR, 2) fwd_kernel(Ptrs P_unused) {
    extern __shared__ __attribute__((aligned(16))) unsigned char lds_raw[];
    LAS unsigned char* lds = (LAS unsigned char*)lds_raw;
    volatile LAS unsigned* MISC = (volatile LAS unsigned*)(lds + MISC_OFF);
    for (int u = threadIdx.x; u < (LDS_BYTES - LDSCTL_OFF) / 4; u += NTHR) ((LAS unsigned*)(lds + LDSCTL_OFF))[u] = 0u;
    __syncthreads();
    int lo, hi;
    XcdBarrier bar;
    { const CAS Ptrs* PP = kargs(); lo = PP->ph_lo; hi = PP->ph_hi; unsigned* bw = (unsigned*)(PP->ws + WS_CTL) + CW_BAR;
      bar.bar = bw; bar.x = 0; bar.st = nullptr; if (hi - lo > 1) bar = xcd_barrier_post(bw, MISC + 8); }
    int seq = 0;
#define PH_BEGIN(S_) if (seq >= lo && seq < hi) { const CAS Ptrs* PP = kargs(); unsigned char* const ws = PP->ws; float* const X = PP->out; (void)X; \
        int tid = threadIdx.x, bx = blockIdx.x, G = gridDim.x; asm volatile("" : "+v"(tid), "+s"(bx), "+s"(G)); \
        const int lane = tid & 63, wave = __builtin_amdgcn_readfirstlane(tid >> 6); const int vcu = (G % 8 == 0) ? (bx % 8) * (G / 8) + bx / 8 : bx; \
        const int gw = vcu * NWAVES + wave, NGW = G * NWAVES, gtid = vcu * NTHR + tid, NGT = G * NTHR; (void)lane; (void)gw; (void)NGW; (void)gtid; (void)NGT; \
        for (int rep_ = 0; rep_ < 1 + (int)((REP_MASK >> (S_)) & 1u); ++rep_) { if (rep_) __syncthreads(); \
        h16* const X16 = (h16*)(ws + WS_X16); h16* const PROJ = (h16*)(ws + WS_BA + BA_PROJ); h16* const U16 = (h16*)(ws + WS_BA + BA_U); (void)X16; (void)PROJ; (void)U16;
#define PH_END   } if (seq + 1 < hi) xcd_barrier(bar); } ++seq;
#define RSQ(i_) ((float*)(ws + WS_CTL + WS_ROWSQ) + (size_t)(i_) * T)
#define PARTA ((float*)(ws + WS_PARTA))
#define PARTB ((float*)(ws + WS_PARTB))

    PH_BEGIN(0) p0_prologue(PP, lds, gw, NGW, wave, lane, gtid, NGT); norm0_phase(PP->x, X16, RSQ(0), gw, NGW, lane); PH_END

#pragma unroll 1
    for (int layer = 0; layer < DEPTH; ++layer) {
        const int kind = layer % 3, j = layer / 3;
        if (kind == 0) {
            PH_BEGIN(2) { pg8::Gemm g{X16, (const h16*)(ws + WS_WINA) + (size_t)j * A_INP * D, T, A_INP, D, D, 1 << 20, D, 128, 128}; pg8::StaticOrder S; S.init(T, A_INP, G, bx);
                       pg8::EpiF16<0> E{PROJ, A_INP, layer == 0 ? RSQ(0) : PARTB, 0, layer == 0 ? 0 : 32}; pg8::gemm_phase<pg8::EpiF16<0>, pg8::StaticOrder, true, true>(lds, g, S, E, tid); } PH_END
            PH_BEGIN(3) dsa_post_phase(PROJ, PP->attn_qn + j * HD, PP->attn_kn + j * HD, (const float*)(ws + WS_COS128), (const float*)(ws + WS_SIN128), (const float*)(ws + WS_COS64), (const float*)(ws + WS_SIN64),
                                    (unsigned char*)(ws + WS_QH), (unsigned char*)(ws + WS_KH), (unsigned char*)(ws + WS_VH), (h16*)(ws + WS_IQ), (h16*)(ws + WS_IK), (float*)(ws + WS_IW), gw, NGW, lane); PH_END
            PH_BEGIN(4) idx_scores_phase((const h16*)(ws + WS_IQ), (const h16*)(ws + WS_IK), (const float*)(ws + WS_IW), (h16*)(ws + WS_BA + BA_SC), lds, vcu, G, tid, wave, lane); PH_END
            PH_BEGIN(5) topk_phase((const h16*)(ws + WS_BA + BA_SC), (int*)(ws + WS_SEL), lds, gw, NGW, wave, lane); PH_END
            PH_BEGIN(6) attn_mfma_phase((const unsigned char*)(ws + WS_QH), (const unsigned char*)(ws + WS_KH), (const unsigned char*)(ws + WS_VH), (const int*)(ws + WS_SEL), (h16*)(ws + WS_BA + BA_O16), lds, bx, G, wave, lane); PH_END
            PH_BEGIN(7) { pg8::Gemm g{(const h16*)(ws + WS_BA + BA_O16), (const h16*)(ws + WS_WOUTA) + (size_t)j * D * D, T, D, D, D, 1 << 20, D, 128, 128}; pg8::StaticOrder S; S.init(T, D, G, bx);
                       pg8::EpiResid E{X16, X16, nullptr, D, nullptr, nullptr, PARTA}; pg8::gemm_phase<pg8::EpiResid, pg8::StaticOrder, true, true>(lds, g, S, E, tid); } PH_END
        } else if (kind == 1) {
            PH_BEGIN(9) { pg8::Gemm g{X16, (const h16*)(ws + WS_WINR), T, 4096, D, D, 1 << 20, D, 128, 128}; pg8::StaticOrder S; S.init(T, 4096, G, bx);
                       pg8::EpiF16<0> E{PROJ, 4096, layer == 0 ? RSQ(0) : PARTB, 0, layer == 0 ? 0 : 32}; pg8::gemm_phase<pg8::EpiF16<0>, pg8::StaticOrder, true, true>(lds, g, S, E, tid); } PH_END
            PH_BEGIN(10) conv_phase(PROJ, PP->conv_w, PP->conv_b, (h16*)(ws + WS_BA + BA_XC), gtid, NGT); PH_END
            PH_BEGIN(11) { int kg = 256; asm volatile("" : "+s"(kg));
                       pg8::Gemm g{(const h16*)(ws + WS_BA + BA_XC), (const h16*)(ws + WS_WGR), T, 4096, kg, D, 2, kg, 128, 128}; pg8::StaticOrder S; S.init(T, 4096, G, bx);
                       pg8::EpiGates E{(const h16*)(ws + WS_BA + BA_XC), PP->ga_b, PP->gx_b, PP->lam, (h16*)(ws + WS_BA + BA_AF), (h16*)(ws + WS_BA + BA_BF)};
                       pg8::gemm_phase<pg8::EpiGates, pg8::StaticOrder, true, true>(lds, g, S, E, tid); } PH_END
            PH_BEGIN(12) scan_agg_phase((const h16*)(ws + WS_BA + BA_AF), (const h16*)(ws + WS_BA + BA_BF), (float*)(ws + WS_AGGA), (float*)(ws + WS_AGGB), gtid, NGT); PH_END
            PH_BEGIN(13) scan_final_phase((const h16*)(ws + WS_BA + BA_AF), (const h16*)(ws + WS_BA + BA_BF), (const float*)(ws + WS_AGGA), (const float*)(ws + WS_AGGB), PROJ, (h16*)(ws + WS_BA + BA_XC), gtid, NGT); PH_END
            PH_BEGIN(14) { pg8::Gemm g{(const h16*)(ws + WS_BA + BA_XC), (const h16*)(ws + WS_WOUTR), T, D, D, D, 1 << 20, D, 128, 128}; pg8::StaticOrder S; S.init(T, D, G, bx);
                       pg8::EpiResid E{X16, X16, nullptr, D, nullptr, nullptr, PARTA}; pg8::gemm_phase<pg8::EpiResid, pg8::StaticOrder, true, true>(lds, g, S, E, tid); } PH_END
        } else {
            PH_BEGIN(15) pool_phase(X16, PP->pool_norm, (h16*)(ws + WS_BA + BA_XC), lds, vcu, G, tid, wave, lane); PH_END
            PH_BEGIN(16) { pg8::Gemm g{(const h16*)(ws + WS_BA + BA_XC), (const h16*)(ws + WS_WPOOL), T, D, 512, D, 2, 512, 128, 128}; pg8::StaticOrder S; S.init(T, D, G, bx);
                       pg8::EpiResid E{X16, X16, nullptr, D, PP->pool_b, PP->pool_scale, PARTA}; pg8::gemm_phase<pg8::EpiResid, pg8::StaticOrder, true, true>(lds, g, S, E, tid); } PH_END
        }
        PH_BEGIN(17) quant_rows(X16, T, (signed char*)(ws + WS_BA + BA_A8), (float*)(ws + WS_RS), PARTA, nullptr, gw, NGW, lane);
                     quant_rows((const h16*)(ws + WS_WUP) + (size_t)layer * D * FF, FF, (signed char*)(ws + WS_BA + BA_W8), (float*)(ws + WS_CS), nullptr, (const unsigned*)(ws + WS_BLKMAX) + (size_t)layer * 32 * FF, gw, NGW, lane); PH_END
        PH_BEGIN(18) { pg8::Gemm g{(const h16*)(ws + WS_BA + BA_A8), (const h16*)(ws + WS_BA + BA_W8), T, FF, D / 2, D / 2, 1 << 20, D / 2, 128, 128}; pg8::StaticOrder S; S.init(T, FF, G, bx);
                   pg8::EpiQRelu2<pg8::i32x4> E{U16, (const float*)(ws + WS_RS), (const float*)(ws + WS_CS), T}; pg8::gemm_phase_i8<pg8::EpiQRelu2<pg8::i32x4>, pg8::StaticOrder, true, true>(lds, g, S, E, tid); } PH_END
        PH_BEGIN(19) quant_kblk<true>(U16, T, (signed char*)(ws + WS_BA + BA_U8), (float*)(ws + WS_RS2), nullptr, nullptr, gw, NGW, lane);
                     quant_kblk<false>((const h16*)(ws + WS_WDOWN) + (size_t)layer * D * FF, D, (signed char*)(ws + WS_BA + BA_W8D), (float*)(ws + WS_CS2), (float*)(ws + WS_CSUM), (const unsigned*)(ws + WS_BLKMAXD) + (size_t)layer * 128 * D, gw, NGW, lane); PH_END
        PH_BEGIN(20) { pg8::Gemm g{(const h16*)(ws + WS_BA + BA_U8), (const h16*)(ws + WS_BA + BA_W8D), T, D, FF / 2, 64, 1 << 20, 64, (size_t)T * 128, (size_t)D * 128}; pg8::StaticOrder S; S.init(T, D, G, bx);
                   const bool lastl = layer + 1 >= DEPTH, needsq = !lastl && (layer + 1) % 3 != 2;
                   pg8::EpiResidQ E{X16, X16, lastl ? X : nullptr, D, (const float*)(ws + WS_RS2), (const float*)(ws + WS_CS2), (const float*)(ws + WS_CSUM), needsq ? PARTB : nullptr};
                   pg8::gemm_phase_i8<pg8::EpiResidQ, pg8::StaticOrder, true, true>(lds, g, S, E, tid); } PH_END
    }
#undef PH_BEGIN
#undef PH_END
#undef RSQ
#undef PARTA
#undef PARTB
}

extern "C" void kernel_launch(void* const* d_in, const int* in_sizes, int n_in, void* d_out, int out_size, void* d_ws, size_t ws_size, hipStream_t stream) {
    static int grid = 0;
    if (grid == 0) {
        if (n_in != 24 || in_sizes[0] != T * D || out_size != T * D || ws_size < WS_END) { fprintf(stderr, "kernel_launch: unexpected shapes / workspace (n_in %d, in0 %d, out %d, ws %zu, need %zu); nothing launched\n", n_in, n_in > 0 ? in_sizes[0] : -1, out_size, ws_size, (size_t)WS_END); grid = -1; return; }
        int dev = 0, cus = 0, per_cu = 0;
        if (hipGetDevice(&dev) != hipSuccess || hipDeviceGetAttribute(&cus, hipDeviceAttributeMultiprocessorCount, dev) != hipSuccess) { grid = -1; return; }
        if (hipFuncSetAttribute((const void*)fwd_kernel, hipFuncAttributeMaxDynamicSharedMemorySize, LDS_BYTES) != hipSuccess) { fprintf(stderr, "kernel_launch: hipFuncSetAttribute failed\n"); grid = -1; return; }
        if (hipOccupancyMaxActiveBlocksPerMultiprocessor(&per_cu, (const void*)fwd_kernel, NTHR, LDS_BYTES) != hipSuccess || per_cu < 1) { fprintf(stderr, "kernel_launch: occupancy query reports %d workgroups per CU\n", per_cu); }
        (void)hipGetLastError();
        grid = cus;
    }
    if (grid < 0) return;
    if (hipMemsetAsync((char*)d_ws + WS_CTL, 0, CTL_ZERO_BYTES, stream) != hipSuccess) return;
    Ptrs p{};
    p.x = (const float*)d_in[0]; p.pos = (const int*)d_in[1];
    p.attn_norm = (const float*)d_in[2]; p.attn_w_in = (const float*)d_in[3]; p.attn_qn = (const float*)d_in[4]; p.attn_kn = (const float*)d_in[5]; p.attn_w_out = (const float*)d_in[6];
    p.rnn_norm = (const float*)d_in[7]; p.rnn_w_in = (const float*)d_in[8]; p.conv_w = (const float*)d_in[9]; p.conv_b = (const float*)d_in[10]; p.ga_w = (const float*)d_in[11]; p.ga_b = (const float*)d_in[12];
    p.gx_w = (const float*)d_in[13]; p.gx_b = (const float*)d_in[14]; p.lam = (const float*)d_in[15]; p.rnn_w_out = (const float*)d_in[16];
    p.pool_norm = (const float*)d_in[17]; p.pool_w = (const float*)d_in[18]; p.pool_b = (const float*)d_in[19]; p.pool_scale = (const float*)d_in[20];
    p.mlp_norm = (const float*)d_in[21]; p.mlp_w_up = (const float*)d_in[22]; p.mlp_w_down = (const float*)d_in[23];
    p.out = (float*)d_out; p.ws = (unsigned char*)d_ws;
#if MK_SPLIT
    for (int ph = 0; ph < NPH; ++ph) { p.ph_lo = ph; p.ph_hi = ph + 1; hipLaunchKernelGGL(fwd_kernel, dim3(grid), dim3(NTHR), LDS_BYTES, stream, p); }
#else
    p.ph_lo = 0; p.ph_hi = NPH; hipLaunchKernelGGL(fwd_kernel, dim3(grid), dim3(NTHR), LDS_BYTES, stream, p);
#endif
}
```

```cpp
#include <hip/hip_runtime.h>
#include <cstdio>
#include <cstdint>

#ifndef REP_MASK
#define REP_MASK 0u
#endif
#ifndef MK_SPLIT
#define MK_SPLIT 0
#endif

namespace pg8 {
#define PG8_LAS __attribute__((address_space(3)))
typedef _Float16 bf16_t;
typedef _Float16 bf16x8 __attribute__((ext_vector_type(8)));
typedef float f32x4 __attribute__((ext_vector_type(4)));
typedef unsigned u32x4 __attribute__((ext_vector_type(4)));
typedef unsigned u32x2 __attribute__((ext_vector_type(2)));
typedef _Float16 h16x2 __attribute__((ext_vector_type(2)));
typedef _Float16 h16x4 __attribute__((ext_vector_type(4)));
typedef _Float16 h16x8e __attribute__((ext_vector_type(8)));
constexpr int BM = 256, BK = 64, HALF = 128, HTB = HALF * BK * 2  , STAGE_BYTES = 8 * HTB, NXCD = 8, WGM = 8;

__host__ __device__ __forceinline__ int lds_byte(int r, int c) { const int st = (r >> 4) * 2 + (c >> 5), rr = r & 15, cc = c & 31, ob = rr * 64 + cc * 2; return st * 1024 + (ob ^ (((ob >> 9) & 1) << 5)); }
__host__ __device__ __forceinline__ void stage_rc(int b, int& R, int& C) { const int st = b / 1024, sb = b % 1024, swz = sb ^ (((sb >> 9) & 1) << 5); R = (st >> 1) * 16 + swz / 64; C = (st & 1) * 32 + (swz % 64) / 2; }
__host__ __device__ __forceinline__ int perm32(int rho) { const int n = rho >> 4, i = rho & 15; return 8 * (i >> 2) + 4 * n + (i & 3); }

struct Unit { int pm, pn; };
struct Gemm { const bf16_t* A; const bf16_t* Bt; int M, N, K, lda, npg, ldb; size_t kstepA, kstepB; };

struct StaticOrder {
    int nM, nN, nwg, G, c;
    __host__ __device__ void init(int M, int N, int G_, int c_) { nM = M / BM; nN = N / BM; nwg = nM * nN; G = G_; c = c_; }
    __host__ __device__ bool next(int i, Unit& u) const {
        const long L = (long)i * G + c; if (L >= nwg) return false;
        int wgid = (int)L; { const int q = nwg / NXCD, r = nwg % NXCD, xcd = wgid % NXCD, off = wgid / NXCD; wgid = (xcd < r ? xcd * (q + 1) : r * (q + 1) + (xcd - r) * q) + off; }
        const int nig = WGM * nN, gid = wgid / nig, fm = gid * WGM, gsz = (nM - fm) < WGM ? (nM - fm) : WGM;
        u.pm = fm + ((wgid % nig) % gsz); u.pn = (wgid % nig) / gsz; return true;
    }
    __device__ __forceinline__ void a_ready(const Unit&) const {}
    __device__ __forceinline__ void done(const Unit&) const {}
};

__device__ __forceinline__ unsigned pk_h2(float lo, float hi) { h16x2 v = {(_Float16)lo, (_Float16)hi}; return __builtin_bit_cast(unsigned, v); }

template <int ACT> struct EpiF16 {
    static constexpr bool PERM = true, WIDE = true, AFTER_DRAIN = false;
    bf16_t* O; int ldc; const float* rowsq; int kblk_rows; int npart;
    __device__ __forceinline__ void operator()(const f32x4 (&acc)[2][2][4][2], const Unit& u, int wr, int wc, int fr, int fq) const {
        const int row0 = u.pm * BM + wr * 64 + fr, col0 = u.pn * BM + wc * 64 + 8 * fq;
#pragma unroll
        for (int ai = 0; ai < 2; ++ai)
#pragma unroll
            for (int m = 0; m < 4; ++m) { const int row = row0 + ai * HALF + m * 16;
                bf16_t* rowp = kblk_rows ? O + ((size_t)(col0 >> 6) * kblk_rows + row) * 64 + (col0 & 63) : O + (size_t)row * ldc + col0;
                const size_t bjstep = 32;
                float rs = 1.0f; if (rowsq) { float ssq;
                    if (npart) { const f32x4* pp = (const f32x4*)(rowsq + (size_t)row * 32); f32x4 a4 = pp[0];
#pragma unroll
                        for (int q = 1; q < 8; ++q) a4 += pp[q];
                        ssq = (a4[0] + a4[1]) + (a4[2] + a4[3]); }
                    else ssq = rowsq[row];
                    rs = 1.0f / sqrtf(ssq * (1.0f / 2048.0f) + 1e-6f); if (ACT == 1) rs = rs * rs; }
#pragma unroll
                for (int bj = 0; bj < 2; ++bj) { f32x4 v0 = acc[ai][bj][m][0], v1 = acc[ai][bj][m][1];
                    if (ACT == 1) {
#pragma unroll
                        for (int j = 0; j < 4; ++j) { const float a = fmaxf(v0[j], 0.f), b = fmaxf(v1[j], 0.f); v0[j] = a * a; v1[j] = b * b; } }
                    v0 = v0 * rs; v1 = v1 * rs;
                    u32x4 w; w.x = pk_h2(v0[0], v0[1]); w.y = pk_h2(v0[2], v0[3]); w.z = pk_h2(v1[0], v1[1]); w.w = pk_h2(v1[2], v1[3]);
                    *(u32x4*)(rowp + bj * bjstep) = w; } }
    }
};
typedef int i32x4e __attribute__((ext_vector_type(4)));
template <class AccV> struct EpiQRelu2;
template <class AccV> struct EpiQRelu2 {
    static constexpr bool PERM = true, WIDE = true, AFTER_DRAIN = false;
    bf16_t* O; const float* rs; const float* cs; int kblk_rows;
    __device__ __forceinline__ void operator()(const AccV (&acc)[2][2][4][2], const Unit& u, int wr, int wc, int fr, int fq) const {
        const int row0 = u.pm * BM + wr * 64 + fr, col0 = u.pn * BM + wc * 64 + 8 * fq;
        f32x4 cv[2][2];
#pragma unroll
        for (int bj = 0; bj < 2; ++bj)
#pragma unroll
            for (int n = 0; n < 2; ++n) cv[bj][n] = *(const f32x4*)(cs + col0 + bj * 32 + 4 * n);
#pragma unroll
        for (int ai = 0; ai < 2; ++ai)
#pragma unroll
            for (int m = 0; m < 4; ++m) { const int row = row0 + ai * HALF + m * 16; const float r = rs[row];
                bf16_t* rowp = O + ((size_t)(col0 >> 6) * kblk_rows + row) * 64 + (col0 & 63); const size_t bjstep = 32;
#pragma unroll
                for (int bj = 0; bj < 2; ++bj) { f32x4 v0, v1;
#pragma unroll
                    for (int j = 0; j < 4; ++j) { const float a = fmaxf((float)acc[ai][bj][m][0][j] * (r * cv[bj][0][j]), 0.f), b = fmaxf((float)acc[ai][bj][m][1][j] * (r * cv[bj][1][j]), 0.f); v0[j] = a * a; v1[j] = b * b; }
                    u32x4 w; w.x = pk_h2(v0[0], v0[1]); w.y = pk_h2(v0[2], v0[3]); w.z = pk_h2(v1[0], v1[1]); w.w = pk_h2(v1[2], v1[3]);
                    *(u32x4*)(rowp + bj * bjstep) = w; } }
    }
};
struct EpiResid {
    static constexpr bool PERM = true, WIDE = true, AFTER_DRAIN = false;
    const bf16_t* res; bf16_t* out; float* out32; int ldc; const float* bias; const float* scale; float* rowsq;
    __device__ __forceinline__ void operator()(const f32x4 (&acc)[2][2][4][2], const Unit& u, int wr, int wc, int fr, int fq) const {
        const int row0 = u.pm * BM + wr * 64 + fr, col0 = u.pn * BM + wc * 64 + 8 * fq;
#pragma unroll
        for (int ai = 0; ai < 2; ++ai)
#pragma unroll
            for (int m = 0; m < 4; ++m) { const int row = row0 + ai * HALF + m * 16; const size_t off = (size_t)row * ldc + col0; float sq = 0.f;
#pragma unroll
                for (int bj = 0; bj < 2; ++bj) { const int cc = bj * 32; const h16x8e rh = *(const h16x8e*)(res + off + cc); float o[8];
#pragma unroll
                    for (int n = 0; n < 2; ++n) { const f32x4 bv = bias ? *(const f32x4*)(bias + col0 + cc + 4 * n) : (f32x4){0.f, 0.f, 0.f, 0.f}, sv = scale ? *(const f32x4*)(scale + col0 + cc + 4 * n) : (f32x4){1.f, 1.f, 1.f, 1.f};
#pragma unroll
                        for (int j = 0; j < 4; ++j) { o[4 * n + j] = (float)rh[4 * n + j] + (acc[ai][bj][m][n][j] + bv[j]) * sv[j]; sq += o[4 * n + j] * o[4 * n + j]; } }
                    if (out32) { *(f32x4*)(out32 + off + cc) = (f32x4){o[0], o[1], o[2], o[3]}; *(f32x4*)(out32 + off + cc + 4) = (f32x4){o[4], o[5], o[6], o[7]}; }
                    else { u32x4 w; w.x = pk_h2(o[0], o[1]); w.y = pk_h2(o[2], o[3]); w.z = pk_h2(o[4], o[5]); w.w = pk_h2(o[6], o[7]); *(u32x4*)(out + off + cc) = w; } }
                if (rowsq) { sq += __shfl_xor(sq, 16); sq += __shfl_xor(sq, 32); if (fq == 0) rowsq[(size_t)row * 32 + u.pn * 4 + wc] = sq; }
                asm volatile("" ::: "memory"); }
    }
};
struct EpiResidQ {
    static constexpr bool PERM = true, WIDE = true, AFTER_DRAIN = false;
    const bf16_t* res; bf16_t* out; float* out32; int ldc; const float* rs; const float* cs; const float* csum; float* rowsq;
    __device__ __forceinline__ void operator()(const i32x4e (&acc)[2][2][4][2], const Unit& u, int wr, int wc, int fr, int fq) const {
        const int row0 = u.pm * BM + wr * 64 + fr, col0 = u.pn * BM + wc * 64 + 8 * fq;
#pragma unroll
        for (int ai = 0; ai < 2; ++ai)
#pragma unroll
            for (int m = 0; m < 4; ++m) { const int row = row0 + ai * HALF + m * 16; const size_t off = (size_t)row * ldc + col0; float sq = 0.f; const float rsv = rs[row];
#pragma unroll
                for (int bj = 0; bj < 2; ++bj) { const int cc = bj * 32; const h16x8e rh = *(const h16x8e*)(res + off + cc); float o[8];
#pragma unroll
                    for (int n = 0; n < 2; ++n) { const f32x4 cv = *(const f32x4*)(cs + col0 + cc + 4 * n), zv = *(const f32x4*)(csum + col0 + cc + 4 * n);
#pragma unroll
                        for (int j = 0; j < 4; ++j) { o[4 * n + j] = (float)rh[4 * n + j] + (rsv * cv[j]) * ((float)acc[ai][bj][m][n][j] + 128.0f * zv[j]); sq += o[4 * n + j] * o[4 * n + j]; } }
                    if (out32) { *(f32x4*)(out32 + off + cc) = (f32x4){o[0], o[1], o[2], o[3]}; *(f32x4*)(out32 + off + cc + 4) = (f32x4){o[4], o[5], o[6], o[7]}; }
                    else { u32x4 w; w.x = pk_h2(o[0], o[1]); w.y = pk_h2(o[2], o[3]); w.z = pk_h2(o[4], o[5]); w.w = pk_h2(o[6], o[7]); *(u32x4*)(out + off + cc) = w; } }
                if (rowsq) { sq += __shfl_xor(sq, 16); sq += __shfl_xor(sq, 32); if (fq == 0) rowsq[(size_t)row * 32 + u.pn * 4 + wc] = sq; }
                asm volatile("" ::: "memory"); }
    }
};
struct EpiGates {
    static constexpr bool PERM = false, WIDE = false, AFTER_DRAIN = false;
    const bf16_t* XC; const float* ba; const float* bx; const float* lam; bf16_t* AF; bf16_t* BF;
    __device__ __forceinline__ void operator()(const f32x4 (&acc)[2][2][4][2], const Unit& u, int wr, int wc, int fr, int fq) const {
        const int row0 = u.pm * BM + wr * 64 + fr, ch0 = (u.pn >> 1) * 256 + (u.pn & 1) * 128 + wc * 32 + 4 * fq;
#pragma unroll
        for (int n = 0; n < 2; ++n) {
            const f32x4 bav = *(const f32x4*)(ba + ch0 + n * 16), bxv = *(const f32x4*)(bx + ch0 + n * 16), l = *(const f32x4*)(lam + ch0 + n * 16); f32x4 spv;
#pragma unroll
            for (int j = 0; j < 4; ++j) spv[j] = -8.0f * log1pf(__expf(-l[j]));
#pragma unroll
            for (int ai = 0; ai < 2; ++ai)
#pragma unroll
                for (int m = 0; m < 4; ++m) { const size_t off = (size_t)(row0 + ai * HALF + m * 16) * 2048 + ch0 + n * 16;
                    const h16x4 xh = *(const h16x4*)(XC + off); f32x4 av, bv;
#pragma unroll
                    for (int j = 0; j < 4; ++j) { const float r = __builtin_amdgcn_rcpf(1.0f + __expf(-(acc[ai][0][m][n][j] + bav[j]))), ig = __builtin_amdgcn_rcpf(1.0f + __expf(-(acc[ai][1][m][n][j] + bxv[j])));
                        const float la = r * spv[j]; av[j] = la;
                        const float y = 2.0f * la;
                        const float em = y * (1.0f + y * 0.5f * (1.0f + y * (1.0f / 3.0f) * (1.0f + y * 0.25f * (1.0f + y * 0.2f * (1.0f + y * (1.0f / 6.0f) * (1.0f + y * (1.0f / 7.0f)))))));
                        const float om = (y > -0.5f) ? -em : 1.0f - __expf(y);
                        bv[j] = (float)xh[j] * ig * __builtin_amdgcn_sqrtf(fmaxf(om, 0.f)); }
                    { u32x2 w; w.x = pk_h2(av[0], av[1]); w.y = pk_h2(av[2], av[3]); *(u32x2*)(AF + off) = w; w.x = pk_h2(bv[0], bv[1]); w.y = pk_h2(bv[2], bv[3]); *(u32x2*)(BF + off) = w; }
                    asm volatile("" ::: "memory"); }
        }
    }
};

template <class Epi, class Sched, bool ALIGN_EPI = false, bool SP2 = false>
__device__ __forceinline__ void gemm_phase(PG8_LAS unsigned char* lds, const Gemm g, const Sched& S, const Epi& E, const int tid) {
    const int wid = __builtin_amdgcn_readfirstlane(tid >> 6), lane = tid & 63, wr = wid >> 2, wc = wid & 3, fr = lane & 15, fq = lane >> 4;
    const int K = g.K, nt = K / BK;
    unsigned voffA[2], voffB[2];
#pragma unroll
    for (int i = 0; i < 2; ++i) { int R, C; stage_rc(tid * 16 + i * 8192, R, C); const int Rb = Epi::WIDE ? (64 * (R >> 5) + perm32(R & 31)) : (Epi::PERM ? ((R & ~31) + perm32(R & 31)) : R);
        voffA[i] = (unsigned)(R * g.lda + C) * 2u; voffB[i] = (unsigned)(Rb * g.ldb + C) * 2u; }
    const size_t kstepA = g.kstepA, kstepB = g.kstepB;
    const size_t hstepA = (size_t)HALF * g.lda * 2, hstepB = (size_t)(Epi::WIDE ? 32 : HALF) * g.ldb * 2;
#define PG8_ABASE(u) ((const char*)g.A + ((size_t)(u).pm * BM * g.lda + (size_t)((u).pn / g.npg) * K) * 2)
#define PG8_BBASE(u) ((const char*)g.Bt + (size_t)(u).pn * BM * g.ldb * 2)
    const unsigned ldsw = (unsigned)wid * 1024u;
    const int aoff = lds_byte(wr * 64 + fr, fq * 8), boff = lds_byte(wc * 32 + fr, fq * 8);
#define PG8_SA(b, h) (((b) * 2 + (h)) * HTB)
#define PG8_SB(b, h) ((4 + (b) * 2 + (h)) * HTB)
#define PG8_STAGE(bufoff, gbase, voff) do { _Pragma("unroll") for (int _i = 0; _i < 2; ++_i) \
        __builtin_amdgcn_global_load_lds((const unsigned*)((const char*)(gbase) + (voff)[_i]), (PG8_LAS unsigned*)(lds + (bufoff) + ldsw + _i * 8192), 16, 0, 0); } while (0)
#define PG8_LDA(dst, b, h) do { _Pragma("unroll") for (int m = 0; m < 4; ++m) _Pragma("unroll") for (int k = 0; k < 2; ++k) dst[m][k] = *(const PG8_LAS bf16x8*)(lds + PG8_SA(b, h) + aoff + m * 2048 + k * 1024); } while (0)
#define PG8_LDB(dst, b, h) do { _Pragma("unroll") for (int n = 0; n < 2; ++n) _Pragma("unroll") for (int k = 0; k < 2; ++k) dst[n][k] = *(const PG8_LAS bf16x8*)(lds + PG8_SB(b, h) + boff + n * 2048 + k * 1024); } while (0)
#define PG8_MMA(ai, bj, At, Bt) do { __builtin_amdgcn_s_setprio(1); _Pragma("unroll") for (int m = 0; m < 4; ++m) _Pragma("unroll") for (int n = 0; n < 2; ++n) _Pragma("unroll") for (int k = 0; k < 2; ++k) \
        acc[ai][bj][m][n] = __builtin_amdgcn_mfma_f32_16x16x32_f16(Bt[n][k], At[m][k], acc[ai][bj][m][n], 0, 0, 0); __builtin_amdgcn_s_setprio(0); } while (0)
#define PG8_WAIT_V(n) asm volatile("s_waitcnt vmcnt(" #n ")" ::: "memory")
#define PG8_WAIT_L(n) asm volatile("s_waitcnt lgkmcnt(" #n ")" ::: "memory")
#define PG8_BAR __builtin_amdgcn_s_barrier()
#define PG8_SCHED __builtin_amdgcn_sched_barrier(0)
    Unit cur, nxt; int ui = 0;
    if (!S.next(0, cur)) return;
    f32x4 acc[2][2][4][2];
#pragma unroll
    for (int a = 0; a < 2; ++a)
#pragma unroll
        for (int b = 0; b < 2; ++b)
#pragma unroll
            for (int m = 0; m < 4; ++m)
#pragma unroll
                for (int n = 0; n < 2; ++n) acc[a][b][m][n] = (f32x4){0.f, 0.f, 0.f, 0.f};
    bf16x8 At[4][2], B0[2][2], B1[2][2];
    const char* cA = PG8_ABASE(cur); const char* cB = PG8_BBASE(cur);
    S.a_ready(cur);
    if constexpr (SP2) {
        PG8_STAGE(PG8_SB(0, 0), cB, voffB); PG8_STAGE(PG8_SB(0, 1), cB + hstepB, voffB); PG8_STAGE(PG8_SA(0, 0), cA, voffA); PG8_STAGE(PG8_SA(0, 1), cA + hstepA, voffA);
        if (wr == 1) PG8_BAR;
        PG8_WAIT_V(2); PG8_BAR;
        PG8_STAGE(PG8_SB(1, 0), cB + kstepB, voffB); PG8_STAGE(PG8_SA(1, 0), cA + kstepA, voffA); PG8_STAGE(PG8_SB(1, 1), cB + hstepB + kstepB, voffB);
        PG8_WAIT_V(6); PG8_BAR;
    } else {
        PG8_STAGE(PG8_SB(0, 0), cB, voffB); PG8_STAGE(PG8_SA(0, 0), cA, voffA); PG8_STAGE(PG8_SB(0, 1), cB + hstepB, voffB); PG8_STAGE(PG8_SA(0, 1), cA + hstepA, voffA);
        if (wr == 1) PG8_BAR;
        PG8_WAIT_V(4); PG8_BAR;
        PG8_STAGE(PG8_SB(1, 0), cB + kstepB, voffB); PG8_STAGE(PG8_SA(1, 0), cA + kstepA, voffA); PG8_STAGE(PG8_SB(1, 1), cB + hstepB + kstepB, voffB);
        PG8_WAIT_V(6); PG8_BAR;
    }
    for (;;) {
        const bool has_next = S.next(ui + 1, nxt);
        const char* nA = has_next ? PG8_ABASE(nxt) : cA; const char* nB = has_next ? PG8_BBASE(nxt) : cB;
        for (int t = 0; t < nt; t += 2) {
            const bool last = (t == nt - 2);
            const char* a1 = cA + (size_t)(t + 1) * kstepA;
            const char* a2 = last ? nA : cA + (size_t)(t + 2) * kstepA; const char* b2 = last ? nB : cB + (size_t)(t + 2) * kstepB;
            const char* a3 = a2 + kstepA; const char* b3 = b2 + kstepB;
            if (last && has_next) S.a_ready(nxt);
            if constexpr (SP2) {
            PG8_LDB(B0, 0, 0); PG8_LDB(B1, 0, 1); PG8_SCHED; PG8_LDA(At, 0, 0); PG8_STAGE(PG8_SA(1, 1), a1 + hstepA, voffA);
            PG8_WAIT_V(8); PG8_WAIT_L(0); PG8_BAR; PG8_MMA(0, 0, At, B0); PG8_MMA(0, 1, At, B1); PG8_BAR; PG8_SCHED;
            PG8_LDA(At, 0, 1); PG8_STAGE(PG8_SB(0, 0), b2, voffB); PG8_STAGE(PG8_SB(0, 1), b2 + hstepB, voffB); PG8_STAGE(PG8_SA(0, 0), a2, voffA);
            PG8_WAIT_V(8); PG8_WAIT_L(0); PG8_BAR; PG8_MMA(1, 0, At, B0); PG8_MMA(1, 1, At, B1); PG8_BAR; PG8_SCHED;
            PG8_LDB(B0, 1, 0); PG8_LDB(B1, 1, 1); PG8_SCHED; PG8_LDA(At, 1, 0); PG8_STAGE(PG8_SA(0, 1), a2 + hstepA, voffA);
            PG8_WAIT_V(8); PG8_WAIT_L(0); PG8_BAR; PG8_MMA(0, 0, At, B0); PG8_MMA(0, 1, At, B1); PG8_BAR; PG8_SCHED;
            PG8_LDA(At, 1, 1); PG8_STAGE(PG8_SB(1, 0), b3, voffB); PG8_STAGE(PG8_SB(1, 1), b3 + hstepB, voffB); PG8_STAGE(PG8_SA(1, 0), a3, voffA);
            PG8_WAIT_V(8); PG8_WAIT_L(0); PG8_BAR; PG8_MMA(1, 0, At, B0); PG8_MMA(1, 1, At, B1); PG8_BAR; PG8_SCHED;
            } else {
            PG8_LDB(B0, 0, 0); PG8_SCHED; PG8_LDA(At, 0, 0); PG8_STAGE(PG8_SA(1, 1), a1 + hstepA, voffA);
            PG8_WAIT_L(8); PG8_BAR; PG8_WAIT_L(0); PG8_MMA(0, 0, At, B0); PG8_BAR; PG8_SCHED;
            PG8_LDB(B1, 0, 1); PG8_STAGE(PG8_SB(0, 0), b2, voffB);
            PG8_BAR; PG8_WAIT_L(0); PG8_MMA(0, 1, At, B1); PG8_BAR;
            PG8_LDA(At, 0, 1); PG8_STAGE(PG8_SA(0, 0), a2, voffA);
            PG8_BAR; PG8_WAIT_L(0); PG8_MMA(1, 0, At, B0); PG8_BAR; PG8_SCHED;
            PG8_STAGE(PG8_SB(0, 1), b2 + hstepB, voffB);
            PG8_WAIT_V(6); PG8_BAR; PG8_MMA(1, 1, At, B1); PG8_BAR;
            PG8_LDB(B0, 1, 0); PG8_SCHED; PG8_LDA(At, 1, 0); PG8_STAGE(PG8_SA(0, 1), a2 + hstepA, voffA);
            PG8_WAIT_L(8); PG8_BAR; PG8_WAIT_L(0); PG8_MMA(0, 0, At, B0); PG8_BAR; PG8_SCHED;
            PG8_LDB(B1, 1, 1); PG8_STAGE(PG8_SB(1, 0), b3, voffB);
            PG8_BAR; PG8_WAIT_L(0); PG8_MMA(0, 1, At, B1); PG8_BAR;
            PG8_LDA(At, 1, 1); PG8_STAGE(PG8_SA(1, 0), a3, voffA);
            PG8_BAR; PG8_WAIT_L(0); PG8_MMA(1, 0, At, B0); PG8_BAR; PG8_SCHED;
            PG8_STAGE(PG8_SB(1, 1), b3 + hstepB, voffB);
            PG8_WAIT_V(6); PG8_BAR; PG8_MMA(1, 1, At, B1); PG8_BAR;
            }
        }
        if constexpr (ALIGN_EPI) { if (wr == 0) PG8_BAR; }
        if constexpr (!Epi::AFTER_DRAIN) { E(acc, cur, wr, wc, fr, fq); S.done(cur); }
        if (!has_next) break;
#pragma unroll
        for (int a = 0; a < 2; ++a)
#pragma unroll
            for (int b = 0; b < 2; ++b)
#pragma unroll
                for (int m = 0; m < 4; ++m)
#pragma unroll
                    for (int n = 0; n < 2; ++n) acc[a][b][m][n] = (f32x4){0.f, 0.f, 0.f, 0.f};
        cur = nxt; cA = nA; cB = nB; ++ui;
        if constexpr (ALIGN_EPI) { if (wr == 1) PG8_BAR; }
    }
    PG8_WAIT_V(0);
    if constexpr (!ALIGN_EPI) { if (wr == 0) PG8_BAR; }
    PG8_BAR;
    if constexpr (Epi::AFTER_DRAIN) { E.fused(acc, cur, wr, wc, fr, fq, lds, wid, lane); S.done(cur); }
#undef PG8_ABASE
#undef PG8_BBASE
#undef PG8_SA
#undef PG8_SB
#undef PG8_STAGE
#undef PG8_LDA
#undef PG8_LDB
#undef PG8_MMA
#undef PG8_WAIT_V
#undef PG8_WAIT_L
#undef PG8_BAR
#undef PG8_SCHED
}
typedef int i32x4 __attribute__((ext_vector_type(4)));
template <class Epi, class Sched, bool ALIGN_EPI = false, bool SP2 = false>
__device__ __forceinline__ void gemm_phase_i8(PG8_LAS unsigned char* lds, const Gemm g, const Sched& S, const Epi& E, const int tid) {
    const int wid = __builtin_amdgcn_readfirstlane(tid >> 6), lane = tid & 63, wr = wid >> 2, wc = wid & 3, fr = lane & 15, fq = lane >> 4;
    const int K = g.K, nt = K / BK;
    unsigned voffA[2], voffB[2];
#pragma unroll
    for (int i = 0; i < 2; ++i) { int R, C; stage_rc(tid * 16 + i * 8192, R, C); const int Rb = Epi::WIDE ? (64 * (R >> 5) + perm32(R & 31)) : (Epi::PERM ? ((R & ~31) + perm32(R & 31)) : R);
        voffA[i] = (unsigned)(R * g.lda + C) * 2u; voffB[i] = (unsigned)(Rb * g.ldb + C) * 2u; }
    const size_t kstepA = g.kstepA, kstepB = g.kstepB;
    const size_t hstepA = (size_t)HALF * g.lda * 2, hstepB = (size_t)(Epi::WIDE ? 32 : HALF) * g.ldb * 2;
#define PG8_ABASE(u) ((const char*)g.A + ((size_t)(u).pm * BM * g.lda + (size_t)((u).pn / g.npg) * K) * 2)
#define PG8_BBASE(u) ((const char*)g.Bt + (size_t)(u).pn * BM * g.ldb * 2)
    const unsigned ldsw = (unsigned)wid * 1024u;
    const int aoff = lds_byte(wr * 64 + fr, fq * 8), boff = lds_byte(wc * 32 + fr, fq * 8);
#define PG8_SA(b, h) (((b) * 2 + (h)) * HTB)
#define PG8_SB(b, h) ((4 + (b) * 2 + (h)) * HTB)
#define PG8_STAGE(bufoff, gbase, voff) do { _Pragma("unroll") for (int _i = 0; _i < 2; ++_i) \
        __builtin_amdgcn_global_load_lds((const unsigned*)((const char*)(gbase) + (voff)[_i]), (PG8_LAS unsigned*)(lds + (bufoff) + ldsw + _i * 8192), 16, 0, 0); } while (0)
#define PG8_LDA(dst, b, h) do { _Pragma("unroll") for (int m = 0; m < 4; ++m) _Pragma("unroll") for (int k = 0; k < 2; ++k) dst[m][k] = *(const PG8_LAS bf16x8*)(lds + PG8_SA(b, h) + aoff + m * 2048 + k * 1024); } while (0)
#define PG8_LDB(dst, b, h) do { _Pragma("unroll") for (int n = 0; n < 2; ++n) _Pragma("unroll") for (int k = 0; k < 2; ++k) dst[n][k] = *(const PG8_LAS bf16x8*)(lds + PG8_SB(b, h) + boff + n * 2048 + k * 1024); } while (0)
#define PG8_MMA(ai, bj, At, Bt) do { __builtin_amdgcn_s_setprio(1); _Pragma("unroll") for (int m = 0; m < 4; ++m) _Pragma("unroll") for (int n = 0; n < 2; ++n) _Pragma("unroll") for (int k = 0; k < 2; ++k) \
        acc[ai][bj][m][n] = __builtin_amdgcn_mfma_i32_16x16x64_i8(__builtin_bit_cast(i32x4, Bt[n][k]), __builtin_bit_cast(i32x4, At[m][k]), acc[ai][bj][m][n], 0, 0, 0); __builtin_amdgcn_s_setprio(0); } while (0)
#define PG8_WAIT_V(n) asm volatile("s_waitcnt vmcnt(" #n ")" ::: "memory")
#define PG8_WAIT_L(n) asm volatile("s_waitcnt lgkmcnt(" #n ")" ::: "memory")
#define PG8_BAR __builtin_amdgcn_s_barrier()
#define PG8_SCHED __builtin_amdgcn_sched_barrier(0)
    Unit cur, nxt; int ui = 0;
    if (!S.next(0, cur)) return;
    i32x4 acc[2][2][4][2];
#pragma unroll
    for (int a = 0; a < 2; ++a)
#pragma unroll
        for (int b = 0; b < 2; ++b)
#pragma unroll
            for (int m = 0; m < 4; ++m)
#pragma unroll
                for (int n = 0; n < 2; ++n) acc[a][b][m][n] = (i32x4){0, 0, 0, 0};
    bf16x8 At[4][2], B0[2][2], B1[2][2];
    const char* cA = PG8_ABASE(cur); const char* cB = PG8_BBASE(cur);
    S.a_ready(cur);
    if constexpr (SP2) {
        PG8_STAGE(PG8_SB(0, 0), cB, voffB); PG8_STAGE(PG8_SB(0, 1), cB + hstepB, voffB); PG8_STAGE(PG8_SA(0, 0), cA, voffA); PG8_STAGE(PG8_SA(0, 1), cA + hstepA, voffA);
        if (wr == 1) PG8_BAR;
        PG8_WAIT_V(2); PG8_BAR;
        PG8_STAGE(PG8_SB(1, 0), cB + kstepB, voffB); PG8_STAGE(PG8_SA(1, 0), cA + kstepA, voffA); PG8_STAGE(PG8_SB(1, 1), cB + hstepB + kstepB, voffB);
        PG8_WAIT_V(6); PG8_BAR;
    } else {
        PG8_STAGE(PG8_SB(0, 0), cB, voffB); PG8_STAGE(PG8_SA(0, 0), cA, voffA); PG8_STAGE(PG8_SB(0, 1), cB + hstepB, voffB); PG8_STAGE(PG8_SA(0, 1), cA + hstepA, voffA);
        if (wr == 1) PG8_BAR;
        PG8_WAIT_V(4); PG8_BAR;
        PG8_STAGE(PG8_SB(1, 0), cB + kstepB, voffB); PG8_STAGE(PG8_SA(1, 0), cA + kstepA, voffA); PG8_STAGE(PG8_SB(1, 1), cB + hstepB + kstepB, voffB);
        PG8_WAIT_V(6); PG8_BAR;
    }
    for (;;) {
        const bool has_next = S.next(ui + 1, nxt);
        const char* nA = has_next ? PG8_ABASE(nxt) : cA; const char* nB = has_next ? PG8_BBASE(nxt) : cB;
        for (int t = 0; t < nt; t += 2) {
            const bool last = (t == nt - 2);
            const char* a1 = cA + (size_t)(t + 1) * kstepA;
            const char* a2 = last ? nA : cA + (size_t)(t + 2) * kstepA; const char* b2 = last ? nB : cB + (size_t)(t + 2) * kstepB;
            const char* a3 = a2 + kstepA; const char* b3 = b2 + kstepB;
            if (last && has_next) S.a_ready(nxt);
            if constexpr (SP2) {
            PG8_LDB(B0, 0, 0); PG8_LDB(B1, 0, 1); PG8_SCHED; PG8_LDA(At, 0, 0); PG8_STAGE(PG8_SA(1, 1), a1 + hstepA, voffA);
            PG8_WAIT_V(8); PG8_WAIT_L(0); PG8_BAR; PG8_MMA(0, 0, At, B0); PG8_MMA(0, 1, At, B1); PG8_BAR; PG8_SCHED;
            PG8_LDA(At, 0, 1); PG8_STAGE(PG8_SB(0, 0), b2, voffB); PG8_STAGE(PG8_SB(0, 1), b2 + hstepB, voffB); PG8_STAGE(PG8_SA(0, 0), a2, voffA);
            PG8_WAIT_V(8); PG8_WAIT_L(0); PG8_BAR; PG8_MMA(1, 0, At, B0); PG8_MMA(1, 1, At, B1); PG8_BAR; PG8_SCHED;
            PG8_LDB(B0, 1, 0); PG8_LDB(B1, 1, 1); PG8_SCHED; PG8_LDA(At, 1, 0); PG8_STAGE(PG8_SA(0, 1), a2 + hstepA, voffA);
            PG8_WAIT_V(8); PG8_WAIT_L(0); PG8_BAR; PG8_MMA(0, 0, At, B0); PG8_MMA(0, 1, At, B1); PG8_BAR; PG8_SCHED;
            PG8_LDA(At, 1, 1); PG8_STAGE(PG8_SB(1, 0), b3, voffB); PG8_STAGE(PG8_SB(1, 1), b3 + hstepB, voffB); PG8_STAGE(PG8_SA(1, 0), a3, voffA);
            PG8_WAIT_V(8); PG8_WAIT_L(0); PG8_BAR; PG8_MMA(1, 0, At, B0); PG8_MMA(1, 1, At, B1); PG8_BAR; PG8_SCHED;
            } else {
            PG8_LDB(B0, 0, 0); PG8_SCHED; PG8_LDA(At, 0, 0); PG8_STAGE(PG8_SA(1, 1), a1 + hstepA, voffA);
            PG8_WAIT_L(8); PG8_BAR; PG8_WAIT_L(0); PG8_MMA(0, 0, At, B0); PG8_BAR; PG8_SCHED;
            PG8_LDB(B1, 0, 1); PG8_STAGE(PG8_SB(0, 0), b2, voffB);
            PG8_BAR; PG8_WAIT_L(0); PG8_MMA(0, 1, At, B1); PG8_BAR;
            PG8_LDA(At, 0, 1); PG8_STAGE(PG8_SA(0, 0), a2, voffA);
            PG8_BAR; PG8_WAIT_L(0); PG8_MMA(1, 0, At, B0); PG8_BAR; PG8_SCHED;
            PG8_STAGE(PG8_SB(0, 1), b2 + hstepB, voffB);
            PG8_WAIT_V(6); PG8_BAR; PG8_MMA(1, 1, At, B1); PG8_BAR;
            PG8_LDB(B0, 1, 0); PG8_SCHED; PG8_LDA(At, 1, 0); PG8_STAGE(PG8_SA(0, 1), a2 + hstepA, voffA);
            PG8_WAIT_L(8); PG8_BAR; PG8_WAIT_L(0); PG8_MMA(0, 0, At, B0); PG8_BAR; PG8_SCHED;
            PG8_LDB(B1, 1, 1); PG8_STAGE(PG8_SB(1, 0), b3, voffB);
            PG8_BAR; PG8_WAIT_L(0); PG8_MMA(0, 1, At, B1); PG8_BAR;
            PG8_LDA(At, 1, 1); PG8_STAGE(PG8_SA(1, 0), a3, voffA);
            PG8_BAR; PG8_WAIT_L(0); PG8_MMA(1, 0, At, B0); PG8_BAR; PG8_SCHED;
            PG8_STAGE(PG8_SB(1, 1), b3 + hstepB, voffB);
            PG8_WAIT_V(6); PG8_BAR; PG8_MMA(1, 1, At, B1); PG8_BAR;
            }
        }
        if constexpr (ALIGN_EPI) { if (wr == 0) PG8_BAR; }
        if constexpr (!Epi::AFTER_DRAIN) { E(acc, cur, wr, wc, fr, fq); S.done(cur); }
        if (!has_next) break;
#pragma unroll
        for (int a = 0; a < 2; ++a)
#pragma unroll
            for (int b = 0; b < 2; ++b)
#pragma unroll
                for (int m = 0; m < 4; ++m)
#pragma unroll
                    for (int n = 0; n < 2; ++n) acc[a][b][m][n] = (i32x4){0, 0, 0, 0};
        cur = nxt; cA = nA; cB = nB; ++ui;
        if constexpr (ALIGN_EPI) { if (wr == 1) PG8_BAR; }
    }
    PG8_WAIT_V(0);
    if constexpr (!ALIGN_EPI) { if (wr == 0) PG8_BAR; }
    PG8_BAR;
    if constexpr (Epi::AFTER_DRAIN) { E.fused(acc, cur, wr, wc, fr, fq, lds, wid, lane); S.done(cur); }
#undef PG8_ABASE
#undef PG8_BBASE
#undef PG8_SA
#undef PG8_SB
#undef PG8_STAGE
#undef PG8_LDA
#undef PG8_LDB
#undef PG8_MMA
#undef PG8_WAIT_V
#undef PG8_WAIT_L
#undef PG8_BAR
#undef PG8_SCHED
}
}

constexpr int T = 8192, D = 2048, FF = 8192, DEPTH = 4;
constexpr int NH = 16, HD = 128, NKV = 4, TOPK = 256;
constexpr int A_IN = 5264, A_INP = 5376;
constexpr int C_Q = 0, C_K = 2048, C_V = 2560, C_IQ = 3072, C_IK = 5120, C_IW = 5248;
constexpr float EPS = 1e-6f;
constexpr int NWAVES = 8, NTHR = NWAVES * 64;

constexpr size_t MiB = 1u << 20;
constexpr size_t WS_CTL = 0, CTL_ZERO_BYTES = 1 * MiB;
constexpr size_t WS_COS128 = 1 * MiB, WS_SIN128 = 3 * MiB, WS_COS64 = 5 * MiB, WS_SIN64 = 6 * MiB;
constexpr size_t WS_IW = 7 * MiB;
constexpr size_t WS_AGGA = 8 * MiB, WS_AGGB = 9 * MiB;
constexpr size_t WS_WINA = 10 * MiB;
constexpr size_t WS_WOUTA = 52 * MiB;
constexpr size_t WS_WINR = 68 * MiB;
constexpr size_t WS_WGR = 84 * MiB;
constexpr size_t WS_WOUTR = 86 * MiB;
constexpr size_t WS_WPOOL = 94 * MiB;
constexpr size_t WS_WUP = 96 * MiB;
constexpr size_t WS_WDOWN = 224 * MiB;
constexpr size_t WS_BA = 352 * MiB;
constexpr size_t BA_SC = 0;
constexpr int SC_LD = T + 64;
constexpr size_t BA_O16 = 0;
constexpr size_t BA_U = 0;
constexpr size_t BA_AF = 0, BA_BF = 64 * MiB;
constexpr size_t BA_H16 = 128 * MiB;
constexpr size_t BA_PROJ = 160 * MiB;
constexpr size_t BA_XC = 224 * MiB;
constexpr size_t WS_QH = 616 * MiB, WS_KH = 632 * MiB, WS_VH = 636 * MiB, WS_IK = 640 * MiB, WS_SEL = 642 * MiB, WS_IQ = 650 * MiB, WS_PARTA = 686 * MiB, WS_PARTB = 687 * MiB, WS_BLKMAXD = 688 * MiB, WS_X16 = 692 * MiB, WS_END = 724 * MiB;
constexpr int CW_BAR = 4096;
constexpr size_t WS_BLKMAX = 682 * MiB;
constexpr size_t WS_RS = 7 * MiB + 512 * 1024, WS_CS = WS_RS + 64 * 1024;
constexpr size_t WS_RS2 = WS_RS + 128 * 1024, WS_CS2 = WS_RS + 192 * 1024, WS_CSUM = WS_RS + 208 * 1024;
constexpr size_t BA_U8 = 192 * MiB, BA_W8D = 176 * MiB;
constexpr size_t BA_A8 = 160 * MiB, BA_W8 = 176 * MiB;
constexpr size_t WS_ROWSQ = 256 * 1024;

constexpr int RING_BYTES = 131072;
constexpr int LDSCTL_OFF = RING_BYTES, MISC_OFF = LDSCTL_OFF + 320;
constexpr int LDS_BYTES = 155648;

#define GAS __attribute__((address_space(1)))
#define LAS __attribute__((address_space(3)))
typedef _Float16 h16;
typedef _Float16 h16x2 __attribute__((ext_vector_type(2)));
typedef _Float16 h16x4 __attribute__((ext_vector_type(4)));
typedef _Float16 h16x8 __attribute__((ext_vector_type(8)));
typedef unsigned v4u __attribute__((ext_vector_type(4)));
typedef unsigned v2u __attribute__((ext_vector_type(2)));
typedef float f32x4 __attribute__((ext_vector_type(4)));
#define LDS_WAIT() asm volatile("s_waitcnt lgkmcnt(0)" ::: "memory")
#define VM_WAIT() asm volatile("s_waitcnt vmcnt(0)" ::: "memory")
__device__ __forceinline__ unsigned pkh(float lo, float hi) { h16x2 v = {(h16)lo, (h16)hi}; return __builtin_bit_cast(unsigned, v); }
__device__ __forceinline__ float wave_sum(float v) {
#pragma unroll
    for (int o = 1; o < 64; o <<= 1) v += __shfl_xor(v, o);
    return v;
}
__device__ __forceinline__ float wave_max(float v) {
#pragma unroll
    for (int o = 1; o < 64; o <<= 1) v = fmaxf(v, __shfl_xor(v, o));
    return v;
}

#define XB_TMO      128
#define XB_XCNT(j)  (256  + 64 * (j))
#define XB_XSUB(j)  (1280 + 64 * (j))
#define XB_XGEN(j)  (2304 + 64 * (j))
#define XB_TOP      3328
#define XB_TOPGEN   3392
#define XCD_BAR_WORDS 3456
#define XB_SPIN_CAP (1u << 18)

__device__ __forceinline__ unsigned xb_ld(unsigned* p)              { return __hip_atomic_load(p, __ATOMIC_RELAXED, __HIP_MEMORY_SCOPE_AGENT); }
__device__ __forceinline__ unsigned xb_add(unsigned* p, unsigned v) { return __hip_atomic_fetch_add(p, v, __ATOMIC_RELAXED, __HIP_MEMORY_SCOPE_AGENT); }
__device__ __forceinline__ unsigned xb_xcc_id() { return (unsigned)__builtin_amdgcn_s_getreg((3 << 11) | 20) & 0xFu; }
#define XB_SPIN(cond, bar) do { unsigned _sp = 0; while (cond) { __builtin_amdgcn_s_sleep(1); \
    if ((++_sp & 255u) == 0u) { if (xb_ld(&(bar)[XB_TMO])) break; if (_sp > XB_SPIN_CAP) { atomicAdd(&(bar)[XB_TMO], 1u); break; } } } } while (0)

struct XcdBarrier { unsigned* bar; unsigned x; volatile LAS unsigned* st; };

__device__ __forceinline__ XcdBarrier xcd_barrier_post(unsigned* bar, volatile LAS unsigned* st) {
    XcdBarrier b; b.bar = bar; b.x = xb_xcc_id(); b.st = st;
    if (threadIdx.x == 0) (void)xb_add(&bar[XB_XCNT(b.x)], 1u);
    return b;
}
__device__ __forceinline__ void xcd_barrier_complete(unsigned* bar, unsigned x, unsigned& nloc, unsigned& nx) {
    const unsigned G = gridDim.x * gridDim.y * gridDim.z;
    unsigned sum, cnt, mine, sp = 0u;
    for (;;) {
        sum = 0u; cnt = 0u; mine = 0u;
#pragma unroll
        for (unsigned j = 0; j < 16; ++j) { const unsigned c = xb_ld(&bar[XB_XCNT(j)]); sum += c; cnt += (c > 0u) ? 1u : 0u; mine = (j == x) ? c : mine; }
        if (sum == G) break;
        __builtin_amdgcn_s_sleep(1);
        if ((++sp & 255u) == 0u) { if (xb_ld(&bar[XB_TMO])) break; if (sp > XB_SPIN_CAP) { atomicAdd(&bar[XB_TMO], 1u); break; } }
    }
    nloc = mine > 0u ? mine : 1u; nx = cnt > 0u ? cnt : 1u;
}
__device__ __forceinline__ void xcd_barrier(const XcdBarrier& b) {
    asm volatile("s_waitcnt vmcnt(0)" ::: "memory");
    __syncthreads();
    if (threadIdx.x == 0) {
        unsigned* bar = b.bar;
        __builtin_amdgcn_s_waitcnt(0);
        unsigned nloc = b.st[0], nx = b.st[1];
        if (nloc == 0u) { xcd_barrier_complete(bar, b.x, nloc, nx); b.st[0] = nloc; b.st[1] = nx; }
        const unsigned old = xb_add(&bar[XB_XSUB(b.x)], 1u);
        const unsigned gen = old / nloc;
        if (old + 1u == (gen + 1u) * nloc) {
            __builtin_amdgcn_fence(__ATOMIC_RELEASE, "agent");
            asm volatile("s_waitcnt vmcnt(0)" ::: "memory");
            const unsigned og = xb_add(&bar[XB_TOP], 1u);
            const unsigned tg = og / nx;
            if (og + 1u == (tg + 1u) * nx) xb_add(&bar[XB_TOPGEN], 1u);
            else XB_SPIN(xb_ld(&bar[XB_TOPGEN]) == tg, bar);
            __builtin_amdgcn_fence(__ATOMIC_ACQUIRE, "agent");
            xb_add(&bar[XB_XGEN(b.x)], 1u);
            asm volatile("s_waitcnt vmcnt(0)" ::: "memory");
        } else {
            XB_SPIN(xb_ld(&bar[XB_XGEN(b.x)]) == gen, bar);
            __builtin_amdgcn_fence(__ATOMIC_ACQUIRE, "agent");
            asm volatile("s_waitcnt vmcnt(0)" ::: "memory");
        }
    }
    __syncthreads();
}

__device__ __forceinline__ void tr_item(const float* src, int ldw, int nvalid, h16* dst, int ldd, LAS float* scr, int lane, unsigned* colmax = nullptr, const float* gk = nullptr) {
    const int nn = lane & 31; float v[32];
#pragma unroll
    for (int i = 0; i < 32; ++i) { const int kk = 2 * i + (lane >> 5); v[i] = (nn < nvalid) ? src[(size_t)kk * ldw + nn] * (gk ? gk[kk] : 1.0f) : 0.f; }
    __builtin_amdgcn_sched_barrier(0);
#pragma unroll
    for (int i = 0; i < 32; ++i) { const int kk = 2 * i + (lane >> 5); scr[kk * 33 + nn] = v[i]; }
    LDS_WAIT();
    const int c = lane & 7;
#pragma unroll
    for (int j = 0; j < 4; ++j) { const int n = (lane >> 3) + 8 * j; const LAS float* s = scr + (8 * c) * 33 + n;
        v4u o; o.x = pkh(s[0 * 33], s[1 * 33]); o.y = pkh(s[2 * 33], s[3 * 33]); o.z = pkh(s[4 * 33], s[5 * 33]); o.w = pkh(s[6 * 33], s[7 * 33]);
        *(v4u*)(dst + (size_t)n * ldd + 8 * c) = o;
        if (colmax) {
            float mx = fmaxf(fmaxf(fmaxf(fabsf(s[0 * 33]), fabsf(s[1 * 33])), fmaxf(fabsf(s[2 * 33]), fabsf(s[3 * 33]))), fmaxf(fmaxf(fabsf(s[4 * 33]), fabsf(s[5 * 33])), fmaxf(fabsf(s[6 * 33]), fabsf(s[7 * 33]))));
            mx = fmaxf(mx, __shfl_xor(mx, 1)); mx = fmaxf(mx, __shfl_xor(mx, 2)); mx = fmaxf(mx, __shfl_xor(mx, 4));
            if (c == 0) colmax[n] = __float_as_uint(mx); } }
    LDS_WAIT();
}

struct Ptrs {
    const float* x; const int* pos;
    const float *attn_norm, *attn_w_in, *attn_qn, *attn_kn, *attn_w_out;
    const float *rnn_norm, *rnn_w_in, *conv_w, *conv_b, *ga_w, *ga_b, *gx_w, *gx_b, *lam, *rnn_w_out;
    const float *pool_norm, *pool_w, *pool_b, *pool_scale;
    const float *mlp_norm, *mlp_w_up, *mlp_w_down;
    float* out; unsigned char* ws;
    int ph_lo, ph_hi;
};

#define CAS __attribute__((address_space(4)))
__device__ __forceinline__ const CAS Ptrs* kargs() { const CAS Ptrs* p = (const CAS Ptrs*)__builtin_amdgcn_kernarg_segment_ptr(); asm volatile("" : "+s"(p)); return p; }
__device__ __forceinline__ void p0_prologue(const CAS Ptrs* PP, LAS unsigned char* lds, int gw, int NGW, int wave, int lane, int gtid, int NGT) {
    LAS float* scr = (LAS float*)(lds + wave * 16384);
    unsigned char* ws = PP->ws;
    constexpr int I_WINA = 32 * 165, I_WOUTA = 32 * 64, I_WINR = 32 * 128, I_G = 4 * 8, I_WOUTR = 32 * 64, I_POOL = 8 * 16, I_UP = 32 * 256, I_DN = 128 * 64, I_Z = 384;
    constexpr int NITEMS = 2 * I_WINA + 2 * I_WOUTA + I_WINR + 16 * I_G + I_WOUTR + 4 * I_POOL + 4 * I_UP + 4 * I_DN + 2 * I_Z;
    for (int it = gw; it < NITEMS; it += NGW) {
        int r = it;
        if (r < 2 * I_WINA) { const int j = r / I_WINA; r -= j * I_WINA; const int kb = r / 165, nb = r % 165, n0 = 32 * nb; const int nv = (A_IN - n0) < 32 ? (A_IN - n0) : 32;
            tr_item(PP->attn_w_in + (size_t)j * D * A_IN + (size_t)(64 * kb) * A_IN + n0, A_IN, nv, (h16*)(ws + WS_WINA) + (size_t)j * A_INP * D + (size_t)n0 * D + 64 * kb, D, scr, lane, nullptr, PP->attn_norm + (size_t)j * D + 64 * kb); continue; }
        r -= 2 * I_WINA;
        if (r < 2 * I_WOUTA) { const int j = r / I_WOUTA; r -= j * I_WOUTA; const int kb = r / 64, nb = r % 64;
            tr_item(PP->attn_w_out + (size_t)j * D * D + (size_t)(64 * kb) * D + 32 * nb, D, 32, (h16*)(ws + WS_WOUTA) + (size_t)j * D * D + (size_t)(32 * nb) * D + 64 * kb, D, scr, lane); continue; }
        r -= 2 * I_WOUTA;
        if (r < I_WINR) { const int kb = r / 128, nb = r % 128;
            tr_item(PP->rnn_w_in + (size_t)(64 * kb) * 4096 + 32 * nb, 4096, 32, (h16*)(ws + WS_WINR) + (size_t)(32 * nb) * D + 64 * kb, D, scr, lane, nullptr, PP->rnn_norm + 64 * kb); continue; }
        r -= I_WINR;
        if (r < 16 * I_G) { const int mi = r / I_G; r -= mi * I_G; const int which = mi >> 3, blk = mi & 7, kb = r / 8, nb = r % 8, d0 = 32 * nb;
            const float* src = (which ? PP->gx_w : PP->ga_w) + (size_t)blk * 65536 + (size_t)(64 * kb) * 256 + d0;
            const int drow = 256 * (2 * blk + (d0 >> 7)) + 128 * which + (d0 & 127);
            tr_item(src, 256, 32, (h16*)(ws + WS_WGR) + (size_t)drow * 256 + 64 * kb, 256, scr, lane); continue; }
        r -= 16 * I_G;
        if (r < I_WOUTR) { const int kb = r / 64, nb = r % 64;
            tr_item(PP->rnn_w_out + (size_t)(64 * kb) * D + 32 * nb, D, 32, (h16*)(ws + WS_WOUTR) + (size_t)(32 * nb) * D + 64 * kb, D, scr, lane); continue; }
        r -= I_WOUTR;
        if (r < 4 * I_POOL) { const int g = r / I_POOL; r -= g * I_POOL; const int kb = r / 16, nb = r % 16;
            tr_item(PP->pool_w + (size_t)g * 262144 + (size_t)(64 * kb) * 512 + 32 * nb, 512, 32, (h16*)(ws + WS_WPOOL) + (size_t)(512 * g + 32 * nb) * 512 + 64 * kb, 512, scr, lane); continue; }
        r -= 4 * I_POOL;
        if (r < 4 * I_UP) { const int i = r / I_UP; r -= i * I_UP; const int kb = r / 256, nb = r % 256;
            tr_item(PP->mlp_w_up + (size_t)i * D * FF + (size_t)(64 * kb) * FF + 32 * nb, FF, 32, (h16*)(ws + WS_WUP) + (size_t)i * D * FF + (size_t)(32 * nb) * D + 64 * kb, D, scr, lane, (unsigned*)(ws + WS_BLKMAX) + ((size_t)i * 32 + kb) * FF + 32 * nb, PP->mlp_norm + (size_t)i * D + 64 * kb); continue; }
        r -= 4 * I_UP;
        if (r < 4 * I_DN) { const int i = r / I_DN; r -= i * I_DN; const int kb = r / 64, nb = r % 64;
            tr_item(PP->mlp_w_down + (size_t)i * D * FF + (size_t)(64 * kb) * D + 32 * nb, D, 32, (h16*)(ws + WS_WDOWN) + (size_t)i * D * FF + ((size_t)kb * D + 32 * nb) * 64, 64, scr, lane, (unsigned*)(ws + WS_BLKMAXD) + ((size_t)i * 128 + kb) * D + 32 * nb); continue; }
        r -= 4 * I_DN;
        { const int j = r / I_Z; r -= j * I_Z;
            v4u* z = (v4u*)((h16*)(ws + WS_WINA) + (size_t)j * A_INP * D + (size_t)5280 * D); z[(size_t)r * 64 + lane] = (v4u){0u, 0u, 0u, 0u}; }
    }
    for (int e = gtid; e < T * 96; e += NGT) {
        const int t = e / 96, i = e % 96; const bool big = i < 64; const int fi = big ? i : i - 64;
        const double base = big ? 0.8659643233600653 : 0.7498942093324559;
        double inv = 1.0; for (int k = 0; k < fi; ++k) inv *= base;
        const double ang = (double)PP->pos[t] * inv;
        const double n = __builtin_rint(ang * 0.15915494309189535); const double rr = ang - n * 6.283185307179586 - n * 2.4492935982947064e-16;
        const double r2 = rr * rr; double sn = 1.0, cs = 1.0;
#pragma unroll
        for (int k = 14; k >= 1; --k) { sn = 1.0 - sn * r2 * (1.0 / (double)((2 * k) * (2 * k + 1))); cs = 1.0 - cs * r2 * (1.0 / (double)((2 * k - 1) * (2 * k))); }
        sn *= rr;
        if (big) { ((float*)(ws + WS_COS128))[t * 64 + fi] = (float)cs; ((float*)(ws + WS_SIN128))[t * 64 + fi] = (float)sn; }
        else { ((float*)(ws + WS_COS64))[t * 32 + fi] = (float)cs; ((float*)(ws + WS_SIN64))[t * 32 + fi] = (float)sn; }
    }
}

__device__ __forceinline__ void quant_rows(const h16* src, int nrows, signed char* dst, float* scale_out, const float* rowsq, const unsigned* colmax, int gw, int NGW, int lane) {
    h16x8 vn[4]; float cmn = 0.f;
    if (gw < nrows) {
#pragma unroll
        for (int j = 0; j < 4; ++j) vn[j] = *(const h16x8*)(src + (size_t)gw * D + 512 * j + 8 * lane);
        if (colmax) cmn = lane < 32 ? __uint_as_float(colmax[(size_t)lane * FF + gw]) : 0.f; }
    for (int r = gw; r < nrows; r += NGW) {
        h16x8 v[4]; const float cm = cmn;
#pragma unroll
        for (int j = 0; j < 4; ++j) v[j] = vn[j];
        const int rn = r + NGW;
        if (rn < nrows) {
#pragma unroll
            for (int j = 0; j < 4; ++j) vn[j] = *(const h16x8*)(src + (size_t)rn * D + 512 * j + 8 * lane);
            if (colmax) cmn = lane < 32 ? __uint_as_float(colmax[(size_t)lane * FF + rn]) : 0.f; }
        float mx;
        if (colmax) mx = wave_max(cm);
        else { mx = 0.f;
#pragma unroll
            for (int j = 0; j < 4; ++j)
#pragma unroll
                for (int e = 0; e < 8; ++e) mx = fmaxf(mx, fabsf((float)v[j][e]));
            mx = wave_max(mx); }
        const float step = mx > 0.f ? mx * (1.0f / 127.0f) : 1.0f, inv = 1.0f / step;
        if (lane == 0) { float sc = step;
            if (rowsq) { const f32x4* pp = (const f32x4*)(rowsq + (size_t)r * 32); f32x4 a4 = pp[0];
#pragma unroll
                for (int q = 1; q < 8; ++q) a4 += pp[q];
                sc = step / sqrtf(((a4[0] + a4[1]) + (a4[2] + a4[3])) * (1.0f / D) + EPS); }
            scale_out[r] = sc; }
#pragma unroll
        for (int j = 0; j < 4; ++j) { unsigned w[2];
#pragma unroll
            for (int hh = 0; hh < 2; ++hh) { unsigned p = 0u;
#pragma unroll
                for (int e = 0; e < 4; ++e) { int qv = (int)rintf((float)v[j][4 * hh + e] * inv); qv = qv > 127 ? 127 : (qv < -127 ? -127 : qv); p |= ((unsigned)qv & 255u) << (8 * e); }
                w[hh] = p; }
            *(v2u*)(dst + (size_t)r * D + 512 * j + 8 * lane) = (v2u){w[0], w[1]}; }
    }
}
template <bool UNSIGNED>
__device__ __forceinline__ void quant_kblk(const h16* src, int R, signed char* dst, float* scale_out, float* csum, const unsigned* blkmax, int gw, int NGW, int lane) {
    const int bsub = lane >> 3, c8 = (lane & 7) * 8;
    h16x8 vn[16]; float cmn = 0.f;
#define QK_LOAD(r_) do { _Pragma("unroll") for (int i = 0; i < 16; ++i) vn[i] = *(const h16x8*)(src + ((size_t)(8 * i + bsub) * R + (r_)) * 64 + c8); \
        if (!UNSIGNED) cmn = fmaxf(__uint_as_float(blkmax[(size_t)lane * R + (r_)]), __uint_as_float(blkmax[(size_t)(64 + lane) * R + (r_)])); } while (0)
    if (gw < R) QK_LOAD(gw);
    for (int r = gw; r < R; r += NGW) {
        h16x8 v[16]; const float cm = cmn;
#pragma unroll
        for (int i = 0; i < 16; ++i) v[i] = vn[i];
        if (r + NGW < R) QK_LOAD(r + NGW);
        float mx;
        if (UNSIGNED) { mx = 0.f;
#pragma unroll
            for (int i = 0; i < 16; ++i)
#pragma unroll
                for (int e = 0; e < 8; ++e) mx = fmaxf(mx, (float)v[i][e]);
            mx = wave_max(mx); }
        else mx = wave_max(cm);
        const float step = mx > 0.f ? mx * (UNSIGNED ? 1.0f / 255.0f : 1.0f / 127.0f) : 1.0f, inv = 1.0f / step;
        int ssum = 0;
#pragma unroll
        for (int i = 0; i < 16; ++i) { unsigned w[2];
#pragma unroll
            for (int hh = 0; hh < 2; ++hh) { unsigned p = 0u;
#pragma unroll
                for (int e = 0; e < 4; ++e) { int qv = (int)rintf((float)v[i][4 * hh + e] * inv);
                    if (UNSIGNED) { qv = qv > 255 ? 255 : (qv < 0 ? 0 : qv); qv -= 128; } else { qv = qv > 127 ? 127 : (qv < -127 ? -127 : qv); ssum += qv; }
                    p |= ((unsigned)qv & 255u) << (8 * e); }
                w[hh] = p; }
            const int b = 8 * i + bsub;
            *(v2u*)(dst + ((size_t)(b >> 1) * R + r) * 128 + 64 * (b & 1) + c8) = (v2u){w[0], w[1]}; }
        if (!UNSIGNED) { float fs = (float)ssum; fs = wave_sum(fs); if (lane == 0) csum[r] = fs; }
        if (lane == 0) scale_out[r] = step;
    }
#undef QK_LOAD
}
__device__ __forceinline__ void norm0_phase(const float* src, h16* dst, float* rowsq, int gw, int NGW, int lane) {
    for (int m = gw; m < T; m += NGW) {
        const f32x4* xr = (const f32x4*)(src + (size_t)m * D) + lane;
        f32x4 v[8]; float s = 0.f;
#pragma unroll
        for (int j = 0; j < 8; ++j) { v[j] = xr[64 * j]; s += (v[j].x * v[j].x + v[j].y * v[j].y) + (v[j].z * v[j].z + v[j].w * v[j].w); }
        s = wave_sum(s); if (lane == 0) rowsq[m] = s;
        v2u* o = (v2u*)(dst + (size_t)m * D) + lane;
#pragma unroll
        for (int j = 0; j < 8; ++j) { v2u w; w.x = pkh(v[j].x, v[j].y); w.y = pkh(v[j].z, v[j].w); o[64 * j] = w; }
    }
}

__device__ __forceinline__ unsigned char f8(float x) { return (unsigned char)(__builtin_amdgcn_cvt_pk_fp8_f32(x, x, 0, false) & 0xFF); }
__device__ __forceinline__ float sum16(float v) { v += __shfl_xor(v, 1); v += __shfl_xor(v, 2); v += __shfl_xor(v, 4); v += __shfl_xor(v, 8); return v; }
__device__ __forceinline__ unsigned f8x4(float a, float b, float c, float d) { int p = __builtin_amdgcn_cvt_pk_fp8_f32(a, b, 0, false); p = __builtin_amdgcn_cvt_pk_fp8_f32(c, d, p, true); return (unsigned)p; }
__device__ __forceinline__ void dsa_post_phase(const h16* PROJ, const float* qn, const float* kn, const float* c128, const float* s128, const float* c64, const float* s64,
                                               unsigned char* Q8, unsigned char* K8, unsigned char* V8, h16* IQ, h16* IK, float* IW, int gw, int NGW, int lane) {
    const int hh = lane >> 4, m = lane & 15;
    const f32x4 gqa = *(const f32x4*)(qn + 4 * m), gqb = *(const f32x4*)(qn + 64 + 4 * m), gka = *(const f32x4*)(kn + 4 * m), gkb = *(const f32x4*)(kn + 64 + 4 * m);
    const bool rot = m < 8; const int ioa = rot ? 4 * m : 32 + 4 * m, iob = ioa + 32;
    for (int t = gw; t < T; t += NGW) {
        const h16* pr = PROJ + (size_t)t * A_INP;
        const f32x4 c = *(const f32x4*)(c128 + t * 64 + 4 * m), s = *(const f32x4*)(s128 + t * 64 + 4 * m);
        f32x4 ci = {1.f, 1.f, 1.f, 1.f}, si = {0.f, 0.f, 0.f, 0.f};
        if (rot) { ci = *(const f32x4*)(c64 + t * 32 + 4 * m); si = *(const f32x4*)(s64 + t * 32 + 4 * m); }
#pragma unroll
        for (int p = 0; p < 5; ++p) {
            const int cb = (p < 4 ? C_Q + (4 * p + hh) * HD : C_K + hh * HD) + 4 * m;
            const h16x4 a4 = *(const h16x4*)(pr + cb), b4 = *(const h16x4*)(pr + cb + 64);
            float a[4], b[4], ss = 0.f;
#pragma unroll
            for (int e = 0; e < 4; ++e) { a[e] = (float)a4[e]; b[e] = (float)b4[e]; ss += a[e] * a[e] + b[e] * b[e]; }
            const float rstd = 1.0f / sqrtf(sum16(ss) * (1.0f / HD) + EPS);
            float oa[4], ob[4];
#pragma unroll
            for (int e = 0; e < 4; ++e) { const float ya = a[e] * rstd * (p < 4 ? gqa[e] : gka[e]), yb = b[e] * rstd * (p < 4 ? gqb[e] : gkb[e]); oa[e] = ya * c[e] - yb * s[e]; ob[e] = yb * c[e] + ya * s[e]; }
            unsigned char* o8 = (p < 4 ? Q8 + (size_t)t * D + (4 * p + hh) * HD : K8 + (size_t)t * 512 + hh * HD) + 4 * m;
            *(unsigned*)o8 = f8x4(oa[0], oa[1], oa[2], oa[3]); *(unsigned*)(o8 + 64) = f8x4(ob[0], ob[1], ob[2], ob[3]);
        }
        { const h16x8 vv = *(const h16x8*)(pr + C_V + lane * 8);
          *(v2u*)(V8 + (size_t)t * 512 + lane * 8) = (v2u){f8x4((float)vv[0], (float)vv[1], (float)vv[2], (float)vv[3]), f8x4((float)vv[4], (float)vv[5], (float)vv[6], (float)vv[7])}; }
#pragma unroll
        for (int p = 0; p < 5; ++p) {
            const int hd = p < 4 ? 4 * p + hh : 0; const int cb = p < 4 ? C_IQ + hd * HD : C_IK;
            const h16x4 a4 = *(const h16x4*)(pr + cb + ioa), b4 = *(const h16x4*)(pr + cb + iob);
            h16x4 oa, ob;
#pragma unroll
            for (int e = 0; e < 4; ++e) { const float av = (float)a4[e], bv = (float)b4[e]; oa[e] = (h16)(av * ci[e] - bv * si[e]); ob[e] = (h16)(bv * ci[e] + av * si[e]); }
            if (p < 4) { *(h16x4*)(IQ + (size_t)t * D + hd * HD + ioa) = oa; *(h16x4*)(IQ + (size_t)t * D + hd * HD + iob) = ob; }
            else if (hh == 0) { *(h16x4*)(IK + (size_t)t * HD + ioa) = oa; *(h16x4*)(IK + (size_t)t * HD + iob) = ob; }
        }
        if (lane < 16) IW[t * 16 + lane] = (float)pr[C_IW + lane] * 0.02209708691207961f;
    }
}

__device__ __forceinline__ float relu_i(float x) { const int b = __float_as_int(x); return __int_as_float(b > 0 ? b : 0); }
constexpr int IDX_ITEMS = 8320, IDX_ROWB = 272, IDX_TILEB = 128 * IDX_ROWB;
__device__ __forceinline__ void idx_decode(int L, int& qb, int& kc) {
    int m = (int)((sqrtf(1.0f + 2.0f * (float)L) - 1.0f) * 0.5f);
    while (2 * (m + 1) * (m + 2) <= L) ++m;
    while (2 * m * (m + 1) > L) --m;
    const int rem = L - 2 * m * (m + 1); qb = 4 * m + rem / (m + 1); kc = rem % (m + 1);
}
__device__ __forceinline__ void idx_scores_phase(const h16* IQ, const h16* IK, const float* IW, h16* SC, LAS unsigned char* lds, int wg, int G, int tid, int wave, int lane) {
    const int L0 = (int)(((long)IDX_ITEMS * wg) / G), L1 = (int)(((long)IDX_ITEMS * (wg + 1)) / G);
    if (L0 >= L1) return;
    int qb, kc; idx_decode(L0, qb, kc);
    const int fr = lane & 15, fq = lane >> 4;
    h16x8 st[4];
#define IDX_LOAD(kc_) do { _Pragma("unroll") for (int i = 0; i < 4; ++i) { const int p = tid + 512 * i; st[i] = *(const h16x8*)(IK + (size_t)((kc_) * 128 + (p >> 4)) * HD + (p & 15) * 8); } } while (0)
#define IDX_WRITE(buf_) do { _Pragma("unroll") for (int i = 0; i < 4; ++i) { const int p = tid + 512 * i; *(LAS h16x8*)(lds + (buf_) * IDX_TILEB + (p >> 4) * IDX_ROWB + (p & 15) * 16) = st[i]; } } while (0)
    IDX_LOAD(kc); IDX_WRITE(0);
    __syncthreads();
    h16x8 a[4][4]; f32x4 w4[4]; int cur_qb = -1; int par = 0;
    for (int L = L0; L < L1; ++L) {
        int qbn = qb, kcn = kc + 1; if (kcn > (qb >> 2)) { kcn = 0; qbn = qb + 1; }
        const bool more = (L + 1 < L1);
        if (qb != cur_qb) { cur_qb = qb; const int tq = 32 * qb + 4 * wave;
#pragma unroll
            for (int q = 0; q < 4; ++q) {
#pragma unroll
                for (int ks = 0; ks < 4; ++ks) a[q][ks] = *(const h16x8*)(IQ + (size_t)(tq + q) * D + fr * HD + ks * 32 + fq * 8);
                w4[q] = *(const f32x4*)(IW + (size_t)(tq + q) * 16 + 4 * fq); } }
        { const int kcp = more ? kcn : kc; IDX_LOAD(kcp); }
        const LAS unsigned char* bb = lds + par * IDX_TILEB + fr * IDX_ROWB + fq * 16;
        float pq[4][4];
#ifdef IDX_REP
#pragma unroll 1
        for (int irep = 0; irep < IDX_REP; ++irep)
#endif
        h16x8 bq[2][4];
#pragma unroll
        for (int ks = 0; ks < 4; ++ks) bq[0][ks] = *(const LAS h16x8*)(bb + ks * 64);
#pragma unroll
        for (int kt = 0; kt < 8; ++kt) {
            if (kt + 1 < 8) {
#pragma unroll
                for (int ks = 0; ks < 4; ++ks) bq[(kt + 1) & 1][ks] = *(const LAS h16x8*)(bb + (kt + 1) * 16 * IDX_ROWB + ks * 64);
                __builtin_amdgcn_sched_barrier(0); }
            const h16x8 (&b)[4] = bq[kt & 1];
#pragma unroll
            for (int q = 0; q < 4; ++q) { f32x4 acc = {0.f, 0.f, 0.f, 0.f};
#pragma unroll
                for (int ks = 0; ks < 4; ++ks) acc = __builtin_amdgcn_mfma_f32_16x16x32_f16(a[q][ks], b[ks], acc, 0, 0, 0);
                pq[q][kt & 3] = w4[q][0] * relu_i(acc[0]) + w4[q][1] * relu_i(acc[1]) + w4[q][2] * relu_i(acc[2]) + w4[q][3] * relu_i(acc[3]); }
            if ((kt & 3) == 3) { const int tq = 32 * qb + 4 * wave;
#pragma unroll
                for (int q = 0; q < 4; ++q) {
                    const auto r02 = __builtin_amdgcn_permlane32_swap(__float_as_uint(pq[q][0]), __float_as_uint(pq[q][2]), false, false);
                    const auto r13 = __builtin_amdgcn_permlane32_swap(__float_as_uint(pq[q][1]), __float_as_uint(pq[q][3]), false, false);
                    const float a02 = __uint_as_float(r02[0]) + __uint_as_float(r02[1]), a13 = __uint_as_float(r13[0]) + __uint_as_float(r13[1]);
                    const float keep = (fq & 1) ? a13 : a02, send = (fq & 1) ? a02 : a13;
                    SC[(size_t)(tq + q) * SC_LD + kc * 128 + 64 * (kt >> 2) + lane] = (h16)(keep + __shfl_xor(send, 16)); } }
        }
        IDX_WRITE(par ^ 1);
        asm volatile("s_waitcnt lgkmcnt(0)" ::: "memory"); __builtin_amdgcn_s_barrier(); asm volatile("" ::: "memory");
        par ^= 1; qb = qbn; kc = kcn;
    }
#undef IDX_LOAD
#undef IDX_WRITE
}

template <int NR>
__device__ __forceinline__ unsigned kth_largest(const unsigned (&u)[NR], int K) {
    unsigned prefix = 0u;
#pragma unroll 1
    for (int bit = 15; bit >= 0; --bit) { const unsigned cand = prefix | (1u << bit); int cnt = 0;
#pragma unroll
        for (int i = 0; i < NR; ++i) { cnt += __builtin_popcountll(__ballot(u[i] >= cand)); if ((i & 31) == 31) __builtin_amdgcn_sched_barrier(0); }
        if (cnt >= K) prefix = cand; }
    return prefix;
}
template <int NR, bool ARR>
__device__ __forceinline__ void emit_topk(const unsigned (&u)[NR], unsigned thr_in, int* sel, const int (&keys)[ARR ? NR : 1], int lane) {
    unsigned thr = thr_in; int cgt = 0;
#pragma unroll
    for (int i = 0; i < NR; ++i) { cgt += __builtin_popcountll(__ballot(u[i] > thr)); if ((i & 7) == 7) __builtin_amdgcn_sched_barrier(0); }
    const int need = TOPK - cgt;
    asm volatile("" : "+s"(thr));
    int base = 0, eqseen = 0;
#pragma unroll
    for (int i = 0; i < NR; ++i) {
        const bool gt = u[i] > thr, eq = u[i] == thr;
        const unsigned long long eb = __ballot(eq);
        const int erank = eqseen + (int)__builtin_amdgcn_mbcnt_hi((unsigned)(eb >> 32), __builtin_amdgcn_mbcnt_lo((unsigned)eb, 0u));
        const bool take = gt || (eq && erank < need);
        const unsigned long long tb = __ballot(take);
        const int pos = base + (int)__builtin_amdgcn_mbcnt_hi((unsigned)(tb >> 32), __builtin_amdgcn_mbcnt_lo((unsigned)tb, 0u));
        if (take) sel[pos] = ARR ? keys[ARR ? i : 0] : 64 * i + lane;
        base += __builtin_popcountll(tb); eqseen += __builtin_popcountll(eb);
        __builtin_amdgcn_sched_barrier(0);
    }
}
constexpr int TK_CAP = 768, TK_TARGET = 448;
template <int NREG>
__device__ __forceinline__ void topk_load_row(unsigned (&u)[NREG], const h16* sc_in, int t_in, int lane) {
    static_assert(NREG % 16 == 0, "chunks of 16 registers");
#pragma unroll
    for (int c = 0; c < NREG / 16; ++c) {
        const GAS unsigned short* pc = (const GAS unsigned short*)(sc_in + 1024 * c); asm volatile("" : "+s"(pc));
#pragma unroll
        for (int k = 0; k < 16; ++k) u[16 * c + k] = (unsigned)pc[64 * k + lane];
    }
#pragma unroll
    for (int c = 0; c < NREG / 16; ++c) {
        int tl = t_in - 1024 * c; asm volatile("" : "+s"(tl));
#pragma unroll
        for (int k = 0; k < 16; ++k) { const unsigned b = u[16 * c + k]; const unsigned mk = (b >> 15) ? 0xFFFFu : 0x8000u; u[16 * c + k] = (lane <= tl - 64 * k) ? (b ^ mk) : 0u; }
        __builtin_amdgcn_sched_barrier(0);
    }
}
template <int NREG>
__device__ __forceinline__ void topk_row(const h16* sc_in, int t_in, int* sel, int lane_in, LAS unsigned long long* cand) {
    int lane = lane_in; asm volatile("" : "+v"(lane));
    if constexpr (NREG >= 64) {
        int cn = 0;
        {   unsigned u[NREG];
            topk_load_row<NREG>(u, sc_in, t_in, lane);
            constexpr int NS = NREG / 8;
            unsigned us[NS]; int nsv = 0;
#pragma unroll
            for (int s = 0; s < NS; ++s) { us[s] = u[8 * s]; const int rem = t_in + 1 - 512 * s; nsv += rem < 0 ? 0 : (rem > 64 ? 64 : rem); }
            int Ks = (TK_TARGET * nsv) / (t_in + 1); Ks = Ks < 1 ? 1 : Ks;
            unsigned tau = kth_largest<NS>(us, Ks);
            asm volatile("" : "+s"(tau));
#pragma unroll
            for (int c = 0; c < NREG / 16; ++c) {
                int kb = 1024 * c + lane; asm volatile("" : "+v"(kb));
#pragma unroll
                for (int k = 0; k < 16; ++k) { const int i = 16 * c + k; const bool m = u[i] >= tau && tau != 0u; const unsigned long long mb = __ballot(m);
                    const int pos = cn + (int)__builtin_amdgcn_mbcnt_hi((unsigned)(mb >> 32), __builtin_amdgcn_mbcnt_lo((unsigned)mb, 0u));
                    if (m && pos < TK_CAP) cand[pos] = ((unsigned long long)u[i] << 32) | (unsigned)(kb + 64 * k);
                    cn += __builtin_popcountll(mb); if ((k & 3) == 3) __builtin_amdgcn_sched_barrier(0); }
            }
        }
        asm volatile("" : "+s"(cn));
        if (cn >= TOPK && cn <= TK_CAP) {
            LDS_WAIT();
            unsigned cu[TK_CAP / 64]; int ck[TK_CAP / 64];
#pragma unroll
            for (int k = 0; k < TK_CAP / 64; ++k) { const int ix = 64 * k + lane; const unsigned long long v = cand[ix]; cu[k] = ix < cn ? (unsigned)(v >> 32) : 0u; ck[k] = (int)(unsigned)v; }
            const unsigned thr = kth_largest<TK_CAP / 64>(cu, TOPK);
            emit_topk<TK_CAP / 64, true>(cu, thr, sel, ck, lane);
            LDS_WAIT();
            return;
        }
    }
    {   unsigned u[NREG];
        topk_load_row<NREG>(u, sc_in, t_in, lane);
        const unsigned thr = kth_largest<NREG>(u, TOPK);
        const int nokeys[1] = {0}; emit_topk<NREG, false>(u, thr, sel, nokeys, lane); }
}
__device__ __forceinline__ void topk_phase(const h16* SC, int* SEL, LAS unsigned char* lds, int gw, int NGW, int wave, int lane) {
    LAS unsigned long long* cand = (LAS unsigned long long*)(lds + wave * (TK_CAP * 8));
    for (int t = gw; t < T; t += NGW) {
        const h16* sc = SC + (size_t)t * SC_LD; int* sel = SEL + (size_t)t * TOPK;
        if (t < TOPK) {
#pragma unroll
            for (int j = 0; j < 4; ++j) { const int k = lane + 64 * j; sel[k] = (k <= t) ? k : -1; }
        } else if (t < 2048) topk_row<32>(sc, t, sel, lane, cand);
        else if (t < 4096) topk_row<64>(sc, t, sel, lane, cand);
        else if (t < 6144) topk_row<96>(sc, t, sel, lane, cand);
        else topk_row<128>(sc, t, sel, lane, cand);
    }
}

__device__ __forceinline__ float dot8(h16x8 a, h16x8 b, float c) {
#if __has_builtin(__builtin_amdgcn_fdot2)
    c = __builtin_amdgcn_fdot2((h16x2){a[0], a[1]}, (h16x2){b[0], b[1]}, c, false); c = __builtin_amdgcn_fdot2((h16x2){a[2], a[3]}, (h16x2){b[2], b[3]}, c, false);
    c = __builtin_amdgcn_fdot2((h16x2){a[4], a[5]}, (h16x2){b[4], b[5]}, c, false); c = __builtin_amdgcn_fdot2((h16x2){a[6], a[7]}, (h16x2){b[6], b[7]}, c, false);
#else
#pragma unroll
    for (int e = 0; e < 8; ++e) c += (float)a[e] * (float)b[e];
#endif
    return c;
}
__device__ __forceinline__ void attn_phase(const h16* QH, const h16* KH, const h16* VH, const int* SEL, h16* O, LAS unsigned char* lds, int wg, int G, int wave, int lane) {
    LAS h16* qs = (LAS h16*)(lds + wave * 6144);
    LAS float* ps = (LAS float*)(lds + wave * 6144 + 1024);
    LAS int* is = (LAS int*)(lds + wave * 6144 + 5120);
    const int grp = lane >> 4, c = lane & 15;
    for (int L = wg; L < (T / 8) * NKV; L += G) {
        const int g = L & 3, t = 8 * (L >> 2) + wave;
        int idx[4];
#pragma unroll
        for (int j = 0; j < 4; ++j) idx[j] = SEL[(size_t)t * TOPK + lane + 64 * j];
        *(LAS h16x8*)(qs + lane * 8) = *(const h16x8*)(QH + (size_t)t * D + g * 512 + lane * 8);
#pragma unroll
        for (int j = 0; j < 4; ++j) is[lane + 64 * j] = idx[j] < 0 ? 0 : idx[j];
        LDS_WAIT();
        float sc[4][4];
#pragma unroll
        for (int j = 0; j < 4; ++j) { const h16* krow = KH + (size_t)(idx[j] < 0 ? 0 : idx[j]) * 512 + g * HD; h16x8 kf[16];
#pragma unroll
            for (int cc = 0; cc < 16; ++cc) kf[cc] = *(const h16x8*)(krow + 8 * cc);
#pragma unroll
            for (int hh = 0; hh < 4; ++hh) { float s = 0.f;
#pragma unroll
                for (int cc = 0; cc < 16; ++cc) s = dot8(kf[cc], *(const LAS h16x8*)(qs + hh * HD + 8 * cc), s);
                sc[j][hh] = (idx[j] < 0) ? -__builtin_inff() : s * 0.08838834764831845f; }
            __builtin_amdgcn_sched_barrier(0); }
#pragma unroll
        for (int hh = 0; hh < 4; ++hh) {
            const float mx = wave_max(fmaxf(fmaxf(sc[0][hh], sc[1][hh]), fmaxf(sc[2][hh], sc[3][hh])));
            float e0 = __expf(sc[0][hh] - mx), e1 = __expf(sc[1][hh] - mx), e2 = __expf(sc[2][hh] - mx), e3 = __expf(sc[3][hh] - mx);
            const float inv = 1.0f / wave_sum((e0 + e1) + (e2 + e3));
            sc[0][hh] = e0 * inv; sc[1][hh] = e1 * inv; sc[2][hh] = e2 * inv; sc[3][hh] = e3 * inv; }
#pragma unroll
        for (int j = 0; j < 4; ++j) *(LAS f32x4*)(ps + 4 * (lane + 64 * j)) = (f32x4){sc[j][0], sc[j][1], sc[j][2], sc[j][3]};
        LDS_WAIT();
        float acc[4][8];
#pragma unroll
        for (int hh = 0; hh < 4; ++hh)
#pragma unroll
            for (int e = 0; e < 8; ++e) acc[hh][e] = 0.f;
#pragma unroll 4
        for (int it = 0; it < 64; ++it) { const int kk = 4 * it + grp; const int ik = is[kk]; const f32x4 p4 = *(const LAS f32x4*)(ps + 4 * kk);
            const h16x8 v8 = *(const h16x8*)(VH + (size_t)ik * 512 + g * HD + 8 * c);
#pragma unroll
            for (int hh = 0; hh < 4; ++hh)
#pragma unroll
                for (int e = 0; e < 8; ++e) acc[hh][e] += p4[hh] * (float)v8[e];
            if ((it & 3) == 3) __builtin_amdgcn_sched_barrier(0); }
#pragma unroll
        for (int hh = 0; hh < 4; ++hh)
#pragma unroll
            for (int e = 0; e < 8; ++e) { float v = acc[hh][e]; v += __shfl_xor(v, 16); v += __shfl_xor(v, 32); acc[hh][e] = v; }
        float o8[8];
#pragma unroll
        for (int e = 0; e < 8; ++e) o8[e] = grp == 0 ? acc[0][e] : grp == 1 ? acc[1][e] : grp == 2 ? acc[2][e] : acc[3][e];
        v4u w; w.x = pkh(o8[0], o8[1]); w.y = pkh(o8[2], o8[3]); w.z = pkh(o8[4], o8[5]); w.w = pkh(o8[6], o8[7]);
        *(v4u*)(O + (size_t)t * D + (4 * g + grp) * HD + 8 * c) = w;
        LDS_WAIT();
    }
}

__device__ __forceinline__ void conv_phase(const h16* PROJ, const float* cw, const float* cb, h16* XC, int gtid, int NGT) {
    h16x8 xn[4];
#define CONV_LOAD(i_) do { const int c8_ = ((i_) & 255) * 8, t_ = (i_) >> 8; _Pragma("unroll") for (int j = 0; j < 4; ++j) { const int tt = t_ - 3 + j; xn[j] = *(const h16x8*)(PROJ + (size_t)(tt < 0 ? 0 : tt) * 4096 + 2048 + c8_); } } while (0)
    if (gtid < T * 256) CONV_LOAD(gtid);
    for (int i = gtid; i < T * 256; i += NGT) { const int c8 = (i & 255) * 8, t = i >> 8;
        h16x8 xv[4];
#pragma unroll
        for (int j = 0; j < 4; ++j) xv[j] = xn[j];
        if (i + NGT < T * 256) CONV_LOAD(i + NGT);
        float acc[8];
#pragma unroll
        for (int e = 0; e < 8; ++e) acc[e] = cb[c8 + e];
#pragma unroll
        for (int j = 0; j < 4; ++j) { const int tt = t - 3 + j; if (tt >= 0) {
            const f32x4 w0 = *(const f32x4*)(cw + j * 2048 + c8), w1 = *(const f32x4*)(cw + j * 2048 + c8 + 4);
#pragma unroll
            for (int e = 0; e < 4; ++e) { acc[e] += (float)xv[j][e] * w0[e]; acc[4 + e] += (float)xv[j][4 + e] * w1[e]; } } }
        v4u w; w.x = pkh(acc[0], acc[1]); w.y = pkh(acc[2], acc[3]); w.z = pkh(acc[4], acc[5]); w.w = pkh(acc[6], acc[7]);
        *(v4u*)(XC + (size_t)t * 2048 + c8) = w; }
#undef CONV_LOAD
}
constexpr int SCAN_LC = 64, SCAN_NCH = T / SCAN_LC;
__device__ __forceinline__ f32x4 ld_a4(const h16* LA, size_t o) { const h16x4 v = *(const h16x4*)(LA + o); return (f32x4){__expf((float)v[0]), __expf((float)v[1]), __expf((float)v[2]), __expf((float)v[3])}; }
__device__ __forceinline__ f32x4 ld_b4(const h16* BF, size_t o) { const h16x4 v = *(const h16x4*)(BF + o); return (f32x4){(float)v[0], (float)v[1], (float)v[2], (float)v[3]}; }
__device__ __forceinline__ void scan_agg_phase(const h16* AF, const h16* BF, float* AGGA, float* AGGB, int gtid, int NGT) {
    for (int i = gtid; i < SCAN_NCH * 512; i += NGT) { const int cg = (i & 511) * 4, k = i >> 9;
        f32x4 Pr = {1.f, 1.f, 1.f, 1.f}, H = {0.f, 0.f, 0.f, 0.f};
#pragma unroll 16
        for (int r = 0; r < SCAN_LC; ++r) { const size_t o = (size_t)(k * SCAN_LC + r) * 2048 + cg; const f32x4 a = ld_a4(AF, o), b = ld_b4(BF, o); H = a * H + b; Pr = Pr * a; }
        *(f32x4*)(AGGA + (size_t)k * 2048 + cg) = Pr; *(f32x4*)(AGGB + (size_t)k * 2048 + cg) = H; }
}
__device__ __forceinline__ float gelu_tanh(float x) { const float u = 0.7978845608028654f * (x + 0.044715f * x * x * x); const float e = __expf(2.0f * u); const float th = 1.0f - 2.0f / (e + 1.0f); return 0.5f * x * (1.0f + th); }
__device__ __forceinline__ void scan_final_phase(const h16* AF, const h16* BF, const float* AGGA, const float* AGGB, const h16* PROJ, h16* Y, int gtid, int NGT) {
    for (int i = gtid; i < SCAN_NCH * 512; i += NGT) { const int cg = (i & 511) * 4, k = i >> 9;
        f32x4 H = {0.f, 0.f, 0.f, 0.f};
#pragma unroll 8
        for (int j = 0; j < k; ++j) { const f32x4 a = *(const f32x4*)(AGGA + (size_t)j * 2048 + cg), b = *(const f32x4*)(AGGB + (size_t)j * 2048 + cg); H = a * H + b; }
#pragma unroll 8
        for (int r = 0; r < SCAN_LC; ++r) { const int t = k * SCAN_LC + r; const size_t o = (size_t)t * 2048 + cg; const f32x4 a = ld_a4(AF, o), b = ld_b4(BF, o); H = a * H + b;
            const h16x4 gt = *(const h16x4*)(PROJ + (size_t)t * 4096 + cg);
            v2u w; w.x = pkh(H[0] * gelu_tanh((float)gt[0]), H[1] * gelu_tanh((float)gt[1])); w.y = pkh(H[2] * gelu_tanh((float)gt[2]), H[3] * gelu_tanh((float)gt[3]));
            *(v2u*)(Y + o) = w; } }
}
__device__ __forceinline__ f32x4 ldx4(const h16* p) { const h16x4 v = *(const h16x4*)p; return (f32x4){(float)v[0], (float)v[1], (float)v[2], (float)v[3]}; }
__device__ __forceinline__ void pool_phase(const h16* X, const float* gain, h16* Y, LAS unsigned char* lds, int wg, int G, int tid, int wave, int lane) {
    LAS float* rs = (LAS float*)lds;
    const int c4 = tid * 4; const int w = 2 << (tid >> 7);
    const f32x4 gn = *(const f32x4*)(gain + c4);
    for (int u = wg; u < T / 32; u += G) { const int t0 = 32 * u;
        __syncthreads();
        for (int r = wave; r < 47; r += NWAVES) { const int t = t0 - 15 + r;
            if (t >= 0) { const h16* xr = X + (size_t)t * D + 4 * lane; float s = 0.f;
#pragma unroll
                for (int j = 0; j < 8; ++j) { const f32x4 v = ldx4(xr + 256 * j); s += (v.x * v.x + v.y * v.y) + (v.z * v.z + v.w * v.w); }
                s = wave_sum(s); if (lane == 0) rs[r] = 1.0f / sqrtf(s * (1.0f / D) + EPS); } }
        __syncthreads();
        f32x4 sum = {0.f, 0.f, 0.f, 0.f};
        { const int n0 = (t0 + 1) < w ? (t0 + 1) : w;
          for (int j = 1; j < n0; ++j) sum += ldx4(X + (size_t)(t0 - j) * D + c4) * rs[15 - j]; }
#pragma unroll 8
        for (int r = 0; r < 32; ++r) { const int t = t0 + r; const int n = (t + 1) < w ? (t + 1) : w;
            const f32x4 h0 = ldx4(X + (size_t)t * D + c4) * rs[15 + r];
            sum += h0;
            const float invn = 1.0f / (float)n;
            const f32x4 y = (sum * invn - h0) * gn;
            v2u o; o.x = pkh(y.x, y.y); o.y = pkh(y.z, y.w); *(v2u*)(Y + (size_t)t * D + c4) = o;
            if (t + 1 >= w) sum -= ldx4(X + (size_t)(t + 1 - w) * D + c4) * rs[15 + r + 1 - w]; }
    }
}

__device__ __forceinline__ h16x8 f8x8_to_h(unsigned d0, unsigned d1) {
    const h16x2 a = __builtin_amdgcn_cvt_scalef32_pk_f16_fp8((int)d0, 1.0f, false), b = __builtin_amdgcn_cvt_scalef32_pk_f16_fp8((int)d0, 1.0f, true);
    const h16x2 c = __builtin_amdgcn_cvt_scalef32_pk_f16_fp8((int)d1, 1.0f, false), d = __builtin_amdgcn_cvt_scalef32_pk_f16_fp8((int)d1, 1.0f, true);
    return (h16x8){a[0], a[1], b[0], b[1], c[0], c[1], d[0], d[1]};
}
__device__ __forceinline__ unsigned attn_off_b(unsigned row, unsigned ch) { return 256u * row + 16u * (ch ^ (((row & 3u) << 2) | ((row >> 2) & 3u))); }
__device__ __forceinline__ void attn_mfma_phase(const unsigned char* Q8, const unsigned char* K8, const unsigned char* V8, const int* SEL, h16* O, LAS unsigned char* lds, int wg, int G, int wave, int lane_in) {
    typedef int i32x4 __attribute__((ext_vector_type(4)));
    typedef int i32x2 __attribute__((ext_vector_type(2)));
    typedef long i64x2 __attribute__((ext_vector_type(2)));
    i32x4 svn = {0, 0, 0, 0}; i64x2 qfn[2] = {{0, 0}, {0, 0}};
#define AT_PREF(L_) do { const int g_ = (L_) & 3, t_ = 8 * ((L_) >> 2) + wave; svn = *(const i32x4*)(SEL + (size_t)t_ * TOPK + 4 * lane_in); \
        _Pragma("unroll") for (int pp = 0; pp < 2; ++pp) qfn[pp] = *(const i64x2*)(Q8 + (size_t)t_ * D + (4 * g_ + (lane_in & 3)) * HD + 64 * pp + 16 * (lane_in >> 4)); } while (0)
    v4u kga[4], kgb[4];
#define AT_LOADK2(buf, G_, selk_, kbase_) do { const i32x2 i0 = *(const LAS i32x2*)((selk_) + 2 * (G_)), i1 = *(const LAS i32x2*)((selk_) + 128 + 2 * (G_)); \
            buf[0] = *(const v4u*)((kbase_) + (size_t)(i0.x < 0 ? 0 : i0.x) * 512); buf[1] = *(const v4u*)((kbase_) + (size_t)(i1.x < 0 ? 0 : i1.x) * 512); \
            buf[2] = *(const v4u*)((kbase_) + (size_t)(i0.y < 0 ? 0 : i0.y) * 512); buf[3] = *(const v4u*)((kbase_) + (size_t)(i1.y < 0 ? 0 : i1.y) * 512); } while (0)
#define AT_PREP(L_, par_) do { LAS int* sst_ = (LAS int*)(lds + LDSCTL_OFF + 1024 + wave * 2048 + (par_) * 1024); *(LAS i32x4*)(sst_ + 4 * lane_in) = svn; \
        asm volatile("s_waitcnt lgkmcnt(0)" ::: "memory"); \
        const LAS int* selk_ = sst_ + 16 * (lane_in >> 3); const unsigned char* kbase_ = K8 + ((L_) & 3) * HD + 16 * (lane_in & 7); \
        AT_LOADK2(kga, 0, selk_, kbase_); AT_LOADK2(kgb, 1, selk_, kbase_); } while (0)
    if (wg < (T / 8) * NKV) { AT_PREF(wg); AT_PREP(wg, 0); }
    int itpar = 0;
    for (int L = wg; L < (T / 8) * NKV; L += G, itpar ^= 1) {
        int lane = lane_in; asm volatile("" : "+v"(lane));
        const int jl = lane & 15, gi = lane >> 4;
        const int g = L & 3, t = 8 * (L >> 2) + wave;
        const int* sel = SEL + (size_t)t * TOPK; (void)sel;
        const int nvalid = (t + 1) < TOPK ? (t + 1) : TOPK;
        LAS int* sst = (LAS int*)(lds + LDSCTL_OFF + 1024 + wave * 2048 + itpar * 1024);
        i64x2 qf[2];
#pragma unroll
        for (int pp = 0; pp < 2; ++pp) qf[pp] = qfn[pp];
        LAS unsigned char* vimg = lds + wave * 16384;
        const LAS int* selk = sst + 16 * (lane >> 3);
        const unsigned char* kbase = K8 + g * HD + 16 * (lane & 7);
        const unsigned kwr = 136u * (unsigned)(lane >> 3) + 16u * (unsigned)(lane & 7), krd = 136u * (unsigned)jl + 16u * (unsigned)gi;
        f32x4 s[16];
#define AT_LOADK(buf, G_) AT_LOADK2(buf, G_, selk, kbase)
#define AT_KSTEP(buf, G_) do { LAS unsigned char* kb_ = vimg + ((G_) & 1) * 8192; \
            _Pragma("unroll") for (int j = 0; j < 4; ++j) { *(LAS v2u*)(kb_ + kwr + 1088 * j) = (v2u){buf[j].x, buf[j].y}; *(LAS v2u*)(kb_ + kwr + 1088 * j + 8) = (v2u){buf[j].z, buf[j].w}; } \
            if ((G_) + 2 < 8) AT_LOADK(buf, (G_) + 2); \
            _Pragma("unroll") for (int tt = 0; tt < 2; ++tt) { f32x4 acc = {0.f, 0.f, 0.f, 0.f}; \
                _Pragma("unroll") for (int pp = 0; pp < 2; ++pp) { const long a0 = *(const LAS long*)(kb_ + krd + 2176 * tt + 64 * pp), a1 = *(const LAS long*)(kb_ + krd + 2176 * tt + 64 * pp + 8); \
                    acc = __builtin_amdgcn_mfma_f32_16x16x32_fp8_fp8(a0, qf[pp].x, acc, 0, 0, 0); acc = __builtin_amdgcn_mfma_f32_16x16x32_fp8_fp8(a1, qf[pp].y, acc, 0, 0, 0); } \
                s[2 * (G_) + tt] = acc; } } while (0)
        if (L + G < (T / 8) * NKV) AT_PREF(L + G);
        AT_KSTEP(kga, 0); AT_KSTEP(kgb, 1); AT_KSTEP(kga, 2); AT_KSTEP(kgb, 3); AT_KSTEP(kga, 4); AT_KSTEP(kgb, 5); AT_KSTEP(kga, 6); AT_KSTEP(kgb, 7);
#undef AT_LOADK
#undef AT_KSTEP
        const LAS int* selv = sst + ((lane >> 5) & 1) + 16 * ((lane >> 3) & 3);
        const unsigned char* vbase = V8 + g * HD + 16 * (lane & 7);
        v4u vsa[4], vsb[4];
#define AT_LOADV(vst, Tt) do { _Pragma("unroll") for (int i = 0; i < 4; ++i) { const int ix = selv[2 * (Tt) + 64 * i]; vst[i] = *(const v4u*)(vbase + (size_t)(ix < 0 ? 0 : ix) * 512); } } while (0)
        AT_LOADV(vsa, 0); AT_LOADV(vsb, 1);
        __builtin_amdgcn_sched_barrier(0);
        if (nvalid < TOPK) {
#pragma unroll
            for (int kt = 0; kt < 16; ++kt)
#pragma unroll
                for (int r = 0; r < 4; ++r) if (kt + 64 * gi + 16 * r >= nvalid) s[kt][r] = -__builtin_inff();
        }
        float mx = -__builtin_inff();
#pragma unroll
        for (int kt = 0; kt < 16; ++kt) mx = fmaxf(mx, fmaxf(fmaxf(s[kt][0], s[kt][1]), fmaxf(s[kt][2], s[kt][3])));
        mx = fmaxf(mx, __shfl_xor(mx, 16)); mx = fmaxf(mx, __shfl_xor(mx, 32));
        constexpr float C2 = 0.08838834764831845f * 1.4426950408889634f;
        const float mb = -mx * C2; float sum = 0.f;
        h16x8 pf[8];
#pragma unroll
        for (int Tt = 0; Tt < 8; ++Tt) { float p[8];
#pragma unroll
            for (int r = 0; r < 4; ++r) { p[r] = __builtin_amdgcn_exp2f(fmaf(s[2 * Tt][r], C2, mb)); p[4 + r] = __builtin_amdgcn_exp2f(fmaf(s[2 * Tt + 1][r], C2, mb)); }
            sum += ((p[0] + p[1]) + (p[2] + p[3])) + ((p[4] + p[5]) + (p[6] + p[7]));
            pf[Tt] = (h16x8){(h16)p[0], (h16)p[1], (h16)p[2], (h16)p[3], (h16)p[4], (h16)p[5], (h16)p[6], (h16)p[7]}; }
        sum += __shfl_xor(sum, 16); sum += __shfl_xor(sum, 32);
        const float linv = 1.0f / sum;
        const unsigned q4 = (unsigned)jl >> 2, p4 = (unsigned)jl & 3u;
        unsigned wr_off[8], rd_off[2];
#pragma unroll
        for (int i = 0; i < 4; ++i) { wr_off[2 * i] = attn_off_b((unsigned)((lane >> 3) + 8 * i), 2u * (lane & 7)); wr_off[2 * i + 1] = attn_off_b((unsigned)((lane >> 3) + 8 * i), 2u * (lane & 7) + 1u); }
#pragma unroll
        for (int tt = 0; tt < 2; ++tt) { const unsigned row = 8u * gi + 4u * tt + q4; const unsigned x = ((row & 3u) << 2) | ((row >> 2) & 3u);
            rd_off[tt] = 256u * row + 16u * ((p4 >> 1) ^ (x & 1u)) + 8u * (p4 & 1u) + 32u * (x >> 1); }
        f32x4 o[8];
#pragma unroll
        for (int c = 0; c < 8; ++c) o[c] = (f32x4){0.f, 0.f, 0.f, 0.f};
#define AT_STEP(vst, Tt) do { \
            _Pragma("unroll") for (int i = 0; i < 4; ++i) {     \
                *(LAS h16x8*)(vimg + ((Tt) & 1) * 8192 + wr_off[2 * i]) = f8x8_to_h(vst[i].x, vst[i].y); *(LAS h16x8*)(vimg + ((Tt) & 1) * 8192 + wr_off[2 * i + 1]) = f8x8_to_h(vst[i].z, vst[i].w); } \
            if ((Tt) + 2 < 8) AT_LOADV(vst, (Tt) + 2); \
            const unsigned ib = (unsigned)(size_t)(vimg + ((Tt) & 1) * 8192); \
            h16x4 lo[8], hi[8]; \
            asm volatile("s_waitcnt lgkmcnt(0)" ::: "memory"); \
            _Pragma("unroll") for (int c = 0; c < 8; ++c) { \
                asm volatile("ds_read_b64_tr_b16 %0, %1" : "=&v"(lo[c]) : "v"(ib + (rd_off[0] ^ ((unsigned)c << 5))) : "memory"); \
                asm volatile("ds_read_b64_tr_b16 %0, %1" : "=&v"(hi[c]) : "v"(ib + (rd_off[1] ^ ((unsigned)c << 5))) : "memory"); } \
            asm volatile("s_waitcnt lgkmcnt(0)" ::: "memory"); __builtin_amdgcn_sched_barrier(0); \
            _Pragma("unroll") for (int c = 0; c < 8; ++c) o[c] = __builtin_amdgcn_mfma_f32_16x16x32_f16(pf[Tt], (h16x8){lo[c][0], lo[c][1], lo[c][2], lo[c][3], hi[c][0], hi[c][1], hi[c][2], hi[c][3]}, o[c], 0, 0, 0); \
        } while (0)
        AT_STEP(vsa, 0); AT_STEP(vsb, 1); AT_STEP(vsa, 2); AT_STEP(vsb, 3); AT_STEP(vsa, 4); AT_STEP(vsb, 5); AT_STEP(vsa, 6); AT_STEP(vsb, 7);
#undef AT_STEP
#undef AT_LOADV
        const float li = __shfl(linv, gi);
        h16* orow = O + (size_t)t * D + (4 * g + gi) * HD + jl;
#pragma unroll
        for (int c = 0; c < 8; ++c) { const float v = gi == 0 ? o[c][0] : gi == 1 ? o[c][1] : gi == 2 ? o[c][2] : o[c][3]; orow[16 * c] = (h16)(v * li); }
        asm volatile("s_waitcnt lgkmcnt(0)" ::: "memory");
        if (L + G < (T / 8) * NKV) AT_PREP(L + G, itpar ^ 1);
    }
#undef AT_PREF
#undef AT_PREP
#undef AT_LOADK2
}

constexpr int NPH = 37;
__global__ void __launch_bounds__(NTHR, 2) fwd_kernel(Ptrs P_unused) {
    extern __shared__ __attribute__((aligned(16))) unsigned char lds_raw[];
    LAS unsigned char* lds = (LAS unsigned char*)lds_raw;
    volatile LAS unsigned* MISC = (volatile LAS unsigned*)(lds + MISC_OFF);
    for (int u = threadIdx.x; u < (LDS_BYTES - LDSCTL_OFF) / 4; u += NTHR) ((LAS unsigned*)(lds + LDSCTL_OFF))[u] = 0u;
    __syncthreads();
    int lo, hi;
    XcdBarrier bar;
    { const CAS Ptrs* PP = kargs(); lo = PP->ph_lo; hi = PP->ph_hi; unsigned* bw = (unsigned*)(PP->ws + WS_CTL) + CW_BAR;
      bar.bar = bw; bar.x = 0; bar.st = nullptr; if (hi - lo > 1) bar = xcd_barrier_post(bw, MISC + 8); }
    int seq = 0;
#define PH_BEGIN(S_) if (seq >= lo && seq < hi) { const CAS Ptrs* PP = kargs(); unsigned char* const ws = PP->ws; float* const X = PP->out; (void)X; \
        int tid = threadIdx.x, bx = blockIdx.x, G = gridDim.x; asm volatile("" : "+v"(tid), "+s"(bx), "+s"(G)); \
        const int lane = tid & 63, wave = __builtin_amdgcn_readfirstlane(tid >> 6); const int vcu = (G % 8 == 0) ? (bx % 8) * (G / 8) + bx / 8 : bx; \
        const int gw = vcu * NWAVES + wave, NGW = G * NWAVES, gtid = vcu * NTHR + tid, NGT = G * NTHR; (void)lane; (void)gw; (void)NGW; (void)gtid; (void)NGT; \
        for (int rep_ = 0; rep_ < 1 + (int)((REP_MASK >> (S_)) & 1u); ++rep_) { if (rep_) __syncthreads(); \
        h16* const X16 = (h16*)(ws + WS_X16); h16* const PROJ = (h16*)(ws + WS_BA + BA_PROJ); h16* const U16 = (h16*)(ws + WS_BA + BA_U); (void)X16; (void)PROJ; (void)U16;
#define PH_END   } if (seq + 1 < hi) xcd_barrier(bar); } ++seq;
#define RSQ(i_) ((float*)(ws + WS_CTL + WS_ROWSQ) + (size_t)(i_) * T)
#define PARTA ((float*)(ws + WS_PARTA))
#define PARTB ((float*)(ws + WS_PARTB))

    PH_BEGIN(0) p0_prologue(PP, lds, gw, NGW, wave, lane, gtid, NGT); norm0_phase(PP->x, X16, RSQ(0), gw, NGW, lane); PH_END

#pragma unroll 1
    for (int layer = 0; layer < DEPTH; ++layer) {
        const int kind = layer % 3, j = layer / 3;
        if (kind == 0) {
            PH_BEGIN(2) { pg8::Gemm g{X16, (const h16*)(ws + WS_WINA) + (size_t)j * A_INP * D, T, A_INP, D, D, 1 << 20, D, 128, 128}; pg8::StaticOrder S; S.init(T, A_INP, G, bx);
                       pg8::EpiF16<0> E{PROJ, A_INP, layer == 0 ? RSQ(0) : PARTB, 0, layer == 0 ? 0 : 32}; pg8::gemm_phase<pg8::EpiF16<0>, pg8::StaticOrder, true, true>(lds, g, S, E, tid); } PH_END
            PH_BEGIN(3) dsa_post_phase(PROJ, PP->attn_qn + j * HD, PP->attn_kn + j * HD, (const float*)(ws + WS_COS128), (const float*)(ws + WS_SIN128), (const float*)(ws + WS_COS64), (const float*)(ws + WS_SIN64),
                                    (unsigned char*)(ws + WS_QH), (unsigned char*)(ws + WS_KH), (unsigned char*)(ws + WS_VH), (h16*)(ws + WS_IQ), (h16*)(ws + WS_IK), (float*)(ws + WS_IW), gw, NGW, lane); PH_END
            PH_BEGIN(4) idx_scores_phase((const h16*)(ws + WS_IQ), (const h16*)(ws + WS_IK), (const float*)(ws + WS_IW), (h16*)(ws + WS_BA + BA_SC), lds, vcu, G, tid, wave, lane); PH_END
            PH_BEGIN(5) topk_phase((const h16*)(ws + WS_BA + BA_SC), (int*)(ws + WS_SEL), lds, gw, NGW, wave, lane); PH_END
            PH_BEGIN(6) attn_mfma_phase((const unsigned char*)(ws + WS_QH), (const unsigned char*)(ws + WS_KH), (const unsigned char*)(ws + WS_VH), (const int*)(ws + WS_SEL), (h16*)(ws + WS_BA + BA_O16), lds, bx, G, wave, lane); PH_END
            PH_BEGIN(7) { pg8::Gemm g{(const h16*)(ws + WS_BA + BA_O16), (const h16*)(ws + WS_WOUTA) + (size_t)j * D * D, T, D, D, D, 1 << 20, D, 128, 128}; pg8::StaticOrder S; S.init(T, D, G, bx);
                       pg8::EpiResid E{X16, X16, nullptr, D, nullptr, nullptr, PARTA}; pg8::gemm_phase<pg8::EpiResid, pg8::StaticOrder, true, true>(lds, g, S, E, tid); } PH_END
        } else if (kind == 1) {
            PH_BEGIN(9) { pg8::Gemm g{X16, (const h16*)(ws + WS_WINR), T, 4096, D, D, 1 << 20, D, 128, 128}; pg8::StaticOrder S; S.init(T, 4096, G, bx);
                       pg8::EpiF16<0> E{PROJ, 4096, layer == 0 ? RSQ(0) : PARTB, 0, layer == 0 ? 0 : 32}; pg8::gemm_phase<pg8::EpiF16<0>, pg8::StaticOrder, true, true>(lds, g, S, E, tid); } PH_END
            PH_BEGIN(10) conv_phase(PROJ, PP->conv_w, PP->conv_b, (h16*)(ws + WS_BA + BA_XC), gtid, NGT); PH_END
            PH_BEGIN(11) { int kg = 256; asm volatile("" : "+s"(kg));
                       pg8::Gemm g{(const h16*)(ws + WS_BA + BA_XC), (const h16*)(ws + WS_WGR), T, 4096, kg, D, 2, kg, 128, 128}; pg8::StaticOrder S; S.init(T, 4096, G, bx);
                       pg8::EpiGates E{(const h16*)(ws + WS_BA + BA_XC), PP->ga_b, PP->gx_b, PP->lam, (h16*)(ws + WS_BA + BA_AF), (h16*)(ws + WS_BA + BA_BF)};
                       pg8::gemm_phase<pg8::EpiGates, pg8::StaticOrder, true, true>(lds, g, S, E, tid); } PH_END
            PH_BEGIN(12) scan_agg_phase((const h16*)(ws + WS_BA + BA_AF), (const h16*)(ws + WS_BA + BA_BF), (float*)(ws + WS_AGGA), (float*)(ws + WS_AGGB), gtid, NGT); PH_END
            PH_BEGIN(13) scan_final_phase((const h16*)(ws + WS_BA + BA_AF), (const h16*)(ws + WS_BA + BA_BF), (const float*)(ws + WS_AGGA), (const float*)(ws + WS_AGGB), PROJ, (h16*)(ws + WS_BA + BA_XC), gtid, NGT); PH_END
            PH_BEGIN(14) { pg8::Gemm g{(const h16*)(ws + WS_BA + BA_XC), (const h16*)(ws + WS_WOUTR), T, D, D, D, 1 << 20, D, 128, 128}; pg8::StaticOrder S; S.init(T, D, G, bx);
                       pg8::EpiResid E{X16, X16, nullptr, D, nullptr, nullptr, PARTA}; pg8::gemm_phase<pg8::EpiResid, pg8::StaticOrder, true, true>(lds, g, S, E, tid); } PH_END
        } else {
            PH_BEGIN(15) pool_phase(X16, PP->pool_norm, (h16*)(ws + WS_BA + BA_XC), lds, vcu, G, tid, wave, lane); PH_END
            PH_BEGIN(16) { pg8::Gemm g{(const h16*)(ws + WS_BA + BA_XC), (const h16*)(ws + WS_WPOOL), T, D, 512, D, 2, 512, 128, 128}; pg8::StaticOrder S; S.init(T, D, G, bx);
                       pg8::EpiResid E{X16, X16, nullptr, D, PP->pool_b, PP->pool_scale, PARTA}; pg8::gemm_phase<pg8::EpiResid, pg8::StaticOrder, true, true>(lds, g, S, E, tid); } PH_END
        }
        PH_BEGIN(17) quant_rows(X16, T, (signed char*)(ws + WS_BA + BA_A8), (float*)(ws + WS_RS), PARTA, nullptr, gw, NGW, lane);
                     quant_rows((const h16*)(ws + WS_WUP) + (size_t)layer * D * FF, FF, (signed char*)(ws + WS_BA + BA_W8), (float*)(ws + WS_CS), nullptr, (const unsigned*)(ws + WS_BLKMAX) + (size_t)layer * 32 * FF, gw, NGW, lane); PH_END
        PH_BEGIN(18) { pg8::Gemm g{(const h16*)(ws + WS_BA + BA_A8), (const h16*)(ws + WS_BA + BA_W8), T, FF, D / 2, D / 2, 1 << 20, D / 2, 128, 128}; pg8::StaticOrder S; S.init(T, FF, G, bx);
                   pg8::EpiQRelu2<pg8::i32x4> E{U16, (const float*)(ws + WS_RS), (const float*)(ws + WS_CS), T}; pg8::gemm_phase_i8<pg8::EpiQRelu2<pg8::i32x4>, pg8::StaticOrder, true, true>(lds, g, S, E, tid); } PH_END
        PH_BEGIN(19) quant_kblk<true>(U16, T, (signed char*)(ws + WS_BA + BA_U8), (float*)(ws + WS_RS2), nullptr, nullptr, gw, NGW, lane);
                     quant_kblk<false>((const h16*)(ws + WS_WDOWN) + (size_t)layer * D * FF, D, (signed char*)(ws + WS_BA + BA_W8D), (float*)(ws + WS_CS2), (float*)(ws + WS_CSUM), (const unsigned*)(ws + WS_BLKMAXD) + (size_t)layer * 128 * D, gw, NGW, lane); PH_END
        PH_BEGIN(20) { pg8::Gemm g{(const h16*)(ws + WS_BA + BA_U8), (const h16*)(ws + WS_BA + BA_W8D), T, D, FF / 2, 64, 1 << 20, 64, (size_t)T * 128, (size_t)D * 128}; pg8::StaticOrder S; S.init(T, D, G, bx);
                   const bool lastl = layer + 1 >= DEPTH, needsq = !lastl && (layer + 1) % 3 != 2;
                   pg8::EpiResidQ E{X16, X16, lastl ? X : nullptr, D, (const float*)(ws + WS_RS2), (const float*)(ws + WS_CS2), (const float*)(ws + WS_CSUM), needsq ? PARTB : nullptr};
                   pg8::gemm_phase_i8<pg8::EpiResidQ, pg8::StaticOrder, true, true>(lds, g, S, E, tid); } PH_END
    }
#undef PH_BEGIN
#undef PH_END
#undef RSQ
#undef PARTA
#undef PARTB
}

extern "C" void kernel_launch(void* const* d_in, const int* in_sizes, int n_in, void* d_out, int out_size, void* d_ws, size_t ws_size, hipStream_t stream) {
    static int grid = 0;
    if (grid == 0) {
        if (n_in != 24 || in_sizes[0] != T * D || out_size != T * D || ws_size < WS_END) { fprintf(stderr, "kernel_launch: unexpected shapes / workspace (n_in %d, in0 %d, out %d, ws %zu, need %zu); nothing launched\n", n_in, n_in > 0 ? in_sizes[0] : -1, out_size, ws_size, (size_t)WS_END); grid = -1; return; }
        int dev = 0, cus = 0, per_cu = 0;
        if (hipGetDevice(&dev) != hipSuccess || hipDeviceGetAttribute(&cus, hipDeviceAttributeMultiprocessorCount, dev) != hipSuccess) { grid = -1; return; }
        if (hipFuncSetAttribute((const void*)fwd_kernel, hipFuncAttributeMaxDynamicSharedMemorySize, LDS_BYTES) != hipSuccess) { fprintf(stderr, "kernel_launch: hipFuncSetAttribute failed\n"); grid = -1; return; }
        if (hipOccupancyMaxActiveBlocksPerMultiprocessor(&per_cu, (const void*)fwd_kernel, NTHR, LDS_BYTES) != hipSuccess || per_cu < 1) { fprintf(stderr, "kernel_launch: occupancy query reports %d workgroups per CU\n", per_cu); }
        (void)hipGetLastError();
        grid = cus;
    }
    if (grid < 0) return;
    if (hipMemsetAsync((char*)d_ws + WS_CTL, 0, CTL_ZERO_BYTES, stream) != hipSuccess) return;
    Ptrs p{};
    p.x = (const float*)d_in[0]; p.pos = (const int*)d_in[1];
    p.attn_norm = (const float*)d_in[2]; p.attn_w_in = (const float*)d_in[3]; p.attn_qn = (const float*)d_in[4]; p.attn_kn = (const float*)d_in[5]; p.attn_w_out = (const float*)d_in[6];
    p.rnn_norm = (const float*)d_in[7]; p.rnn_w_in = (const float*)d_in[8]; p.conv_w = (const float*)d_in[9]; p.conv_b = (const float*)d_in[10]; p.ga_w = (const float*)d_in[11]; p.ga_b = (const float*)d_in[12];
    p.gx_w = (const float*)d_in[13]; p.gx_b = (const float*)d_in[14]; p.lam = (const float*)d_in[15]; p.rnn_w_out = (const float*)d_in[16];
    p.pool_norm = (const float*)d_in[17]; p.pool_w = (const float*)d_in[18]; p.pool_b = (const float*)d_in[19]; p.pool_scale = (const float*)d_in[20];
    p.mlp_norm = (const float*)d_in[21]; p.mlp_w_up = (const float*)d_in[22]; p.mlp_w_down = (const float*)d_in[23];
    p.out = (float*)d_out; p.ws = (unsigned char*)d_ws;
#if MK_SPLIT
    for (int ph = 0; ph < NPH; ++ph) { p.ph_lo = ph; p.ph_hi = ph + 1; hipLaunchKernelGGL(fwd_kernel, dim3(grid), dim3(NTHR), LDS_BYTES, stream, p); }
#else
    p.ph_lo = 0; p.ph_hi = NPH; hipLaunchKernelGGL(fwd_kernel, dim3(grid), dim3(NTHR), LDS_BYTES, stream, p);
#endif
}
```

```cpp
#include <hip/hip_runtime.h>
#include <cstdio>
#include <cstdint>

#ifndef REP_MASK
#define REP_MASK 0u
#endif
#ifndef MK_SPLIT
#define MK_SPLIT 0
#endif

namespace pg8 {
#define PG8_LAS __attribute__((address_space(3)))
typedef _Float16 bf16_t;
typedef _Float16 bf16x8 __attribute__((ext_vector_type(8)));
typedef float f32x4 __attribute__((ext_vector_type(4)));
typedef unsigned u32x4 __attribute__((ext_vector_type(4)));
typedef unsigned u32x2 __attribute__((ext_vector_type(2)));
typedef _Float16 h16x2 __attribute__((ext_vector_type(2)));
typedef _Float16 h16x4 __attribute__((ext_vector_type(4)));
typedef _Float16 h16x8e __attribute__((ext_vector_type(8)));
constexpr int BM = 256, BK = 64, HALF = 128, HTB = HALF * BK * 2  , STAGE_BYTES = 8 * HTB, NXCD = 8, WGM = 8;

__host__ __device__ __forceinline__ int lds_byte(int r, int c) { const int st = (r >> 4) * 2 + (c >> 5), rr = r & 15, cc = c & 31, ob = rr * 64 + cc * 2; return st * 1024 + (ob ^ (((ob >> 9) & 1) << 5)); }
__host__ __device__ __forceinline__ void stage_rc(int b, int& R, int& C) { const int st = b / 1024, sb = b % 1024, swz = sb ^ (((sb >> 9) & 1) << 5); R = (st >> 1) * 16 + swz / 64; C = (st & 1) * 32 + (swz % 64) / 2; }
__host__ __device__ __forceinline__ int perm32(int rho) { const int n = rho >> 4, i = rho & 15; return 8 * (i >> 2) + 4 * n + (i & 3); }

struct Unit { int pm, pn; };
struct Gemm { const bf16_t* A; const bf16_t* Bt; int M, N, K, lda, npg, ldb; size_t kstepA, kstepB; };

struct StaticOrder {
    int nM, nN, nwg, G, c;
    __host__ __device__ void init(int M, int N, int G_, int c_) { nM = M / BM; nN = N / BM; nwg = nM * nN; G = G_; c = c_; }
    __host__ __device__ bool next(int i, Unit& u) const {
        const long L = (long)i * G + c; if (L >= nwg) return false;
        int wgid = (int)L; { const int q = nwg / NXCD, r = nwg % NXCD, xcd = wgid % NXCD, off = wgid / NXCD; wgid = (xcd < r ? xcd * (q + 1) : r * (q + 1) + (xcd - r) * q) + off; }
        const int nig = WGM * nN, gid = wgid / nig, fm = gid * WGM, gsz = (nM - fm) < WGM ? (nM - fm) : WGM;
        u.pm = fm + ((wgid % nig) % gsz); u.pn = (wgid % nig) / gsz; return true;
    }
    __device__ __forceinline__ void a_ready(const Unit&) const {}
    __device__ __forceinline__ void done(const Unit&) const {}
};

__device__ __forceinline__ unsigned pk_h2(float lo, float hi) { h16x2 v = {(_Float16)lo, (_Float16)hi}; return __builtin_bit_cast(unsigned, v); }

template <int ACT> struct EpiF16 {
    static constexpr bool PERM = true, WIDE = true, AFTER_DRAIN = false;
    bf16_t* O; int ldc; const float* rowsq; int kblk_rows; int npart;
    __device__ __forceinline__ void operator()(const f32x4 (&acc)[2][2][4][2], const Unit& u, int wr, int wc, int fr, int fq) const {
        const int row0 = u.pm * BM + wr * 64 + fr, col0 = u.pn * BM + wc * 64 + 8 * fq;
#pragma unroll
        for (int ai = 0; ai < 2; ++ai)
#pragma unroll
            for (int m = 0; m < 4; ++m) { const int row = row0 + ai * HALF + m * 16;
                bf16_t* rowp = kblk_rows ? O + ((size_t)(col0 >> 6) * kblk_rows + row) * 64 + (col0 & 63) : O + (size_t)row * ldc + col0;
                const size_t bjstep = 32;
                float rs = 1.0f; if (rowsq) { float ssq;
                    if (npart) { const f32x4* pp = (const f32x4*)(rowsq + (size_t)row * 32); f32x4 a4 = pp[0];
#pragma unroll
                        for (int q = 1; q < 8; ++q) a4 += pp[q];
                        ssq = (a4[0] + a4[1]) + (a4[2] + a4[3]); }
                    else ssq = rowsq[row];
                    rs = 1.0f / sqrtf(ssq * (1.0f / 2048.0f) + 1e-6f); if (ACT == 1) rs = rs * rs; }
#pragma unroll
                for (int bj = 0; bj < 2; ++bj) { f32x4 v0 = acc[ai][bj][m][0], v1 = acc[ai][bj][m][1];
                    if (ACT == 1) {
#pragma unroll
                        for (int j = 0; j < 4; ++j) { const float a = fmaxf(v0[j], 0.f), b = fmaxf(v1[j], 0.f); v0[j] = a * a; v1[j] = b * b; } }
                    v0 = v0 * rs; v1 = v1 * rs;
                    u32x4 w; w.x = pk_h2(v0[0], v0[1]); w.y = pk_h2(v0[2], v0[3]); w.z = pk_h2(v1[0], v1[1]); w.w = pk_h2(v1[2], v1[3]);
                    *(u32x4*)(rowp + bj * bjstep) = w; } }
    }
};
typedef int i32x4e __attribute__((ext_vector_type(4)));
template <class AccV> struct EpiQRelu2;
template <class AccV> struct EpiQRelu2 {
    static constexpr bool PERM = true, WIDE = true, AFTER_DRAIN = false;
    bf16_t* O; const float* rs; const float* cs; int kblk_rows;
    __device__ __forceinline__ void operator()(const AccV (&acc)[2][2][4][2], const Unit& u, int wr, int wc, int fr, int fq) const {
        const int row0 = u.pm * BM + wr * 64 + fr, col0 = u.pn * BM + wc * 64 + 8 * fq;
        f32x4 cv[2][2];
#pragma unroll
        for (int bj = 0; bj < 2; ++bj)
#pragma unroll
            for (int n = 0; n < 2; ++n) cv[bj][n] = *(const f32x4*)(cs + col0 + bj * 32 + 4 * n);
#pragma unroll
        for (int ai = 0; ai < 2; ++ai)
#pragma unroll
            for (int m = 0; m < 4; ++m) { const int row = row0 + ai * HALF + m * 16; const float r = rs[row];
                bf16_t* rowp = O + ((size_t)(col0 >> 6) * kblk_rows + row) * 64 + (col0 & 63); const size_t bjstep = 32;
#pragma unroll
                for (int bj = 0; bj < 2; ++bj) { f32x4 v0, v1;
#pragma unroll
                    for (int j = 0; j < 4; ++j) { const float a = fmaxf((float)acc[ai][bj][m][0][j] * (r * cv[bj][0][j]), 0.f), b = fmaxf((float)acc[ai][bj][m][1][j] * (r * cv[bj][1][j]), 0.f); v0[j] = a * a; v1[j] = b * b; }
                    u32x4 w; w.x = pk_h2(v0[0], v0[1]); w.y = pk_h2(v0[2], v0[3]); w.z = pk_h2(v1[0], v1[1]); w.w = pk_h2(v1[2], v1[3]);
                    *(u32x4*)(rowp + bj * bjstep) = w; } }
    }
};
struct EpiResid {
    static constexpr bool PERM = true, WIDE = true, AFTER_DRAIN = false;
    const bf16_t* res; bf16_t* out; float* out32; int ldc; const float* bias; const float* scale; float* rowsq;
    __device__ __forceinline__ void operator()(const f32x4 (&acc)[2][2][4][2], const Unit& u, int wr, int wc, int fr, int fq) const {
        const int row0 = u.pm * BM + wr * 64 + fr, col0 = u.pn * BM + wc * 64 + 8 * fq;
#pragma unroll
        for (int ai = 0; ai < 2; ++ai)
#pragma unroll
            for (int m = 0; m < 4; ++m) { const int row = row0 + ai * HALF + m * 16; const size_t off = (size_t)row * ldc + col0; float sq = 0.f;
#pragma unroll
                for (int bj = 0; bj < 2; ++bj) { const int cc = bj * 32; const h16x8e rh = *(const h16x8e*)(res + off + cc); float o[8];
#pragma unroll
                    for (int n = 0; n < 2; ++n) { const f32x4 bv = bias ? *(const f32x4*)(bias + col0 + cc + 4 * n) : (f32x4){0.f, 0.f, 0.f, 0.f}, sv = scale ? *(const f32x4*)(scale + col0 + cc + 4 * n) : (f32x4){1.f, 1.f, 1.f, 1.f};
#pragma unroll
                        for (int j = 0; j < 4; ++j) { o[4 * n + j] = (float)rh[4 * n + j] + (acc[ai][bj][m][n][j] + bv[j]) * sv[j]; sq += o[4 * n + j] * o[4 * n + j]; } }
                    if (out32) { *(f32x4*)(out32 + off + cc) = (f32x4){o[0], o[1], o[2], o[3]}; *(f32x4*)(out32 + off + cc + 4) = (f32x4){o[4], o[5], o[6], o[7]}; }
                    else { u32x4 w; w.x = pk_h2(o[0], o[1]); w.y = pk_h2(o[2], o[3]); w.z = pk_h2(o[4], o[5]); w.w = pk_h2(o[6], o[7]); *(u32x4*)(out + off + cc) = w; } }
                if (rowsq) { sq += __shfl_xor(sq, 16); sq += __shfl_xor(sq, 32); if (fq == 0) rowsq[(size_t)row * 32 + u.pn * 4 + wc] = sq; }
                asm volatile("" ::: "memory"); }
    }
};
struct EpiResidQ {
    static constexpr bool PERM = true, WIDE = true, AFTER_DRAIN = false;
    const bf16_t* res; bf16_t* out; float* out32; int ldc; const float* rs; const float* cs; const float* csum; float* rowsq;
    __device__ __forceinline__ void operator()(const i32x4e (&acc)[2][2][4][2], const Unit& u, int wr, int wc, int fr, int fq) const {
        const int row0 = u.pm * BM + wr * 64 + fr, col0 = u.pn * BM + wc * 64 + 8 * fq;
#pragma unroll
        for (int ai = 0; ai < 2; ++ai)
#pragma unroll
            for (int m = 0; m < 4; ++m) { const int row = row0 + ai * HALF + m * 16; const size_t off = (size_t)row * ldc + col0; float sq = 0.f; const float rsv = rs[row];
#pragma unroll
                for (int bj = 0; bj < 2; ++bj) { const int cc = bj * 32; const h16x8e rh = *(const h16x8e*)(res + off + cc); float o[8];
#pragma unroll
                    for (int n = 0; n < 2; ++n) { const f32x4 cv = *(const f32x4*)(cs + col0 + cc + 4 * n), zv = *(const f32x4*)(csum + col0 + cc + 4 * n);
#pragma unroll
                        for (int j = 0; j < 4; ++j) { o[4 * n + j] = (float)rh[4 * n + j] + (rsv * cv[j]) * ((float)acc[ai][bj][m][n][j] + 128.0f * zv[j]); sq += o[4 * n + j] * o[4 * n + j]; } }
                    if (out32) { *(f32x4*)(out32 + off + cc) = (f32x4){o[0], o[1], o[2], o[3]}; *(f32x4*)(out32 + off + cc + 4) = (f32x4){o[4], o[5], o[6], o[7]}; }
                    else { u32x4 w; w.x = pk_h2(o[0], o[1]); w.y = pk_h2(o[2], o[3]); w.z = pk_h2(o[4], o[5]); w.w = pk_h2(o[6], o[7]); *(u32x4*)(out + off + cc) = w; } }
                if (rowsq) { sq += __shfl_xor(sq, 16); sq += __shfl_xor(sq, 32); if (fq == 0) rowsq[(size_t)row * 32 + u.pn * 4 + wc] = sq; }
                asm volatile("" ::: "memory"); }
    }
};
struct EpiGates {
    static constexpr bool PERM = false, WIDE = false, AFTER_DRAIN = false;
    const bf16_t* XC; const float* ba; const float* bx; const float* lam; bf16_t* AF; bf16_t* BF;
    __device__ __forceinline__ void operator()(const f32x4 (&acc)[2][2][4][2], const Unit& u, int wr, int wc, int fr, int fq) const {
        const int row0 = u.pm * BM + wr * 64 + fr, ch0 = (u.pn >> 1) * 256 + (u.pn & 1) * 128 + wc * 32 + 4 * fq;
#pragma unroll
        for (int n = 0; n < 2; ++n) {
            const f32x4 bav = *(const f32x4*)(ba + ch0 + n * 16), bxv = *(const f32x4*)(bx + ch0 + n * 16), l = *(const f32x4*)(lam + ch0 + n * 16); f32x4 spv;
#pragma unroll
            for (int j = 0; j < 4; ++j) spv[j] = -8.0f * log1pf(__expf(-l[j]));
#pragma unroll
            for (int ai = 0; ai < 2; ++ai)
#pragma unroll
                for (int m = 0; m < 4; ++m) { const size_t off = (size_t)(row0 + ai * HALF + m * 16) * 2048 + ch0 + n * 16;
                    const h16x4 xh = *(const h16x4*)(XC + off); f32x4 av, bv;
#pragma unroll
                    for (int j = 0; j < 4; ++j) { const float r = __builtin_amdgcn_rcpf(1.0f + __expf(-(acc[ai][0][m][n][j] + bav[j]))), ig = __builtin_amdgcn_rcpf(1.0f + __expf(-(acc[ai][1][m][n][j] + bxv[j])));
                        const float la = r * spv[j]; av[j] = la;
                        const float y = 2.0f * la;
                        const float em = y * (1.0f + y * 0.5f * (1.0f + y * (1.0f / 3.0f) * (1.0f + y * 0.25f * (1.0f + y * 0.2f * (1.0f + y * (1.0f / 6.0f) * (1.0f + y * (1.0f / 7.0f)))))));
                        const float om = (y > -0.5f) ? -em : 1.0f - __expf(y);
                        bv[j] = (float)xh[j] * ig * __builtin_amdgcn_sqrtf(fmaxf(om, 0.f)); }
                    { u32x2 w; w.x = pk_h2(av[0], av[1]); w.y = pk_h2(av[2], av[3]); *(u32x2*)(AF + off) = w; w.x = pk_h2(bv[0], bv[1]); w.y = pk_h2(bv[2], bv[3]); *(u32x2*)(BF + off) = w; }
                    asm volatile("" ::: "memory"); }
        }
    }
};

template <class Epi, class Sched, bool ALIGN_EPI = false, bool SP2 = false>
__device__ __forceinline__ void gemm_phase(PG8_LAS unsigned char* lds, const Gemm g, const Sched& S, const Epi& E, const int tid) {
    const int wid = __builtin_amdgcn_readfirstlane(tid >> 6), lane = tid & 63, wr = wid >> 2, wc = wid & 3, fr = lane & 15, fq = lane >> 4;
    const int K = g.K, nt = K / BK;
    unsigned voffA[2], voffB[2];
#pragma unroll
    for (int i = 0; i < 2; ++i) { int R, C; stage_rc(tid * 16 + i * 8192, R, C); const int Rb = Epi::WIDE ? (64 * (R >> 5) + perm32(R & 31)) : (Epi::PERM ? ((R & ~31) + perm32(R & 31)) : R);
        voffA[i] = (unsigned)(R * g.lda + C) * 2u; voffB[i] = (unsigned)(Rb * g.ldb + C) * 2u; }
    const size_t kstepA = g.kstepA, kstepB = g.kstepB;
    const size_t hstepA = (size_t)HALF * g.lda * 2, hstepB = (size_t)(Epi::WIDE ? 32 : HALF) * g.ldb * 2;
#define PG8_ABASE(u) ((const char*)g.A + ((size_t)(u).pm * BM * g.lda + (size_t)((u).pn / g.npg) * K) * 2)
#define PG8_BBASE(u) ((const char*)g.Bt + (size_t)(u).pn * BM * g.ldb * 2)
    const unsigned ldsw = (unsigned)wid * 1024u;
    const int aoff = lds_byte(wr * 64 + fr, fq * 8), boff = lds_byte(wc * 32 + fr, fq * 8);
#define PG8_SA(b, h) (((b) * 2 + (h)) * HTB)
#define PG8_SB(b, h) ((4 + (b) * 2 + (h)) * HTB)
#define PG8_STAGE(bufoff, gbase, voff) do { _Pragma("unroll") for (int _i = 0; _i < 2; ++_i) \
        __builtin_amdgcn_global_load_lds((const unsigned*)((const char*)(gbase) + (voff)[_i]), (PG8_LAS unsigned*)(lds + (bufoff) + ldsw + _i * 8192), 16, 0, 0); } while (0)
#define PG8_LDA(dst, b, h) do { _Pragma("unroll") for (int m = 0; m < 4; ++m) _Pragma("unroll") for (int k = 0; k < 2; ++k) dst[m][k] = *(const PG8_LAS bf16x8*)(lds + PG8_SA(b, h) + aoff + m * 2048 + k * 1024); } while (0)
#define PG8_LDB(dst, b, h) do { _Pragma("unroll") for (int n = 0; n < 2; ++n) _Pragma("unroll") for (int k = 0; k < 2; ++k) dst[n][k] = *(const PG8_LAS bf16x8*)(lds + PG8_SB(b, h) + boff + n * 2048 + k * 1024); } while (0)
#define PG8_MMA(ai, bj, At, Bt) do { __builtin_amdgcn_s_setprio(1); _Pragma("unroll") for (int m = 0; m < 4; ++m) _Pragma("unroll") for (int n = 0; n < 2; ++n) _Pragma("unroll") for (int k = 0; k < 2; ++k) \
        acc[ai][bj][m][n] = __builtin_amdgcn_mfma_f32_16x16x32_f16(Bt[n][k], At[m][k], acc[ai][bj][m][n], 0, 0, 0); __builtin_amdgcn_s_setprio(0); } while (0)
#define PG8_WAIT_V(n) asm volatile("s_waitcnt vmcnt(" #n ")" ::: "memory")
#define PG8_WAIT_L(n) asm volatile("s_waitcnt lgkmcnt(" #n ")" ::: "memory")
#define PG8_BAR __builtin_amdgcn_s_barrier()
#define PG8_SCHED __builtin_amdgcn_sched_barrier(0)
    Unit cur, nxt; int ui = 0;
    if (!S.next(0, cur)) return;
    f32x4 acc[2][2][4][2];
#pragma unroll
    for (int a = 0; a < 2; ++a)
#pragma unroll
        for (int b = 0; b < 2; ++b)
#pragma unroll
            for (int m = 0; m < 4; ++m)
#pragma unroll
                for (int n = 0; n < 2; ++n) acc[a][b][m][n] = (f32x4){0.f, 0.f, 0.f, 0.f};
    bf16x8 At[4][2], B0[2][2], B1[2][2];
    const char* cA = PG8_ABASE(cur); const char* cB = PG8_BBASE(cur);
    S.a_ready(cur);
    if constexpr (SP2) {
        PG8_STAGE(PG8_SB(0, 0), cB, voffB); PG8_STAGE(PG8_SB(0, 1), cB + hstepB, voffB); PG8_STAGE(PG8_SA(0, 0), cA, voffA); PG8_STAGE(PG8_SA(0, 1), cA + hstepA, voffA);
        if (wr == 1) PG8_BAR;
        PG8_WAIT_V(2); PG8_BAR;
        PG8_STAGE(PG8_SB(1, 0), cB + kstepB, voffB); PG8_STAGE(PG8_SA(1, 0), cA + kstepA, voffA); PG8_STAGE(PG8_SB(1, 1), cB + hstepB + kstepB, voffB);
        PG8_WAIT_V(6); PG8_BAR;
    } else {
        PG8_STAGE(PG8_SB(0, 0), cB, voffB); PG8_STAGE(PG8_SA(0, 0), cA, voffA); PG8_STAGE(PG8_SB(0, 1), cB + hstepB, voffB); PG8_STAGE(PG8_SA(0, 1), cA + hstepA, voffA);
        if (wr == 1) PG8_BAR;
        PG8_WAIT_V(4); PG8_BAR;
        PG8_STAGE(PG8_SB(1, 0), cB + kstepB, voffB); PG8_STAGE(PG8_SA(1, 0), cA + kstepA, voffA); PG8_STAGE(PG8_SB(1, 1), cB + hstepB + kstepB, voffB);
        PG8_WAIT_V(6); PG8_BAR;
    }
    for (;;) {
        const bool has_next = S.next(ui + 1, nxt);
        const char* nA = has_next ? PG8_ABASE(nxt) : cA; const char* nB = has_next ? PG8_BBASE(nxt) : cB;
        for (int t = 0; t < nt; t += 2) {
            const bool last = (t == nt - 2);
            const char* a1 = cA + (size_t)(t + 1) * kstepA;
            const char* a2 = last ? nA : cA + (size_t)(t + 2) * kstepA; const char* b2 = last ? nB : cB + (size_t)(t + 2) * kstepB;
            const char* a3 = a2 + kstepA; const char* b3 = b2 + kstepB;
            if (last && has_next) S.a_ready(nxt);
            if constexpr (SP2) {
            PG8_LDB(B0, 0, 0); PG8_LDB(B1, 0, 1); PG8_SCHED; PG8_LDA(At, 0, 0); PG8_STAGE(PG8_SA(1, 1), a1 + hstepA, voffA);
            PG8_WAIT_V(8); PG8_WAIT_L(0); PG8_BAR; PG8_MMA(0, 0, At, B0); PG8_MMA(0, 1, At, B1); PG8_BAR; PG8_SCHED;
            PG8_LDA(At, 0, 1); PG8_STAGE(PG8_SB(0, 0), b2, voffB); PG8_STAGE(PG8_SB(0, 1), b2 + hstepB, voffB); PG8_STAGE(PG8_SA(0, 0), a2, voffA);
            PG8_WAIT_V(8); PG8_WAIT_L(0); PG8_BAR; PG8_MMA(1, 0, At, B0); PG8_MMA(1, 1, At, B1); PG8_BAR; PG8_SCHED;
            PG8_LDB(B0, 1, 0); PG8_LDB(B1, 1, 1); PG8_SCHED; PG8_LDA(At, 1, 0); PG8_STAGE(PG8_SA(0, 1), a2 + hstepA, voffA);
            PG8_WAIT_V(8); PG8_WAIT_L(0); PG8_BAR; PG8_MMA(0, 0, At, B0); PG8_MMA(0, 1, At, B1); PG8_BAR; PG8_SCHED;
            PG8_LDA(At, 1, 1); PG8_STAGE(PG8_SB(1, 0), b3, voffB); PG8_STAGE(PG8_SB(1, 1), b3 + hstepB, voffB); PG8_STAGE(PG8_SA(1, 0), a3, voffA);
            PG8_WAIT_V(8); PG8_WAIT_L(0); PG8_BAR; PG8_MMA(1, 0, At, B0); PG8_MMA(1, 1, At, B1); PG8_BAR; PG8_SCHED;
            } else {
            PG8_LDB(B0, 0, 0); PG8_SCHED; PG8_LDA(At, 0, 0); PG8_STAGE(PG8_SA(1, 1), a1 + hstepA, voffA);
            PG8_WAIT_L(8); PG8_BAR; PG8_WAIT_L(0); PG8_MMA(0, 0, At, B0); PG8_BAR; PG8_SCHED;
            PG8_LDB(B1, 0, 1); PG8_STAGE(PG8_SB(0, 0), b2, voffB);
            PG8_BAR; PG8_WAIT_L(0); PG8_MMA(0, 1, At, B1); PG8_BAR;
            PG8_LDA(At, 0, 1); PG8_STAGE(PG8_SA(0, 0), a2, voffA);
            PG8_BAR; PG8_WAIT_L(0); PG8_MMA(1, 0, At, B0); PG8_BAR; PG8_SCHED;
            PG8_STAGE(PG8_SB(0, 1), b2 + hstepB, voffB);
            PG8_WAIT_V(6); PG8_BAR; PG8_MMA(1, 1, At, B1); PG8_BAR;
            PG8_LDB(B0, 1, 0); PG8_SCHED; PG8_LDA(At, 1, 0); PG8_STAGE(PG8_SA(0, 1), a2 + hstepA, voffA);
            PG8_WAIT_L(8); PG8_BAR; PG8_WAIT_L(0); PG8_MMA(0, 0, At, B0); PG8_BAR; PG8_SCHED;
            PG8_LDB(B1, 1, 1); PG8_STAGE(PG8_SB(1, 0), b3, voffB);
            PG8_BAR; PG8_WAIT_L(0); PG8_MMA(0, 1, At, B1); PG8_BAR;
            PG8_LDA(At, 1, 1); PG8_STAGE(PG8_SA(1, 0), a3, voffA);
            PG8_BAR; PG8_WAIT_L(0); PG8_MMA(1, 0, At, B0); PG8_BAR; PG8_SCHED;
            PG8_STAGE(PG8_SB(1, 1), b3 + hstepB, voffB);
            PG8_WAIT_V(6); PG8_BAR; PG8_MMA(1, 1, At, B1); PG8_BAR;
            }
        }
        if constexpr (ALIGN_EPI) { if (wr == 0) PG8_BAR; }
        if constexpr (!Epi::AFTER_DRAIN) { E(acc, cur, wr, wc, fr, fq); S.done(cur); }
        if (!has_next) break;
#pragma unroll
        for (int a = 0; a < 2; ++a)
#pragma unroll
            for (int b = 0; b < 2; ++b)
#pragma unroll
                for (int m = 0; m < 4; ++m)
#pragma unroll
                    for (int n = 0; n < 2; ++n) acc[a][b][m][n] = (f32x4){0.f, 0.f, 0.f, 0.f};
        cur = nxt; cA = nA; cB = nB; ++ui;
        if constexpr (ALIGN_EPI) { if (wr == 1) PG8_BAR; }
    }
    PG8_WAIT_V(0);
    if constexpr (!ALIGN_EPI) { if (wr == 0) PG8_BAR; }
    PG8_BAR;
    if constexpr (Epi::AFTER_DRAIN) { E.fused(acc, cur, wr, wc, fr, fq, lds, wid, lane); S.done(cur); }
#undef PG8_ABASE
#undef PG8_BBASE
#undef PG8_SA
#undef PG8_SB
#undef PG8_STAGE
#undef PG8_LDA
#undef PG8_LDB
#undef PG8_MMA
#undef PG8_WAIT_V
#undef PG8_WAIT_L
#undef PG8_BAR
#undef PG8_SCHED
}
typedef int i32x4 __attribute__((ext_vector_type(4)));
template <class Epi, class Sched, bool ALIGN_EPI = false, bool SP2 = false>
__device__ __forceinline__ void gemm_phase_i8(PG8_LAS unsigned char* lds, const Gemm g, const Sched& S, const Epi& E, const int tid) {
    const int wid = __builtin_amdgcn_readfirstlane(tid >> 6), lane = tid & 63, wr = wid >> 2, wc = wid & 3, fr = lane & 15, fq = lane >> 4;
    const int K = g.K, nt = K / BK;
    unsigned voffA[2], voffB[2];
#pragma unroll
    for (int i = 0; i < 2; ++i) { int R, C; stage_rc(tid * 16 + i * 8192, R, C); const int Rb = Epi::WIDE ? (64 * (R >> 5) + perm32(R & 31)) : (Epi::PERM ? ((R & ~31) + perm32(R & 31)) : R);
        voffA[i] = (unsigned)(R * g.lda + C) * 2u; voffB[i] = (unsigned)(Rb * g.ldb + C) * 2u; }
    const size_t kstepA = g.kstepA, kstepB = g.kstepB;
    const size_t hstepA = (size_t)HALF * g.lda * 2, hstepB = (size_t)(Epi::WIDE ? 32 : HALF) * g.ldb * 2;
#define PG8_ABASE(u) ((const char*)g.A + ((size_t)(u).pm * BM * g.lda + (size_t)((u).pn / g.npg) * K) * 2)
#define PG8_BBASE(u) ((const char*)g.Bt + (size_t)(u).pn * BM * g.ldb * 2)
    const unsigned ldsw = (unsigned)wid * 1024u;
    const int aoff = lds_byte(wr * 64 + fr, fq * 8), boff = lds_byte(wc * 32 + fr, fq * 8);
#define PG8_SA(b, h) (((b) * 2 + (h)) * HTB)
#define PG8_SB(b, h) ((4 + (b) * 2 + (h)) * HTB)
#define PG8_STAGE(bufoff, gbase, voff) do { _Pragma("unroll") for (int _i = 0; _i < 2; ++_i) \
        __builtin_amdgcn_global_load_lds((const unsigned*)((const char*)(gbase) + (voff)[_i]), (PG8_LAS unsigned*)(lds + (bufoff) + ldsw + _i * 8192), 16, 0, 0); } while (0)
#define PG8_LDA(dst, b, h) do { _Pragma("unroll") for (int m = 0; m < 4; ++m) _Pragma("unroll") for (int k = 0; k < 2; ++k) dst[m][k] = *(const PG8_LAS bf16x8*)(lds + PG8_SA(b, h) + aoff + m * 2048 + k * 1024); } while (0)
#define PG8_LDB(dst, b, h) do { _Pragma("unroll") for (int n = 0; n < 2; ++n) _Pragma("unroll") for (int k = 0; k < 2; ++k) dst[n][k] = *(const PG8_LAS bf16x8*)(lds + PG8_SB(b, h) + boff + n * 2048 + k * 1024); } while (0)
#define PG8_MMA(ai, bj, At, Bt) do { __builtin_amdgcn_s_setprio(1); _Pragma("unroll") for (int m = 0; m < 4; ++m) _Pragma("unroll") for (int n = 0; n < 2; ++n) _Pragma("unroll") for (int k = 0; k < 2; ++k) \
        acc[ai][bj][m][n] = __builtin_amdgcn_mfma_i32_16x16x64_i8(__builtin_bit_cast(i32x4, Bt[n][k]), __builtin_bit_cast(i32x4, At[m][k]), acc[ai][bj][m][n], 0, 0, 0); __builtin_amdgcn_s_setprio(0); } while (0)
#define PG8_WAIT_V(n) asm volatile("s_waitcnt vmcnt(" #n ")" ::: "memory")
#define PG8_WAIT_L(n) asm volatile("s_waitcnt lgkmcnt(" #n ")" ::: "memory")
#define PG8_BAR __builtin_amdgcn_s_barrier()
#define PG8_SCHED __builtin_amdgcn_sched_barrier(0)
    Unit cur, nxt; int ui = 0;
    if (!S.next(0, cur)) return;
    i32x4 acc[2][2][4][2];
#pragma unroll
    for (int a = 0; a < 2; ++a)
#pragma unroll
        for (int b = 0; b < 2; ++b)
#pragma unroll
            for (int m = 0; m < 4; ++m)
#pragma unroll
                for (int n = 0; n < 2; ++n) acc[a][b][m][n] = (i32x4){0, 0, 0, 0};
    bf16x8 At[4][2], B0[2][2], B1[2][2];
    const char* cA = PG8_ABASE(cur); const char* cB = PG8_BBASE(cur);
    S.a_ready(cur);
    if constexpr (SP2) {
        PG8_STAGE(PG8_SB(0, 0), cB, voffB); PG8_STAGE(PG8_SB(0, 1), cB + hstepB, voffB); PG8_STAGE(PG8_SA(0, 0), cA, voffA); PG8_STAGE(PG8_SA(0, 1), cA + hstepA, voffA);
        if (wr == 1) PG8_BAR;
        PG8_WAIT_V(2); PG8_BAR;
        PG8_STAGE(PG8_SB(1, 0), cB + kstepB, voffB); PG8_STAGE(PG8_SA(1, 0), cA + kstepA, voffA); PG8_STAGE(PG8_SB(1, 1), cB + hstepB + kstepB, voffB);
        PG8_WAIT_V(6); PG8_BAR;
    } else {
        PG8_STAGE(PG8_SB(0, 0), cB, voffB); PG8_STAGE(PG8_SA(0, 0), cA, voffA); PG8_STAGE(PG8_SB(0, 1), cB + hstepB, voffB); PG8_STAGE(PG8_SA(0, 1), cA + hstepA, voffA);
        if (wr == 1) PG8_BAR;
        PG8_WAIT_V(4); PG8_BAR;
        PG8_STAGE(PG8_SB(1, 0), cB + kstepB, voffB); PG8_STAGE(PG8_SA(1, 0), cA + kstepA, voffA); PG8_STAGE(PG8_SB(1, 1), cB + hstepB + kstepB, voffB);
        PG8_WAIT_V(6); PG8_BAR;
    }
    for (;;) {
        const bool has_next = S.next(ui + 1, nxt);
        const char* nA = has_next ? PG8_ABASE(nxt) : cA; const char* nB = has_next ? PG8_BBASE(nxt) : cB;
        for (int t = 0; t < nt; t += 2) {
            const bool last = (t == nt - 2);
            const char* a1 = cA + (size_t)(t + 1) * kstepA;
            const char* a2 = last ? nA : cA + (size_t)(t + 2) * kstepA; const char* b2 = last ? nB : cB + (size_t)(t + 2) * kstepB;
            const char* a3 = a2 + kstepA; const char* b3 = b2 + kstepB;
            if (last && has_next) S.a_ready(nxt);
            if constexpr (SP2) {
            PG8_LDB(B0, 0, 0); PG8_LDB(B1, 0, 1); PG8_SCHED; PG8_LDA(At, 0, 0); PG8_STAGE(PG8_SA(1, 1), a1 + hstepA, voffA);
            PG8_WAIT_V(8); PG8_WAIT_L(0); PG8_BAR; PG8_MMA(0, 0, At, B0); PG8_MMA(0, 1, At, B1); PG8_BAR; PG8_SCHED;
            PG8_LDA(At, 0, 1); PG8_STAGE(PG8_SB(0, 0), b2, voffB); PG8_STAGE(PG8_SB(0, 1), b2 + hstepB, voffB); PG8_STAGE(PG8_SA(0, 0), a2, voffA);
            PG8_WAIT_V(8); PG8_WAIT_L(0); PG8_BAR; PG8_MMA(1, 0, At, B0); PG8_MMA(1, 1, At, B1); PG8_BAR; PG8_SCHED;
            PG8_LDB(B0, 1, 0); PG8_LDB(B1, 1, 1); PG8_SCHED; PG8_LDA(At, 1, 0); PG8_STAGE(PG8_SA(0, 1), a2 + hstepA, voffA);
            PG8_WAIT_V(8); PG8_WAIT_L(0); PG8_BAR; PG8_MMA(0, 0, At, B0); PG8_MMA(0, 1, At, B1); PG8_BAR; PG8_SCHED;
            PG8_LDA(At, 1, 1); PG8_STAGE(PG8_SB(1, 0), b3, voffB); PG8_STAGE(PG8_SB(1, 1), b3 + hstepB, voffB); PG8_STAGE(PG8_SA(1, 0), a3, voffA);
            PG8_WAIT_V(8); PG8_WAIT_L(0); PG8_BAR; PG8_MMA(1, 0, At, B0); PG8_MMA(1, 1, At, B1); PG8_BAR; PG8_SCHED;
            } else {
            PG8_LDB(B0, 0, 0); PG8_SCHED; PG8_LDA(At, 0, 0); PG8_STAGE(PG8_SA(1, 1), a1 + hstepA, voffA);
            PG8_WAIT_L(8); PG8_BAR; PG8_WAIT_L(0); PG8_MMA(0, 0, At, B0); PG8_BAR; PG8_SCHED;
            PG8_LDB(B1, 0, 1); PG8_STAGE(PG8_SB(0, 0), b2, voffB);
            PG8_BAR; PG8_WAIT_L(0); PG8_MMA(0, 1, At, B1); PG8_BAR;
            PG8_LDA(At, 0, 1); PG8_STAGE(PG8_SA(0, 0), a2, voffA);
            PG8_BAR; PG8_WAIT_L(0); PG8_MMA(1, 0, At, B0); PG8_BAR; PG8_SCHED;
            PG8_STAGE(PG8_SB(0, 1), b2 + hstepB, voffB);
            PG8_WAIT_V(6); PG8_BAR; PG8_MMA(1, 1, At, B1); PG8_BAR;
            PG8_LDB(B0, 1, 0); PG8_SCHED; PG8_LDA(At, 1, 0); PG8_STAGE(PG8_SA(0, 1), a2 + hstepA, voffA);
            PG8_WAIT_L(8); PG8_BAR; PG8_WAIT_L(0); PG8_MMA(0, 0, At, B0); PG8_BAR; PG8_SCHED;
            PG8_LDB(B1, 1, 1); PG8_STAGE(PG8_SB(1, 0), b3, voffB);
            PG8_BAR; PG8_WAIT_L(0); PG8_MMA(0, 1, At, B1); PG8_BAR;
            PG8_LDA(At, 1, 1); PG8_STAGE(PG8_SA(1, 0), a3, voffA);
            PG8_BAR; PG8_WAIT_L(0); PG8_MMA(1, 0, At, B0); PG8_BAR; PG8_SCHED;
            PG8_STAGE(PG8_SB(1, 1), b3 + hstepB, voffB);
            PG8_WAIT_V(6); PG8_BAR; PG8_MMA(1, 1, At, B1); PG8_BAR;
            }
        }
        if constexpr (ALIGN_EPI) { if (wr == 0) PG8_BAR; }
        if constexpr (!Epi::AFTER_DRAIN) { E(acc, cur, wr, wc, fr, fq); S.done(cur); }
        if (!has_next) break;
#pragma unroll
        for (int a = 0; a < 2; ++a)
#pragma unroll
            for (int b = 0; b < 2; ++b)
#pragma unroll
                for (int m = 0; m < 4; ++m)
#pragma unroll
                    for (int n = 0; n < 2; ++n) acc[a][b][m][n] = (i32x4){0, 0, 0, 0};
        cur = nxt; cA = nA; cB = nB; ++ui;
        if constexpr (ALIGN_EPI) { if (wr == 1) PG8_BAR; }
    }
    PG8_WAIT_V(0);
    if constexpr (!ALIGN_EPI) { if (wr == 0) PG8_BAR; }
    PG8_BAR;
    if constexpr (Epi::AFTER_DRAIN) { E.fused(acc, cur, wr, wc, fr, fq, lds, wid, lane); S.done(cur); }
#undef PG8_ABASE
#undef PG8_BBASE
#undef PG8_SA
#undef PG8_SB
#undef PG8_STAGE
#undef PG8_LDA
#undef PG8_LDB
#undef PG8_MMA
#undef PG8_WAIT_V
#undef PG8_WAIT_L
#undef PG8_BAR
#undef PG8_SCHED
}
}

constexpr int T = 8192, D = 2048, FF = 8192, DEPTH = 4;
constexpr int NH = 16, HD = 128, NKV = 4, TOPK = 256;
constexpr int A_IN = 5264, A_INP = 5376;
constexpr int C_Q = 0, C_K = 2048, C_V = 2560, C_IQ = 3072, C_IK = 5120, C_IW = 5248;
constexpr float EPS = 1e-6f;
constexpr int NWAVES = 8, NTHR = NWAVES * 64;

constexpr size_t MiB = 1u << 20;
constexpr size_t WS_CTL = 0, CTL_ZERO_BYTES = 1 * MiB;
constexpr size_t WS_COS128 = 1 * MiB, WS_SIN128 = 3 * MiB, WS_COS64 = 5 * MiB, WS_SIN64 = 6 * MiB;
constexpr size_t WS_IW = 7 * MiB;
constexpr size_t WS_AGGA = 8 * MiB, WS_AGGB = 9 * MiB;
constexpr size_t WS_WINA = 10 * MiB;
constexpr size_t WS_WOUTA = 52 * MiB;
constexpr size_t WS_WINR = 68 * MiB;
constexpr size_t WS_WGR = 84 * MiB;
constexpr size_t WS_WOUTR = 86 * MiB;
constexpr size_t WS_WPOOL = 94 * MiB;
constexpr size_t WS_WUP = 96 * MiB;
constexpr size_t WS_WDOWN = 224 * MiB;
constexpr size_t WS_BA = 352 * MiB;
constexpr size_t BA_SC = 0;
constexpr int SC_LD = T + 64;
constexpr size_t BA_O16 = 0;
constexpr size_t BA_U = 0;
constexpr size_t BA_AF = 0, BA_BF = 64 * MiB;
constexpr size_t BA_H16 = 128 * MiB;
constexpr size_t BA_PROJ = 160 * MiB;
constexpr size_t BA_XC = 224 * MiB;
constexpr size_t WS_QH = 616 * MiB, WS_KH = 632 * MiB, WS_VH = 636 * MiB, WS_IK = 640 * MiB, WS_SEL = 642 * MiB, WS_IQ = 650 * MiB, WS_PARTA = 686 * MiB, WS_PARTB = 687 * MiB, WS_BLKMAXD = 688 * MiB, WS_X16 = 692 * MiB, WS_END = 724 * MiB;
constexpr int CW_BAR = 4096;
constexpr size_t WS_BLKMAX = 682 * MiB;
constexpr size_t WS_RS = 7 * MiB + 512 * 1024, WS_CS = WS_RS + 64 * 1024;
constexpr size_t WS_RS2 = WS_RS + 128 * 1024, WS_CS2 = WS_RS + 192 * 1024, WS_CSUM = WS_RS + 208 * 1024;
constexpr size_t BA_U8 = 192 * MiB, BA_W8D = 176 * MiB;
constexpr size_t BA_A8 = 160 * MiB, BA_W8 = 176 * MiB;
constexpr size_t WS_ROWSQ = 256 * 1024;

constexpr int RING_BYTES = 131072;
constexpr int LDSCTL_OFF = RING_BYTES, MISC_OFF = LDSCTL_OFF + 320;
constexpr int LDS_BYTES = 155648;

#define GAS __attribute__((address_space(1)))
#define LAS __attribute__((address_space(3)))
typedef _Float16 h16;
typedef _Float16 h16x2 __attribute__((ext_vector_type(2)));
typedef _Float16 h16x4 __attribute__((ext_vector_type(4)));
typedef _Float16 h16x8 __attribute__((ext_vector_type(8)));
typedef unsigned v4u __attribute__((ext_vector_type(4)));
typedef unsigned v2u __attribute__((ext_vector_type(2)));
typedef float f32x4 __attribute__((ext_vector_type(4)));
#define LDS_WAIT() asm volatile("s_waitcnt lgkmcnt(0)" ::: "memory")
#define VM_WAIT() asm volatile("s_waitcnt vmcnt(0)" ::: "memory")
__device__ __forceinline__ unsigned pkh(float lo, float hi) { h16x2 v = {(h16)lo, (h16)hi}; return __builtin_bit_cast(unsigned, v); }
__device__ __forceinline__ float wave_sum(float v) {
#pragma unroll
    for (int o = 1; o < 64; o <<= 1) v += __shfl_xor(v, o);
    return v;
}
__device__ __forceinline__ float wave_max(float v) {
#pragma unroll
    for (int o = 1; o < 64; o <<= 1) v = fmaxf(v, __shfl_xor(v, o));
    return v;
}

#define XB_TMO      128
#define XB_XCNT(j)  (256  + 64 * (j))
#define XB_XSUB(j)  (1280 + 64 * (j))
#define XB_XGEN(j)  (2304 + 64 * (j))
#define XB_TOP      3328
#define XB_TOPGEN   3392
#define XCD_BAR_WORDS 3456
#define XB_SPIN_CAP (1u << 18)

__device__ __forceinline__ unsigned xb_ld(unsigned* p)              { return __hip_atomic_load(p, __ATOMIC_RELAXED, __HIP_MEMORY_SCOPE_AGENT); }
__device__ __forceinline__ unsigned xb_add(unsigned* p, unsigned v) { return __hip_atomic_fetch_add(p, v, __ATOMIC_RELAXED, __HIP_MEMORY_SCOPE_AGENT); }
__device__ __forceinline__ unsigned xb_xcc_id() { return (unsigned)__builtin_amdgcn_s_getreg((3 << 11) | 20) & 0xFu; }
#define XB_SPIN(cond, bar) do { unsigned _sp = 0; while (cond) { __builtin_amdgcn_s_sleep(1); \
    if ((++_sp & 255u) == 0u) { if (xb_ld(&(bar)[XB_TMO])) break; if (_sp > XB_SPIN_CAP) { atomicAdd(&(bar)[XB_TMO], 1u); break; } } } } while (0)

struct XcdBarrier { unsigned* bar; unsigned x; volatile LAS unsigned* st; };

__device__ __forceinline__ XcdBarrier xcd_barrier_post(unsigned* bar, volatile LAS unsigned* st) {
    XcdBarrier b; b.bar = bar; b.x = xb_xcc_id(); b.st = st;
    if (threadIdx.x == 0) (void)xb_add(&bar[XB_XCNT(b.x)], 1u);
    return b;
}
__device__ __forceinline__ void xcd_barrier_complete(unsigned* bar, unsigned x, unsigned& nloc, unsigned& nx) {
    const unsigned G = gridDim.x * gridDim.y * gridDim.z;
    unsigned sum, cnt, mine, sp = 0u;
    for (;;) {
        sum = 0u; cnt = 0u; mine = 0u;
#pragma unroll
        for (unsigned j = 0; j < 16; ++j) { const unsigned c = xb_ld(&bar[XB_XCNT(j)]); sum += c; cnt += (c > 0u) ? 1u : 0u; mine = (j == x) ? c : mine; }
        if (sum == G) break;
        __builtin_amdgcn_s_sleep(1);
        if ((++sp & 255u) == 0u) { if (xb_ld(&bar[XB_TMO])) break; if (sp > XB_SPIN_CAP) { atomicAdd(&bar[XB_TMO], 1u); break; } }
    }
    nloc = mine > 0u ? mine : 1u; nx = cnt > 0u ? cnt : 1u;
}
__device__ __forceinline__ void xcd_barrier(const XcdBarrier& b) {
    asm volatile("s_waitcnt vmcnt(0)" ::: "memory");
    __syncthreads();
    if (threadIdx.x == 0) {
        unsigned* bar = b.bar;
        __builtin_amdgcn_s_waitcnt(0);
        unsigned nloc = b.st[0], nx = b.st[1];
        if (nloc == 0u) { xcd_barrier_complete(bar, b.x, nloc, nx); b.st[0] = nloc; b.st[1] = nx; }
        const unsigned old = xb_add(&bar[XB_XSUB(b.x)], 1u);
        const unsigned gen = old / nloc;
        if (old + 1u == (gen + 1u) * nloc) {
            __builtin_amdgcn_fence(__ATOMIC_RELEASE, "agent");
            asm volatile("s_waitcnt vmcnt(0)" ::: "memory");
            const unsigned og = xb_add(&bar[XB_TOP], 1u);
            const unsigned tg = og / nx;
            if (og + 1u == (tg + 1u) * nx) xb_add(&bar[XB_TOPGEN], 1u);
            else XB_SPIN(xb_ld(&bar[XB_TOPGEN]) == tg, bar);
            __builtin_amdgcn_fence(__ATOMIC_ACQUIRE, "agent");
            xb_add(&bar[XB_XGEN(b.x)], 1u);
            asm volatile("s_waitcnt vmcnt(0)" ::: "memory");
        } else {
            XB_SPIN(xb_ld(&bar[XB_XGEN(b.x)]) == gen, bar);
            __builtin_amdgcn_fence(__ATOMIC_ACQUIRE, "agent");
            asm volatile("s_waitcnt vmcnt(0)" ::: "memory");
        }
    }
    __syncthreads();
}

__device__ __forceinline__ void tr_item(const float* src, int ldw, int nvalid, h16* dst, int ldd, LAS float* scr, int lane, unsigned* colmax = nullptr, const float* gk = nullptr) {
    const int nn = lane & 31; float v[32];
#pragma unroll
    for (int i = 0; i < 32; ++i) { const int kk = 2 * i + (lane >> 5); v[i] = (nn < nvalid) ? src[(size_t)kk * ldw + nn] * (gk ? gk[kk] : 1.0f) : 0.f; }
    __builtin_amdgcn_sched_barrier(0);
#pragma unroll
    for (int i = 0; i < 32; ++i) { const int kk = 2 * i + (lane >> 5); scr[kk * 33 + nn] = v[i]; }
    LDS_WAIT();
    const int c = lane & 7;
#pragma unroll
    for (int j = 0; j < 4; ++j) { const int n = (lane >> 3) + 8 * j; const LAS float* s = scr + (8 * c) * 33 + n;
        v4u o; o.x = pkh(s[0 * 33], s[1 * 33]); o.y = pkh(s[2 * 33], s[3 * 33]); o.z = pkh(s[4 * 33], s[5 * 33]); o.w = pkh(s[6 * 33], s[7 * 33]);
        *(v4u*)(dst + (size_t)n * ldd + 8 * c) = o;
        if (colmax) {
            float mx = fmaxf(fmaxf(fmaxf(fabsf(s[0 * 33]), fabsf(s[1 * 33])), fmaxf(fabsf(s[2 * 33]), fabsf(s[3 * 33]))), fmaxf(fmaxf(fabsf(s[4 * 33]), fabsf(s[5 * 33])), fmaxf(fabsf(s[6 * 33]), fabsf(s[7 * 33]))));
            mx = fmaxf(mx, __shfl_xor(mx, 1)); mx = fmaxf(mx, __shfl_xor(mx, 2)); mx = fmaxf(mx, __shfl_xor(mx, 4));
            if (c == 0) colmax[n] = __float_as_uint(mx); } }
    LDS_WAIT();
}

struct Ptrs {
    const float* x; const int* pos;
    const float *attn_norm, *attn_w_in, *attn_qn, *attn_kn, *attn_w_out;
    const float *rnn_norm, *rnn_w_in, *conv_w, *conv_b, *ga_w, *ga_b, *gx_w, *gx_b, *lam, *rnn_w_out;
    const float *pool_norm, *pool_w, *pool_b, *pool_scale;
    const float *mlp_norm, *mlp_w_up, *mlp_w_down;
    float* out; unsigned char* ws;
    int ph_lo, ph_hi;
};

#define CAS __attribute__((address_space(4)))
__device__ __forceinline__ const CAS Ptrs* kargs() { const CAS Ptrs* p = (const CAS Ptrs*)__builtin_amdgcn_kernarg_segment_ptr(); asm volatile("" : "+s"(p)); return p; }
__device__ __forceinline__ void p0_prologue(const CAS Ptrs* PP, LAS unsigned char* lds, int gw, int NGW, int wave, int lane, int gtid, int NGT) {
    LAS float* scr = (LAS float*)(lds + wave * 16384);
    unsigned char* ws = PP->ws;
    constexpr int I_WINA = 32 * 165, I_WOUTA = 32 * 64, I_WINR = 32 * 128, I_G = 4 * 8, I_WOUTR = 32 * 64, I_POOL = 8 * 16, I_UP = 32 * 256, I_DN = 128 * 64, I_Z = 384;
    constexpr int NITEMS = 2 * I_WINA + 2 * I_WOUTA + I_WINR + 16 * I_G + I_WOUTR + 4 * I_POOL + 4 * I_UP + 4 * I_DN + 2 * I_Z;
    for (int it = gw; it < NITEMS; it += NGW) {
        int r = it;
        if (r < 2 * I_WINA) { const int j = r / I_WINA; r -= j * I_WINA; const int kb = r / 165, nb = r % 165, n0 = 32 * nb; const int nv = (A_IN - n0) < 32 ? (A_IN - n0) : 32;
            tr_item(PP->attn_w_in + (size_t)j * D * A_IN + (size_t)(64 * kb) * A_IN + n0, A_IN, nv, (h16*)(ws + WS_WINA) + (size_t)j * A_INP * D + (size_t)n0 * D + 64 * kb, D, scr, lane, nullptr, PP->attn_norm + (size_t)j * D + 64 * kb); continue; }
        r -= 2 * I_WINA;
        if (r < 2 * I_WOUTA) { const int j = r / I_WOUTA; r -= j * I_WOUTA; const int kb = r / 64, nb = r % 64;
            tr_item(PP->attn_w_out + (size_t)j * D * D + (size_t)(64 * kb) * D + 32 * nb, D, 32, (h16*)(ws + WS_WOUTA) + (size_t)j * D * D + (size_t)(32 * nb) * D + 64 * kb, D, scr, lane); continue; }
        r -= 2 * I_WOUTA;
        if (r < I_WINR) { const int kb = r / 128, nb = r % 128;
            tr_item(PP->rnn_w_in + (size_t)(64 * kb) * 4096 + 32 * nb, 4096, 32, (h16*)(ws + WS_WINR) + (size_t)(32 * nb) * D + 64 * kb, D, scr, lane, nullptr, PP->rnn_norm + 64 * kb); continue; }
        r -= I_WINR;
        if (r < 16 * I_G) { const int mi = r / I_G; r -= mi * I_G; const int which = mi >> 3, blk = mi & 7, kb = r / 8, nb = r % 8, d0 = 32 * nb;
            const float* src = (which ? PP->gx_w : PP->ga_w) + (size_t)blk * 65536 + (size_t)(64 * kb) * 256 + d0;
            const int drow = 256 * (2 * blk + (d0 >> 7)) + 128 * which + (d0 & 127);
            tr_item(src, 256, 32, (h16*)(ws + WS_WGR) + (size_t)drow * 256 + 64 * kb, 256, scr, lane); continue; }
        r -= 16 * I_G;
        if (r < I_WOUTR) { const int kb = r / 64, nb = r % 64;
            tr_item(PP->rnn_w_out + (size_t)(64 * kb) * D + 32 * nb, D, 32, (h16*)(ws + WS_WOUTR) + (size_t)(32 * nb) * D + 64 * kb, D, scr, lane); continue; }
        r -= I_WOUTR;
        if (r < 4 * I_POOL) { const int g = r / I_POOL; r -= g * I_POOL; const int kb = r / 16, nb = r % 16;
            tr_item(PP->pool_w + (size_t)g * 262144 + (size_t)(64 * kb) * 512 + 32 * nb, 512, 32, (h16*)(ws + WS_WPOOL) + (size_t)(512 * g + 32 * nb) * 512 + 64 * kb, 512, scr, lane); continue; }
        r -= 4 * I_POOL;
        if (r < 4 * I_UP) { const int i = r / I_UP; r -= i * I_UP; const int kb = r / 256, nb = r % 256;
            tr_item(PP->mlp_w_up + (size_t)i * D * FF + (size_t)(64 * kb) * FF + 32 * nb, FF, 32, (h16*)(ws + WS_WUP) + (size_t)i * D * FF + (size_t)(32 * nb) * D + 64 * kb, D, scr, lane, (unsigned*)(ws + WS_BLKMAX) + ((size_t)i * 32 + kb) * FF + 32 * nb, PP->mlp_norm + (size_t)i * D + 64 * kb); continue; }
        r -= 4 * I_UP;
        if (r < 4 * I_DN) { const int i = r / I_DN; r -= i * I_DN; const int kb = r / 64, nb = r % 64;
            tr_item(PP->mlp_w_down + (size_t)i * D * FF + (size_t)(64 * kb) * D + 32 * nb, D, 32, (h16*)(ws + WS_WDOWN) + (size_t)i * D * FF + ((size_t)kb * D + 32 * nb) * 64, 64, scr, lane, (unsigned*)(ws + WS_BLKMAXD) + ((size_t)i * 128 + kb) * D + 32 * nb); continue; }
        r -= 4 * I_DN;
        { const int j = r / I_Z; r -= j * I_Z;
            v4u* z = (v4u*)((h16*)(ws + WS_WINA) + (size_t)j * A_INP * D + (size_t)5280 * D); z[(size_t)r * 64 + lane] = (v4u){0u, 0u, 0u, 0u}; }
    }
    for (int e = gtid; e < T * 96; e += NGT) {
        const int t = e / 96, i = e % 96; const bool big = i < 64; const int fi = big ? i : i - 64;
        const double base = big ? 0.8659643233600653 : 0.7498942093324559;
        double inv = 1.0; for (int k = 0; k < fi; ++k) inv *= base;
        const double ang = (double)PP->pos[t] * inv;
        const double n = __builtin_rint(ang * 0.15915494309189535); const double rr = ang - n * 6.283185307179586 - n * 2.4492935982947064e-16;
        const double r2 = rr * rr; double sn = 1.0, cs = 1.0;
#pragma unroll
        for (int k = 14; k >= 1; --k) { sn = 1.0 - sn * r2 * (1.0 / (double)((2 * k) * (2 * k + 1))); cs = 1.0 - cs * r2 * (1.0 / (double)((2 * k - 1) * (2 * k))); }
        sn *= rr;
        if (big) { ((float*)(ws + WS_COS128))[t * 64 + fi] = (float)cs; ((float*)(ws + WS_SIN128))[t * 64 + fi] = (float)sn; }
        else { ((float*)(ws + WS_COS64))[t * 32 + fi] = (float)cs; ((float*)(ws + WS_SIN64))[t * 32 + fi] = (float)sn; }
    }
}

__device__ __forceinline__ void quant_rows(const h16* src, int nrows, signed char* dst, float* scale_out, const float* rowsq, const unsigned* colmax, int gw, int NGW, int lane) {
    h16x8 vn[4]; float cmn = 0.f;
    if (gw < nrows) {
#pragma unroll
        for (int j = 0; j < 4; ++j) vn[j] = *(const h16x8*)(src + (size_t)gw * D + 512 * j + 8 * lane);
        if (colmax) cmn = lane < 32 ? __uint_as_float(colmax[(size_t)lane * FF + gw]) : 0.f; }
    for (int r = gw; r < nrows; r += NGW) {
        h16x8 v[4]; const float cm = cmn;
#pragma unroll
        for (int j = 0; j < 4; ++j) v[j] = vn[j];
        const int rn = r + NGW;
        if (rn < nrows) {
#pragma unroll
            for (int j = 0; j < 4; ++j) vn[j] = *(const h16x8*)(src + (size_t)rn * D + 512 * j + 8 * lane);
            if (colmax) cmn = lane < 32 ? __uint_as_float(colmax[(size_t)lane * FF + rn]) : 0.f; }
        float mx;
        if (colmax) mx = wave_max(cm);
        else { mx = 0.f;
#pragma unroll
            for (int j = 0; j < 4; ++j)
#pragma unroll
                for (int e = 0; e < 8; ++e) mx = fmaxf(mx, fabsf((float)v[j][e]));
            mx = wave_max(mx); }
        const float step = mx > 0.f ? mx * (1.0f / 127.0f) : 1.0f, inv = 1.0f / step;
        if (lane == 0) { float sc = step;
            if (rowsq) { const f32x4* pp = (const f32x4*)(rowsq + (size_t)r * 32); f32x4 a4 = pp[0];
#pragma unroll
                for (int q = 1; q < 8; ++q) a4 += pp[q];
                sc = step / sqrtf(((a4[0] + a4[1]) + (a4[2] + a4[3])) * (1.0f / D) + EPS); }
            scale_out[r] = sc; }
#pragma unroll
        for (int j = 0; j < 4; ++j) { unsigned w[2];
#pragma unroll
            for (int hh = 0; hh < 2; ++hh) { unsigned p = 0u;
#pragma unroll
                for (int e = 0; e < 4; ++e) { int qv = (int)rintf((float)v[j][4 * hh + e] * inv); qv = qv > 127 ? 127 : (qv < -127 ? -127 : qv); p |= ((unsigned)qv & 255u) << (8 * e); }
                w[hh] = p; }
            *(v2u*)(dst + (size_t)r * D + 512 * j + 8 * lane) = (v2u){w[0], w[1]}; }
    }
}
template <bool UNSIGNED>
__device__ __forceinline__ void quant_kblk(const h16* src, int R, signed char* dst, float* scale_out, float* csum, const unsigned* blkmax, int gw, int NGW, int lane) {
    const int bsub = lane >> 3, c8 = (lane & 7) * 8;
    h16x8 vn[16]; float cmn = 0.f;
#define QK_LOAD(r_) do { _Pragma("unroll") for (int i = 0; i < 16; ++i) vn[i] = *(const h16x8*)(src + ((size_t)(8 * i + bsub) * R + (r_)) * 64 + c8); \
        if (!UNSIGNED) cmn = fmaxf(__uint_as_float(blkmax[(size_t)lane * R + (r_)]), __uint_as_float(blkmax[(size_t)(64 + lane) * R + (r_)])); } while (0)
    if (gw < R) QK_LOAD(gw);
    for (int r = gw; r < R; r += NGW) {
        h16x8 v[16]; const float cm = cmn;
#pragma unroll
        for (int i = 0; i < 16; ++i) v[i] = vn[i];
        if (r + NGW < R) QK_LOAD(r + NGW);
        float mx;
        if (UNSIGNED) { mx = 0.f;
#pragma unroll
            for (int i = 0; i < 16; ++i)
#pragma unroll
                for (int e = 0; e < 8; ++e) mx = fmaxf(mx, (float)v[i][e]);
            mx = wave_max(mx); }
        else mx = wave_max(cm);
        const float step = mx > 0.f ? mx * (UNSIGNED ? 1.0f / 255.0f : 1.0f / 127.0f) : 1.0f, inv = 1.0f / step;
        int ssum = 0;
#pragma unroll
        for (int i = 0; i < 16; ++i) { unsigned w[2];
#pragma unroll
            for (int hh = 0; hh < 2; ++hh) { unsigned p = 0u;
#pragma unroll
                for (int e = 0; e < 4; ++e) { int qv = (int)rintf((float)v[i][4 * hh + e] * inv);
                    if (UNSIGNED) { qv = qv > 255 ? 255 : (qv < 0 ? 0 : qv); qv -= 128; } else { qv = qv > 127 ? 127 : (qv < -127 ? -127 : qv); ssum += qv; }
                    p |= ((unsigned)qv & 255u) << (8 * e); }
                w[hh] = p; }
            const int b = 8 * i + bsub;
            *(v2u*)(dst + ((size_t)(b >> 1) * R + r) * 128 + 64 * (b & 1) + c8) = (v2u){w[0], w[1]}; }
        if (!UNSIGNED) { float fs = (float)ssum; fs = wave_sum(fs); if (lane == 0) csum[r] = fs; }
        if (lane == 0) scale_out[r] = step;
    }
#undef QK_LOAD
}
__device__ __forceinline__ void norm0_phase(const float* src, h16* dst, float* rowsq, int gw, int NGW, int lane) {
    for (int m = gw; m < T; m += NGW) {
        const f32x4* xr = (const f32x4*)(src + (size_t)m * D) + lane;
        f32x4 v[8]; float s = 0.f;
#pragma unroll
        for (int j = 0; j < 8; ++j) { v[j] = xr[64 * j]; s += (v[j].x * v[j].x + v[j].y * v[j].y) + (v[j].z * v[j].z + v[j].w * v[j].w); }
        s = wave_sum(s); if (lane == 0) rowsq[m] = s;
        v2u* o = (v2u*)(dst + (size_t)m * D) + lane;
#pragma unroll
        for (int j = 0; j < 8; ++j) { v2u w; w.x = pkh(v[j].x, v[j].y); w.y = pkh(v[j].z, v[j].w); o[64 * j] = w; }
    }
}

__device__ __forceinline__ unsigned char f8(float x) { return (unsigned char)(__builtin_amdgcn_cvt_pk_fp8_f32(x, x, 0, false) & 0xFF); }
__device__ __forceinline__ float sum16(float v) { v += __shfl_xor(v, 1); v += __shfl_xor(v, 2); v += __shfl_xor(v, 4); v += __shfl_xor(v, 8); return v; }
__device__ __forceinline__ unsigned f8x4(float a, float b, float c, float d) { int p = __builtin_amdgcn_cvt_pk_fp8_f32(a, b, 0, false); p = __builtin_amdgcn_cvt_pk_fp8_f32(c, d, p, true); return (unsigned)p; }
__device__ __forceinline__ void dsa_post_phase(const h16* PROJ, const float* qn, const float* kn, const float* c128, const float* s128, const float* c64, const float* s64,
                                               unsigned char* Q8, unsigned char* K8, unsigned char* V8, h16* IQ, h16* IK, float* IW, int gw, int NGW, int lane) {
    const int hh = lane >> 4, m = lane & 15;
    const f32x4 gqa = *(const f32x4*)(qn + 4 * m), gqb = *(const f32x4*)(qn + 64 + 4 * m), gka = *(const f32x4*)(kn + 4 * m), gkb = *(const f32x4*)(kn + 64 + 4 * m);
    const bool rot = m < 8; const int ioa = rot ? 4 * m : 32 + 4 * m, iob = ioa + 32;
    for (int t = gw; t < T; t += NGW) {
        const h16* pr = PROJ + (size_t)t * A_INP;
        const f32x4 c = *(const f32x4*)(c128 + t * 64 + 4 * m), s = *(const f32x4*)(s128 + t * 64 + 4 * m);
        f32x4 ci = {1.f, 1.f, 1.f, 1.f}, si = {0.f, 0.f, 0.f, 0.f};
        if (rot) { ci = *(const f32x4*)(c64 + t * 32 + 4 * m); si = *(const f32x4*)(s64 + t * 32 + 4 * m); }
#pragma unroll
        for (int p = 0; p < 5; ++p) {
            const int cb = (p < 4 ? C_Q + (4 * p + hh) * HD : C_K + hh * HD) + 4 * m;
            const h16x4 a4 = *(const h16x4*)(pr + cb), b4 = *(const h16x4*)(pr + cb + 64);
            float a[4], b[4], ss = 0.f;
#pragma unroll
            for (int e = 0; e < 4; ++e) { a[e] = (float)a4[e]; b[e] = (float)b4[e]; ss += a[e] * a[e] + b[e] * b[e]; }
            const float rstd = 1.0f / sqrtf(sum16(ss) * (1.0f / HD) + EPS);
            float oa[4], ob[4];
#pragma unroll
            for (int e = 0; e < 4; ++e) { const float ya = a[e] * rstd * (p < 4 ? gqa[e] : gka[e]), yb = b[e] * rstd * (p < 4 ? gqb[e] : gkb[e]); oa[e] = ya * c[e] - yb * s[e]; ob[e] = yb * c[e] + ya * s[e]; }
            unsigned char* o8 = (p < 4 ? Q8 + (size_t)t * D + (4 * p + hh) * HD : K8 + (size_t)t * 512 + hh * HD) + 4 * m;
            *(unsigned*)o8 = f8x4(oa[0], oa[1], oa[2], oa[3]); *(unsigned*)(o8 + 64) = f8x4(ob[0], ob[1], ob[2], ob[3]);
        }
        { const h16x8 vv = *(const h16x8*)(pr + C_V + lane * 8);
          *(v2u*)(V8 + (size_t)t * 512 + lane * 8) = (v2u){f8x4((float)vv[0], (float)vv[1], (float)vv[2], (float)vv[3]), f8x4((float)vv[4], (float)vv[5], (float)vv[6], (float)vv[7])}; }
#pragma unroll
        for (int p = 0; p < 5; ++p) {
            const int hd = p < 4 ? 4 * p + hh : 0; const int cb = p < 4 ? C_IQ + hd * HD : C_IK;
            const h16x4 a4 = *(const h16x4*)(pr + cb + ioa), b4 = *(const h16x4*)(pr + cb + iob);
            h16x4 oa, ob;
#pragma unroll
            for (int e = 0; e < 4; ++e) { const float av = (float)a4[e], bv = (float)b4[e]; oa[e] = (h16)(av * ci[e] - bv * si[e]); ob[e] = (h16)(bv * ci[e] + av * si[e]); }
            if (p < 4) { *(h16x4*)(IQ + (size_t)t * D + hd * HD + ioa) = oa; *(h16x4*)(IQ + (size_t)t * D + hd * HD + iob) = ob; }
            else if (hh == 0) { *(h16x4*)(IK + (size_t)t * HD + ioa) = oa; *(h16x4*)(IK + (size_t)t * HD + iob) = ob; }
        }
        if (lane < 16) IW[t * 16 + lane] = (float)pr[C_IW + lane] * 0.02209708691207961f;
    }
}

__device__ __forceinline__ float relu_i(float x) { const int b = __float_as_int(x); return __int_as_float(b > 0 ? b : 0); }
constexpr int IDX_ITEMS = 8320, IDX_ROWB = 272, IDX_TILEB = 128 * IDX_ROWB;
__device__ __forceinline__ void idx_decode(int L, int& qb, int& kc) {
    int m = (int)((sqrtf(1.0f + 2.0f * (float)L) - 1.0f) * 0.5f);
    while (2 * (m + 1) * (m + 2) <= L) ++m;
    while (2 * m * (m + 1) > L) --m;
    const int rem = L - 2 * m * (m + 1); qb = 4 * m + rem / (m + 1); kc = rem % (m + 1);
}
constexpr int IDX_HDR = 2;
__device__ __forceinline__ int idx_cut(int v) {
    int m = (int)((sqrtf((float)((1 + 2 * IDX_HDR) * (1 + 2 * IDX_HDR)) + 2.0f * (float)v) - (float)(1 + 2 * IDX_HDR)) * 0.5f);
    while (2 * (m + 1) * (m + 2) + 4 * IDX_HDR * (m + 1) <= v) ++m;
    while (2 * m * (m + 1) + 4 * IDX_HDR * m > v) --m;
    const int rem = v - (2 * m * (m + 1) + 4 * IDX_HDR * m), j = rem / (m + 1 + IDX_HDR), slot = rem % (m + 1 + IDX_HDR);
    return 2 * m * (m + 1) + j * (m + 1) + (slot < IDX_HDR ? 0 : slot - IDX_HDR);
}
__device__ __forceinline__ void idx_scores_phase(const h16* IQ, const h16* IK, const float* IW, h16* SC, LAS unsigned char* lds, int wg, int G, int tid, int wave, int lane) {
    const int L0 = idx_cut((int)(((long)(IDX_ITEMS + 256 * IDX_HDR) * wg) / G)), L1 = idx_cut((int)(((long)(IDX_ITEMS + 256 * IDX_HDR) * (wg + 1)) / G));
    if (L0 >= L1) return;
    int qb, kc; idx_decode(L0, qb, kc);
    const int fr = lane & 15, fq = lane >> 4;
    h16x8 st[4];
#define IDX_LOAD(kc_) do { _Pragma("unroll") for (int i = 0; i < 4; ++i) { const int p = tid + 512 * i; st[i] = *(const h16x8*)(IK + (size_t)((kc_) * 128 + (p >> 4)) * HD + (p & 15) * 8); } } while (0)
#define IDX_WRITE(buf_) do { _Pragma("unroll") for (int i = 0; i < 4; ++i) { const int p = tid + 512 * i; *(LAS h16x8*)(lds + (buf_) * IDX_TILEB + (p >> 4) * IDX_ROWB + (p & 15) * 16) = st[i]; } } while (0)
    IDX_LOAD(kc); IDX_WRITE(0);
    __syncthreads();
    int par = 0, L = L0;
#pragma unroll 1
    while (L < L1) {
        int kend = kc + (L1 - L) - 1; if (kend > (qb >> 2)) kend = (qb >> 2);
        h16x8 a[4][4]; v4u A2[4][2];
        { const int tq = 32 * qb + 4 * wave; f32x4 w4[4];
#pragma unroll
            for (int q = 0; q < 4; ++q) {
#pragma unroll
                for (int ks = 0; ks < 4; ++ks) a[q][ks] = *(const h16x8*)(IQ + (size_t)(tq + q) * D + fr * HD + ks * 32 + fq * 8);
                w4[q] = *(const f32x4*)(IW + (size_t)(tq + q) * 16 + 4 * fq); }
            __builtin_amdgcn_s_waitcnt(0x0F70);
            unsigned wp[4][2];
#pragma unroll
            for (int q = 0; q < 4; ++q) { wp[q][0] = pg8::pk_h2(w4[q][0], w4[q][1]); wp[q][1] = pg8::pk_h2(w4[q][2], w4[q][3]); }
#pragma unroll
            for (int r = 0; r < 4; ++r)
#pragma unroll
                for (int p = 0; p < 2; ++p) { const int i0 = 4 * r + 2 * p; const bool e0 = (fr == i0), e1 = (fr == i0 + 1);
                    A2[r][p] = (v4u){e0 ? wp[2 * p][0] : 0u, e0 ? wp[2 * p][1] : 0u, e1 ? wp[2 * p + 1][0] : 0u, e1 ? wp[2 * p + 1][1] : 0u}; } }
        __builtin_amdgcn_sched_barrier(0);
#pragma unroll 1
        for (; kc <= kend; ++kc, ++L) {
            const bool more = (L + 1 < L1);
            { const int kcp = more ? (kc < (qb >> 2) ? kc + 1 : 0) : kc; IDX_LOAD(kcp); }
            const LAS unsigned char* bb = lds + par * IDX_TILEB + fr * IDX_ROWB + fq * 16;
            h16x8 bq[2][4];
#pragma unroll
            for (int ks = 0; ks < 4; ++ks) bq[0][ks] = *(const LAS h16x8*)(bb + ks * 64);
            f32x4 d2 = {0.f, 0.f, 0.f, 0.f};
#pragma unroll
            for (int kt = 0; kt < 8; ++kt) {
                if (kt + 1 < 8) {
#pragma unroll
                    for (int ks = 0; ks < 4; ++ks) bq[(kt + 1) & 1][ks] = *(const LAS h16x8*)(bb + (kt + 1) * 16 * IDX_ROWB + ks * 64);
                    __builtin_amdgcn_sched_barrier(0); }
                const h16x8 (&b)[4] = bq[kt & 1];
#pragma unroll
                for (int p = 0; p < 2; ++p) { f32x4 s0 = {0.f, 0.f, 0.f, 0.f}, s1 = {0.f, 0.f, 0.f, 0.f};
#pragma unroll
                    for (int ks = 0; ks < 4; ++ks) { s0 = __builtin_amdgcn_mfma_f32_16x16x32_f16(a[2 * p][ks], b[ks], s0, 0, 0, 0); s1 = __builtin_amdgcn_mfma_f32_16x16x32_f16(a[2 * p + 1][ks], b[ks], s1, 0, 0, 0); }
                    const h16x2 z2 = {(h16)0.f, (h16)0.f};
                    h16x2 r0 = {(h16)s0[0], (h16)s0[1]}, r1 = {(h16)s0[2], (h16)s0[3]}, r2 = {(h16)s1[0], (h16)s1[1]}, r3 = {(h16)s1[2], (h16)s1[3]};
                    r0 = __builtin_elementwise_max(r0, z2); r1 = __builtin_elementwise_max(r1, z2); r2 = __builtin_elementwise_max(r2, z2); r3 = __builtin_elementwise_max(r3, z2);
                    const h16x8 b2 = {r0[0], r0[1], r1[0], r1[1], r2[0], r2[1], r3[0], r3[1]};
                    d2 = __builtin_amdgcn_mfma_f32_16x16x32_f16(__builtin_bit_cast(h16x8, A2[kt & 3][p]), b2, d2, 0, 0, 0); }
                if ((kt & 3) == 3) { const int tq = 32 * qb + 4 * wave;
#pragma unroll
                    for (int q = 0; q < 4; ++q) SC[(size_t)(tq + q) * SC_LD + kc * 128 + 64 * (kt >> 2) + lane] = (h16)d2[q];
                    d2 = (f32x4){0.f, 0.f, 0.f, 0.f}; }
            }
            IDX_WRITE(par ^ 1);
            asm volatile("s_waitcnt lgkmcnt(0)" ::: "memory"); __builtin_amdgcn_s_barrier(); asm volatile("" ::: "memory");
            par ^= 1;
        }
        ++qb; kc = 0;
    }
#undef IDX_LOAD
#undef IDX_WRITE
}

template <int NR>
__device__ __forceinline__ unsigned kth_largest(const unsigned (&u)[NR], int K) {
    unsigned prefix = 0u;
#pragma unroll 1
    for (int bit = 15; bit >= 0; --bit) { const unsigned cand = prefix | (1u << bit); int cnt = 0;
#pragma unroll
        for (int i = 0; i < NR; ++i) { cnt += __builtin_popcountll(__ballot(u[i] >= cand)); if ((i & 31) == 31) __builtin_amdgcn_sched_barrier(0); }
        if (cnt >= K) prefix = cand; }
    return prefix;
}
template <int NR, bool ARR>
__device__ __forceinline__ void emit_topk(const unsigned (&u)[NR], unsigned thr_in, int* sel, const int (&keys)[ARR ? NR : 1], int lane) {
    unsigned thr = thr_in; int cgt = 0;
#pragma unroll
    for (int i = 0; i < NR; ++i) { cgt += __builtin_popcountll(__ballot(u[i] > thr)); if ((i & 7) == 7) __builtin_amdgcn_sched_barrier(0); }
    const int need = TOPK - cgt;
    asm volatile("" : "+s"(thr));
    int base = 0, eqseen = 0;
#pragma unroll
    for (int i = 0; i < NR; ++i) {
        const bool gt = u[i] > thr, eq = u[i] == thr;
        const unsigned long long eb = __ballot(eq);
        const int erank = eqseen + (int)__builtin_amdgcn_mbcnt_hi((unsigned)(eb >> 32), __builtin_amdgcn_mbcnt_lo((unsigned)eb, 0u));
        const bool take = gt || (eq && erank < need);
        const unsigned long long tb = __ballot(take);
        const int pos = base + (int)__builtin_amdgcn_mbcnt_hi((unsigned)(tb >> 32), __builtin_amdgcn_mbcnt_lo((unsigned)tb, 0u));
        if (take) sel[pos] = ARR ? keys[ARR ? i : 0] : 64 * i + lane;
        base += __builtin_popcountll(tb); eqseen += __builtin_popcountll(eb);
        __builtin_amdgcn_sched_barrier(0);
    }
}
constexpr int TK_CAP = 768, TK_TARGET = 448;
template <int NREG>
__device__ __forceinline__ void topk_load_row(unsigned (&u)[NREG], const h16* sc_in, int t_in, int lane) {
    static_assert(NREG % 16 == 0, "chunks of 16 registers");
#pragma unroll
    for (int c = 0; c < NREG / 16; ++c) {
        const GAS unsigned short* pc = (const GAS unsigned short*)(sc_in + 1024 * c); asm volatile("" : "+s"(pc));
#pragma unroll
        for (int k = 0; k < 16; ++k) u[16 * c + k] = (unsigned)pc[64 * k + lane];
    }
#pragma unroll
    for (int c = 0; c < NREG / 16; ++c) {
        int tl = t_in - 1024 * c; asm volatile("" : "+s"(tl));
#pragma unroll
        for (int k = 0; k < 16; ++k) { const unsigned b = u[16 * c + k]; const unsigned mk = (b >> 15) ? 0xFFFFu : 0x8000u; u[16 * c + k] = (lane <= tl - 64 * k) ? (b ^ mk) : 0u; }
        __builtin_amdgcn_sched_barrier(0);
    }
}
template <int NREG>
__device__ __forceinline__ void topk_row(const h16* sc_in, int t_in, int* sel, int lane_in, LAS unsigned long long* cand) {
    int lane = lane_in; asm volatile("" : "+v"(lane));
    if constexpr (NREG >= 64) {
        int cn = 0;
        {   unsigned u[NREG];
            topk_load_row<NREG>(u, sc_in, t_in, lane);
            constexpr int NS = NREG / 8;
            unsigned us[NS]; int nsv = 0;
#pragma unroll
            for (int s = 0; s < NS; ++s) { us[s] = u[8 * s]; const int rem = t_in + 1 - 512 * s; nsv += rem < 0 ? 0 : (rem > 64 ? 64 : rem); }
            int Ks = (TK_TARGET * nsv) / (t_in + 1); Ks = Ks < 1 ? 1 : Ks;
            unsigned tau = kth_largest<NS>(us, Ks);
            asm volatile("" : "+s"(tau));
#pragma unroll
            for (int c = 0; c < NREG / 16; ++c) {
                int kb = 1024 * c + lane; asm volatile("" : "+v"(kb));
#pragma unroll
                for (int k = 0; k < 16; ++k) { const int i = 16 * c + k; const bool m = u[i] >= tau && tau != 0u; const unsigned long long mb = __ballot(m);
                    const int pos = cn + (int)__builtin_amdgcn_mbcnt_hi((unsigned)(mb >> 32), __builtin_amdgcn_mbcnt_lo((unsigned)mb, 0u));
                    if (m && pos < TK_CAP) cand[pos] = ((unsigned long long)u[i] << 32) | (unsigned)(kb + 64 * k);
                    cn += __builtin_popcountll(mb); if ((k & 3) == 3) __builtin_amdgcn_sched_barrier(0); }
            }
        }
        asm volatile("" : "+s"(cn));
        if (cn >= TOPK && cn <= TK_CAP) {
            LDS_WAIT();
            unsigned cu[TK_CAP / 64]; int ck[TK_CAP / 64];
#pragma unroll
            for (int k = 0; k < TK_CAP / 64; ++k) { const int ix = 64 * k + lane; const unsigned long long v = cand[ix]; cu[k] = ix < cn ? (unsigned)(v >> 32) : 0u; ck[k] = (int)(unsigned)v; }
            const unsigned thr = kth_largest<TK_CAP / 64>(cu, TOPK);
            emit_topk<TK_CAP / 64, true>(cu, thr, sel, ck, lane);
            LDS_WAIT();
            return;
        }
    }
    {   unsigned u[NREG];
        topk_load_row<NREG>(u, sc_in, t_in, lane);
        const unsigned thr = kth_largest<NREG>(u, TOPK);
        const int nokeys[1] = {0}; emit_topk<NREG, false>(u, thr, sel, nokeys, lane); }
}
__device__ __forceinline__ void topk_phase(const h16* SC, int* SEL, LAS unsigned char* lds, int gw, int NGW, int wave, int lane) {
    LAS unsigned long long* cand = (LAS unsigned long long*)(lds + wave * (TK_CAP * 8));
    for (int t = gw; t < T; t += NGW) {
        const h16* sc = SC + (size_t)t * SC_LD; int* sel = SEL + (size_t)t * TOPK;
        if (t < TOPK) {
#pragma unroll
            for (int j = 0; j < 4; ++j) { const int k = lane + 64 * j; sel[k] = (k <= t) ? k : -1; }
        } else if (t < 2048) topk_row<32>(sc, t, sel, lane, cand);
        else if (t < 4096) topk_row<64>(sc, t, sel, lane, cand);
        else if (t < 6144) topk_row<96>(sc, t, sel, lane, cand);
        else topk_row<128>(sc, t, sel, lane, cand);
    }
}

__device__ __forceinline__ float dot8(h16x8 a, h16x8 b, float c) {
#if __has_builtin(__builtin_amdgcn_fdot2)
    c = __builtin_amdgcn_fdot2((h16x2){a[0], a[1]}, (h16x2){b[0], b[1]}, c, false); c = __builtin_amdgcn_fdot2((h16x2){a[2], a[3]}, (h16x2){b[2], b[3]}, c, false);
    c = __builtin_amdgcn_fdot2((h16x2){a[4], a[5]}, (h16x2){b[4], b[5]}, c, false); c = __builtin_amdgcn_fdot2((h16x2){a[6], a[7]}, (h16x2){b[6], b[7]}, c, false);
#else
#pragma unroll
    for (int e = 0; e < 8; ++e) c += (float)a[e] * (float)b[e];
#endif
    return c;
}
__device__ __forceinline__ void attn_phase(const h16* QH, const h16* KH, const h16* VH, const int* SEL, h16* O, LAS unsigned char* lds, int wg, int G, int wave, int lane) {
    LAS h16* qs = (LAS h16*)(lds + wave * 6144);
    LAS float* ps = (LAS float*)(lds + wave * 6144 + 1024);
    LAS int* is = (LAS int*)(lds + wave * 6144 + 5120);
    const int grp = lane >> 4, c = lane & 15;
    for (int L = wg; L < (T / 8) * NKV; L += G) {
        const int g = L & 3, t = 8 * (L >> 2) + wave;
        int idx[4];
#pragma unroll
        for (int j = 0; j < 4; ++j) idx[j] = SEL[(size_t)t * TOPK + lane + 64 * j];
        *(LAS h16x8*)(qs + lane * 8) = *(const h16x8*)(QH + (size_t)t * D + g * 512 + lane * 8);
#pragma unroll
        for (int j = 0; j < 4; ++j) is[lane + 64 * j] = idx[j] < 0 ? 0 : idx[j];
        LDS_WAIT();
        float sc[4][4];
#pragma unroll
        for (int j = 0; j < 4; ++j) { const h16* krow = KH + (size_t)(idx[j] < 0 ? 0 : idx[j]) * 512 + g * HD; h16x8 kf[16];
#pragma unroll
            for (int cc = 0; cc < 16; ++cc) kf[cc] = *(const h16x8*)(krow + 8 * cc);
#pragma unroll
            for (int hh = 0; hh < 4; ++hh) { float s = 0.f;
#pragma unroll
                for (int cc = 0; cc < 16; ++cc) s = dot8(kf[cc], *(const LAS h16x8*)(qs + hh * HD + 8 * cc), s);
                sc[j][hh] = (idx[j] < 0) ? -__builtin_inff() : s * 0.08838834764831845f; }
            __builtin_amdgcn_sched_barrier(0); }
#pragma unroll
        for (int hh = 0; hh < 4; ++hh) {
            const float mx = wave_max(fmaxf(fmaxf(sc[0][hh], sc[1][hh]), fmaxf(sc[2][hh], sc[3][hh])));
            float e0 = __expf(sc[0][hh] - mx), e1 = __expf(sc[1][hh] - mx), e2 = __expf(sc[2][hh] - mx), e3 = __expf(sc[3][hh] - mx);
            const float inv = 1.0f / wave_sum((e0 + e1) + (e2 + e3));
            sc[0][hh] = e0 * inv; sc[1][hh] = e1 * inv; sc[2][hh] = e2 * inv; sc[3][hh] = e3 * inv; }
#pragma unroll
        for (int j = 0; j < 4; ++j) *(LAS f32x4*)(ps + 4 * (lane + 64 * j)) = (f32x4){sc[j][0], sc[j][1], sc[j][2], sc[j][3]};
        LDS_WAIT();
        float acc[4][8];
#pragma unroll
        for (int hh = 0; hh < 4; ++hh)
#pragma unroll
            for (int e = 0; e < 8; ++e) acc[hh][e] = 0.f;
#pragma unroll 4
        for (int it = 0; it < 64; ++it) { const int kk = 4 * it + grp; const int ik = is[kk]; const f32x4 p4 = *(const LAS f32x4*)(ps + 4 * kk);
            const h16x8 v8 = *(const h16x8*)(VH + (size_t)ik * 512 + g * HD + 8 * c);
#pragma unroll
            for (int hh = 0; hh < 4; ++hh)
#pragma unroll
                for (int e = 0; e < 8; ++e) acc[hh][e] += p4[hh] * (float)v8[e];
            if ((it & 3) == 3) __builtin_amdgcn_sched_barrier(0); }
#pragma unroll
        for (int hh = 0; hh < 4; ++hh)
#pragma unroll
            for (int e = 0; e < 8; ++e) { float v = acc[hh][e]; v += __shfl_xor(v, 16); v += __shfl_xor(v, 32); acc[hh][e] = v; }
        float o8[8];
#pragma unroll
        for (int e = 0; e < 8; ++e) o8[e] = grp == 0 ? acc[0][e] : grp == 1 ? acc[1][e] : grp == 2 ? acc[2][e] : acc[3][e];
        v4u w; w.x = pkh(o8[0], o8[1]); w.y = pkh(o8[2], o8[3]); w.z = pkh(o8[4], o8[5]); w.w = pkh(o8[6], o8[7]);
        *(v4u*)(O + (size_t)t * D + (4 * g + grp) * HD + 8 * c) = w;
        LDS_WAIT();
    }
}

__device__ __forceinline__ void conv_phase(const h16* PROJ, const float* cw, const float* cb, h16* XC, int gtid, int NGT) {
    h16x8 xn[4];
#define CONV_LOAD(i_) do { const int c8_ = ((i_) & 255) * 8, t_ = (i_) >> 8; _Pragma("unroll") for (int j = 0; j < 4; ++j) { const int tt = t_ - 3 + j; xn[j] = *(const h16x8*)(PROJ + (size_t)(tt < 0 ? 0 : tt) * 4096 + 2048 + c8_); } } while (0)
    if (gtid < T * 256) CONV_LOAD(gtid);
    for (int i = gtid; i < T * 256; i += NGT) { const int c8 = (i & 255) * 8, t = i >> 8;
        h16x8 xv[4];
#pragma unroll
        for (int j = 0; j < 4; ++j) xv[j] = xn[j];
        if (i + NGT < T * 256) CONV_LOAD(i + NGT);
        float acc[8];
#pragma unroll
        for (int e = 0; e < 8; ++e) acc[e] = cb[c8 + e];
#pragma unroll
        for (int j = 0; j < 4; ++j) { const int tt = t - 3 + j; if (tt >= 0) {
            const f32x4 w0 = *(const f32x4*)(cw + j * 2048 + c8), w1 = *(const f32x4*)(cw + j * 2048 + c8 + 4);
#pragma unroll
            for (int e = 0; e < 4; ++e) { acc[e] += (float)xv[j][e] * w0[e]; acc[4 + e] += (float)xv[j][4 + e] * w1[e]; } } }
        v4u w; w.x = pkh(acc[0], acc[1]); w.y = pkh(acc[2], acc[3]); w.z = pkh(acc[4], acc[5]); w.w = pkh(acc[6], acc[7]);
        *(v4u*)(XC + (size_t)t * 2048 + c8) = w; }
#undef CONV_LOAD
}
constexpr int SCAN_LC = 64, SCAN_NCH = T / SCAN_LC;
__device__ __forceinline__ f32x4 ld_a4(const h16* LA, size_t o) { const h16x4 v = *(const h16x4*)(LA + o); return (f32x4){__expf((float)v[0]), __expf((float)v[1]), __expf((float)v[2]), __expf((float)v[3])}; }
__device__ __forceinline__ f32x4 ld_b4(const h16* BF, size_t o) { const h16x4 v = *(const h16x4*)(BF + o); return (f32x4){(float)v[0], (float)v[1], (float)v[2], (float)v[3]}; }
__device__ __forceinline__ void scan_agg_phase(const h16* AF, const h16* BF, float* AGGA, float* AGGB, int gtid, int NGT) {
    for (int i = gtid; i < SCAN_NCH * 512; i += NGT) { const int cg = (i & 511) * 4, k = i >> 9;
        f32x4 Pr = {1.f, 1.f, 1.f, 1.f}, H = {0.f, 0.f, 0.f, 0.f};
#pragma unroll 16
        for (int r = 0; r < SCAN_LC; ++r) { const size_t o = (size_t)(k * SCAN_LC + r) * 2048 + cg; const f32x4 a = ld_a4(AF, o), b = ld_b4(BF, o); H = a * H + b; Pr = Pr * a; }
        *(f32x4*)(AGGA + (size_t)k * 2048 + cg) = Pr; *(f32x4*)(AGGB + (size_t)k * 2048 + cg) = H; }
}
__device__ __forceinline__ float gelu_tanh(float x) { const float u = 0.7978845608028654f * (x + 0.044715f * x * x * x); const float e = __expf(2.0f * u); const float th = 1.0f - 2.0f / (e + 1.0f); return 0.5f * x * (1.0f + th); }
__device__ __forceinline__ void scan_final_phase(const h16* AF, const h16* BF, const float* AGGA, const float* AGGB, const h16* PROJ, h16* Y, int gtid, int NGT) {
    for (int i = gtid; i < SCAN_NCH * 512; i += NGT) { const int cg = (i & 511) * 4, k = i >> 9;
        f32x4 H = {0.f, 0.f, 0.f, 0.f};
#pragma unroll 8
        for (int j = 0; j < k; ++j) { const f32x4 a = *(const f32x4*)(AGGA + (size_t)j * 2048 + cg), b = *(const f32x4*)(AGGB + (size_t)j * 2048 + cg); H = a * H + b; }
#pragma unroll 8
        for (int r = 0; r < SCAN_LC; ++r) { const int t = k * SCAN_LC + r; const size_t o = (size_t)t * 2048 + cg; const f32x4 a = ld_a4(AF, o), b = ld_b4(BF, o); H = a * H + b;
            const h16x4 gt = *(const h16x4*)(PROJ + (size_t)t * 4096 + cg);
            v2u w; w.x = pkh(H[0] * gelu_tanh((float)gt[0]), H[1] * gelu_tanh((float)gt[1])); w.y = pkh(H[2] * gelu_tanh((float)gt[2]), H[3] * gelu_tanh((float)gt[3]));
            *(v2u*)(Y + o) = w; } }
}
__device__ __forceinline__ f32x4 ldx4(const h16* p) { const h16x4 v = *(const h16x4*)p; return (f32x4){(float)v[0], (float)v[1], (float)v[2], (float)v[3]}; }
__device__ __forceinline__ void pool_phase(const h16* X, const float* gain, h16* Y, LAS unsigned char* lds, int wg, int G, int tid, int wave, int lane) {
    LAS float* rs = (LAS float*)lds;
    const int c4 = tid * 4; const int w = 2 << (tid >> 7);
    const f32x4 gn = *(const f32x4*)(gain + c4);
    for (int u = wg; u < T / 32; u += G) { const int t0 = 32 * u;
        __syncthreads();
        for (int r = wave; r < 47; r += NWAVES) { const int t = t0 - 15 + r;
            if (t >= 0) { const h16* xr = X + (size_t)t * D + 4 * lane; float s = 0.f;
#pragma unroll
                for (int j = 0; j < 8; ++j) { const f32x4 v = ldx4(xr + 256 * j); s += (v.x * v.x + v.y * v.y) + (v.z * v.z + v.w * v.w); }
                s = wave_sum(s); if (lane == 0) rs[r] = 1.0f / sqrtf(s * (1.0f / D) + EPS); } }
        __syncthreads();
        f32x4 sum = {0.f, 0.f, 0.f, 0.f};
        { const int n0 = (t0 + 1) < w ? (t0 + 1) : w;
          for (int j = 1; j < n0; ++j) sum += ldx4(X + (size_t)(t0 - j) * D + c4) * rs[15 - j]; }
#pragma unroll 8
        for (int r = 0; r < 32; ++r) { const int t = t0 + r; const int n = (t + 1) < w ? (t + 1) : w;
            const f32x4 h0 = ldx4(X + (size_t)t * D + c4) * rs[15 + r];
            sum += h0;
            const float invn = 1.0f / (float)n;
            const f32x4 y = (sum * invn - h0) * gn;
            v2u o; o.x = pkh(y.x, y.y); o.y = pkh(y.z, y.w); *(v2u*)(Y + (size_t)t * D + c4) = o;
            if (t + 1 >= w) sum -= ldx4(X + (size_t)(t + 1 - w) * D + c4) * rs[15 + r + 1 - w]; }
    }
}

__device__ __forceinline__ h16x8 f8x8_to_h(unsigned d0, unsigned d1) {
    const h16x2 a = __builtin_amdgcn_cvt_scalef32_pk_f16_fp8((int)d0, 1.0f, false), b = __builtin_amdgcn_cvt_scalef32_pk_f16_fp8((int)d0, 1.0f, true);
    const h16x2 c = __builtin_amdgcn_cvt_scalef32_pk_f16_fp8((int)d1, 1.0f, false), d = __builtin_amdgcn_cvt_scalef32_pk_f16_fp8((int)d1, 1.0f, true);
    return (h16x8){a[0], a[1], b[0], b[1], c[0], c[1], d[0], d[1]};
}
__device__ __forceinline__ unsigned attn_off_b(unsigned row, unsigned ch) { return 256u * row + 16u * (ch ^ (((row & 3u) << 2) | ((row >> 2) & 3u))); }
__device__ __forceinline__ void attn_mfma_phase(const unsigned char* Q8, const unsigned char* K8, const unsigned char* V8, const int* SEL, h16* O, LAS unsigned char* lds, int wg, int G, int wave, int lane_in) {
    typedef int i32x4 __attribute__((ext_vector_type(4)));
    typedef int i32x2 __attribute__((ext_vector_type(2)));
    typedef long i64x2 __attribute__((ext_vector_type(2)));
    i32x4 svn = {0, 0, 0, 0}; i64x2 qfn[2] = {{0, 0}, {0, 0}};
#define AT_PREF(L_) do { const int g_ = (L_) & 3, t_ = 8 * ((L_) >> 2) + wave; svn = *(const i32x4*)(SEL + (size_t)t_ * TOPK + 4 * lane_in); \
        _Pragma("unroll") for (int pp = 0; pp < 2; ++pp) qfn[pp] = *(const i64x2*)(Q8 + (size_t)t_ * D + (4 * g_ + (lane_in & 3)) * HD + 64 * pp + 16 * (lane_in >> 4)); } while (0)
    v4u kga[4], kgb[4];
#define AT_LOADK2(buf, G_, selk_, kbase_) do { const i32x2 i0 = *(const LAS i32x2*)((selk_) + 2 * (G_)), i1 = *(const LAS i32x2*)((selk_) + 128 + 2 * (G_)); \
            buf[0] = *(const v4u*)((kbase_) + (size_t)(i0.x < 0 ? 0 : i0.x) * 512); buf[1] = *(const v4u*)((kbase_) + (size_t)(i1.x < 0 ? 0 : i1.x) * 512); \
            buf[2] = *(const v4u*)((kbase_) + (size_t)(i0.y < 0 ? 0 : i0.y) * 512); buf[3] = *(const v4u*)((kbase_) + (size_t)(i1.y < 0 ? 0 : i1.y) * 512); } while (0)
#define AT_PREP(L_, par_) do { LAS int* sst_ = (LAS int*)(lds + LDSCTL_OFF + 1024 + wave * 2048 + (par_) * 1024); *(LAS i32x4*)(sst_ + 4 * lane_in) = svn; \
        asm volatile("s_waitcnt lgkmcnt(0)" ::: "memory"); \
        const LAS int* selk_ = sst_ + 16 * (lane_in >> 3); const unsigned char* kbase_ = K8 + ((L_) & 3) * HD + 16 * (lane_in & 7); \
        AT_LOADK2(kga, 0, selk_, kbase_); AT_LOADK2(kgb, 1, selk_, kbase_); } while (0)
    if (wg < (T / 8) * NKV) { AT_PREF(wg); AT_PREP(wg, 0); }
    int itpar = 0;
    for (int L = wg; L < (T / 8) * NKV; L += G, itpar ^= 1) {
        int lane = lane_in; asm volatile("" : "+v"(lane));
        const int jl = lane & 15, gi = lane >> 4;
        const int g = L & 3, t = 8 * (L >> 2) + wave;
        const int* sel = SEL + (size_t)t * TOPK; (void)sel;
        const int nvalid = (t + 1) < TOPK ? (t + 1) : TOPK;
        LAS int* sst = (LAS int*)(lds + LDSCTL_OFF + 1024 + wave * 2048 + itpar * 1024);
        i64x2 qf[2];
#pragma unroll
        for (int pp = 0; pp < 2; ++pp) qf[pp] = qfn[pp];
        LAS unsigned char* vimg = lds + wave * 16384;
        const LAS int* selk = sst + 16 * (lane >> 3);
        const unsigned char* kbase = K8 + g * HD + 16 * (lane & 7);
        const unsigned kwr = 136u * (unsigned)(lane >> 3) + 16u * (unsigned)(lane & 7), krd = 136u * (unsigned)jl + 16u * (unsigned)gi;
        f32x4 s[16];
#define AT_LOADK(buf, G_) AT_LOADK2(buf, G_, selk, kbase)
#define AT_KSTEP(buf, G_) do { LAS unsigned char* kb_ = vimg + ((G_) & 1) * 8192; \
            _Pragma("unroll") for (int j = 0; j < 4; ++j) { *(LAS v2u*)(kb_ + kwr + 1088 * j) = (v2u){buf[j].x, buf[j].y}; *(LAS v2u*)(kb_ + kwr + 1088 * j + 8) = (v2u){buf[j].z, buf[j].w}; } \
            if ((G_) + 2 < 8) AT_LOADK(buf, (G_) + 2); \
            _Pragma("unroll") for (int tt = 0; tt < 2; ++tt) { f32x4 acc = {0.f, 0.f, 0.f, 0.f}; \
                _Pragma("unroll") for (int pp = 0; pp < 2; ++pp) { const long a0 = *(const LAS long*)(kb_ + krd + 2176 * tt + 64 * pp), a1 = *(const LAS long*)(kb_ + krd + 2176 * tt + 64 * pp + 8); \
                    acc = __builtin_amdgcn_mfma_f32_16x16x32_fp8_fp8(a0, qf[pp].x, acc, 0, 0, 0); acc = __builtin_amdgcn_mfma_f32_16x16x32_fp8_fp8(a1, qf[pp].y, acc, 0, 0, 0); } \
                s[2 * (G_) + tt] = acc; } } while (0)
        if (L + G < (T / 8) * NKV) AT_PREF(L + G);
        AT_KSTEP(kga, 0); AT_KSTEP(kgb, 1); AT_KSTEP(kga, 2); AT_KSTEP(kgb, 3); AT_KSTEP(kga, 4); AT_KSTEP(kgb, 5); AT_KSTEP(kga, 6); AT_KSTEP(kgb, 7);
#undef AT_LOADK
#undef AT_KSTEP
        const LAS int* selv = sst + ((lane >> 5) & 1) + 16 * ((lane >> 3) & 3);
        const unsigned char* vbase = V8 + g * HD + 16 * (lane & 7);
        v4u vsa[4], vsb[4];
#define AT_LOADV(vst, Tt) do { _Pragma("unroll") for (int i = 0; i < 4; ++i) { const int ix = selv[2 * (Tt) + 64 * i]; vst[i] = *(const v4u*)(vbase + (size_t)(ix < 0 ? 0 : ix) * 512); } } while (0)
        AT_LOADV(vsa, 0); AT_LOADV(vsb, 1);
        __builtin_amdgcn_sched_barrier(0);
        if (nvalid < TOPK) {
#pragma unroll
            for (int kt = 0; kt < 16; ++kt)
#pragma unroll
                for (int r = 0; r < 4; ++r) if (kt + 64 * gi + 16 * r >= nvalid) s[kt][r] = -__builtin_inff();
        }
        float mx = -__builtin_inff();
#pragma unroll
        for (int kt = 0; kt < 16; ++kt) mx = fmaxf(mx, fmaxf(fmaxf(s[kt][0], s[kt][1]), fmaxf(s[kt][2], s[kt][3])));
        mx = fmaxf(mx, __shfl_xor(mx, 16)); mx = fmaxf(mx, __shfl_xor(mx, 32));
        constexpr float C2 = 0.08838834764831845f * 1.4426950408889634f;
        const float mb = -mx * C2; float sum = 0.f;
        h16x8 pf[8];
#pragma unroll
        for (int Tt = 0; Tt < 8; ++Tt) { float p[8];
#pragma unroll
            for (int r = 0; r < 4; ++r) { p[r] = __builtin_amdgcn_exp2f(fmaf(s[2 * Tt][r], C2, mb)); p[4 + r] = __builtin_amdgcn_exp2f(fmaf(s[2 * Tt + 1][r], C2, mb)); }
            sum += ((p[0] + p[1]) + (p[2] + p[3])) + ((p[4] + p[5]) + (p[6] + p[7]));
            pf[Tt] = (h16x8){(h16)p[0], (h16)p[1], (h16)p[2], (h16)p[3], (h16)p[4], (h16)p[5], (h16)p[6], (h16)p[7]}; }
        sum += __shfl_xor(sum, 16); sum += __shfl_xor(sum, 32);
        const float linv = 1.0f / sum;
        const unsigned q4 = (unsigned)jl >> 2, p4 = (unsigned)jl & 3u;
        unsigned wr_off[8], rd_off[2];
#pragma unroll
        for (int i = 0; i < 4; ++i) { wr_off[2 * i] = attn_off_b((unsigned)((lane >> 3) + 8 * i), 2u * (lane & 7)); wr_off[2 * i + 1] = attn_off_b((unsigned)((lane >> 3) + 8 * i), 2u * (lane & 7) + 1u); }
#pragma unroll
        for (int tt = 0; tt < 2; ++tt) { const unsigned row = 8u * gi + 4u * tt + q4; const unsigned x = ((row & 3u) << 2) | ((row >> 2) & 3u);
            rd_off[tt] = 256u * row + 16u * ((p4 >> 1) ^ (x & 1u)) + 8u * (p4 & 1u) + 32u * (x >> 1); }
        f32x4 o[8];
#pragma unroll
        for (int c = 0; c < 8; ++c) o[c] = (f32x4){0.f, 0.f, 0.f, 0.f};
#define AT_STEP(vst, Tt) do { \
            _Pragma("unroll") for (int i = 0; i < 4; ++i) {     \
                *(LAS h16x8*)(vimg + ((Tt) & 1) * 8192 + wr_off[2 * i]) = f8x8_to_h(vst[i].x, vst[i].y); *(LAS h16x8*)(vimg + ((Tt) & 1) * 8192 + wr_off[2 * i + 1]) = f8x8_to_h(vst[i].z, vst[i].w); } \
            if ((Tt) + 2 < 8) AT_LOADV(vst, (Tt) + 2); \
            const unsigned ib = (unsigned)(size_t)(vimg + ((Tt) & 1) * 8192); \
            h16x4 lo[8], hi[8]; \
            asm volatile("s_waitcnt lgkmcnt(0)" ::: "memory"); \
            _Pragma("unroll") for (int c = 0; c < 8; ++c) { \
                asm volatile("ds_read_b64_tr_b16 %0, %1" : "=&v"(lo[c]) : "v"(ib + (rd_off[0] ^ ((unsigned)c << 5))) : "memory"); \
                asm volatile("ds_read_b64_tr_b16 %0, %1" : "=&v"(hi[c]) : "v"(ib + (rd_off[1] ^ ((unsigned)c << 5))) : "memory"); } \
            asm volatile("s_waitcnt lgkmcnt(0)" ::: "memory"); __builtin_amdgcn_sched_barrier(0); \
            _Pragma("unroll") for (int c = 0; c < 8; ++c) o[c] = __builtin_amdgcn_mfma_f32_16x16x32_f16(pf[Tt], (h16x8){lo[c][0], lo[c][1], lo[c][2], lo[c][3], hi[c][0], hi[c][1], hi[c][2], hi[c][3]}, o[c], 0, 0, 0); \
        } while (0)
        AT_STEP(vsa, 0); AT_STEP(vsb, 1); AT_STEP(vsa, 2); AT_STEP(vsb, 3); AT_STEP(vsa, 4); AT_STEP(vsb, 5); AT_STEP(vsa, 6); AT_STEP(vsb, 7);
#undef AT_STEP
#undef AT_LOADV
        const float li = __shfl(linv, gi);
        h16* orow = O + (size_t)t * D + (4 * g + gi) * HD + jl;
#pragma unroll
        for (int c = 0; c < 8; ++c) { const float v = gi == 0 ? o[c][0] : gi == 1 ? o[c][1] : gi == 2 ? o[c][2] : o[c][3]; orow[16 * c] = (h16)(v * li); }
        asm volatile("s_waitcnt lgkmcnt(0)" ::: "memory");
        if (L + G < (T / 8) * NKV) AT_PREP(L + G, itpar ^ 1);
    }
#undef AT_PREF
#undef AT_PREP
#undef AT_LOADK2
}

constexpr int NPH = 37;
__global__ void __launch_bounds__(NTHR, 2) fwd_kernel(Ptrs P_unused) {
    extern __shared__ __attribute__((aligned(16))) unsigned char lds_raw[];
    LAS unsigned char* lds = (LAS unsigned char*)lds_raw;
    volatile LAS unsigned* MISC = (volatile LAS unsigned*)(lds + MISC_OFF);
    for (int u = threadIdx.x; u < (LDS_BYTES - LDSCTL_OFF) / 4; u += NTHR) ((LAS unsigned*)(lds + LDSCTL_OFF))[u] = 0u;
    __syncthreads();
    int lo, hi;
    XcdBarrier bar;
    { const CAS Ptrs* PP = kargs(); lo = PP->ph_lo; hi = PP->ph_hi; unsigned* bw = (unsigned*)(PP->ws + WS_CTL) + CW_BAR;
      bar.bar = bw; bar.x = 0; bar.st = nullptr; if (hi - lo > 1) bar = xcd_barrier_post(bw, MISC + 8); }
    int seq = 0;
#define PH_BEGIN(S_) if (seq >= lo && seq < hi) { const CAS Ptrs* PP = kargs(); unsigned char* const ws = PP->ws; float* const X = PP->out; (void)X; \
        int tid = threadIdx.x, bx = blockIdx.x, G = gridDim.x; asm volatile("" : "+v"(tid), "+s"(bx), "+s"(G)); \
        const int lane = tid & 63, wave = __builtin_amdgcn_readfirstlane(tid >> 6); const int vcu = (G % 8 == 0) ? (bx % 8) * (G / 8) + bx / 8 : bx; \
        const int gw = vcu * NWAVES + wave, NGW = G * NWAVES, gtid = vcu * NTHR + tid, NGT = G * NTHR; (void)lane; (void)gw; (void)NGW; (void)gtid; (void)NGT; \
        for (int rep_ = 0; rep_ < 1 + (int)((REP_MASK >> (S_)) & 1u); ++rep_) { if (rep_) __syncthreads(); \
        h16* const X16 = (h16*)(ws + WS_X16); h16* const PROJ = (h16*)(ws + WS_BA + BA_PROJ); h16* const U16 = (h16*)(ws + WS_BA + BA_U); (void)X16; (void)PROJ; (void)U16;
#define PH_END   } if (seq + 1 < hi) xcd_barrier(bar); } ++seq;
#define RSQ(i_) ((float*)(ws + WS_CTL + WS_ROWSQ) + (size_t)(i_) * T)
#define PARTA ((float*)(ws + WS_PARTA))
#define PARTB ((float*)(ws + WS_PARTB))

    PH_BEGIN(0) p0_prologue(PP, lds, gw, NGW, wave, lane, gtid, NGT); norm0_phase(PP->x, X16, RSQ(0), gw, NGW, lane); PH_END

#pragma unroll 1
    for (int layer = 0; layer < DEPTH; ++layer) {
        const int kind = layer % 3, j = layer / 3;
        if (kind == 0) {
            PH_BEGIN(2) { pg8::Gemm g{X16, (const h16*)(ws + WS_WINA) + (size_t)j * A_INP * D, T, A_INP, D, D, 1 << 20, D, 128, 128}; pg8::StaticOrder S; S.init(T, A_INP, G, bx);
                       pg8::EpiF16<0> E{PROJ, A_INP, layer == 0 ? RSQ(0) : PARTB, 0, layer == 0 ? 0 : 32}; pg8::gemm_phase<pg8::EpiF16<0>, pg8::StaticOrder, true, true>(lds, g, S, E, tid); } PH_END
            PH_BEGIN(3) dsa_post_phase(PROJ, PP->attn_qn + j * HD, PP->attn_kn + j * HD, (const float*)(ws + WS_COS128), (const float*)(ws + WS_SIN128), (const float*)(ws + WS_COS64), (const float*)(ws + WS_SIN64),
                                    (unsigned char*)(ws + WS_QH), (unsigned char*)(ws + WS_KH), (unsigned char*)(ws + WS_VH), (h16*)(ws + WS_IQ), (h16*)(ws + WS_IK), (float*)(ws + WS_IW), gw, NGW, lane); PH_END
            PH_BEGIN(4) idx_scores_phase((const h16*)(ws + WS_IQ), (const h16*)(ws + WS_IK), (const float*)(ws + WS_IW), (h16*)(ws + WS_BA + BA_SC), lds, vcu, G, tid, wave, lane); PH_END
            PH_BEGIN(5) topk_phase((const h16*)(ws + WS_BA + BA_SC), (int*)(ws + WS_SEL), lds, gw, NGW, wave, lane); PH_END
            PH_BEGIN(6) attn_mfma_phase((const unsigned char*)(ws + WS_QH), (const unsigned char*)(ws + WS_KH), (const unsigned char*)(ws + WS_VH), (const int*)(ws + WS_SEL), (h16*)(ws + WS_BA + BA_O16), lds, bx, G, wave, lane); PH_END
            PH_BEGIN(7) { pg8::Gemm g{(const h16*)(ws + WS_BA + BA_O16), (const h16*)(ws + WS_WOUTA) + (size_t)j * D * D, T, D, D, D, 1 << 20, D, 128, 128}; pg8::StaticOrder S; S.init(T, D, G, bx);
                       pg8::EpiResid E{X16, X16, nullptr, D, nullptr, nullptr, PARTA}; pg8::gemm_phase<pg8::EpiResid, pg8::StaticOrder, true, true>(lds, g, S, E, tid); } PH_END
        } else if (kind == 1) {
            PH_BEGIN(9) { pg8::Gemm g{X16, (const h16*)(ws + WS_WINR), T, 4096, D, D, 1 << 20, D, 128, 128}; pg8::StaticOrder S; S.init(T, 4096, G, bx);
                       pg8::EpiF16<0> E{PROJ, 4096, layer == 0 ? RSQ(0) : PARTB, 0, layer == 0 ? 0 : 32}; pg8::gemm_phase<pg8::EpiF16<0>, pg8::StaticOrder, true, true>(lds, g, S, E, tid); } PH_END
            PH_BEGIN(10) conv_phase(PROJ, PP->conv_w, PP->conv_b, (h16*)(ws + WS_BA + BA_XC), gtid, NGT); PH_END
            PH_BEGIN(11) { int kg = 256; asm volatile("" : "+s"(kg));
                       pg8::Gemm g{(const h16*)(ws + WS_BA + BA_XC), (const h16*)(ws + WS_WGR), T, 4096, kg, D, 2, kg, 128, 128}; pg8::StaticOrder S; S.init(T, 4096, G, bx);
                       pg8::EpiGates E{(const h16*)(ws + WS_BA + BA_XC), PP->ga_b, PP->gx_b, PP->lam, (h16*)(ws + WS_BA + BA_AF), (h16*)(ws + WS_BA + BA_BF)};
                       pg8::gemm_phase<pg8::EpiGates, pg8::StaticOrder, true, true>(lds, g, S, E, tid); } PH_END
            PH_BEGIN(12) scan_agg_phase((const h16*)(ws + WS_BA + BA_AF), (const h16*)(ws + WS_BA + BA_BF), (float*)(ws + WS_AGGA), (float*)(ws + WS_AGGB), gtid, NGT); PH_END
            PH_BEGIN(13) scan_final_phase((const h16*)(ws + WS_BA + BA_AF), (const h16*)(ws + WS_BA + BA_BF), (const float*)(ws + WS_AGGA), (const float*)(ws + WS_AGGB), PROJ, (h16*)(ws + WS_BA + BA_XC), gtid, NGT); PH_END
            PH_BEGIN(14) { pg8::Gemm g{(const h16*)(ws + WS_BA + BA_XC), (const h16*)(ws + WS_WOUTR), T, D, D, D, 1 << 20, D, 128, 128}; pg8::StaticOrder S; S.init(T, D, G, bx);
                       pg8::EpiResid E{X16, X16, nullptr, D, nullptr, nullptr, PARTA}; pg8::gemm_phase<pg8::EpiResid, pg8::StaticOrder, true, true>(lds, g, S, E, tid); } PH_END
        } else {
            PH_BEGIN(15) pool_phase(X16, PP->pool_norm, (h16*)(ws + WS_BA + BA_XC), lds, vcu, G, tid, wave, lane); PH_END
            PH_BEGIN(16) { pg8::Gemm g{(const h16*)(ws + WS_BA + BA_XC), (const h16*)(ws + WS_WPOOL), T, D, 512, D, 2, 512, 128, 128}; pg8::StaticOrder S; S.init(T, D, G, bx);
                       pg8::EpiResid E{X16, X16, nullptr, D, PP->pool_b, PP->pool_scale, PARTA}; pg8::gemm_phase<pg8::EpiResid, pg8::StaticOrder, true, true>(lds, g, S, E, tid); } PH_END
        }
        PH_BEGIN(17) quant_rows(X16, T, (signed char*)(ws + WS_BA + BA_A8), (float*)(ws + WS_RS), PARTA, nullptr, gw, NGW, lane);
                     quant_rows((const h16*)(ws + WS_WUP) + (size_t)layer * D * FF, FF, (signed char*)(ws + WS_BA + BA_W8), (float*)(ws + WS_CS), nullptr, (const unsigned*)(ws + WS_BLKMAX) + (size_t)layer * 32 * FF, gw, NGW, lane); PH_END
        PH_BEGIN(18) { pg8::Gemm g{(const h16*)(ws + WS_BA + BA_A8), (const h16*)(ws + WS_BA + BA_W8), T, FF, D / 2, D / 2, 1 << 20, D / 2, 128, 128}; pg8::StaticOrder S; S.init(T, FF, G, bx);
                   pg8::EpiQRelu2<pg8::i32x4> E{U16, (const float*)(ws + WS_RS), (const float*)(ws + WS_CS), T}; pg8::gemm_phase_i8<pg8::EpiQRelu2<pg8::i32x4>, pg8::StaticOrder, true, true>(lds, g, S, E, tid); } PH_END
        PH_BEGIN(19) quant_kblk<true>(U16, T, (signed char*)(ws + WS_BA + BA_U8), (float*)(ws + WS_RS2), nullptr, nullptr, gw, NGW, lane);
                     quant_kblk<false>((const h16*)(ws + WS_WDOWN) + (size_t)layer * D * FF, D, (signed char*)(ws + WS_BA + BA_W8D), (float*)(ws + WS_CS2), (float*)(ws + WS_CSUM), (const unsigned*)(ws + WS_BLKMAXD) + (size_t)layer * 128 * D, gw, NGW, lane); PH_END
        PH_BEGIN(20) { pg8::Gemm g{(const h16*)(ws + WS_BA + BA_U8), (const h16*)(ws + WS_BA + BA_W8D), T, D, FF / 2, 64, 1 << 20, 64, (size_t)T * 128, (size_t)D * 128}; pg8::StaticOrder S; S.init(T, D, G, bx);
                   const bool lastl = layer + 1 >= DEPTH, needsq = !lastl && (layer + 1) % 3 != 2;
                   pg8::EpiResidQ E{X16, X16, lastl ? X : nullptr, D, (const float*)(ws + WS_RS2), (const float*)(ws + WS_CS2), (const float*)(ws + WS_CSUM), needsq ? PARTB : nullptr};
                   pg8::gemm_phase_i8<pg8::EpiResidQ, pg8::StaticOrder, true, true>(lds, g, S, E, tid); } PH_END
    }
#undef PH_BEGIN
#undef PH_END
#undef RSQ
#undef PARTA
#undef PARTB
}

extern "C" void kernel_launch(void* const* d_in, const int* in_sizes, int n_in, void* d_out, int out_size, void* d_ws, size_t ws_size, hipStream_t stream) {
    static int grid = 0;
    if (grid == 0) {
        if (n_in != 24 || in_sizes[0] != T * D || out_size != T * D || ws_size < WS_END) { fprintf(stderr, "kernel_launch: unexpected shapes / workspace (n_in %d, in0 %d, out %d, ws %zu, need %zu); nothing launched\n", n_in, n_in > 0 ? in_sizes[0] : -1, out_size, ws_size, (size_t)WS_END); grid = -1; return; }
        int dev = 0, cus = 0, per_cu = 0;
        if (hipGetDevice(&dev) != hipSuccess || hipDeviceGetAttribute(&cus, hipDeviceAttributeMultiprocessorCount, dev) != hipSuccess) { grid = -1; return; }
        if (hipFuncSetAttribute((const void*)fwd_kernel, hipFuncAttributeMaxDynamicSharedMemorySize, LDS_BYTES) != hipSuccess) { fprintf(stderr, "kernel_launch: hipFuncSetAttribute failed\n"); grid = -1; return; }
        if (hipOccupancyMaxActiveBlocksPerMultiprocessor(&per_cu, (const void*)fwd_kernel, NTHR, LDS_BYTES) != hipSuccess || per_cu < 1) { fprintf(stderr, "kernel_launch: occupancy query reports %d workgroups per CU\n", per_cu); }
        (void)hipGetLastError();
        grid = cus;
    }
    if (grid < 0) return;
    if (hipMemsetAsync((char*)d_ws + WS_CTL, 0, CTL_ZERO_BYTES, stream) != hipSuccess) return;
    Ptrs p{};
    p.x = (const float*)d_in[0]; p.pos = (const int*)d_in[1];
    p.attn_norm = (const float*)d_in[2]; p.attn_w_in = (const float*)d_in[3]; p.attn_qn = (const float*)d_in[4]; p.attn_kn = (const float*)d_in[5]; p.attn_w_out = (const float*)d_in[6];
    p.rnn_norm = (const float*)d_in[7]; p.rnn_w_in = (const float*)d_in[8]; p.conv_w = (const float*)d_in[9]; p.conv_b = (const float*)d_in[10]; p.ga_w = (const float*)d_in[11]; p.ga_b = (const float*)d_in[12];
    p.gx_w = (const float*)d_in[13]; p.gx_b = (const float*)d_in[14]; p.lam = (const float*)d_in[15]; p.rnn_w_out = (const float*)d_in[16];
    p.pool_norm = (const float*)d_in[17]; p.pool_w = (const float*)d_in[18]; p.pool_b = (const float*)d_in[19]; p.pool_scale = (const float*)d_in[20];
    p.mlp_norm = (const float*)d_in[21]; p.mlp_w_up = (const float*)d_in[22]; p.mlp_w_down = (const float*)d_in[23];
    p.out = (float*)d_out; p.ws = (unsigned char*)d_ws;
#if MK_SPLIT
    for (int ph = 0; ph < NPH; ++ph) { p.ph_lo = ph; p.ph_hi = ph + 1; hipLaunchKernelGGL(fwd_kernel, dim3(grid), dim3(NTHR), LDS_BYTES, stream, p); }
#else
    p.ph_lo = 0; p.ph_hi = NPH; hipLaunchKernelGGL(fwd_kernel, dim3(grid), dim3(NTHR), LDS_BYTES, stream, p);
#endif
}
```

```cpp
#include <hip/hip_runtime.h>
#include <cstdio>
#include <cstdint>

#ifndef REP_MASK
#define REP_MASK 0u
#ifndef TPROBE
#define TPROBE 0
#endif
#ifndef TP_MULT
#define TP_MULT 4
#endif
#endif
#ifndef MK_SPLIT
#define MK_SPLIT 0
#endif

namespace pg8 {
#define PG8_LAS __attribute__((address_space(3)))
typedef _Float16 bf16_t;
typedef _Float16 bf16x8 __attribute__((ext_vector_type(8)));
typedef float f32x4 __attribute__((ext_vector_type(4)));
typedef unsigned u32x4 __attribute__((ext_vector_type(4)));
typedef unsigned u32x2 __attribute__((ext_vector_type(2)));
typedef _Float16 h16x2 __attribute__((ext_vector_type(2)));
typedef _Float16 h16x4 __attribute__((ext_vector_type(4)));
typedef _Float16 h16x8e __attribute__((ext_vector_type(8)));
constexpr int BM = 256, BK = 64, HALF = 128, HTB = HALF * BK * 2  , STAGE_BYTES = 8 * HTB, NXCD = 8, WGM = 8;

__host__ __device__ __forceinline__ int lds_byte(int r, int c) { const int st = (r >> 4) * 2 + (c >> 5), rr = r & 15, cc = c & 31, ob = rr * 64 + cc * 2; return st * 1024 + (ob ^ (((ob >> 9) & 1) << 5)); }
__host__ __device__ __forceinline__ void stage_rc(int b, int& R, int& C) { const int st = b / 1024, sb = b % 1024, swz = sb ^ (((sb >> 9) & 1) << 5); R = (st >> 1) * 16 + swz / 64; C = (st & 1) * 32 + (swz % 64) / 2; }
__host__ __device__ __forceinline__ int perm32(int rho) { const int n = rho >> 4, i = rho & 15; return 8 * (i >> 2) + 4 * n + (i & 3); }

struct Unit { int pm, pn; };
struct Gemm { const bf16_t* A; const bf16_t* Bt; int M, N, K, lda, npg, ldb; size_t kstepA, kstepB; };

struct StaticOrder {
    int nM, nN, nwg, G, c;
    __host__ __device__ void init(int M, int N, int G_, int c_) { nM = M / BM; nN = N / BM; nwg = nM * nN; G = G_; c = c_; }
    __host__ __device__ bool next(int i, Unit& u) const {
        const long L = (long)i * G + c; if (L >= nwg) return false;
        int wgid = (int)L; { const int q = nwg / NXCD, r = nwg % NXCD, xcd = wgid % NXCD, off = wgid / NXCD; wgid = (xcd < r ? xcd * (q + 1) : r * (q + 1) + (xcd - r) * q) + off; }
        const int nig = WGM * nN, gid = wgid / nig, fm = gid * WGM, gsz = (nM - fm) < WGM ? (nM - fm) : WGM;
        u.pm = fm + ((wgid % nig) % gsz); u.pn = (wgid % nig) / gsz; return true;
    }
    __device__ __forceinline__ void a_ready(const Unit&) const {}
    __device__ __forceinline__ void done(const Unit&) const {}
};

__device__ __forceinline__ unsigned pk_h2(float lo, float hi) { h16x2 v = {(_Float16)lo, (_Float16)hi}; return __builtin_bit_cast(unsigned, v); }

template <int ACT> struct EpiF16 {
    static constexpr bool PERM = true, WIDE = true, AFTER_DRAIN = false;
    bf16_t* O; int ldc; const float* rowsq; int kblk_rows; int npart;
    __device__ __forceinline__ void operator()(const f32x4 (&acc)[2][2][4][2], const Unit& u, int wr, int wc, int fr, int fq) const {
        const int row0 = u.pm * BM + wr * 64 + fr, col0 = u.pn * BM + wc * 64 + 8 * fq;
#pragma unroll
        for (int ai = 0; ai < 2; ++ai)
#pragma unroll
            for (int m = 0; m < 4; ++m) { const int row = row0 + ai * HALF + m * 16;
                bf16_t* rowp = kblk_rows ? O + ((size_t)(col0 >> 6) * kblk_rows + row) * 64 + (col0 & 63) : O + (size_t)row * ldc + col0;
                const size_t bjstep = 32;
                float rs = 1.0f; if (rowsq) { float ssq;
                    if (npart) { const f32x4* pp = (const f32x4*)(rowsq + (size_t)row * 32); f32x4 a4 = pp[0];
#pragma unroll
                        for (int q = 1; q < 8; ++q) a4 += pp[q];
                        ssq = (a4[0] + a4[1]) + (a4[2] + a4[3]); }
                    else ssq = rowsq[row];
                    rs = 1.0f / sqrtf(ssq * (1.0f / 2048.0f) + 1e-6f); if (ACT == 1) rs = rs * rs; }
#pragma unroll
                for (int bj = 0; bj < 2; ++bj) { f32x4 v0 = acc[ai][bj][m][0], v1 = acc[ai][bj][m][1];
                    if (ACT == 1) {
#pragma unroll
                        for (int j = 0; j < 4; ++j) { const float a = fmaxf(v0[j], 0.f), b = fmaxf(v1[j], 0.f); v0[j] = a * a; v1[j] = b * b; } }
                    v0 = v0 * rs; v1 = v1 * rs;
                    u32x4 w; w.x = pk_h2(v0[0], v0[1]); w.y = pk_h2(v0[2], v0[3]); w.z = pk_h2(v1[0], v1[1]); w.w = pk_h2(v1[2], v1[3]);
                    *(u32x4*)(rowp + bj * bjstep) = w; } }
    }
};
typedef int i32x4e __attribute__((ext_vector_type(4)));
template <class AccV> struct EpiQRelu2;
template <class AccV> struct EpiQRelu2 {
    static constexpr bool PERM = true, WIDE = true, AFTER_DRAIN = false;
    bf16_t* O; const float* rs; const float* cs; int kblk_rows;
    __device__ __forceinline__ void operator()(const AccV (&acc)[2][2][4][2], const Unit& u, int wr, int wc, int fr, int fq) const {
        const int row0 = u.pm * BM + wr * 64 + fr, col0 = u.pn * BM + wc * 64 + 8 * fq;
        f32x4 cv[2][2];
#pragma unroll
        for (int bj = 0; bj < 2; ++bj)
#pragma unroll
            for (int n = 0; n < 2; ++n) cv[bj][n] = *(const f32x4*)(cs + col0 + bj * 32 + 4 * n);
#pragma unroll
        for (int ai = 0; ai < 2; ++ai)
#pragma unroll
            for (int m = 0; m < 4; ++m) { const int row = row0 + ai * HALF + m * 16; const float r = rs[row];
                bf16_t* rowp = O + ((size_t)(col0 >> 6) * kblk_rows + row) * 64 + (col0 & 63); const size_t bjstep = 32;
#pragma unroll
                for (int bj = 0; bj < 2; ++bj) { f32x4 v0, v1;
#pragma unroll
                    for (int j = 0; j < 4; ++j) { const float a = fmaxf((float)acc[ai][bj][m][0][j] * (r * cv[bj][0][j]), 0.f), b = fmaxf((float)acc[ai][bj][m][1][j] * (r * cv[bj][1][j]), 0.f); v0[j] = a * a; v1[j] = b * b; }
                    u32x4 w; w.x = pk_h2(v0[0], v0[1]); w.y = pk_h2(v0[2], v0[3]); w.z = pk_h2(v1[0], v1[1]); w.w = pk_h2(v1[2], v1[3]);
                    *(u32x4*)(rowp + bj * bjstep) = w; } }
    }
};
struct EpiResid {
    static constexpr bool PERM = true, WIDE = true, AFTER_DRAIN = false;
    const bf16_t* res; bf16_t* out; float* out32; int ldc; const float* bias; const float* scale; float* rowsq;
    __device__ __forceinline__ void operator()(const f32x4 (&acc)[2][2][4][2], const Unit& u, int wr, int wc, int fr, int fq) const {
        const int row0 = u.pm * BM + wr * 64 + fr, col0 = u.pn * BM + wc * 64 + 8 * fq;
#pragma unroll
        for (int ai = 0; ai < 2; ++ai)
#pragma unroll
            for (int m = 0; m < 4; ++m) { const int row = row0 + ai * HALF + m * 16; const size_t off = (size_t)row * ldc + col0; float sq = 0.f;
#pragma unroll
                for (int bj = 0; bj < 2; ++bj) { const int cc = bj * 32; const h16x8e rh = *(const h16x8e*)(res + off + cc); float o[8];
#pragma unroll
                    for (int n = 0; n < 2; ++n) { const f32x4 bv = bias ? *(const f32x4*)(bias + col0 + cc + 4 * n) : (f32x4){0.f, 0.f, 0.f, 0.f}, sv = scale ? *(const f32x4*)(scale + col0 + cc + 4 * n) : (f32x4){1.f, 1.f, 1.f, 1.f};
#pragma unroll
                        for (int j = 0; j < 4; ++j) { o[4 * n + j] = (float)rh[4 * n + j] + (acc[ai][bj][m][n][j] + bv[j]) * sv[j]; sq += o[4 * n + j] * o[4 * n + j]; } }
                    if (out32) { *(f32x4*)(out32 + off + cc) = (f32x4){o[0], o[1], o[2], o[3]}; *(f32x4*)(out32 + off + cc + 4) = (f32x4){o[4], o[5], o[6], o[7]}; }
                    else { u32x4 w; w.x = pk_h2(o[0], o[1]); w.y = pk_h2(o[2], o[3]); w.z = pk_h2(o[4], o[5]); w.w = pk_h2(o[6], o[7]); *(u32x4*)(out + off + cc) = w; } }
                if (rowsq) { sq += __shfl_xor(sq, 16); sq += __shfl_xor(sq, 32); if (fq == 0) rowsq[(size_t)row * 32 + u.pn * 4 + wc] = sq; }
                asm volatile("" ::: "memory"); }
    }
};
struct EpiResidQ {
    static constexpr bool PERM = true, WIDE = true, AFTER_DRAIN = false;
    const bf16_t* res; bf16_t* out; float* out32; int ldc; const float* rs; const float* cs; const float* csum; float* rowsq;
    __device__ __forceinline__ void operator()(const i32x4e (&acc)[2][2][4][2], const Unit& u, int wr, int wc, int fr, int fq) const {
        const int row0 = u.pm * BM + wr * 64 + fr, col0 = u.pn * BM + wc * 64 + 8 * fq;
#pragma unroll
        for (int ai = 0; ai < 2; ++ai)
#pragma unroll
            for (int m = 0; m < 4; ++m) { const int row = row0 + ai * HALF + m * 16; const size_t off = (size_t)row * ldc + col0; float sq = 0.f; const float rsv = rs[row];
#pragma unroll
                for (int bj = 0; bj < 2; ++bj) { const int cc = bj * 32; const h16x8e rh = *(const h16x8e*)(res + off + cc); float o[8];
#pragma unroll
                    for (int n = 0; n < 2; ++n) { const f32x4 cv = *(const f32x4*)(cs + col0 + cc + 4 * n), zv = *(const f32x4*)(csum + col0 + cc + 4 * n);
#pragma unroll
                        for (int j = 0; j < 4; ++j) { o[4 * n + j] = (float)rh[4 * n + j] + (rsv * cv[j]) * ((float)acc[ai][bj][m][n][j] + 128.0f * zv[j]); sq += o[4 * n + j] * o[4 * n + j]; } }
                    if (out32) { *(f32x4*)(out32 + off + cc) = (f32x4){o[0], o[1], o[2], o[3]}; *(f32x4*)(out32 + off + cc + 4) = (f32x4){o[4], o[5], o[6], o[7]}; }
                    else { u32x4 w; w.x = pk_h2(o[0], o[1]); w.y = pk_h2(o[2], o[3]); w.z = pk_h2(o[4], o[5]); w.w = pk_h2(o[6], o[7]); *(u32x4*)(out + off + cc) = w; } }
                if (rowsq) { sq += __shfl_xor(sq, 16); sq += __shfl_xor(sq, 32); if (fq == 0) rowsq[(size_t)row * 32 + u.pn * 4 + wc] = sq; }
                asm volatile("" ::: "memory"); }
    }
};
struct EpiGates {
    static constexpr bool PERM = false, WIDE = false, AFTER_DRAIN = false;
    const bf16_t* XC; const float* ba; const float* bx; const float* lam; bf16_t* AF; bf16_t* BF;
    __device__ __forceinline__ void operator()(const f32x4 (&acc)[2][2][4][2], const Unit& u, int wr, int wc, int fr, int fq) const {
        const int row0 = u.pm * BM + wr * 64 + fr, ch0 = (u.pn >> 1) * 256 + (u.pn & 1) * 128 + wc * 32 + 4 * fq;
#pragma unroll
        for (int n = 0; n < 2; ++n) {
            const f32x4 bav = *(const f32x4*)(ba + ch0 + n * 16), bxv = *(const f32x4*)(bx + ch0 + n * 16), l = *(const f32x4*)(lam + ch0 + n * 16); f32x4 spv;
#pragma unroll
            for (int j = 0; j < 4; ++j) spv[j] = -8.0f * log1pf(__expf(-l[j]));
#pragma unroll
            for (int ai = 0; ai < 2; ++ai)
#pragma unroll
                for (int m = 0; m < 4; ++m) { const size_t off = (size_t)(row0 + ai * HALF + m * 16) * 2048 + ch0 + n * 16;
                    const h16x4 xh = *(const h16x4*)(XC + off); f32x4 av, bv;
#pragma unroll
                    for (int j = 0; j < 4; ++j) { const float r = __builtin_amdgcn_rcpf(1.0f + __expf(-(acc[ai][0][m][n][j] + bav[j]))), ig = __builtin_amdgcn_rcpf(1.0f + __expf(-(acc[ai][1][m][n][j] + bxv[j])));
                        const float la = r * spv[j]; av[j] = la;
                        const float y = 2.0f * la;
                        const float em = y * (1.0f + y * 0.5f * (1.0f + y * (1.0f / 3.0f) * (1.0f + y * 0.25f * (1.0f + y * 0.2f * (1.0f + y * (1.0f / 6.0f) * (1.0f + y * (1.0f / 7.0f)))))));
                        const float om = (y > -0.5f) ? -em : 1.0f - __expf(y);
                        bv[j] = (float)xh[j] * ig * __builtin_amdgcn_sqrtf(fmaxf(om, 0.f)); }
                    { u32x2 w; w.x = pk_h2(av[0], av[1]); w.y = pk_h2(av[2], av[3]); *(u32x2*)(AF + off) = w; w.x = pk_h2(bv[0], bv[1]); w.y = pk_h2(bv[2], bv[3]); *(u32x2*)(BF + off) = w; }
                    asm volatile("" ::: "memory"); }
        }
    }
};

template <class Epi, class Sched, bool ALIGN_EPI = false, bool SP2 = false>
__device__ __forceinline__ void gemm_phase(PG8_LAS unsigned char* lds, const Gemm g, const Sched& S, const Epi& E, const int tid) {
    const int wid = __builtin_amdgcn_readfirstlane(tid >> 6), lane = tid & 63, wr = wid >> 2, wc = wid & 3, fr = lane & 15, fq = lane >> 4;
    const int K = g.K, nt = K / BK;
    unsigned voffA[2], voffB[2];
#pragma unroll
    for (int i = 0; i < 2; ++i) { int R, C; stage_rc(tid * 16 + i * 8192, R, C); const int Rb = Epi::WIDE ? (64 * (R >> 5) + perm32(R & 31)) : (Epi::PERM ? ((R & ~31) + perm32(R & 31)) : R);
        voffA[i] = (unsigned)(R * g.lda + C) * 2u; voffB[i] = (unsigned)(Rb * g.ldb + C) * 2u; }
    const size_t kstepA = g.kstepA, kstepB = g.kstepB;
    const size_t hstepA = (size_t)HALF * g.lda * 2, hstepB = (size_t)(Epi::WIDE ? 32 : HALF) * g.ldb * 2;
#define PG8_ABASE(u) ((const char*)g.A + ((size_t)(u).pm * BM * g.lda + (size_t)((u).pn / g.npg) * K) * 2)
#define PG8_BBASE(u) ((const char*)g.Bt + (size_t)(u).pn * BM * g.ldb * 2)
    const unsigned ldsw = (unsigned)wid * 1024u;
    const int aoff = lds_byte(wr * 64 + fr, fq * 8), boff = lds_byte(wc * 32 + fr, fq * 8);
#define PG8_SA(b, h) (((b) * 2 + (h)) * HTB)
#define PG8_SB(b, h) ((4 + (b) * 2 + (h)) * HTB)
#define PG8_STAGE(bufoff, gbase, voff) do { _Pragma("unroll") for (int _i = 0; _i < 2; ++_i) \
        __builtin_amdgcn_global_load_lds((const unsigned*)((const char*)(gbase) + (voff)[_i]), (PG8_LAS unsigned*)(lds + (bufoff) + ldsw + _i * 8192), 16, 0, 0); } while (0)
#define PG8_LDA(dst, b, h) do { _Pragma("unroll") for (int m = 0; m < 4; ++m) _Pragma("unroll") for (int k = 0; k < 2; ++k) dst[m][k] = *(const PG8_LAS bf16x8*)(lds + PG8_SA(b, h) + aoff + m * 2048 + k * 1024); } while (0)
#define PG8_LDB(dst, b, h) do { _Pragma("unroll") for (int n = 0; n < 2; ++n) _Pragma("unroll") for (int k = 0; k < 2; ++k) dst[n][k] = *(const PG8_LAS bf16x8*)(lds + PG8_SB(b, h) + boff + n * 2048 + k * 1024); } while (0)
#define PG8_MMA(ai, bj, At, Bt) do { __builtin_amdgcn_s_setprio(1); _Pragma("unroll") for (int m = 0; m < 4; ++m) _Pragma("unroll") for (int n = 0; n < 2; ++n) _Pragma("unroll") for (int k = 0; k < 2; ++k) \
        acc[ai][bj][m][n] = __builtin_amdgcn_mfma_f32_16x16x32_f16(Bt[n][k], At[m][k], acc[ai][bj][m][n], 0, 0, 0); __builtin_amdgcn_s_setprio(0); } while (0)
#define PG8_WAIT_V(n) asm volatile("s_waitcnt vmcnt(" #n ")" ::: "memory")
#define PG8_WAIT_L(n) asm volatile("s_waitcnt lgkmcnt(" #n ")" ::: "memory")
#define PG8_BAR __builtin_amdgcn_s_barrier()
#define PG8_SCHED __builtin_amdgcn_sched_barrier(0)
    Unit cur, nxt; int ui = 0;
    if (!S.next(0, cur)) return;
    f32x4 acc[2][2][4][2];
#pragma unroll
    for (int a = 0; a < 2; ++a)
#pragma unroll
        for (int b = 0; b < 2; ++b)
#pragma unroll
            for (int m = 0; m < 4; ++m)
#pragma unroll
                for (int n = 0; n < 2; ++n) acc[a][b][m][n] = (f32x4){0.f, 0.f, 0.f, 0.f};
    bf16x8 At[4][2], B0[2][2], B1[2][2];
    const char* cA = PG8_ABASE(cur); const char* cB = PG8_BBASE(cur);
    S.a_ready(cur);
    if constexpr (SP2) {
        PG8_STAGE(PG8_SB(0, 0), cB, voffB); PG8_STAGE(PG8_SB(0, 1), cB + hstepB, voffB); PG8_STAGE(PG8_SA(0, 0), cA, voffA); PG8_STAGE(PG8_SA(0, 1), cA + hstepA, voffA);
        if (wr == 1) PG8_BAR;
        PG8_WAIT_V(2); PG8_BAR;
        PG8_STAGE(PG8_SB(1, 0), cB + kstepB, voffB); PG8_STAGE(PG8_SA(1, 0), cA + kstepA, voffA); PG8_STAGE(PG8_SB(1, 1), cB + hstepB + kstepB, voffB);
        PG8_WAIT_V(6); PG8_BAR;
    } else {
        PG8_STAGE(PG8_SB(0, 0), cB, voffB); PG8_STAGE(PG8_SA(0, 0), cA, voffA); PG8_STAGE(PG8_SB(0, 1), cB + hstepB, voffB); PG8_STAGE(PG8_SA(0, 1), cA + hstepA, voffA);
        if (wr == 1) PG8_BAR;
        PG8_WAIT_V(4); PG8_BAR;
        PG8_STAGE(PG8_SB(1, 0), cB + kstepB, voffB); PG8_STAGE(PG8_SA(1, 0), cA + kstepA, voffA); PG8_STAGE(PG8_SB(1, 1), cB + hstepB + kstepB, voffB);
        PG8_WAIT_V(6); PG8_BAR;
    }
    for (;;) {
        const bool has_next = S.next(ui + 1, nxt);
        const char* nA = has_next ? PG8_ABASE(nxt) : cA; const char* nB = has_next ? PG8_BBASE(nxt) : cB;
        for (int t = 0; t < nt; t += 2) {
            const bool last = (t == nt - 2);
            const char* a1 = cA + (size_t)(t + 1) * kstepA;
            const char* a2 = last ? nA : cA + (size_t)(t + 2) * kstepA; const char* b2 = last ? nB : cB + (size_t)(t + 2) * kstepB;
            const char* a3 = a2 + kstepA; const char* b3 = b2 + kstepB;
            if (last && has_next) S.a_ready(nxt);
            if constexpr (SP2) {
            PG8_LDB(B0, 0, 0); PG8_LDB(B1, 0, 1); PG8_SCHED; PG8_LDA(At, 0, 0); PG8_STAGE(PG8_SA(1, 1), a1 + hstepA, voffA);
            PG8_WAIT_V(8); PG8_WAIT_L(0); PG8_BAR; PG8_MMA(0, 0, At, B0); PG8_MMA(0, 1, At, B1); PG8_BAR; PG8_SCHED;
            PG8_LDA(At, 0, 1); PG8_STAGE(PG8_SB(0, 0), b2, voffB); PG8_STAGE(PG8_SB(0, 1), b2 + hstepB, voffB); PG8_STAGE(PG8_SA(0, 0), a2, voffA);
            PG8_WAIT_V(8); PG8_WAIT_L(0); PG8_BAR; PG8_MMA(1, 0, At, B0); PG8_MMA(1, 1, At, B1); PG8_BAR; PG8_SCHED;
            PG8_LDB(B0, 1, 0); PG8_LDB(B1, 1, 1); PG8_SCHED; PG8_LDA(At, 1, 0); PG8_STAGE(PG8_SA(0, 1), a2 + hstepA, voffA);
            PG8_WAIT_V(8); PG8_WAIT_L(0); PG8_BAR; PG8_MMA(0, 0, At, B0); PG8_MMA(0, 1, At, B1); PG8_BAR; PG8_SCHED;
            PG8_LDA(At, 1, 1); PG8_STAGE(PG8_SB(1, 0), b3, voffB); PG8_STAGE(PG8_SB(1, 1), b3 + hstepB, voffB); PG8_STAGE(PG8_SA(1, 0), a3, voffA);
            PG8_WAIT_V(8); PG8_WAIT_L(0); PG8_BAR; PG8_MMA(1, 0, At, B0); PG8_MMA(1, 1, At, B1); PG8_BAR; PG8_SCHED;
            } else {
            PG8_LDB(B0, 0, 0); PG8_SCHED; PG8_LDA(At, 0, 0); PG8_STAGE(PG8_SA(1, 1), a1 + hstepA, voffA);
            PG8_WAIT_L(8); PG8_BAR; PG8_WAIT_L(0); PG8_MMA(0, 0, At, B0); PG8_BAR; PG8_SCHED;
            PG8_LDB(B1, 0, 1); PG8_STAGE(PG8_SB(0, 0), b2, voffB);
            PG8_BAR; PG8_WAIT_L(0); PG8_MMA(0, 1, At, B1); PG8_BAR;
            PG8_LDA(At, 0, 1); PG8_STAGE(PG8_SA(0, 0), a2, voffA);
            PG8_BAR; PG8_WAIT_L(0); PG8_MMA(1, 0, At, B0); PG8_BAR; PG8_SCHED;
            PG8_STAGE(PG8_SB(0, 1), b2 + hstepB, voffB);
            PG8_WAIT_V(6); PG8_BAR; PG8_MMA(1, 1, At, B1); PG8_BAR;
            PG8_LDB(B0, 1, 0); PG8_SCHED; PG8_LDA(At, 1, 0); PG8_STAGE(PG8_SA(0, 1), a2 + hstepA, voffA);
            PG8_WAIT_L(8); PG8_BAR; PG8_WAIT_L(0); PG8_MMA(0, 0, At, B0); PG8_BAR; PG8_SCHED;
            PG8_LDB(B1, 1, 1); PG8_STAGE(PG8_SB(1, 0), b3, voffB);
            PG8_BAR; PG8_WAIT_L(0); PG8_MMA(0, 1, At, B1); PG8_BAR;
            PG8_LDA(At, 1, 1); PG8_STAGE(PG8_SA(1, 0), a3, voffA);
            PG8_BAR; PG8_WAIT_L(0); PG8_MMA(1, 0, At, B0); PG8_BAR; PG8_SCHED;
            PG8_STAGE(PG8_SB(1, 1), b3 + hstepB, voffB);
            PG8_WAIT_V(6); PG8_BAR; PG8_MMA(1, 1, At, B1); PG8_BAR;
            }
        }
        if constexpr (ALIGN_EPI) { if (wr == 0) PG8_BAR; }
        if constexpr (!Epi::AFTER_DRAIN) { E(acc, cur, wr, wc, fr, fq); S.done(cur); }
        if (!has_next) break;
#pragma unroll
        for (int a = 0; a < 2; ++a)
#pragma unroll
            for (int b = 0; b < 2; ++b)
#pragma unroll
                for (int m = 0; m < 4; ++m)
#pragma unroll
                    for (int n = 0; n < 2; ++n) acc[a][b][m][n] = (f32x4){0.f, 0.f, 0.f, 0.f};
        cur = nxt; cA = nA; cB = nB; ++ui;
        if constexpr (ALIGN_EPI) { if (wr == 1) PG8_BAR; }
    }
    PG8_WAIT_V(0);
    if constexpr (!ALIGN_EPI) { if (wr == 0) PG8_BAR; }
    PG8_BAR;
    if constexpr (Epi::AFTER_DRAIN) { E.fused(acc, cur, wr, wc, fr, fq, lds, wid, lane); S.done(cur); }
#undef PG8_ABASE
#undef PG8_BBASE
#undef PG8_SA
#undef PG8_SB
#undef PG8_STAGE
#undef PG8_LDA
#undef PG8_LDB
#undef PG8_MMA
#undef PG8_WAIT_V
#undef PG8_WAIT_L
#undef PG8_BAR
#undef PG8_SCHED
}
typedef int i32x4 __attribute__((ext_vector_type(4)));
template <class Epi, class Sched, bool ALIGN_EPI = false, bool SP2 = false>
__device__ __forceinline__ void gemm_phase_i8(PG8_LAS unsigned char* lds, const Gemm g, const Sched& S, const Epi& E, const int tid) {
    const int wid = __builtin_amdgcn_readfirstlane(tid >> 6), lane = tid & 63, wr = wid >> 2, wc = wid & 3, fr = lane & 15, fq = lane >> 4;
    const int K = g.K, nt = K / BK;
    unsigned voffA[2], voffB[2];
#pragma unroll
    for (int i = 0; i < 2; ++i) { int R, C; stage_rc(tid * 16 + i * 8192, R, C); const int Rb = Epi::WIDE ? (64 * (R >> 5) + perm32(R & 31)) : (Epi::PERM ? ((R & ~31) + perm32(R & 31)) : R);
        voffA[i] = (unsigned)(R * g.lda + C) * 2u; voffB[i] = (unsigned)(Rb * g.ldb + C) * 2u; }
    const size_t kstepA = g.kstepA, kstepB = g.kstepB;
    const size_t hstepA = (size_t)HALF * g.lda * 2, hstepB = (size_t)(Epi::WIDE ? 32 : HALF) * g.ldb * 2;
#define PG8_ABASE(u) ((const char*)g.A + ((size_t)(u).pm * BM * g.lda + (size_t)((u).pn / g.npg) * K) * 2)
#define PG8_BBASE(u) ((const char*)g.Bt + (size_t)(u).pn * BM * g.ldb * 2)
    const unsigned ldsw = (unsigned)wid * 1024u;
    const int aoff = lds_byte(wr * 64 + fr, fq * 8), boff = lds_byte(wc * 32 + fr, fq * 8);
#define PG8_SA(b, h) (((b) * 2 + (h)) * HTB)
#define PG8_SB(b, h) ((4 + (b) * 2 + (h)) * HTB)
#define PG8_STAGE(bufoff, gbase, voff) do { _Pragma("unroll") for (int _i = 0; _i < 2; ++_i) \
        __builtin_amdgcn_global_load_lds((const unsigned*)((const char*)(gbase) + (voff)[_i]), (PG8_LAS unsigned*)(lds + (bufoff) + ldsw + _i * 8192), 16, 0, 0); } while (0)
#define PG8_LDA(dst, b, h) do { _Pragma("unroll") for (int m = 0; m < 4; ++m) _Pragma("unroll") for (int k = 0; k < 2; ++k) dst[m][k] = *(const PG8_LAS bf16x8*)(lds + PG8_SA(b, h) + aoff + m * 2048 + k * 1024); } while (0)
#define PG8_LDB(dst, b, h) do { _Pragma("unroll") for (int n = 0; n < 2; ++n) _Pragma("unroll") for (int k = 0; k < 2; ++k) dst[n][k] = *(const PG8_LAS bf16x8*)(lds + PG8_SB(b, h) + boff + n * 2048 + k * 1024); } while (0)
#define PG8_MMA(ai, bj, At, Bt) do { __builtin_amdgcn_s_setprio(1); _Pragma("unroll") for (int m = 0; m < 4; ++m) _Pragma("unroll") for (int n = 0; n < 2; ++n) _Pragma("unroll") for (int k = 0; k < 2; ++k) \
        acc[ai][bj][m][n] = __builtin_amdgcn_mfma_i32_16x16x64_i8(__builtin_bit_cast(i32x4, Bt[n][k]), __builtin_bit_cast(i32x4, At[m][k]), acc[ai][bj][m][n], 0, 0, 0); __builtin_amdgcn_s_setprio(0); } while (0)
#define PG8_WAIT_V(n) asm volatile("s_waitcnt vmcnt(" #n ")" ::: "memory")
#define PG8_WAIT_L(n) asm volatile("s_waitcnt lgkmcnt(" #n ")" ::: "memory")
#define PG8_BAR __builtin_amdgcn_s_barrier()
#define PG8_SCHED __builtin_amdgcn_sched_barrier(0)
    Unit cur, nxt; int ui = 0;
    if (!S.next(0, cur)) return;
    i32x4 acc[2][2][4][2];
#pragma unroll
    for (int a = 0; a < 2; ++a)
#pragma unroll
        for (int b = 0; b < 2; ++b)
#pragma unroll
            for (int m = 0; m < 4; ++m)
#pragma unroll
                for (int n = 0; n < 2; ++n) acc[a][b][m][n] = (i32x4){0, 0, 0, 0};
    bf16x8 At[4][2], B0[2][2], B1[2][2];
    const char* cA = PG8_ABASE(cur); const char* cB = PG8_BBASE(cur);
    S.a_ready(cur);
    if constexpr (SP2) {
        PG8_STAGE(PG8_SB(0, 0), cB, voffB); PG8_STAGE(PG8_SB(0, 1), cB + hstepB, voffB); PG8_STAGE(PG8_SA(0, 0), cA, voffA); PG8_STAGE(PG8_SA(0, 1), cA + hstepA, voffA);
        if (wr == 1) PG8_BAR;
        PG8_WAIT_V(2); PG8_BAR;
        PG8_STAGE(PG8_SB(1, 0), cB + kstepB, voffB); PG8_STAGE(PG8_SA(1, 0), cA + kstepA, voffA); PG8_STAGE(PG8_SB(1, 1), cB + hstepB + kstepB, voffB);
        PG8_WAIT_V(6); PG8_BAR;
    } else {
        PG8_STAGE(PG8_SB(0, 0), cB, voffB); PG8_STAGE(PG8_SA(0, 0), cA, voffA); PG8_STAGE(PG8_SB(0, 1), cB + hstepB, voffB); PG8_STAGE(PG8_SA(0, 1), cA + hstepA, voffA);
        if (wr == 1) PG8_BAR;
        PG8_WAIT_V(4); PG8_BAR;
        PG8_STAGE(PG8_SB(1, 0), cB + kstepB, voffB); PG8_STAGE(PG8_SA(1, 0), cA + kstepA, voffA); PG8_STAGE(PG8_SB(1, 1), cB + hstepB + kstepB, voffB);
        PG8_WAIT_V(6); PG8_BAR;
    }
    for (;;) {
        const bool has_next = S.next(ui + 1, nxt);
        const char* nA = has_next ? PG8_ABASE(nxt) : cA; const char* nB = has_next ? PG8_BBASE(nxt) : cB;
        for (int t = 0; t < nt; t += 2) {
            const bool last = (t == nt - 2);
            const char* a1 = cA + (size_t)(t + 1) * kstepA;
            const char* a2 = last ? nA : cA + (size_t)(t + 2) * kstepA; const char* b2 = last ? nB : cB + (size_t)(t + 2) * kstepB;
            const char* a3 = a2 + kstepA; const char* b3 = b2 + kstepB;
            if (last && has_next) S.a_ready(nxt);
            if constexpr (SP2) {
            PG8_LDB(B0, 0, 0); PG8_LDB(B1, 0, 1); PG8_SCHED; PG8_LDA(At, 0, 0); PG8_STAGE(PG8_SA(1, 1), a1 + hstepA, voffA);
            PG8_WAIT_V(8); PG8_WAIT_L(0); PG8_BAR; PG8_MMA(0, 0, At, B0); PG8_MMA(0, 1, At, B1); PG8_BAR; PG8_SCHED;
            PG8_LDA(At, 0, 1); PG8_STAGE(PG8_SB(0, 0), b2, voffB); PG8_STAGE(PG8_SB(0, 1), b2 + hstepB, voffB); PG8_STAGE(PG8_SA(0, 0), a2, voffA);
            PG8_WAIT_V(8); PG8_WAIT_L(0); PG8_BAR; PG8_MMA(1, 0, At, B0); PG8_MMA(1, 1, At, B1); PG8_BAR; PG8_SCHED;
            PG8_LDB(B0, 1, 0); PG8_LDB(B1, 1, 1); PG8_SCHED; PG8_LDA(At, 1, 0); PG8_STAGE(PG8_SA(0, 1), a2 + hstepA, voffA);
            PG8_WAIT_V(8); PG8_WAIT_L(0); PG8_BAR; PG8_MMA(0, 0, At, B0); PG8_MMA(0, 1, At, B1); PG8_BAR; PG8_SCHED;
            PG8_LDA(At, 1, 1); PG8_STAGE(PG8_SB(1, 0), b3, voffB); PG8_STAGE(PG8_SB(1, 1), b3 + hstepB, voffB); PG8_STAGE(PG8_SA(1, 0), a3, voffA);
            PG8_WAIT_V(8); PG8_WAIT_L(0); PG8_BAR; PG8_MMA(1, 0, At, B0); PG8_MMA(1, 1, At, B1); PG8_BAR; PG8_SCHED;
            } else {
            PG8_LDB(B0, 0, 0); PG8_SCHED; PG8_LDA(At, 0, 0); PG8_STAGE(PG8_SA(1, 1), a1 + hstepA, voffA);
            PG8_WAIT_L(8); PG8_BAR; PG8_WAIT_L(0); PG8_MMA(0, 0, At, B0); PG8_BAR; PG8_SCHED;
            PG8_LDB(B1, 0, 1); PG8_STAGE(PG8_SB(0, 0), b2, voffB);
            PG8_BAR; PG8_WAIT_L(0); PG8_MMA(0, 1, At, B1); PG8_BAR;
            PG8_LDA(At, 0, 1); PG8_STAGE(PG8_SA(0, 0), a2, voffA);
            PG8_BAR; PG8_WAIT_L(0); PG8_MMA(1, 0, At, B0); PG8_BAR; PG8_SCHED;
            PG8_STAGE(PG8_SB(0, 1), b2 + hstepB, voffB);
            PG8_WAIT_V(6); PG8_BAR; PG8_MMA(1, 1, At, B1); PG8_BAR;
            PG8_LDB(B0, 1, 0); PG8_SCHED; PG8_LDA(At, 1, 0); PG8_STAGE(PG8_SA(0, 1), a2 + hstepA, voffA);
            PG8_WAIT_L(8); PG8_BAR; PG8_WAIT_L(0); PG8_MMA(0, 0, At, B0); PG8_BAR; PG8_SCHED;
            PG8_LDB(B1, 1, 1); PG8_STAGE(PG8_SB(1, 0), b3, voffB);
            PG8_BAR; PG8_WAIT_L(0); PG8_MMA(0, 1, At, B1); PG8_BAR;
            PG8_LDA(At, 1, 1); PG8_STAGE(PG8_SA(1, 0), a3, voffA);
            PG8_BAR; PG8_WAIT_L(0); PG8_MMA(1, 0, At, B0); PG8_BAR; PG8_SCHED;
            PG8_STAGE(PG8_SB(1, 1), b3 + hstepB, voffB);
            PG8_WAIT_V(6); PG8_BAR; PG8_MMA(1, 1, At, B1); PG8_BAR;
            }
        }
        if constexpr (ALIGN_EPI) { if (wr == 0) PG8_BAR; }
        if constexpr (!Epi::AFTER_DRAIN) { E(acc, cur, wr, wc, fr, fq); S.done(cur); }
        if (!has_next) break;
#pragma unroll
        for (int a = 0; a < 2; ++a)
#pragma unroll
            for (int b = 0; b < 2; ++b)
#pragma unroll
                for (int m = 0; m < 4; ++m)
#pragma unroll
                    for (int n = 0; n < 2; ++n) acc[a][b][m][n] = (i32x4){0, 0, 0, 0};
        cur = nxt; cA = nA; cB = nB; ++ui;
        if constexpr (ALIGN_EPI) { if (wr == 1) PG8_BAR; }
    }
    PG8_WAIT_V(0);
    if constexpr (!ALIGN_EPI) { if (wr == 0) PG8_BAR; }
    PG8_BAR;
    if constexpr (Epi::AFTER_DRAIN) { E.fused(acc, cur, wr, wc, fr, fq, lds, wid, lane); S.done(cur); }
#undef PG8_ABASE
#undef PG8_BBASE
#undef PG8_SA
#undef PG8_SB
#undef PG8_STAGE
#undef PG8_LDA
#undef PG8_LDB
#undef PG8_MMA
#undef PG8_WAIT_V
#undef PG8_WAIT_L
#undef PG8_BAR
#undef PG8_SCHED
}
}

constexpr int T = 8192, D = 2048, FF = 8192, DEPTH = 4;
constexpr int NH = 16, HD = 128, NKV = 4, TOPK = 256;
constexpr int A_IN = 5264, A_INP = 5376;
constexpr int C_Q = 0, C_K = 2048, C_V = 2560, C_IQ = 3072, C_IK = 5120, C_IW = 5248;
constexpr float EPS = 1e-6f;
constexpr int NWAVES = 8, NTHR = NWAVES * 64;

constexpr size_t MiB = 1u << 20;
constexpr size_t WS_CTL = 0, CTL_ZERO_BYTES = 1 * MiB;
constexpr size_t WS_COS128 = 1 * MiB, WS_SIN128 = 3 * MiB, WS_COS64 = 5 * MiB, WS_SIN64 = 6 * MiB;
constexpr size_t WS_IW = 7 * MiB;
constexpr size_t WS_AGGA = 8 * MiB, WS_AGGB = 9 * MiB;
constexpr size_t WS_WINA = 10 * MiB;
constexpr size_t WS_WOUTA = 52 * MiB;
constexpr size_t WS_WINR = 68 * MiB;
constexpr size_t WS_WGR = 84 * MiB;
constexpr size_t WS_WOUTR = 86 * MiB;
constexpr size_t WS_WPOOL = 94 * MiB;
constexpr size_t WS_WUP = 96 * MiB;
constexpr size_t WS_WDOWN = 224 * MiB;
constexpr size_t WS_BA = 352 * MiB;
constexpr size_t BA_SC = 0;
constexpr int SC_LD = T + 64;
constexpr size_t BA_O16 = 0;
constexpr size_t BA_U = 0;
constexpr size_t BA_AF = 0, BA_BF = 64 * MiB;
constexpr size_t BA_H16 = 128 * MiB;
constexpr size_t BA_PROJ = 160 * MiB;
constexpr size_t BA_XC = 224 * MiB;
constexpr size_t WS_QH = 616 * MiB, WS_KH = 632 * MiB, WS_VH = 636 * MiB, WS_IK = 640 * MiB, WS_SEL = 642 * MiB, WS_IQ = 650 * MiB, WS_PARTA = 686 * MiB, WS_PARTB = 687 * MiB, WS_BLKMAXD = 688 * MiB, WS_X16 = 692 * MiB, WS_END = 724 * MiB;
constexpr int CW_BAR = 4096;
constexpr size_t WS_BLKMAX = 682 * MiB;
constexpr size_t WS_RS = 7 * MiB + 512 * 1024, WS_CS = WS_RS + 64 * 1024;
constexpr size_t WS_RS2 = WS_RS + 128 * 1024, WS_CS2 = WS_RS + 192 * 1024, WS_CSUM = WS_RS + 208 * 1024;
constexpr size_t BA_U8 = 192 * MiB, BA_W8D = 176 * MiB;
constexpr size_t BA_A8 = 160 * MiB, BA_W8 = 176 * MiB;
constexpr size_t WS_ROWSQ = 256 * 1024;

constexpr int RING_BYTES = 131072;
constexpr int LDSCTL_OFF = RING_BYTES, MISC_OFF = LDSCTL_OFF + 320;
constexpr int LDS_BYTES = 155648;

#define GAS __attribute__((address_space(1)))
#define LAS __attribute__((address_space(3)))
typedef _Float16 h16;
typedef _Float16 h16x2 __attribute__((ext_vector_type(2)));
typedef _Float16 h16x4 __attribute__((ext_vector_type(4)));
typedef _Float16 h16x8 __attribute__((ext_vector_type(8)));
typedef unsigned v4u __attribute__((ext_vector_type(4)));
typedef unsigned v2u __attribute__((ext_vector_type(2)));
typedef float f32x4 __attribute__((ext_vector_type(4)));
#define LDS_WAIT() asm volatile("s_waitcnt lgkmcnt(0)" ::: "memory")
#define VM_WAIT() asm volatile("s_waitcnt vmcnt(0)" ::: "memory")
__device__ __forceinline__ unsigned pkh(float lo, float hi) { h16x2 v = {(h16)lo, (h16)hi}; return __builtin_bit_cast(unsigned, v); }
__device__ __forceinline__ float wave_sum(float v) {
#pragma unroll
    for (int o = 1; o < 64; o <<= 1) v += __shfl_xor(v, o);
    return v;
}
__device__ __forceinline__ float wave_max(float v) {
#pragma unroll
    for (int o = 1; o < 64; o <<= 1) v = fmaxf(v, __shfl_xor(v, o));
    return v;
}

#define XB_TMO      128
#define XB_XCNT(j)  (256  + 64 * (j))
#define XB_XSUB(j)  (1280 + 64 * (j))
#define XB_XGEN(j)  (2304 + 64 * (j))
#define XB_TOP      3328
#define XB_TOPGEN   3392
#define XCD_BAR_WORDS 3456
#define XB_SPIN_CAP (1u << 18)

__device__ __forceinline__ unsigned xb_ld(unsigned* p)              { return __hip_atomic_load(p, __ATOMIC_RELAXED, __HIP_MEMORY_SCOPE_AGENT); }
__device__ __forceinline__ unsigned xb_add(unsigned* p, unsigned v) { return __hip_atomic_fetch_add(p, v, __ATOMIC_RELAXED, __HIP_MEMORY_SCOPE_AGENT); }
__device__ __forceinline__ unsigned xb_xcc_id() { return (unsigned)__builtin_amdgcn_s_getreg((3 << 11) | 20) & 0xFu; }
#define XB_SPIN(cond, bar) do { unsigned _sp = 0; while (cond) { __builtin_amdgcn_s_sleep(1); \
    if ((++_sp & 255u) == 0u) { if (xb_ld(&(bar)[XB_TMO])) break; if (_sp > XB_SPIN_CAP) { atomicAdd(&(bar)[XB_TMO], 1u); break; } } } } while (0)

struct XcdBarrier { unsigned* bar; unsigned x; volatile LAS unsigned* st; };

__device__ __forceinline__ XcdBarrier xcd_barrier_post(unsigned* bar, volatile LAS unsigned* st) {
    XcdBarrier b; b.bar = bar; b.x = xb_xcc_id(); b.st = st;
    if (threadIdx.x == 0) (void)xb_add(&bar[XB_XCNT(b.x)], 1u);
    return b;
}
__device__ __forceinline__ void xcd_barrier_complete(unsigned* bar, unsigned x, unsigned& nloc, unsigned& nx) {
    const unsigned G = gridDim.x * gridDim.y * gridDim.z;
    unsigned sum, cnt, mine, sp = 0u;
    for (;;) {
        sum = 0u; cnt = 0u; mine = 0u;
#pragma unroll
        for (unsigned j = 0; j < 16; ++j) { const unsigned c = xb_ld(&bar[XB_XCNT(j)]); sum += c; cnt += (c > 0u) ? 1u : 0u; mine = (j == x) ? c : mine; }
        if (sum == G) break;
        __builtin_amdgcn_s_sleep(1);
        if ((++sp & 255u) == 0u) { if (xb_ld(&bar[XB_TMO])) break; if (sp > XB_SPIN_CAP) { atomicAdd(&bar[XB_TMO], 1u); break; } }
    }
    nloc = mine > 0u ? mine : 1u; nx = cnt > 0u ? cnt : 1u;
}
__device__ __forceinline__ void xcd_barrier(const XcdBarrier& b) {
    asm volatile("s_waitcnt vmcnt(0)" ::: "memory");
    __syncthreads();
    if (threadIdx.x == 0) {
        unsigned* bar = b.bar;
        __builtin_amdgcn_s_waitcnt(0);
        unsigned nloc = b.st[0], nx = b.st[1];
        if (nloc == 0u) { xcd_barrier_complete(bar, b.x, nloc, nx); b.st[0] = nloc; b.st[1] = nx; }
        const unsigned old = xb_add(&bar[XB_XSUB(b.x)], 1u);
        const unsigned gen = old / nloc;
        if (old + 1u == (gen + 1u) * nloc) {
            __builtin_amdgcn_fence(__ATOMIC_RELEASE, "agent");
            asm volatile("s_waitcnt vmcnt(0)" ::: "memory");
            const unsigned og = xb_add(&bar[XB_TOP], 1u);
            const unsigned tg = og / nx;
            if (og + 1u == (tg + 1u) * nx) xb_add(&bar[XB_TOPGEN], 1u);
            else XB_SPIN(xb_ld(&bar[XB_TOPGEN]) == tg, bar);
            __builtin_amdgcn_fence(__ATOMIC_ACQUIRE, "agent");
            xb_add(&bar[XB_XGEN(b.x)], 1u);
            asm volatile("s_waitcnt vmcnt(0)" ::: "memory");
        } else {
            XB_SPIN(xb_ld(&bar[XB_XGEN(b.x)]) == gen, bar);
            __builtin_amdgcn_fence(__ATOMIC_ACQUIRE, "agent");
            asm volatile("s_waitcnt vmcnt(0)" ::: "memory");
        }
    }
    __syncthreads();
}

__device__ __forceinline__ void tr_item(const float* src, int ldw, int nvalid, h16* dst, int ldd, LAS float* scr, int lane, unsigned* colmax = nullptr, const float* gk = nullptr) {
    const int nn = lane & 31; float v[32];
#pragma unroll
    for (int i = 0; i < 32; ++i) { const int kk = 2 * i + (lane >> 5); v[i] = (nn < nvalid) ? src[(size_t)kk * ldw + nn] * (gk ? gk[kk] : 1.0f) : 0.f; }
    __builtin_amdgcn_sched_barrier(0);
#pragma unroll
    for (int i = 0; i < 32; ++i) { const int kk = 2 * i + (lane >> 5); scr[kk * 33 + nn] = v[i]; }
    LDS_WAIT();
    const int c = lane & 7;
#pragma unroll
    for (int j = 0; j < 4; ++j) { const int n = (lane >> 3) + 8 * j; const LAS float* s = scr + (8 * c) * 33 + n;
        v4u o; o.x = pkh(s[0 * 33], s[1 * 33]); o.y = pkh(s[2 * 33], s[3 * 33]); o.z = pkh(s[4 * 33], s[5 * 33]); o.w = pkh(s[6 * 33], s[7 * 33]);
        *(v4u*)(dst + (size_t)n * ldd + 8 * c) = o;
        if (colmax) {
            float mx = fmaxf(fmaxf(fmaxf(fabsf(s[0 * 33]), fabsf(s[1 * 33])), fmaxf(fabsf(s[2 * 33]), fabsf(s[3 * 33]))), fmaxf(fmaxf(fabsf(s[4 * 33]), fabsf(s[5 * 33])), fmaxf(fabsf(s[6 * 33]), fabsf(s[7 * 33]))));
            mx = fmaxf(mx, __shfl_xor(mx, 1)); mx = fmaxf(mx, __shfl_xor(mx, 2)); mx = fmaxf(mx, __shfl_xor(mx, 4));
            if (c == 0) colmax[n] = __float_as_uint(mx); } }
    LDS_WAIT();
}

struct Ptrs {
    const float* x; const int* pos;
    const float *attn_norm, *attn_w_in, *attn_qn, *attn_kn, *attn_w_out;
    const float *rnn_norm, *rnn_w_in, *conv_w, *conv_b, *ga_w, *ga_b, *gx_w, *gx_b, *lam, *rnn_w_out;
    const float *pool_norm, *pool_w, *pool_b, *pool_scale;
    const float *mlp_norm, *mlp_w_up, *mlp_w_down;
    float* out; unsigned char* ws;
    int ph_lo, ph_hi;
};

#define CAS __attribute__((address_space(4)))
__device__ __forceinline__ const CAS Ptrs* kargs() { const CAS Ptrs* p = (const CAS Ptrs*)__builtin_amdgcn_kernarg_segment_ptr(); asm volatile("" : "+s"(p)); return p; }
__device__ __forceinline__ void p0_prologue(const CAS Ptrs* PP, LAS unsigned char* lds, int gw, int NGW, int wave, int lane, int gtid, int NGT) {
    LAS float* scr = (LAS float*)(lds + wave * 16384);
    unsigned char* ws = PP->ws;
    constexpr int I_WINA = 32 * 165, I_WOUTA = 32 * 64, I_WINR = 32 * 128, I_G = 4 * 8, I_WOUTR = 32 * 64, I_POOL = 8 * 16, I_UP = 32 * 256, I_DN = 128 * 64, I_Z = 384;
    constexpr int NITEMS = 2 * I_WINA + 2 * I_WOUTA + I_WINR + 16 * I_G + I_WOUTR + 4 * I_POOL + 4 * I_UP + 4 * I_DN + 2 * I_Z;
    for (int it = gw; it < NITEMS; it += NGW) {
        int r = it;
        if (r < 2 * I_WINA) { const int j = r / I_WINA; r -= j * I_WINA; const int kb = r / 165, nb = r % 165, n0 = 32 * nb; const int nv = (A_IN - n0) < 32 ? (A_IN - n0) : 32;
            tr_item(PP->attn_w_in + (size_t)j * D * A_IN + (size_t)(64 * kb) * A_IN + n0, A_IN, nv, (h16*)(ws + WS_WINA) + (size_t)j * A_INP * D + (size_t)n0 * D + 64 * kb, D, scr, lane, nullptr, PP->attn_norm + (size_t)j * D + 64 * kb); continue; }
        r -= 2 * I_WINA;
        if (r < 2 * I_WOUTA) { const int j = r / I_WOUTA; r -= j * I_WOUTA; const int kb = r / 64, nb = r % 64;
            tr_item(PP->attn_w_out + (size_t)j * D * D + (size_t)(64 * kb) * D + 32 * nb, D, 32, (h16*)(ws + WS_WOUTA) + (size_t)j * D * D + (size_t)(32 * nb) * D + 64 * kb, D, scr, lane); continue; }
        r -= 2 * I_WOUTA;
        if (r < I_WINR) { const int kb = r / 128, nb = r % 128;
            tr_item(PP->rnn_w_in + (size_t)(64 * kb) * 4096 + 32 * nb, 4096, 32, (h16*)(ws + WS_WINR) + (size_t)(32 * nb) * D + 64 * kb, D, scr, lane, nullptr, PP->rnn_norm + 64 * kb); continue; }
        r -= I_WINR;
        if (r < 16 * I_G) { const int mi = r / I_G; r -= mi * I_G; const int which = mi >> 3, blk = mi & 7, kb = r / 8, nb = r % 8, d0 = 32 * nb;
            const float* src = (which ? PP->gx_w : PP->ga_w) + (size_t)blk * 65536 + (size_t)(64 * kb) * 256 + d0;
            const int drow = 256 * (2 * blk + (d0 >> 7)) + 128 * which + (d0 & 127);
            tr_item(src, 256, 32, (h16*)(ws + WS_WGR) + (size_t)drow * 256 + 64 * kb, 256, scr, lane); continue; }
        r -= 16 * I_G;
        if (r < I_WOUTR) { const int kb = r / 64, nb = r % 64;
            tr_item(PP->rnn_w_out + (size_t)(64 * kb) * D + 32 * nb, D, 32, (h16*)(ws + WS_WOUTR) + (size_t)(32 * nb) * D + 64 * kb, D, scr, lane); continue; }
        r -= I_WOUTR;
        if (r < 4 * I_POOL) { const int g = r / I_POOL; r -= g * I_POOL; const int kb = r / 16, nb = r % 16;
            tr_item(PP->pool_w + (size_t)g * 262144 + (size_t)(64 * kb) * 512 + 32 * nb, 512, 32, (h16*)(ws + WS_WPOOL) + (size_t)(512 * g + 32 * nb) * 512 + 64 * kb, 512, scr, lane); continue; }
        r -= 4 * I_POOL;
        if (r < 4 * I_UP) { const int i = r / I_UP; r -= i * I_UP; const int kb = r / 256, nb = r % 256;
            tr_item(PP->mlp_w_up + (size_t)i * D * FF + (size_t)(64 * kb) * FF + 32 * nb, FF, 32, (h16*)(ws + WS_WUP) + (size_t)i * D * FF + (size_t)(32 * nb) * D + 64 * kb, D, scr, lane, (unsigned*)(ws + WS_BLKMAX) + ((size_t)i * 32 + kb) * FF + 32 * nb, PP->mlp_norm + (size_t)i * D + 64 * kb); continue; }
        r -= 4 * I_UP;
        if (r < 4 * I_DN) { const int i = r / I_DN; r -= i * I_DN; const int kb = r / 64, nb = r % 64;
            tr_item(PP->mlp_w_down + (size_t)i * D * FF + (size_t)(64 * kb) * D + 32 * nb, D, 32, (h16*)(ws + WS_WDOWN) + (size_t)i * D * FF + ((size_t)kb * D + 32 * nb) * 64, 64, scr, lane, (unsigned*)(ws + WS_BLKMAXD) + ((size_t)i * 128 + kb) * D + 32 * nb); continue; }
        r -= 4 * I_DN;
        { const int j = r / I_Z; r -= j * I_Z;
            v4u* z = (v4u*)((h16*)(ws + WS_WINA) + (size_t)j * A_INP * D + (size_t)5280 * D); z[(size_t)r * 64 + lane] = (v4u){0u, 0u, 0u, 0u}; }
    }
    for (int e = gtid; e < T * 96; e += NGT) {
        const int t = e / 96, i = e % 96; const bool big = i < 64; const int fi = big ? i : i - 64;
        const double base = big ? 0.8659643233600653 : 0.7498942093324559;
        double inv = 1.0; for (int k = 0; k < fi; ++k) inv *= base;
        const double ang = (double)PP->pos[t] * inv;
        const double n = __builtin_rint(ang * 0.15915494309189535); const double rr = ang - n * 6.283185307179586 - n * 2.4492935982947064e-16;
        const double r2 = rr * rr; double sn = 1.0, cs = 1.0;
#pragma unroll
        for (int k = 14; k >= 1; --k) { sn = 1.0 - sn * r2 * (1.0 / (double)((2 * k) * (2 * k + 1))); cs = 1.0 - cs * r2 * (1.0 / (double)((2 * k - 1) * (2 * k))); }
        sn *= rr;
        if (big) { ((float*)(ws + WS_COS128))[t * 64 + fi] = (float)cs; ((float*)(ws + WS_SIN128))[t * 64 + fi] = (float)sn; }
        else { ((float*)(ws + WS_COS64))[t * 32 + fi] = (float)cs; ((float*)(ws + WS_SIN64))[t * 32 + fi] = (float)sn; }
    }
}

__device__ __forceinline__ void quant_rows(const h16* src, int nrows, signed char* dst, float* scale_out, const float* rowsq, const unsigned* colmax, int gw, int NGW, int lane) {
    h16x8 vn[4]; float cmn = 0.f;
    if (gw < nrows) {
#pragma unroll
        for (int j = 0; j < 4; ++j) vn[j] = *(const h16x8*)(src + (size_t)gw * D + 512 * j + 8 * lane);
        if (colmax) cmn = lane < 32 ? __uint_as_float(colmax[(size_t)lane * FF + gw]) : 0.f; }
    for (int r = gw; r < nrows; r += NGW) {
        h16x8 v[4]; const float cm = cmn;
#pragma unroll
        for (int j = 0; j < 4; ++j) v[j] = vn[j];
        const int rn = r + NGW;
        if (rn < nrows) {
#pragma unroll
            for (int j = 0; j < 4; ++j) vn[j] = *(const h16x8*)(src + (size_t)rn * D + 512 * j + 8 * lane);
            if (colmax) cmn = lane < 32 ? __uint_as_float(colmax[(size_t)lane * FF + rn]) : 0.f; }
        float mx;
        if (colmax) mx = wave_max(cm);
        else { mx = 0.f;
#pragma unroll
            for (int j = 0; j < 4; ++j)
#pragma unroll
                for (int e = 0; e < 8; ++e) mx = fmaxf(mx, fabsf((float)v[j][e]));
            mx = wave_max(mx); }
        const float step = mx > 0.f ? mx * (1.0f / 127.0f) : 1.0f, inv = 1.0f / step;
        if (lane == 0) { float sc = step;
            if (rowsq) { const f32x4* pp = (const f32x4*)(rowsq + (size_t)r * 32); f32x4 a4 = pp[0];
#pragma unroll
                for (int q = 1; q < 8; ++q) a4 += pp[q];
                sc = step / sqrtf(((a4[0] + a4[1]) + (a4[2] + a4[3])) * (1.0f / D) + EPS); }
            scale_out[r] = sc; }
#pragma unroll
        for (int j = 0; j < 4; ++j) { unsigned w[2];
#pragma unroll
            for (int hh = 0; hh < 2; ++hh) { unsigned p = 0u;
#pragma unroll
                for (int e = 0; e < 4; ++e) { int qv = (int)rintf((float)v[j][4 * hh + e] * inv); qv = qv > 127 ? 127 : (qv < -127 ? -127 : qv); p |= ((unsigned)qv & 255u) << (8 * e); }
                w[hh] = p; }
            *(v2u*)(dst + (size_t)r * D + 512 * j + 8 * lane) = (v2u){w[0], w[1]}; }
    }
}
template <bool UNSIGNED>
__device__ __forceinline__ void quant_kblk(const h16* src, int R, signed char* dst, float* scale_out, float* csum, const unsigned* blkmax, int gw, int NGW, int lane) {
    const int bsub = lane >> 3, c8 = (lane & 7) * 8;
    h16x8 vn[16]; float cmn = 0.f;
#define QK_LOAD(r_) do { _Pragma("unroll") for (int i = 0; i < 16; ++i) vn[i] = *(const h16x8*)(src + ((size_t)(8 * i + bsub) * R + (r_)) * 64 + c8); \
        if (!UNSIGNED) cmn = fmaxf(__uint_as_float(blkmax[(size_t)lane * R + (r_)]), __uint_as_float(blkmax[(size_t)(64 + lane) * R + (r_)])); } while (0)
    if (gw < R) QK_LOAD(gw);
    for (int r = gw; r < R; r += NGW) {
        h16x8 v[16]; const float cm = cmn;
#pragma unroll
        for (int i = 0; i < 16; ++i) v[i] = vn[i];
        if (r + NGW < R) QK_LOAD(r + NGW);
        float mx;
        if (UNSIGNED) { mx = 0.f;
#pragma unroll
            for (int i = 0; i < 16; ++i)
#pragma unroll
                for (int e = 0; e < 8; ++e) mx = fmaxf(mx, (float)v[i][e]);
            mx = wave_max(mx); }
        else mx = wave_max(cm);
        const float step = mx > 0.f ? mx * (UNSIGNED ? 1.0f / 255.0f : 1.0f / 127.0f) : 1.0f, inv = 1.0f / step;
        int ssum = 0;
#pragma unroll
        for (int i = 0; i < 16; ++i) { unsigned w[2];
#pragma unroll
            for (int hh = 0; hh < 2; ++hh) { unsigned p = 0u;
#pragma unroll
                for (int e = 0; e < 4; ++e) { int qv = (int)rintf((float)v[i][4 * hh + e] * inv);
                    if (UNSIGNED) { qv = qv > 255 ? 255 : (qv < 0 ? 0 : qv); qv -= 128; } else { qv = qv > 127 ? 127 : (qv < -127 ? -127 : qv); ssum += qv; }
                    p |= ((unsigned)qv & 255u) << (8 * e); }
                w[hh] = p; }
            const int b = 8 * i + bsub;
            *(v2u*)(dst + ((size_t)(b >> 1) * R + r) * 128 + 64 * (b & 1) + c8) = (v2u){w[0], w[1]}; }
        if (!UNSIGNED) { float fs = (float)ssum; fs = wave_sum(fs); if (lane == 0) csum[r] = fs; }
        if (lane == 0) scale_out[r] = step;
    }
#undef QK_LOAD
}
__device__ __forceinline__ void norm0_phase(const float* src, h16* dst, float* rowsq, int gw, int NGW, int lane) {
    for (int m = gw; m < T; m += NGW) {
        const f32x4* xr = (const f32x4*)(src + (size_t)m * D) + lane;
        f32x4 v[8]; float s = 0.f;
#pragma unroll
        for (int j = 0; j < 8; ++j) { v[j] = xr[64 * j]; s += (v[j].x * v[j].x + v[j].y * v[j].y) + (v[j].z * v[j].z + v[j].w * v[j].w); }
        s = wave_sum(s); if (lane == 0) rowsq[m] = s;
        v2u* o = (v2u*)(dst + (size_t)m * D) + lane;
#pragma unroll
        for (int j = 0; j < 8; ++j) { v2u w; w.x = pkh(v[j].x, v[j].y); w.y = pkh(v[j].z, v[j].w); o[64 * j] = w; }
    }
}

__device__ __forceinline__ unsigned char f8(float x) { return (unsigned char)(__builtin_amdgcn_cvt_pk_fp8_f32(x, x, 0, false) & 0xFF); }
__device__ __forceinline__ float sum16(float v) { v += __shfl_xor(v, 1); v += __shfl_xor(v, 2); v += __shfl_xor(v, 4); v += __shfl_xor(v, 8); return v; }
__device__ __forceinline__ unsigned f8x4(float a, float b, float c, float d) { int p = __builtin_amdgcn_cvt_pk_fp8_f32(a, b, 0, false); p = __builtin_amdgcn_cvt_pk_fp8_f32(c, d, p, true); return (unsigned)p; }
__device__ __forceinline__ void dsa_post_phase(const h16* PROJ, const float* qn, const float* kn, const float* c128, const float* s128, const float* c64, const float* s64,
                                               unsigned char* Q8, unsigned char* K8, unsigned char* V8, h16* IQ, h16* IK, float* IW, int gw, int NGW, int lane) {
    const int hh = lane >> 4, m = lane & 15;
    const f32x4 gqa = *(const f32x4*)(qn + 4 * m), gqb = *(const f32x4*)(qn + 64 + 4 * m), gka = *(const f32x4*)(kn + 4 * m), gkb = *(const f32x4*)(kn + 64 + 4 * m);
    const bool rot = m < 8; const int ioa = rot ? 4 * m : 32 + 4 * m, iob = ioa + 32;
    for (int t = gw; t < T; t += NGW) {
        const h16* pr = PROJ + (size_t)t * A_INP;
        const f32x4 c = *(const f32x4*)(c128 + t * 64 + 4 * m), s = *(const f32x4*)(s128 + t * 64 + 4 * m);
        f32x4 ci = {1.f, 1.f, 1.f, 1.f}, si = {0.f, 0.f, 0.f, 0.f};
        if (rot) { ci = *(const f32x4*)(c64 + t * 32 + 4 * m); si = *(const f32x4*)(s64 + t * 32 + 4 * m); }
#pragma unroll
        for (int p = 0; p < 5; ++p) {
            const int cb = (p < 4 ? C_Q + (4 * p + hh) * HD : C_K + hh * HD) + 4 * m;
            const h16x4 a4 = *(const h16x4*)(pr + cb), b4 = *(const h16x4*)(pr + cb + 64);
            float a[4], b[4], ss = 0.f;
#pragma unroll
            for (int e = 0; e < 4; ++e) { a[e] = (float)a4[e]; b[e] = (float)b4[e]; ss += a[e] * a[e] + b[e] * b[e]; }
            const float rstd = 1.0f / sqrtf(sum16(ss) * (1.0f / HD) + EPS);
            float oa[4], ob[4];
#pragma unroll
            for (int e = 0; e < 4; ++e) { const float ya = a[e] * rstd * (p < 4 ? gqa[e] : gka[e]), yb = b[e] * rstd * (p < 4 ? gqb[e] : gkb[e]); oa[e] = ya * c[e] - yb * s[e]; ob[e] = yb * c[e] + ya * s[e]; }
            unsigned char* o8 = (p < 4 ? Q8 + (size_t)t * D + (4 * p + hh) * HD : K8 + (size_t)t * 512 + hh * HD) + 4 * m;
            *(unsigned*)o8 = f8x4(oa[0], oa[1], oa[2], oa[3]); *(unsigned*)(o8 + 64) = f8x4(ob[0], ob[1], ob[2], ob[3]);
        }
        { const h16x8 vv = *(const h16x8*)(pr + C_V + lane * 8);
          *(v2u*)(V8 + (size_t)t * 512 + lane * 8) = (v2u){f8x4((float)vv[0], (float)vv[1], (float)vv[2], (float)vv[3]), f8x4((float)vv[4], (float)vv[5], (float)vv[6], (float)vv[7])}; }
#pragma unroll
        for (int p = 0; p < 5; ++p) {
            const int hd = p < 4 ? 4 * p + hh : 0; const int cb = p < 4 ? C_IQ + hd * HD : C_IK;
            const h16x4 a4 = *(const h16x4*)(pr + cb + ioa), b4 = *(const h16x4*)(pr + cb + iob);
            h16x4 oa, ob;
#pragma unroll
            for (int e = 0; e < 4; ++e) { const float av = (float)a4[e], bv = (float)b4[e]; oa[e] = (h16)(av * ci[e] - bv * si[e]); ob[e] = (h16)(bv * ci[e] + av * si[e]); }
            if (p < 4) { *(h16x4*)(IQ + (size_t)t * D + hd * HD + ioa) = oa; *(h16x4*)(IQ + (size_t)t * D + hd * HD + iob) = ob; }
            else if (hh == 0) { *(h16x4*)(IK + (size_t)t * HD + ioa) = oa; *(h16x4*)(IK + (size_t)t * HD + iob) = ob; }
        }
        if (lane < 16) IW[t * 16 + lane] = (float)pr[C_IW + lane] * 0.02209708691207961f;
    }
}

__device__ __forceinline__ float relu_i(float x) { const int b = __float_as_int(x); return __int_as_float(b > 0 ? b : 0); }
constexpr int IDX_ITEMS = 8320, IDX_ROWB = 272, IDX_TILEB = 128 * IDX_ROWB;
__device__ __forceinline__ void idx_decode(int L, int& qb, int& kc) {
    int m = (int)((sqrtf(1.0f + 2.0f * (float)L) - 1.0f) * 0.5f);
    while (2 * (m + 1) * (m + 2) <= L) ++m;
    while (2 * m * (m + 1) > L) --m;
    const int rem = L - 2 * m * (m + 1); qb = 4 * m + rem / (m + 1); kc = rem % (m + 1);
}
constexpr int IDX_HDR = 2, IDX_WKT = 4;
__device__ __forceinline__ int idx_cut(int v) {
    int m = (int)((sqrtf((float)((1 + 2 * IDX_HDR) * (1 + 2 * IDX_HDR)) + 2.0f * (float)v) - (float)(1 + 2 * IDX_HDR)) * 0.5f);
    while (2 * (m + 1) * (m + 2) + 4 * IDX_HDR * (m + 1) <= v) ++m;
    while (2 * m * (m + 1) + 4 * IDX_HDR * m > v) --m;
    const int rem = v - (2 * m * (m + 1) + 4 * IDX_HDR * m), j = rem / (m + 1 + IDX_HDR), slot = rem % (m + 1 + IDX_HDR);
    return 2 * m * (m + 1) + j * (m + 1) + (slot < IDX_HDR ? 0 : slot - IDX_HDR);
}
__device__ __forceinline__ void idx_scores_phase(const h16* IQ, const h16* IK, const float* IW, h16* SC, LAS unsigned char* lds, int wg, int G, int tid, int wave, int lane) {
    const int L0 = idx_cut((int)(((long)(IDX_ITEMS + 256 * IDX_HDR) * wg) / G)), L1 = idx_cut((int)(((long)(IDX_ITEMS + 256 * IDX_HDR) * (wg + 1)) / G));
    if (L0 >= L1) return;
    int qb, kc; idx_decode(L0, qb, kc);
    const int fr = lane & 15, fq = lane >> 4;
    h16x8 st[4];
#define IDX_LOAD(kc_) do { _Pragma("unroll") for (int i = 0; i < 4; ++i) { const int p = tid + 512 * i; st[i] = *(const h16x8*)(IK + (size_t)((kc_) * 128 + (p >> 4)) * HD + (p & 15) * 8); } } while (0)
#define IDX_WRITE(buf_) do { _Pragma("unroll") for (int i = 0; i < 4; ++i) { const int p = tid + 512 * i; *(LAS h16x8*)(lds + (buf_) * IDX_TILEB + (p >> 4) * IDX_ROWB + (p & 15) * 16) = st[i]; } } while (0)
    IDX_LOAD(kc); IDX_WRITE(0);
    __syncthreads();
    int par = 0, L = L0;
#if TPROBE
    unsigned long long tp_acc = 0;
#define TP_T() ({ __builtin_amdgcn_sched_barrier(0); asm volatile("" ::: "memory"); unsigned long long t_ = __builtin_amdgcn_s_memrealtime(); asm volatile("s_waitcnt lgkmcnt(0)" ::: "memory"); __builtin_amdgcn_sched_barrier(0); t_; })
#define TP_BEG(n) unsigned long long tp0_##n = 0; if (TPROBE == n) tp0_##n = TP_T();
#define TP_END(n) if (TPROBE == n) tp_acc += TP_T() - tp0_##n;
#else
#define TP_BEG(n)
#define TP_END(n)
#endif
#pragma unroll 1
    while (L < L1) {
        int kend = kc + (L1 - L) - 1; if (kend > (qb >> 2)) kend = (qb >> 2);
        h16x8 a[4][4]; v4u A2[4][2];
        TP_BEG(3)
        { const int tq = 32 * qb + 4 * wave; f32x4 w4[4];
#pragma unroll
            for (int q = 0; q < 4; ++q) {
#pragma unroll
                for (int ks = 0; ks < 4; ++ks) a[q][ks] = *(const h16x8*)(IQ + (size_t)(tq + q) * D + fr * HD + ks * 32 + fq * 8);
                w4[q] = *(const f32x4*)(IW + (size_t)(tq + q) * 16 + 4 * fq); }
            __builtin_amdgcn_s_waitcnt(0x0F70);
            unsigned wp[4][2];
#pragma unroll
            for (int q = 0; q < 4; ++q) { wp[q][0] = pg8::pk_h2(w4[q][0], w4[q][1]); wp[q][1] = pg8::pk_h2(w4[q][2], w4[q][3]); }
#pragma unroll
            for (int r = 0; r < 4; ++r)
#pragma unroll
                for (int p = 0; p < 2; ++p) { const int i0 = 4 * r + 2 * p; const bool e0 = (fr == i0), e1 = (fr == i0 + 1);
                    A2[r][p] = (v4u){e0 ? wp[2 * p][0] : 0u, e0 ? wp[2 * p][1] : 0u, e1 ? wp[2 * p + 1][0] : 0u, e1 ? wp[2 * p + 1][1] : 0u}; } }
        __builtin_amdgcn_sched_barrier(0);
        TP_END(3)
#pragma unroll 1
        for (; kc <= kend; ++kc, ++L) {
            TP_BEG(2)
            const bool more = (L + 1 < L1);
            { const int kcp = more ? (kc < (qb >> 2) ? kc + 1 : 0) : kc; IDX_LOAD(kcp); }
            const LAS unsigned char* bb = lds + par * IDX_TILEB + fr * IDX_ROWB + fq * 16;
            h16x8 bq[2][4];
#pragma unroll
            for (int ks = 0; ks < 4; ++ks) bq[0][ks] = *(const LAS h16x8*)(bb + ks * 64);
            f32x4 d2 = {0.f, 0.f, 0.f, 0.f};
#pragma unroll
            for (int kt = 0; kt < 8; ++kt) {
                if (kt + 1 < 8) {
#pragma unroll
                    for (int ks = 0; ks < 4; ++ks) bq[(kt + 1) & 1][ks] = *(const LAS h16x8*)(bb + (kt + 1) * 16 * IDX_ROWB + ks * 64);
                    __builtin_amdgcn_sched_barrier(0); }
                const h16x8 (&b)[4] = bq[kt & 1];
#pragma unroll
                for (int p = 0; p < 2; ++p) { f32x4 s0 = {0.f, 0.f, 0.f, 0.f}, s1 = {0.f, 0.f, 0.f, 0.f};
#pragma unroll
                    for (int ks = 0; ks < 4; ++ks) { s0 = __builtin_amdgcn_mfma_f32_16x16x32_f16(a[2 * p][ks], b[ks], s0, 0, 0, 0); s1 = __builtin_amdgcn_mfma_f32_16x16x32_f16(a[2 * p + 1][ks], b[ks], s1, 0, 0, 0); }
                    const h16x2 z2 = {(h16)0.f, (h16)0.f};
                    h16x2 r0 = {(h16)s0[0], (h16)s0[1]}, r1 = {(h16)s0[2], (h16)s0[3]}, r2 = {(h16)s1[0], (h16)s1[1]}, r3 = {(h16)s1[2], (h16)s1[3]};
                    r0 = __builtin_elementwise_max(r0, z2); r1 = __builtin_elementwise_max(r1, z2); r2 = __builtin_elementwise_max(r2, z2); r3 = __builtin_elementwise_max(r3, z2);
                    const h16x8 b2 = {r0[0], r0[1], r1[0], r1[1], r2[0], r2[1], r3[0], r3[1]};
                    d2 = __builtin_amdgcn_mfma_f32_16x16x32_f16(__builtin_bit_cast(h16x8, A2[kt & 3][p]), b2, d2, 0, 0, 0); }
                if ((kt & 3) == 3) { const int tq = 32 * qb + 4 * wave;
#pragma unroll
                    for (int q = 0; q < 4; ++q) SC[(size_t)(tq + q) * SC_LD + kc * 128 + 64 * (kt >> 2) + lane] = (h16)d2[q];
                    d2 = (f32x4){0.f, 0.f, 0.f, 0.f}; }
                if (kt == IDX_WKT) { IDX_WRITE(par ^ 1); }
            }
            TP_BEG(1) TP_BEG(5)
            asm volatile("s_waitcnt lgkmcnt(0)" ::: "memory"); __builtin_amdgcn_s_barrier(); asm volatile("" ::: "memory");
            TP_END(5) TP_END(1) TP_END(2)
            par ^= 1;
        }
        ++qb; kc = 0;
    }
#if TPROBE
    { const unsigned long long t0 = __builtin_amdgcn_s_memrealtime(); while (__builtin_amdgcn_s_memrealtime() - t0 < (unsigned long long)TP_MULT * tp_acc) __builtin_amdgcn_s_sleep(2); }
#endif
#undef IDX_LOAD
#undef IDX_WRITE
}

template <int NR>
__device__ __forceinline__ unsigned kth_largest(const unsigned (&u)[NR], int K) {
    unsigned prefix = 0u;
#pragma unroll 1
    for (int bit = 15; bit >= 0; --bit) { const unsigned cand = prefix | (1u << bit); int cnt = 0;
#pragma unroll
        for (int i = 0; i < NR; ++i) { cnt += __builtin_popcountll(__ballot(u[i] >= cand)); if ((i & 31) == 31) __builtin_amdgcn_sched_barrier(0); }
        if (cnt >= K) prefix = cand; }
    return prefix;
}
template <int NR, bool ARR>
__device__ __forceinline__ void emit_topk(const unsigned (&u)[NR], unsigned thr_in, int* sel, const int (&keys)[ARR ? NR : 1], int lane) {
    unsigned thr = thr_in; int cgt = 0;
#pragma unroll
    for (int i = 0; i < NR; ++i) { cgt += __builtin_popcountll(__ballot(u[i] > thr)); if ((i & 7) == 7) __builtin_amdgcn_sched_barrier(0); }
    const int need = TOPK - cgt;
    asm volatile("" : "+s"(thr));
    int base = 0, eqseen = 0;
#pragma unroll
    for (int i = 0; i < NR; ++i) {
        const bool gt = u[i] > thr, eq = u[i] == thr;
        const unsigned long long eb = __ballot(eq);
        const int erank = eqseen + (int)__builtin_amdgcn_mbcnt_hi((unsigned)(eb >> 32), __builtin_amdgcn_mbcnt_lo((unsigned)eb, 0u));
        const bool take = gt || (eq && erank < need);
        const unsigned long long tb = __ballot(take);
        const int pos = base + (int)__builtin_amdgcn_mbcnt_hi((unsigned)(tb >> 32), __builtin_amdgcn_mbcnt_lo((unsigned)tb, 0u));
        if (take) sel[pos] = ARR ? keys[ARR ? i : 0] : 64 * i + lane;
        base += __builtin_popcountll(tb); eqseen += __builtin_popcountll(eb);
        __builtin_amdgcn_sched_barrier(0);
    }
}
constexpr int TK_CAP = 768, TK_TARGET = 448;
template <int NREG>
__device__ __forceinline__ void topk_load_row(unsigned (&u)[NREG], const h16* sc_in, int t_in, int lane) {
    static_assert(NREG % 16 == 0, "chunks of 16 registers");
#pragma unroll
    for (int c = 0; c < NREG / 16; ++c) {
        const GAS unsigned short* pc = (const GAS unsigned short*)(sc_in + 1024 * c); asm volatile("" : "+s"(pc));
#pragma unroll
        for (int k = 0; k < 16; ++k) u[16 * c + k] = (unsigned)pc[64 * k + lane];
    }
#pragma unroll
    for (int c = 0; c < NREG / 16; ++c) {
        int tl = t_in - 1024 * c; asm volatile("" : "+s"(tl));
#pragma unroll
        for (int k = 0; k < 16; ++k) { const unsigned b = u[16 * c + k]; const unsigned mk = (b >> 15) ? 0xFFFFu : 0x8000u; u[16 * c + k] = (lane <= tl - 64 * k) ? (b ^ mk) : 0u; }
        __builtin_amdgcn_sched_barrier(0);
    }
}
template <int NREG>
__device__ __forceinline__ void topk_row(const h16* sc_in, int t_in, int* sel, int lane_in, LAS unsigned long long* cand) {
    int lane = lane_in; asm volatile("" : "+v"(lane));
    if constexpr (NREG >= 64) {
        int cn = 0;
        {   unsigned u[NREG];
            topk_load_row<NREG>(u, sc_in, t_in, lane);
            constexpr int NS = NREG / 8;
            unsigned us[NS]; int nsv = 0;
#pragma unroll
            for (int s = 0; s < NS; ++s) { us[s] = u[8 * s]; const int rem = t_in + 1 - 512 * s; nsv += rem < 0 ? 0 : (rem > 64 ? 64 : rem); }
            int Ks = (TK_TARGET * nsv) / (t_in + 1); Ks = Ks < 1 ? 1 : Ks;
            unsigned tau = kth_largest<NS>(us, Ks);
            asm volatile("" : "+s"(tau));
#pragma unroll
            for (int c = 0; c < NREG / 16; ++c) {
                int kb = 1024 * c + lane; asm volatile("" : "+v"(kb));
#pragma unroll
                for (int k = 0; k < 16; ++k) { const int i = 16 * c + k; const bool m = u[i] >= tau && tau != 0u; const unsigned long long mb = __ballot(m);
                    const int pos = cn + (int)__builtin_amdgcn_mbcnt_hi((unsigned)(mb >> 32), __builtin_amdgcn_mbcnt_lo((unsigned)mb, 0u));
                    if (m && pos < TK_CAP) cand[pos] = ((unsigned long long)u[i] << 32) | (unsigned)(kb + 64 * k);
                    cn += __builtin_popcountll(mb); if ((k & 3) == 3) __builtin_amdgcn_sched_barrier(0); }
            }
        }
        asm volatile("" : "+s"(cn));
        if (cn >= TOPK && cn <= TK_CAP) {
            LDS_WAIT();
            unsigned cu[TK_CAP / 64]; int ck[TK_CAP / 64];
#pragma unroll
            for (int k = 0; k < TK_CAP / 64; ++k) { const int ix = 64 * k + lane; const unsigned long long v = cand[ix]; cu[k] = ix < cn ? (unsigned)(v >> 32) : 0u; ck[k] = (int)(unsigned)v; }
            const unsigned thr = kth_largest<TK_CAP / 64>(cu, TOPK);
            emit_topk<TK_CAP / 64, true>(cu, thr, sel, ck, lane);
            LDS_WAIT();
            return;
        }
    }
    {   unsigned u[NREG];
        topk_load_row<NREG>(u, sc_in, t_in, lane);
        const unsigned thr = kth_largest<NREG>(u, TOPK);
        const int nokeys[1] = {0}; emit_topk<NREG, false>(u, thr, sel, nokeys, lane); }
}
__device__ __forceinline__ void topk_phase(const h16* SC, int* SEL, LAS unsigned char* lds, int gw, int NGW, int wave, int lane) {
    LAS unsigned long long* cand = (LAS unsigned long long*)(lds + wave * (TK_CAP * 8));
    for (int t = gw; t < T; t += NGW) {
        const h16* sc = SC + (size_t)t * SC_LD; int* sel = SEL + (size_t)t * TOPK;
        if (t < TOPK) {
#pragma unroll
            for (int j = 0; j < 4; ++j) { const int k = lane + 64 * j; sel[k] = (k <= t) ? k : -1; }
        } else if (t < 2048) topk_row<32>(sc, t, sel, lane, cand);
        else if (t < 4096) topk_row<64>(sc, t, sel, lane, cand);
        else if (t < 6144) topk_row<96>(sc, t, sel, lane, cand);
        else topk_row<128>(sc, t, sel, lane, cand);
    }
}

__device__ __forceinline__ float dot8(h16x8 a, h16x8 b, float c) {
#if __has_builtin(__builtin_amdgcn_fdot2)
    c = __builtin_amdgcn_fdot2((h16x2){a[0], a[1]}, (h16x2){b[0], b[1]}, c, false); c = __builtin_amdgcn_fdot2((h16x2){a[2], a[3]}, (h16x2){b[2], b[3]}, c, false);
    c = __builtin_amdgcn_fdot2((h16x2){a[4], a[5]}, (h16x2){b[4], b[5]}, c, false); c = __builtin_amdgcn_fdot2((h16x2){a[6], a[7]}, (h16x2){b[6], b[7]}, c, false);
#else
#pragma unroll
    for (int e = 0; e < 8; ++e) c += (float)a[e] * (float)b[e];
#endif
    return c;
}
__device__ __forceinline__ void attn_phase(const h16* QH, const h16* KH, const h16* VH, const int* SEL, h16* O, LAS unsigned char* lds, int wg, int G, int wave, int lane) {
    LAS h16* qs = (LAS h16*)(lds + wave * 6144);
    LAS float* ps = (LAS float*)(lds + wave * 6144 + 1024);
    LAS int* is = (LAS int*)(lds + wave * 6144 + 5120);
    const int grp = lane >> 4, c = lane & 15;
    for (int L = wg; L < (T / 8) * NKV; L += G) {
        const int g = L & 3, t = 8 * (L >> 2) + wave;
        int idx[4];
#pragma unroll
        for (int j = 0; j < 4; ++j) idx[j] = SEL[(size_t)t * TOPK + lane + 64 * j];
        *(LAS h16x8*)(qs + lane * 8) = *(const h16x8*)(QH + (size_t)t * D + g * 512 + lane * 8);
#pragma unroll
        for (int j = 0; j < 4; ++j) is[lane + 64 * j] = idx[j] < 0 ? 0 : idx[j];
        LDS_WAIT();
        float sc[4][4];
#pragma unroll
        for (int j = 0; j < 4; ++j) { const h16* krow = KH + (size_t)(idx[j] < 0 ? 0 : idx[j]) * 512 + g * HD; h16x8 kf[16];
#pragma unroll
            for (int cc = 0; cc < 16; ++cc) kf[cc] = *(const h16x8*)(krow + 8 * cc);
#pragma unroll
            for (int hh = 0; hh < 4; ++hh) { float s = 0.f;
#pragma unroll
                for (int cc = 0; cc < 16; ++cc) s = dot8(kf[cc], *(const LAS h16x8*)(qs + hh * HD + 8 * cc), s);
                sc[j][hh] = (idx[j] < 0) ? -__builtin_inff() : s * 0.08838834764831845f; }
            __builtin_amdgcn_sched_barrier(0); }
#pragma unroll
        for (int hh = 0; hh < 4; ++hh) {
            const float mx = wave_max(fmaxf(fmaxf(sc[0][hh], sc[1][hh]), fmaxf(sc[2][hh], sc[3][hh])));
            float e0 = __expf(sc[0][hh] - mx), e1 = __expf(sc[1][hh] - mx), e2 = __expf(sc[2][hh] - mx), e3 = __expf(sc[3][hh] - mx);
            const float inv = 1.0f / wave_sum((e0 + e1) + (e2 + e3));
            sc[0][hh] = e0 * inv; sc[1][hh] = e1 * inv; sc[2][hh] = e2 * inv; sc[3][hh] = e3 * inv; }
#pragma unroll
        for (int j = 0; j < 4; ++j) *(LAS f32x4*)(ps + 4 * (lane + 64 * j)) = (f32x4){sc[j][0], sc[j][1], sc[j][2], sc[j][3]};
        LDS_WAIT();
        float acc[4][8];
#pragma unroll
        for (int hh = 0; hh < 4; ++hh)
#pragma unroll
            for (int e = 0; e < 8; ++e) acc[hh][e] = 0.f;
#pragma unroll 4
        for (int it = 0; it < 64; ++it) { const int kk = 4 * it + grp; const int ik = is[kk]; const f32x4 p4 = *(const LAS f32x4*)(ps + 4 * kk);
            const h16x8 v8 = *(const h16x8*)(VH + (size_t)ik * 512 + g * HD + 8 * c);
#pragma unroll
            for (int hh = 0; hh < 4; ++hh)
#pragma unroll
                for (int e = 0; e < 8; ++e) acc[hh][e] += p4[hh] * (float)v8[e];
            if ((it & 3) == 3) __builtin_amdgcn_sched_barrier(0); }
#pragma unroll
        for (int hh = 0; hh < 4; ++hh)
#pragma unroll
            for (int e = 0; e < 8; ++e) { float v = acc[hh][e]; v += __shfl_xor(v, 16); v += __shfl_xor(v, 32); acc[hh][e] = v; }
        float o8[8];
#pragma unroll
        for (int e = 0; e < 8; ++e) o8[e] = grp == 0 ? acc[0][e] : grp == 1 ? acc[1][e] : grp == 2 ? acc[2][e] : acc[3][e];
        v4u w; w.x = pkh(o8[0], o8[1]); w.y = pkh(o8[2], o8[3]); w.z = pkh(o8[4], o8[5]); w.w = pkh(o8[6], o8[7]);
        *(v4u*)(O + (size_t)t * D + (4 * g + grp) * HD + 8 * c) = w;
        LDS_WAIT();
    }
}

__device__ __forceinline__ void conv_phase(const h16* PROJ, const float* cw, const float* cb, h16* XC, int gtid, int NGT) {
    h16x8 xn[4];
#define CONV_LOAD(i_) do { const int c8_ = ((i_) & 255) * 8, t_ = (i_) >> 8; _Pragma("unroll") for (int j = 0; j < 4; ++j) { const int tt = t_ - 3 + j; xn[j] = *(const h16x8*)(PROJ + (size_t)(tt < 0 ? 0 : tt) * 4096 + 2048 + c8_); } } while (0)
    if (gtid < T * 256) CONV_LOAD(gtid);
    for (int i = gtid; i < T * 256; i += NGT) { const int c8 = (i & 255) * 8, t = i >> 8;
        h16x8 xv[4];
#pragma unroll
        for (int j = 0; j < 4; ++j) xv[j] = xn[j];
        if (i + NGT < T * 256) CONV_LOAD(i + NGT);
        float acc[8];
#pragma unroll
        for (int e = 0; e < 8; ++e) acc[e] = cb[c8 + e];
#pragma unroll
        for (int j = 0; j < 4; ++j) { const int tt = t - 3 + j; if (tt >= 0) {
            const f32x4 w0 = *(const f32x4*)(cw + j * 2048 + c8), w1 = *(const f32x4*)(cw + j * 2048 + c8 + 4);
#pragma unroll
            for (int e = 0; e < 4; ++e) { acc[e] += (float)xv[j][e] * w0[e]; acc[4 + e] += (float)xv[j][4 + e] * w1[e]; } } }
        v4u w; w.x = pkh(acc[0], acc[1]); w.y = pkh(acc[2], acc[3]); w.z = pkh(acc[4], acc[5]); w.w = pkh(acc[6], acc[7]);
        *(v4u*)(XC + (size_t)t * 2048 + c8) = w; }
#undef CONV_LOAD
}
constexpr int SCAN_LC = 64, SCAN_NCH = T / SCAN_LC;
__device__ __forceinline__ f32x4 ld_a4(const h16* LA, size_t o) { const h16x4 v = *(const h16x4*)(LA + o); return (f32x4){__expf((float)v[0]), __expf((float)v[1]), __expf((float)v[2]), __expf((float)v[3])}; }
__device__ __forceinline__ f32x4 ld_b4(const h16* BF, size_t o) { const h16x4 v = *(const h16x4*)(BF + o); return (f32x4){(float)v[0], (float)v[1], (float)v[2], (float)v[3]}; }
__device__ __forceinline__ void scan_agg_phase(const h16* AF, const h16* BF, float* AGGA, float* AGGB, int gtid, int NGT) {
    for (int i = gtid; i < SCAN_NCH * 512; i += NGT) { const int cg = (i & 511) * 4, k = i >> 9;
        f32x4 Pr = {1.f, 1.f, 1.f, 1.f}, H = {0.f, 0.f, 0.f, 0.f};
#pragma unroll 16
        for (int r = 0; r < SCAN_LC; ++r) { const size_t o = (size_t)(k * SCAN_LC + r) * 2048 + cg; const f32x4 a = ld_a4(AF, o), b = ld_b4(BF, o); H = a * H + b; Pr = Pr * a; }
        *(f32x4*)(AGGA + (size_t)k * 2048 + cg) = Pr; *(f32x4*)(AGGB + (size_t)k * 2048 + cg) = H; }
}
__device__ __forceinline__ float gelu_tanh(float x) { const float u = 0.7978845608028654f * (x + 0.044715f * x * x * x); const float e = __expf(2.0f * u); const float th = 1.0f - 2.0f / (e + 1.0f); return 0.5f * x * (1.0f + th); }
__device__ __forceinline__ void scan_final_phase(const h16* AF, const h16* BF, const float* AGGA, const float* AGGB, const h16* PROJ, h16* Y, int gtid, int NGT) {
    for (int i = gtid; i < SCAN_NCH * 512; i += NGT) { const int cg = (i & 511) * 4, k = i >> 9;
        f32x4 H = {0.f, 0.f, 0.f, 0.f};
#pragma unroll 8
        for (int j = 0; j < k; ++j) { const f32x4 a = *(const f32x4*)(AGGA + (size_t)j * 2048 + cg), b = *(const f32x4*)(AGGB + (size_t)j * 2048 + cg); H = a * H + b; }
#pragma unroll 8
        for (int r = 0; r < SCAN_LC; ++r) { const int t = k * SCAN_LC + r; const size_t o = (size_t)t * 2048 + cg; const f32x4 a = ld_a4(AF, o), b = ld_b4(BF, o); H = a * H + b;
            const h16x4 gt = *(const h16x4*)(PROJ + (size_t)t * 4096 + cg);
            v2u w; w.x = pkh(H[0] * gelu_tanh((float)gt[0]), H[1] * gelu_tanh((float)gt[1])); w.y = pkh(H[2] * gelu_tanh((float)gt[2]), H[3] * gelu_tanh((float)gt[3]));
            *(v2u*)(Y + o) = w; } }
}
__device__ __forceinline__ f32x4 ldx4(const h16* p) { const h16x4 v = *(const h16x4*)p; return (f32x4){(float)v[0], (float)v[1], (float)v[2], (float)v[3]}; }
__device__ __forceinline__ void pool_phase(const h16* X, const float* gain, h16* Y, LAS unsigned char* lds, int wg, int G, int tid, int wave, int lane) {
    LAS float* rs = (LAS float*)lds;
    const int c4 = tid * 4; const int w = 2 << (tid >> 7);
    const f32x4 gn = *(const f32x4*)(gain + c4);
    for (int u = wg; u < T / 32; u += G) { const int t0 = 32 * u;
        __syncthreads();
        for (int r = wave; r < 47; r += NWAVES) { const int t = t0 - 15 + r;
            if (t >= 0) { const h16* xr = X + (size_t)t * D + 4 * lane; float s = 0.f;
#pragma unroll
                for (int j = 0; j < 8; ++j) { const f32x4 v = ldx4(xr + 256 * j); s += (v.x * v.x + v.y * v.y) + (v.z * v.z + v.w * v.w); }
                s = wave_sum(s); if (lane == 0) rs[r] = 1.0f / sqrtf(s * (1.0f / D) + EPS); } }
        __syncthreads();
        f32x4 sum = {0.f, 0.f, 0.f, 0.f};
        { const int n0 = (t0 + 1) < w ? (t0 + 1) : w;
          for (int j = 1; j < n0; ++j) sum += ldx4(X + (size_t)(t0 - j) * D + c4) * rs[15 - j]; }
#pragma unroll 8
        for (int r = 0; r < 32; ++r) { const int t = t0 + r; const int n = (t + 1) < w ? (t + 1) : w;
            const f32x4 h0 = ldx4(X + (size_t)t * D + c4) * rs[15 + r];
            sum += h0;
            const float invn = 1.0f / (float)n;
            const f32x4 y = (sum * invn - h0) * gn;
            v2u o; o.x = pkh(y.x, y.y); o.y = pkh(y.z, y.w); *(v2u*)(Y + (size_t)t * D + c4) = o;
            if (t + 1 >= w) sum -= ldx4(X + (size_t)(t + 1 - w) * D + c4) * rs[15 + r + 1 - w]; }
    }
}

__device__ __forceinline__ h16x8 f8x8_to_h(unsigned d0, unsigned d1) {
    const h16x2 a = __builtin_amdgcn_cvt_scalef32_pk_f16_fp8((int)d0, 1.0f, false), b = __builtin_amdgcn_cvt_scalef32_pk_f16_fp8((int)d0, 1.0f, true);
    const h16x2 c = __builtin_amdgcn_cvt_scalef32_pk_f16_fp8((int)d1, 1.0f, false), d = __builtin_amdgcn_cvt_scalef32_pk_f16_fp8((int)d1, 1.0f, true);
    return (h16x8){a[0], a[1], b[0], b[1], c[0], c[1], d[0], d[1]};
}
__device__ __forceinline__ unsigned attn_off_b(unsigned row, unsigned ch) { return 256u * row + 16u * (ch ^ (((row & 3u) << 2) | ((row >> 2) & 3u))); }
__device__ __forceinline__ void attn_mfma_phase(const unsigned char* Q8, const unsigned char* K8, const unsigned char* V8, const int* SEL, h16* O, LAS unsigned char* lds, int wg, int G, int wave, int lane_in) {
    typedef int i32x4 __attribute__((ext_vector_type(4)));
    typedef int i32x2 __attribute__((ext_vector_type(2)));
    typedef long i64x2 __attribute__((ext_vector_type(2)));
    i32x4 svn = {0, 0, 0, 0}; i64x2 qfn[2] = {{0, 0}, {0, 0}};
#define AT_PREF(L_) do { const int g_ = (L_) & 3, t_ = 8 * ((L_) >> 2) + wave; svn = *(const i32x4*)(SEL + (size_t)t_ * TOPK + 4 * lane_in); \
        _Pragma("unroll") for (int pp = 0; pp < 2; ++pp) qfn[pp] = *(const i64x2*)(Q8 + (size_t)t_ * D + (4 * g_ + (lane_in & 3)) * HD + 64 * pp + 16 * (lane_in >> 4)); } while (0)
    v4u kga[4], kgb[4];
#define AT_LOADK2(buf, G_, selk_, kbase_) do { const i32x2 i0 = *(const LAS i32x2*)((selk_) + 2 * (G_)), i1 = *(const LAS i32x2*)((selk_) + 128 + 2 * (G_)); \
            buf[0] = *(const v4u*)((kbase_) + (size_t)(i0.x < 0 ? 0 : i0.x) * 512); buf[1] = *(const v4u*)((kbase_) + (size_t)(i1.x < 0 ? 0 : i1.x) * 512); \
            buf[2] = *(const v4u*)((kbase_) + (size_t)(i0.y < 0 ? 0 : i0.y) * 512); buf[3] = *(const v4u*)((kbase_) + (size_t)(i1.y < 0 ? 0 : i1.y) * 512); } while (0)
#define AT_PREP(L_, par_) do { LAS int* sst_ = (LAS int*)(lds + LDSCTL_OFF + 1024 + wave * 2048 + (par_) * 1024); *(LAS i32x4*)(sst_ + 4 * lane_in) = svn; \
        asm volatile("s_waitcnt lgkmcnt(0)" ::: "memory"); \
        const LAS int* selk_ = sst_ + 16 * (lane_in >> 3); const unsigned char* kbase_ = K8 + ((L_) & 3) * HD + 16 * (lane_in & 7); \
        AT_LOADK2(kga, 0, selk_, kbase_); AT_LOADK2(kgb, 1, selk_, kbase_); } while (0)
    if (wg < (T / 8) * NKV) { AT_PREF(wg); AT_PREP(wg, 0); }
    int itpar = 0;
    for (int L = wg; L < (T / 8) * NKV; L += G, itpar ^= 1) {
        int lane = lane_in; asm volatile("" : "+v"(lane));
        const int jl = lane & 15, gi = lane >> 4;
        const int g = L & 3, t = 8 * (L >> 2) + wave;
        const int* sel = SEL + (size_t)t * TOPK; (void)sel;
        const int nvalid = (t + 1) < TOPK ? (t + 1) : TOPK;
        LAS int* sst = (LAS int*)(lds + LDSCTL_OFF + 1024 + wave * 2048 + itpar * 1024);
        i64x2 qf[2];
#pragma unroll
        for (int pp = 0; pp < 2; ++pp) qf[pp] = qfn[pp];
        LAS unsigned char* vimg = lds + wave * 16384;
        const LAS int* selk = sst + 16 * (lane >> 3);
        const unsigned char* kbase = K8 + g * HD + 16 * (lane & 7);
        const unsigned kwr = 136u * (unsigned)(lane >> 3) + 16u * (unsigned)(lane & 7), krd = 136u * (unsigned)jl + 16u * (unsigned)gi;
        f32x4 s[16];
#define AT_LOADK(buf, G_) AT_LOADK2(buf, G_, selk, kbase)
#define AT_KSTEP(buf, G_) do { LAS unsigned char* kb_ = vimg + ((G_) & 1) * 8192; \
            _Pragma("unroll") for (int j = 0; j < 4; ++j) { *(LAS v2u*)(kb_ + kwr + 1088 * j) = (v2u){buf[j].x, buf[j].y}; *(LAS v2u*)(kb_ + kwr + 1088 * j + 8) = (v2u){buf[j].z, buf[j].w}; } \
            if ((G_) + 2 < 8) AT_LOADK(buf, (G_) + 2); \
            _Pragma("unroll") for (int tt = 0; tt < 2; ++tt) { f32x4 acc = {0.f, 0.f, 0.f, 0.f}; \
                _Pragma("unroll") for (int pp = 0; pp < 2; ++pp) { const long a0 = *(const LAS long*)(kb_ + krd + 2176 * tt + 64 * pp), a1 = *(const LAS long*)(kb_ + krd + 2176 * tt + 64 * pp + 8); \
                    acc = __builtin_amdgcn_mfma_f32_16x16x32_fp8_fp8(a0, qf[pp].x, acc, 0, 0, 0); acc = __builtin_amdgcn_mfma_f32_16x16x32_fp8_fp8(a1, qf[pp].y, acc, 0, 0, 0); } \
                s[2 * (G_) + tt] = acc; } } while (0)
        if (L + G < (T / 8) * NKV) AT_PREF(L + G);
        AT_KSTEP(kga, 0); AT_KSTEP(kgb, 1); AT_KSTEP(kga, 2); AT_KSTEP(kgb, 3); AT_KSTEP(kga, 4); AT_KSTEP(kgb, 5); AT_KSTEP(kga, 6); AT_KSTEP(kgb, 7);
#undef AT_LOADK
#undef AT_KSTEP
        const LAS int* selv = sst + ((lane >> 5) & 1) + 16 * ((lane >> 3) & 3);
        const unsigned char* vbase = V8 + g * HD + 16 * (lane & 7);
        v4u vsa[4], vsb[4];
#define AT_LOADV(vst, Tt) do { _Pragma("unroll") for (int i = 0; i < 4; ++i) { const int ix = selv[2 * (Tt) + 64 * i]; vst[i] = *(const v4u*)(vbase + (size_t)(ix < 0 ? 0 : ix) * 512); } } while (0)
        AT_LOADV(vsa, 0); AT_LOADV(vsb, 1);
        __builtin_amdgcn_sched_barrier(0);
        if (nvalid < TOPK) {
#pragma unroll
            for (int kt = 0; kt < 16; ++kt)
#pragma unroll
                for (int r = 0; r < 4; ++r) if (kt + 64 * gi + 16 * r >= nvalid) s[kt][r] = -__builtin_inff();
        }
        float mx = -__builtin_inff();
#pragma unroll
        for (int kt = 0; kt < 16; ++kt) mx = fmaxf(mx, fmaxf(fmaxf(s[kt][0], s[kt][1]), fmaxf(s[kt][2], s[kt][3])));
        mx = fmaxf(mx, __shfl_xor(mx, 16)); mx = fmaxf(mx, __shfl_xor(mx, 32));
        constexpr float C2 = 0.08838834764831845f * 1.4426950408889634f;
        const float mb = -mx * C2; float sum = 0.f;
        h16x8 pf[8];
#pragma unroll
        for (int Tt = 0; Tt < 8; ++Tt) { float p[8];
#pragma unroll
            for (int r = 0; r < 4; ++r) { p[r] = __builtin_amdgcn_exp2f(fmaf(s[2 * Tt][r], C2, mb)); p[4 + r] = __builtin_amdgcn_exp2f(fmaf(s[2 * Tt + 1][r], C2, mb)); }
            sum += ((p[0] + p[1]) + (p[2] + p[3])) + ((p[4] + p[5]) + (p[6] + p[7]));
            pf[Tt] = (h16x8){(h16)p[0], (h16)p[1], (h16)p[2], (h16)p[3], (h16)p[4], (h16)p[5], (h16)p[6], (h16)p[7]}; }
        sum += __shfl_xor(sum, 16); sum += __shfl_xor(sum, 32);
        const float linv = 1.0f / sum;
        const unsigned q4 = (unsigned)jl >> 2, p4 = (unsigned)jl & 3u;
        unsigned wr_off[8], rd_off[2];
#pragma unroll
        for (int i = 0; i < 4; ++i) { wr_off[2 * i] = attn_off_b((unsigned)((lane >> 3) + 8 * i), 2u * (lane & 7)); wr_off[2 * i + 1] = attn_off_b((unsigned)((lane >> 3) + 8 * i), 2u * (lane & 7) + 1u); }
#pragma unroll
        for (int tt = 0; tt < 2; ++tt) { const unsigned row = 8u * gi + 4u * tt + q4; const unsigned x = ((row & 3u) << 2) | ((row >> 2) & 3u);
            rd_off[tt] = 256u * row + 16u * ((p4 >> 1) ^ (x & 1u)) + 8u * (p4 & 1u) + 32u * (x >> 1); }
        f32x4 o[8];
#pragma unroll
        for (int c = 0; c < 8; ++c) o[c] = (f32x4){0.f, 0.f, 0.f, 0.f};
#define AT_STEP(vst, Tt) do { \
            _Pragma("unroll") for (int i = 0; i < 4; ++i) {     \
                *(LAS h16x8*)(vimg + ((Tt) & 1) * 8192 + wr_off[2 * i]) = f8x8_to_h(vst[i].x, vst[i].y); *(LAS h16x8*)(vimg + ((Tt) & 1) * 8192 + wr_off[2 * i + 1]) = f8x8_to_h(vst[i].z, vst[i].w); } \
            if ((Tt) + 2 < 8) AT_LOADV(vst, (Tt) + 2); \
            const unsigned ib = (unsigned)(size_t)(vimg + ((Tt) & 1) * 8192); \
            h16x4 lo[8], hi[8]; \
            asm volatile("s_waitcnt lgkmcnt(0)" ::: "memory"); \
            _Pragma("unroll") for (int c = 0; c < 8; ++c) { \
                asm volatile("ds_read_b64_tr_b16 %0, %1" : "=&v"(lo[c]) : "v"(ib + (rd_off[0] ^ ((unsigned)c << 5))) : "memory"); \
                asm volatile("ds_read_b64_tr_b16 %0, %1" : "=&v"(hi[c]) : "v"(ib + (rd_off[1] ^ ((unsigned)c << 5))) : "memory"); } \
            asm volatile("s_waitcnt lgkmcnt(0)" ::: "memory"); __builtin_amdgcn_sched_barrier(0); \
            _Pragma("unroll") for (int c = 0; c < 8; ++c) o[c] = __builtin_amdgcn_mfma_f32_16x16x32_f16(pf[Tt], (h16x8){lo[c][0], lo[c][1], lo[c][2], lo[c][3], hi[c][0], hi[c][1], hi[c][2], hi[c][3]}, o[c], 0, 0, 0); \
        } while (0)
        AT_STEP(vsa, 0); AT_STEP(vsb, 1); AT_STEP(vsa, 2); AT_STEP(vsb, 3); AT_STEP(vsa, 4); AT_STEP(vsb, 5); AT_STEP(vsa, 6); AT_STEP(vsb, 7);
#undef AT_STEP
#undef AT_LOADV
        const float li = __shfl(linv, gi);
        h16* orow = O + (size_t)t * D + (4 * g + gi) * HD + jl;
#pragma unroll
        for (int c = 0; c < 8; ++c) { const float v = gi == 0 ? o[c][0] : gi == 1 ? o[c][1] : gi == 2 ? o[c][2] : o[c][3]; orow[16 * c] = (h16)(v * li); }
        asm volatile("s_waitcnt lgkmcnt(0)" ::: "memory");
        if (L + G < (T / 8) * NKV) AT_PREP(L + G, itpar ^ 1);
    }
#undef AT_PREF
#undef AT_PREP
#undef AT_LOADK2
}

constexpr int NPH = 37;
__global__ void __launch_bounds__(NTHR, 2) fwd_kernel(Ptrs P_unused) {
    extern __shared__ __attribute__((aligned(16))) unsigned char lds_raw[];
    LAS unsigned char* lds = (LAS unsigned char*)lds_raw;
    volatile LAS unsigned* MISC = (volatile LAS unsigned*)(lds + MISC_OFF);
    for (int u = threadIdx.x; u < (LDS_BYTES - LDSCTL_OFF) / 4; u += NTHR) ((LAS unsigned*)(lds + LDSCTL_OFF))[u] = 0u;
    __syncthreads();
    int lo, hi;
    XcdBarrier bar;
    { const CAS Ptrs* PP = kargs(); lo = PP->ph_lo; hi = PP->ph_hi; unsigned* bw = (unsigned*)(PP->ws + WS_CTL) + CW_BAR;
      bar.bar = bw; bar.x = 0; bar.st = nullptr; if (hi - lo > 1) bar = xcd_barrier_post(bw, MISC + 8); }
    int seq = 0;
#define PH_BEGIN(S_) if (seq >= lo && seq < hi) { const CAS Ptrs* PP = kargs(); unsigned char* const ws = PP->ws; float* const X = PP->out; (void)X; \
        int tid = threadIdx.x, bx = blockIdx.x, G = gridDim.x; asm volatile("" : "+v"(tid), "+s"(bx), "+s"(G)); \
        const int lane = tid & 63, wave = __builtin_amdgcn_readfirstlane(tid >> 6); const int vcu = (G % 8 == 0) ? (bx % 8) * (G / 8) + bx / 8 : bx; \
        const int gw = vcu * NWAVES + wave, NGW = G * NWAVES, gtid = vcu * NTHR + tid, NGT = G * NTHR; (void)lane; (void)gw; (void)NGW; (void)gtid; (void)NGT; \
        for (int rep_ = 0; rep_ < 1 + (int)((REP_MASK >> (S_)) & 1u); ++rep_) { if (rep_) __syncthreads(); \
        h16* const X16 = (h16*)(ws + WS_X16); h16* const PROJ = (h16*)(ws + WS_BA + BA_PROJ); h16* const U16 = (h16*)(ws + WS_BA + BA_U); (void)X16; (void)PROJ; (void)U16;
#define PH_END   } if (seq + 1 < hi) xcd_barrier(bar); } ++seq;
#define RSQ(i_) ((float*)(ws + WS_CTL + WS_ROWSQ) + (size_t)(i_) * T)
#define PARTA ((float*)(ws + WS_PARTA))
#define PARTB ((float*)(ws + WS_PARTB))

    PH_BEGIN(0) p0_prologue(PP, lds, gw, NGW, wave, lane, gtid, NGT); norm0_phase(PP->x, X16, RSQ(0), gw, NGW, lane); PH_END

#pragma unroll 1
    for (int layer = 0; layer < DEPTH; ++layer) {
        const int kind = layer % 3, j = layer / 3;
        if (kind == 0) {
            PH_BEGIN(2) { pg8::Gemm g{X16, (const h16*)(ws + WS_WINA) + (size_t)j * A_INP * D, T, A_INP, D, D, 1 << 20, D, 128, 128}; pg8::StaticOrder S; S.init(T, A_INP, G, bx);
                       pg8::EpiF16<0> E{PROJ, A_INP, layer == 0 ? RSQ(0) : PARTB, 0, layer == 0 ? 0 : 32}; pg8::gemm_phase<pg8::EpiF16<0>, pg8::StaticOrder, true, true>(lds, g, S, E, tid); } PH_END
            PH_BEGIN(3) dsa_post_phase(PROJ, PP->attn_qn + j * HD, PP->attn_kn + j * HD, (const float*)(ws + WS_COS128), (const float*)(ws + WS_SIN128), (const float*)(ws + WS_COS64), (const float*)(ws + WS_SIN64),
                                    (unsigned char*)(ws + WS_QH), (unsigned char*)(ws + WS_KH), (unsigned char*)(ws + WS_VH), (h16*)(ws + WS_IQ), (h16*)(ws + WS_IK), (float*)(ws + WS_IW), gw, NGW, lane); PH_END
            PH_BEGIN(4) idx_scores_phase((const h16*)(ws + WS_IQ), (const h16*)(ws + WS_IK), (const float*)(ws + WS_IW), (h16*)(ws + WS_BA + BA_SC), lds, vcu, G, tid, wave, lane); PH_END
            PH_BEGIN(5) topk_phase((const h16*)(ws + WS_BA + BA_SC), (int*)(ws + WS_SEL), lds, gw, NGW, wave, lane); PH_END
            PH_BEGIN(6) attn_mfma_phase((const unsigned char*)(ws + WS_QH), (const unsigned char*)(ws + WS_KH), (const unsigned char*)(ws + WS_VH), (const int*)(ws + WS_SEL), (h16*)(ws + WS_BA + BA_O16), lds, bx, G, wave, lane); PH_END
            PH_BEGIN(7) { pg8::Gemm g{(const h16*)(ws + WS_BA + BA_O16), (const h16*)(ws + WS_WOUTA) + (size_t)j * D * D, T, D, D, D, 1 << 20, D, 128, 128}; pg8::StaticOrder S; S.init(T, D, G, bx);
                       pg8::EpiResid E{X16, X16, nullptr, D, nullptr, nullptr, PARTA}; pg8::gemm_phase<pg8::EpiResid, pg8::StaticOrder, true, true>(lds, g, S, E, tid); } PH_END
        } else if (kind == 1) {
            PH_BEGIN(9) { pg8::Gemm g{X16, (const h16*)(ws + WS_WINR), T, 4096, D, D, 1 << 20, D, 128, 128}; pg8::StaticOrder S; S.init(T, 4096, G, bx);
                       pg8::EpiF16<0> E{PROJ, 4096, layer == 0 ? RSQ(0) : PARTB, 0, layer == 0 ? 0 : 32}; pg8::gemm_phase<pg8::EpiF16<0>, pg8::StaticOrder, true, true>(lds, g, S, E, tid); } PH_END
            PH_BEGIN(10) conv_phase(PROJ, PP->conv_w, PP->conv_b, (h16*)(ws + WS_BA + BA_XC), gtid, NGT); PH_END
            PH_BEGIN(11) { int kg = 256; asm volatile("" : "+s"(kg));
                       pg8::Gemm g{(const h16*)(ws + WS_BA + BA_XC), (const h16*)(ws + WS_WGR), T, 4096, kg, D, 2, kg, 128, 128}; pg8::StaticOrder S; S.init(T, 4096, G, bx);
                       pg8::EpiGates E{(const h16*)(ws + WS_BA + BA_XC), PP->ga_b, PP->gx_b, PP->lam, (h16*)(ws + WS_BA + BA_AF), (h16*)(ws + WS_BA + BA_BF)};
                       pg8::gemm_phase<pg8::EpiGates, pg8::StaticOrder, true, true>(lds, g, S, E, tid); } PH_END
            PH_BEGIN(12) scan_agg_phase((const h16*)(ws + WS_BA + BA_AF), (const h16*)(ws + WS_BA + BA_BF), (float*)(ws + WS_AGGA), (float*)(ws + WS_AGGB), gtid, NGT); PH_END
            PH_BEGIN(13) scan_final_phase((const h16*)(ws + WS_BA + BA_AF), (const h16*)(ws + WS_BA + BA_BF), (const float*)(ws + WS_AGGA), (const float*)(ws + WS_AGGB), PROJ, (h16*)(ws + WS_BA + BA_XC), gtid, NGT); PH_END
            PH_BEGIN(14) { pg8::Gemm g{(const h16*)(ws + WS_BA + BA_XC), (const h16*)(ws + WS_WOUTR), T, D, D, D, 1 << 20, D, 128, 128}; pg8::StaticOrder S; S.init(T, D, G, bx);
                       pg8::EpiResid E{X16, X16, nullptr, D, nullptr, nullptr, PARTA}; pg8::gemm_phase<pg8::EpiResid, pg8::StaticOrder, true, true>(lds, g, S, E, tid); } PH_END
        } else {
            PH_BEGIN(15) pool_phase(X16, PP->pool_norm, (h16*)(ws + WS_BA + BA_XC), lds, vcu, G, tid, wave, lane); PH_END
            PH_BEGIN(16) { pg8::Gemm g{(const h16*)(ws + WS_BA + BA_XC), (const h16*)(ws + WS_WPOOL), T, D, 512, D, 2, 512, 128, 128}; pg8::StaticOrder S; S.init(T, D, G, bx);
                       pg8::EpiResid E{X16, X16, nullptr, D, PP->pool_b, PP->pool_scale, PARTA}; pg8::gemm_phase<pg8::EpiResid, pg8::StaticOrder, true, true>(lds, g, S, E, tid); } PH_END
        }
        PH_BEGIN(17) quant_rows(X16, T, (signed char*)(ws + WS_BA + BA_A8), (float*)(ws + WS_RS), PARTA, nullptr, gw, NGW, lane);
                     quant_rows((const h16*)(ws + WS_WUP) + (size_t)layer * D * FF, FF, (signed char*)(ws + WS_BA + BA_W8), (float*)(ws + WS_CS), nullptr, (const unsigned*)(ws + WS_BLKMAX) + (size_t)layer * 32 * FF, gw, NGW, lane); PH_END
        PH_BEGIN(18) { pg8::Gemm g{(const h16*)(ws + WS_BA + BA_A8), (const h16*)(ws + WS_BA + BA_W8), T, FF, D / 2, D / 2, 1 << 20, D / 2, 128, 128}; pg8::StaticOrder S; S.init(T, FF, G, bx);
                   pg8::EpiQRelu2<pg8::i32x4> E{U16, (const float*)(ws + WS_RS), (const float*)(ws + WS_CS), T}; pg8::gemm_phase_i8<pg8::EpiQRelu2<pg8::i32x4>, pg8::StaticOrder, true, true>(lds, g, S, E, tid); } PH_END
        PH_BEGIN(19) quant_kblk<true>(U16, T, (signed char*)(ws + WS_BA + BA_U8), (float*)(ws + WS_RS2), nullptr, nullptr, gw, NGW, lane);
                     quant_kblk<false>((const h16*)(ws + WS_WDOWN) + (size_t)layer * D * FF, D, (signed char*)(ws + WS_BA + BA_W8D), (float*)(ws + WS_CS2), (float*)(ws + WS_CSUM), (const unsigned*)(ws + WS_BLKMAXD) + (size_t)layer * 128 * D, gw, NGW, lane); PH_END
        PH_BEGIN(20) { pg8::Gemm g{(const h16*)(ws + WS_BA + BA_U8), (const h16*)(ws + WS_BA + BA_W8D), T, D, FF / 2, 64, 1 << 20, 64, (size_t)T * 128, (size_t)D * 128}; pg8::StaticOrder S; S.init(T, D, G, bx);
                   const bool lastl = layer + 1 >= DEPTH, needsq = !lastl && (layer + 1) % 3 != 2;
                   pg8::EpiResidQ E{X16, X16, lastl ? X : nullptr, D, (const float*)(ws + WS_RS2), (const float*)(ws + WS_CS2), (const float*)(ws + WS_CSUM), needsq ? PARTB : nullptr};
                   pg8::gemm_phase_i8<pg8::EpiResidQ, pg8::StaticOrder, true, true>(lds, g, S, E, tid); } PH_END
    }
#undef PH_BEGIN
#undef PH_END
#undef RSQ
#undef PARTA
#undef PARTB
}

extern "C" void kernel_launch(void* const* d_in, const int* in_sizes, int n_in, void* d_out, int out_size, void* d_ws, size_t ws_size, hipStream_t stream) {
    static int grid = 0;
    if (grid == 0) {
        if (n_in != 24 || in_sizes[0] != T * D || out_size != T * D || ws_size < WS_END) { fprintf(stderr, "kernel_launch: unexpected shapes / workspace (n_in %d, in0 %d, out %d, ws %zu, need %zu); nothing launched\n", n_in, n_in > 0 ? in_sizes[0] : -1, out_size, ws_size, (size_t)WS_END); grid = -1; return; }
        int dev = 0, cus = 0, per_cu = 0;
        if (hipGetDevice(&dev) != hipSuccess || hipDeviceGetAttribute(&cus, hipDeviceAttributeMultiprocessorCount, dev) != hipSuccess) { grid = -1; return; }
        if (hipFuncSetAttribute((const void*)fwd_kernel, hipFuncAttributeMaxDynamicSharedMemorySize, LDS_BYTES) != hipSuccess) { fprintf(stderr, "kernel_launch: hipFuncSetAttribute failed\n"); grid = -1; return; }
        if (hipOccupancyMaxActiveBlocksPerMultiprocessor(&per_cu, (const void*)fwd_kernel, NTHR, LDS_BYTES) != hipSuccess || per_cu < 1) { fprintf(stderr, "kernel_launch: occupancy query reports %d workgroups per CU\n", per_cu); }
        (void)hipGetLastError();
        grid = cus;
    }
    if (grid < 0) return;
    if (hipMemsetAsync((char*)d_ws + WS_CTL, 0, CTL_ZERO_BYTES, stream) != hipSuccess) return;
    Ptrs p{};
    p.x = (const float*)d_in[0]; p.pos = (const int*)d_in[1];
    p.attn_norm = (const float*)d_in[2]; p.attn_w_in = (const float*)d_in[3]; p.attn_qn = (const float*)d_in[4]; p.attn_kn = (const float*)d_in[5]; p.attn_w_out = (const float*)d_in[6];
    p.rnn_norm = (const float*)d_in[7]; p.rnn_w_in = (const float*)d_in[8]; p.conv_w = (const float*)d_in[9]; p.conv_b = (const float*)d_in[10]; p.ga_w = (const float*)d_in[11]; p.ga_b = (const float*)d_in[12];
    p.gx_w = (const float*)d_in[13]; p.gx_b = (const float*)d_in[14]; p.lam = (const float*)d_in[15]; p.rnn_w_out = (const float*)d_in[16];
    p.pool_norm = (const float*)d_in[17]; p.pool_w = (const float*)d_in[18]; p.pool_b = (const float*)d_in[19]; p.pool_scale = (const float*)d_in[20];
    p.mlp_norm = (const float*)d_in[21]; p.mlp_w_up = (const float*)d_in[22]; p.mlp_w_down = (const float*)d_in[23];
    p.out = (float*)d_out; p.ws = (unsigned char*)d_ws;
#if MK_SPLIT
    for (int ph = 0; ph < NPH; ++ph) { p.ph_lo = ph; p.ph_hi = ph + 1; hipLaunchKernelGGL(fwd_kernel, dim3(grid), dim3(NTHR), LDS_BYTES, stream, p); }
#else
    p.ph_lo = 0; p.ph_hi = NPH; hipLaunchKernelGGL(fwd_kernel, dim3(grid), dim3(NTHR), LDS_BYTES, stream, p);
#endif
}
```

```cpp
#include <hip/hip_runtime.h>
#include <cstdio>
#include <cstdint>

#ifndef REP_MASK
#define REP_MASK 0u
#ifndef TPROBE
#define TPROBE 0
#endif
#ifndef TP_MULT
#define TP_MULT 4
#endif
#ifndef TPH_SITE
#define TPH_SITE (-1)
#define TPH_MULT 1
#endif
#endif
#ifndef MK_SPLIT
#define MK_SPLIT 0
#endif

namespace pg8 {
#define PG8_LAS __attribute__((address_space(3)))
typedef _Float16 bf16_t;
typedef _Float16 bf16x8 __attribute__((ext_vector_type(8)));
typedef float f32x4 __attribute__((ext_vector_type(4)));
typedef unsigned u32x4 __attribute__((ext_vector_type(4)));
typedef unsigned u32x2 __attribute__((ext_vector_type(2)));
typedef _Float16 h16x2 __attribute__((ext_vector_type(2)));
typedef _Float16 h16x4 __attribute__((ext_vector_type(4)));
typedef _Float16 h16x8e __attribute__((ext_vector_type(8)));
constexpr int BM = 256, BK = 64, HALF = 128, HTB = HALF * BK * 2  , STAGE_BYTES = 8 * HTB, NXCD = 8, WGM = 8;

__host__ __device__ __forceinline__ int lds_byte(int r, int c) { const int st = (r >> 4) * 2 + (c >> 5), rr = r & 15, cc = c & 31, ob = rr * 64 + cc * 2; return st * 1024 + (ob ^ (((ob >> 9) & 1) << 5)); }
__host__ __device__ __forceinline__ void stage_rc(int b, int& R, int& C) { const int st = b / 1024, sb = b % 1024, swz = sb ^ (((sb >> 9) & 1) << 5); R = (st >> 1) * 16 + swz / 64; C = (st & 1) * 32 + (swz % 64) / 2; }
__host__ __device__ __forceinline__ int perm32(int rho) { const int n = rho >> 4, i = rho & 15; return 8 * (i >> 2) + 4 * n + (i & 3); }

struct Unit { int pm, pn; };
struct Gemm { const bf16_t* A; const bf16_t* Bt; int M, N, K, lda, npg, ldb; size_t kstepA, kstepB; };

struct StaticOrder {
    int nM, nN, nwg, G, c;
    __host__ __device__ void init(int M, int N, int G_, int c_) { nM = M / BM; nN = N / BM; nwg = nM * nN; G = G_; c = c_; }
    __host__ __device__ bool next(int i, Unit& u) const {
        const long L = (long)i * G + c; if (L >= nwg) return false;
        int wgid = (int)L; { const int q = nwg / NXCD, r = nwg % NXCD, xcd = wgid % NXCD, off = wgid / NXCD; wgid = (xcd < r ? xcd * (q + 1) : r * (q + 1) + (xcd - r) * q) + off; }
        const int nig = WGM * nN, gid = wgid / nig, fm = gid * WGM, gsz = (nM - fm) < WGM ? (nM - fm) : WGM;
        u.pm = fm + ((wgid % nig) % gsz); u.pn = (wgid % nig) / gsz; return true;
    }
    __device__ __forceinline__ void a_ready(const Unit&) const {}
    __device__ __forceinline__ void done(const Unit&) const {}
};

__device__ __forceinline__ unsigned pk_h2(float lo, float hi) { h16x2 v = {(_Float16)lo, (_Float16)hi}; return __builtin_bit_cast(unsigned, v); }

template <int ACT> struct EpiF16 {
    static constexpr bool PERM = true, WIDE = true, AFTER_DRAIN = false;
    bf16_t* O; int ldc; const float* rowsq; int kblk_rows; int npart;
    __device__ __forceinline__ void operator()(const f32x4 (&acc)[2][2][4][2], const Unit& u, int wr, int wc, int fr, int fq) const {
        const int row0 = u.pm * BM + wr * 64 + fr, col0 = u.pn * BM + wc * 64 + 8 * fq;
#pragma unroll
        for (int ai = 0; ai < 2; ++ai)
#pragma unroll
            for (int m = 0; m < 4; ++m) { const int row = row0 + ai * HALF + m * 16;
                bf16_t* rowp = kblk_rows ? O + ((size_t)(col0 >> 6) * kblk_rows + row) * 64 + (col0 & 63) : O + (size_t)row * ldc + col0;
                const size_t bjstep = 32;
                float rs = 1.0f; if (rowsq) { float ssq;
                    if (npart) { const f32x4* pp = (const f32x4*)(rowsq + (size_t)row * 32); f32x4 a4 = pp[0];
#pragma unroll
                        for (int q = 1; q < 8; ++q) a4 += pp[q];
                        ssq = (a4[0] + a4[1]) + (a4[2] + a4[3]); }
                    else ssq = rowsq[row];
                    rs = 1.0f / sqrtf(ssq * (1.0f / 2048.0f) + 1e-6f); if (ACT == 1) rs = rs * rs; }
#pragma unroll
                for (int bj = 0; bj < 2; ++bj) { f32x4 v0 = acc[ai][bj][m][0], v1 = acc[ai][bj][m][1];
                    if (ACT == 1) {
#pragma unroll
                        for (int j = 0; j < 4; ++j) { const float a = fmaxf(v0[j], 0.f), b = fmaxf(v1[j], 0.f); v0[j] = a * a; v1[j] = b * b; } }
                    v0 = v0 * rs; v1 = v1 * rs;
                    u32x4 w; w.x = pk_h2(v0[0], v0[1]); w.y = pk_h2(v0[2], v0[3]); w.z = pk_h2(v1[0], v1[1]); w.w = pk_h2(v1[2], v1[3]);
                    *(u32x4*)(rowp + bj * bjstep) = w; } }
    }
};
typedef int i32x4e __attribute__((ext_vector_type(4)));
template <class AccV> struct EpiQRelu2;
template <class AccV> struct EpiQRelu2 {
    static constexpr bool PERM = true, WIDE = true, AFTER_DRAIN = false;
    bf16_t* O; const float* rs; const float* cs; int kblk_rows;
    __device__ __forceinline__ void operator()(const AccV (&acc)[2][2][4][2], const Unit& u, int wr, int wc, int fr, int fq) const {
        const int row0 = u.pm * BM + wr * 64 + fr, col0 = u.pn * BM + wc * 64 + 8 * fq;
        f32x4 cv[2][2];
#pragma unroll
        for (int bj = 0; bj < 2; ++bj)
#pragma unroll
            for (int n = 0; n < 2; ++n) cv[bj][n] = *(const f32x4*)(cs + col0 + bj * 32 + 4 * n);
#pragma unroll
        for (int ai = 0; ai < 2; ++ai)
#pragma unroll
            for (int m = 0; m < 4; ++m) { const int row = row0 + ai * HALF + m * 16; const float r = rs[row];
                bf16_t* rowp = O + ((size_t)(col0 >> 6) * kblk_rows + row) * 64 + (col0 & 63); const size_t bjstep = 32;
#pragma unroll
                for (int bj = 0; bj < 2; ++bj) { f32x4 v0, v1;
#pragma unroll
                    for (int j = 0; j < 4; ++j) { const float a = fmaxf((float)acc[ai][bj][m][0][j] * (r * cv[bj][0][j]), 0.f), b = fmaxf((float)acc[ai][bj][m][1][j] * (r * cv[bj][1][j]), 0.f); v0[j] = a * a; v1[j] = b * b; }
                    u32x4 w; w.x = pk_h2(v0[0], v0[1]); w.y = pk_h2(v0[2], v0[3]); w.z = pk_h2(v1[0], v1[1]); w.w = pk_h2(v1[2], v1[3]);
                    *(u32x4*)(rowp + bj * bjstep) = w; } }
    }
};
struct EpiResid {
    static constexpr bool PERM = true, WIDE = true, AFTER_DRAIN = false;
    const bf16_t* res; bf16_t* out; float* out32; int ldc; const float* bias; const float* scale; float* rowsq;
    __device__ __forceinline__ void operator()(const f32x4 (&acc)[2][2][4][2], const Unit& u, int wr, int wc, int fr, int fq) const {
        const int row0 = u.pm * BM + wr * 64 + fr, col0 = u.pn * BM + wc * 64 + 8 * fq;
#pragma unroll
        for (int ai = 0; ai < 2; ++ai)
#pragma unroll
            for (int m = 0; m < 4; ++m) { const int row = row0 + ai * HALF + m * 16; const size_t off = (size_t)row * ldc + col0; float sq = 0.f;
#pragma unroll
                for (int bj = 0; bj < 2; ++bj) { const int cc = bj * 32; const h16x8e rh = *(const h16x8e*)(res + off + cc); float o[8];
#pragma unroll
                    for (int n = 0; n < 2; ++n) { const f32x4 bv = bias ? *(const f32x4*)(bias + col0 + cc + 4 * n) : (f32x4){0.f, 0.f, 0.f, 0.f}, sv = scale ? *(const f32x4*)(scale + col0 + cc + 4 * n) : (f32x4){1.f, 1.f, 1.f, 1.f};
#pragma unroll
                        for (int j = 0; j < 4; ++j) { o[4 * n + j] = (float)rh[4 * n + j] + (acc[ai][bj][m][n][j] + bv[j]) * sv[j]; sq += o[4 * n + j] * o[4 * n + j]; } }
                    if (out32) { *(f32x4*)(out32 + off + cc) = (f32x4){o[0], o[1], o[2], o[3]}; *(f32x4*)(out32 + off + cc + 4) = (f32x4){o[4], o[5], o[6], o[7]}; }
                    else { u32x4 w; w.x = pk_h2(o[0], o[1]); w.y = pk_h2(o[2], o[3]); w.z = pk_h2(o[4], o[5]); w.w = pk_h2(o[6], o[7]); *(u32x4*)(out + off + cc) = w; } }
                if (rowsq) { sq += __shfl_xor(sq, 16); sq += __shfl_xor(sq, 32); if (fq == 0) rowsq[(size_t)row * 32 + u.pn * 4 + wc] = sq; }
                asm volatile("" ::: "memory"); }
    }
};
struct EpiResidQ {
    static constexpr bool PERM = true, WIDE = true, AFTER_DRAIN = false;
    const bf16_t* res; bf16_t* out; float* out32; int ldc; const float* rs; const float* cs; const float* csum; float* rowsq;
    __device__ __forceinline__ void operator()(const i32x4e (&acc)[2][2][4][2], const Unit& u, int wr, int wc, int fr, int fq) const {
        const int row0 = u.pm * BM + wr * 64 + fr, col0 = u.pn * BM + wc * 64 + 8 * fq;
#pragma unroll
        for (int ai = 0; ai < 2; ++ai)
#pragma unroll
            for (int m = 0; m < 4; ++m) { const int row = row0 + ai * HALF + m * 16; const size_t off = (size_t)row * ldc + col0; float sq = 0.f; const float rsv = rs[row];
#pragma unroll
                for (int bj = 0; bj < 2; ++bj) { const int cc = bj * 32; const h16x8e rh = *(const h16x8e*)(res + off + cc); float o[8];
#pragma unroll
                    for (int n = 0; n < 2; ++n) { const f32x4 cv = *(const f32x4*)(cs + col0 + cc + 4 * n), zv = *(const f32x4*)(csum + col0 + cc + 4 * n);
#pragma unroll
                        for (int j = 0; j < 4; ++j) { o[4 * n + j] = (float)rh[4 * n + j] + (rsv * cv[j]) * ((float)acc[ai][bj][m][n][j] + 128.0f * zv[j]); sq += o[4 * n + j] * o[4 * n + j]; } }
                    if (out32) { *(f32x4*)(out32 + off + cc) = (f32x4){o[0], o[1], o[2], o[3]}; *(f32x4*)(out32 + off + cc + 4) = (f32x4){o[4], o[5], o[6], o[7]}; }
                    else { u32x4 w; w.x = pk_h2(o[0], o[1]); w.y = pk_h2(o[2], o[3]); w.z = pk_h2(o[4], o[5]); w.w = pk_h2(o[6], o[7]); *(u32x4*)(out + off + cc) = w; } }
                if (rowsq) { sq += __shfl_xor(sq, 16); sq += __shfl_xor(sq, 32); if (fq == 0) rowsq[(size_t)row * 32 + u.pn * 4 + wc] = sq; }
                asm volatile("" ::: "memory"); }
    }
};
struct EpiGates {
    static constexpr bool PERM = false, WIDE = false, AFTER_DRAIN = false;
    const bf16_t* XC; const float* ba; const float* bx; const float* lam; bf16_t* AF; bf16_t* BF;
    __device__ __forceinline__ void operator()(const f32x4 (&acc)[2][2][4][2], const Unit& u, int wr, int wc, int fr, int fq) const {
        const int row0 = u.pm * BM + wr * 64 + fr, ch0 = (u.pn >> 1) * 256 + (u.pn & 1) * 128 + wc * 32 + 4 * fq;
#pragma unroll
        for (int n = 0; n < 2; ++n) {
            const f32x4 bav = *(const f32x4*)(ba + ch0 + n * 16), bxv = *(const f32x4*)(bx + ch0 + n * 16), l = *(const f32x4*)(lam + ch0 + n * 16); f32x4 spv;
#pragma unroll
            for (int j = 0; j < 4; ++j) spv[j] = -8.0f * log1pf(__expf(-l[j]));
#pragma unroll
            for (int ai = 0; ai < 2; ++ai)
#pragma unroll
                for (int m = 0; m < 4; ++m) { const size_t off = (size_t)(row0 + ai * HALF + m * 16) * 2048 + ch0 + n * 16;
                    const h16x4 xh = *(const h16x4*)(XC + off); f32x4 av, bv;
#pragma unroll
                    for (int j = 0; j < 4; ++j) { const float r = __builtin_amdgcn_rcpf(1.0f + __expf(-(acc[ai][0][m][n][j] + bav[j]))), ig = __builtin_amdgcn_rcpf(1.0f + __expf(-(acc[ai][1][m][n][j] + bxv[j])));
                        const float la = r * spv[j]; av[j] = la;
                        const float y = 2.0f * la;
                        const float em = y * (1.0f + y * 0.5f * (1.0f + y * (1.0f / 3.0f) * (1.0f + y * 0.25f * (1.0f + y * 0.2f * (1.0f + y * (1.0f / 6.0f) * (1.0f + y * (1.0f / 7.0f)))))));
                        const float om = (y > -0.5f) ? -em : 1.0f - __expf(y);
                        bv[j] = (float)xh[j] * ig * __builtin_amdgcn_sqrtf(fmaxf(om, 0.f)); }
                    { u32x2 w; w.x = pk_h2(av[0], av[1]); w.y = pk_h2(av[2], av[3]); *(u32x2*)(AF + off) = w; w.x = pk_h2(bv[0], bv[1]); w.y = pk_h2(bv[2], bv[3]); *(u32x2*)(BF + off) = w; }
                    asm volatile("" ::: "memory"); }
        }
    }
};

template <class Epi, class Sched, bool ALIGN_EPI = false, bool SP2 = false>
__device__ __forceinline__ void gemm_phase(PG8_LAS unsigned char* lds, const Gemm g, const Sched& S, const Epi& E, const int tid) {
    const int wid = __builtin_amdgcn_readfirstlane(tid >> 6), lane = tid & 63, wr = wid >> 2, wc = wid & 3, fr = lane & 15, fq = lane >> 4;
    const int K = g.K, nt = K / BK;
    unsigned voffA[2], voffB[2];
#pragma unroll
    for (int i = 0; i < 2; ++i) { int R, C; stage_rc(tid * 16 + i * 8192, R, C); const int Rb = Epi::WIDE ? (64 * (R >> 5) + perm32(R & 31)) : (Epi::PERM ? ((R & ~31) + perm32(R & 31)) : R);
        voffA[i] = (unsigned)(R * g.lda + C) * 2u; voffB[i] = (unsigned)(Rb * g.ldb + C) * 2u; }
    const size_t kstepA = g.kstepA, kstepB = g.kstepB;
    const size_t hstepA = (size_t)HALF * g.lda * 2, hstepB = (size_t)(Epi::WIDE ? 32 : HALF) * g.ldb * 2;
#define PG8_ABASE(u) ((const char*)g.A + ((size_t)(u).pm * BM * g.lda + (size_t)((u).pn / g.npg) * K) * 2)
#define PG8_BBASE(u) ((const char*)g.Bt + (size_t)(u).pn * BM * g.ldb * 2)
    const unsigned ldsw = (unsigned)wid * 1024u;
    const int aoff = lds_byte(wr * 64 + fr, fq * 8), boff = lds_byte(wc * 32 + fr, fq * 8);
#define PG8_SA(b, h) (((b) * 2 + (h)) * HTB)
#define PG8_SB(b, h) ((4 + (b) * 2 + (h)) * HTB)
#define PG8_STAGE(bufoff, gbase, voff) do { _Pragma("unroll") for (int _i = 0; _i < 2; ++_i) \
        __builtin_amdgcn_global_load_lds((const unsigned*)((const char*)(gbase) + (voff)[_i]), (PG8_LAS unsigned*)(lds + (bufoff) + ldsw + _i * 8192), 16, 0, 0); } while (0)
#define PG8_LDA(dst, b, h) do { _Pragma("unroll") for (int m = 0; m < 4; ++m) _Pragma("unroll") for (int k = 0; k < 2; ++k) dst[m][k] = *(const PG8_LAS bf16x8*)(lds + PG8_SA(b, h) + aoff + m * 2048 + k * 1024); } while (0)
#define PG8_LDB(dst, b, h) do { _Pragma("unroll") for (int n = 0; n < 2; ++n) _Pragma("unroll") for (int k = 0; k < 2; ++k) dst[n][k] = *(const PG8_LAS bf16x8*)(lds + PG8_SB(b, h) + boff + n * 2048 + k * 1024); } while (0)
#define PG8_MMA(ai, bj, At, Bt) do { __builtin_amdgcn_s_setprio(1); _Pragma("unroll") for (int m = 0; m < 4; ++m) _Pragma("unroll") for (int n = 0; n < 2; ++n) _Pragma("unroll") for (int k = 0; k < 2; ++k) \
        acc[ai][bj][m][n] = __builtin_amdgcn_mfma_f32_16x16x32_f16(Bt[n][k], At[m][k], acc[ai][bj][m][n], 0, 0, 0); __builtin_amdgcn_s_setprio(0); } while (0)
#define PG8_WAIT_V(n) asm volatile("s_waitcnt vmcnt(" #n ")" ::: "memory")
#define PG8_WAIT_L(n) asm volatile("s_waitcnt lgkmcnt(" #n ")" ::: "memory")
#define PG8_BAR __builtin_amdgcn_s_barrier()
#define PG8_SCHED __builtin_amdgcn_sched_barrier(0)
    Unit cur, nxt; int ui = 0;
    if (!S.next(0, cur)) return;
    f32x4 acc[2][2][4][2];
#pragma unroll
    for (int a = 0; a < 2; ++a)
#pragma unroll
        for (int b = 0; b < 2; ++b)
#pragma unroll
            for (int m = 0; m < 4; ++m)
#pragma unroll
                for (int n = 0; n < 2; ++n) acc[a][b][m][n] = (f32x4){0.f, 0.f, 0.f, 0.f};
    bf16x8 At[4][2], B0[2][2], B1[2][2];
    const char* cA = PG8_ABASE(cur); const char* cB = PG8_BBASE(cur);
    S.a_ready(cur);
    if constexpr (SP2) {
        PG8_STAGE(PG8_SB(0, 0), cB, voffB); PG8_STAGE(PG8_SB(0, 1), cB + hstepB, voffB); PG8_STAGE(PG8_SA(0, 0), cA, voffA); PG8_STAGE(PG8_SA(0, 1), cA + hstepA, voffA);
        if (wr == 1) PG8_BAR;
        PG8_WAIT_V(2); PG8_BAR;
        PG8_STAGE(PG8_SB(1, 0), cB + kstepB, voffB); PG8_STAGE(PG8_SA(1, 0), cA + kstepA, voffA); PG8_STAGE(PG8_SB(1, 1), cB + hstepB + kstepB, voffB);
        PG8_WAIT_V(6); PG8_BAR;
    } else {
        PG8_STAGE(PG8_SB(0, 0), cB, voffB); PG8_STAGE(PG8_SA(0, 0), cA, voffA); PG8_STAGE(PG8_SB(0, 1), cB + hstepB, voffB); PG8_STAGE(PG8_SA(0, 1), cA + hstepA, voffA);
        if (wr == 1) PG8_BAR;
        PG8_WAIT_V(4); PG8_BAR;
        PG8_STAGE(PG8_SB(1, 0), cB + kstepB, voffB); PG8_STAGE(PG8_SA(1, 0), cA + kstepA, voffA); PG8_STAGE(PG8_SB(1, 1), cB + hstepB + kstepB, voffB);
        PG8_WAIT_V(6); PG8_BAR;
    }
    for (;;) {
        const bool has_next = S.next(ui + 1, nxt);
        const char* nA = has_next ? PG8_ABASE(nxt) : cA; const char* nB = has_next ? PG8_BBASE(nxt) : cB;
        for (int t = 0; t < nt; t += 2) {
            const bool last = (t == nt - 2);
            const char* a1 = cA + (size_t)(t + 1) * kstepA;
            const char* a2 = last ? nA : cA + (size_t)(t + 2) * kstepA; const char* b2 = last ? nB : cB + (size_t)(t + 2) * kstepB;
            const char* a3 = a2 + kstepA; const char* b3 = b2 + kstepB;
            if (last && has_next) S.a_ready(nxt);
            if constexpr (SP2) {
            PG8_LDB(B0, 0, 0); PG8_LDB(B1, 0, 1); PG8_SCHED; PG8_LDA(At, 0, 0); PG8_STAGE(PG8_SA(1, 1), a1 + hstepA, voffA);
            PG8_WAIT_V(8); PG8_WAIT_L(0); PG8_BAR; PG8_MMA(0, 0, At, B0); PG8_MMA(0, 1, At, B1); PG8_BAR; PG8_SCHED;
            PG8_LDA(At, 0, 1); PG8_STAGE(PG8_SB(0, 0), b2, voffB); PG8_STAGE(PG8_SB(0, 1), b2 + hstepB, voffB); PG8_STAGE(PG8_SA(0, 0), a2, voffA);
            PG8_WAIT_V(8); PG8_WAIT_L(0); PG8_BAR; PG8_MMA(1, 0, At, B0); PG8_MMA(1, 1, At, B1); PG8_BAR; PG8_SCHED;
            PG8_LDB(B0, 1, 0); PG8_LDB(B1, 1, 1); PG8_SCHED; PG8_LDA(At, 1, 0); PG8_STAGE(PG8_SA(0, 1), a2 + hstepA, voffA);
            PG8_WAIT_V(8); PG8_WAIT_L(0); PG8_BAR; PG8_MMA(0, 0, At, B0); PG8_MMA(0, 1, At, B1); PG8_BAR; PG8_SCHED;
            PG8_LDA(At, 1, 1); PG8_STAGE(PG8_SB(1, 0), b3, voffB); PG8_STAGE(PG8_SB(1, 1), b3 + hstepB, voffB); PG8_STAGE(PG8_SA(1, 0), a3, voffA);
            PG8_WAIT_V(8); PG8_WAIT_L(0); PG8_BAR; PG8_MMA(1, 0, At, B0); PG8_MMA(1, 1, At, B1); PG8_BAR; PG8_SCHED;
            } else {
            PG8_LDB(B0, 0, 0); PG8_SCHED; PG8_LDA(At, 0, 0); PG8_STAGE(PG8_SA(1, 1), a1 + hstepA, voffA);
            PG8_WAIT_L(8); PG8_BAR; PG8_WAIT_L(0); PG8_MMA(0, 0, At, B0); PG8_BAR; PG8_SCHED;
            PG8_LDB(B1, 0, 1); PG8_STAGE(PG8_SB(0, 0), b2, voffB);
            PG8_BAR; PG8_WAIT_L(0); PG8_MMA(0, 1, At, B1); PG8_BAR;
            PG8_LDA(At, 0, 1); PG8_STAGE(PG8_SA(0, 0), a2, voffA);
            PG8_BAR; PG8_WAIT_L(0); PG8_MMA(1, 0, At, B0); PG8_BAR; PG8_SCHED;
            PG8_STAGE(PG8_SB(0, 1), b2 + hstepB, voffB);
            PG8_WAIT_V(6); PG8_BAR; PG8_MMA(1, 1, At, B1); PG8_BAR;
            PG8_LDB(B0, 1, 0); PG8_SCHED; PG8_LDA(At, 1, 0); PG8_STAGE(PG8_SA(0, 1), a2 + hstepA, voffA);
            PG8_WAIT_L(8); PG8_BAR; PG8_WAIT_L(0); PG8_MMA(0, 0, At, B0); PG8_BAR; PG8_SCHED;
            PG8_LDB(B1, 1, 1); PG8_STAGE(PG8_SB(1, 0), b3, voffB);
            PG8_BAR; PG8_WAIT_L(0); PG8_MMA(0, 1, At, B1); PG8_BAR;
            PG8_LDA(At, 1, 1); PG8_STAGE(PG8_SA(1, 0), a3, voffA);
            PG8_BAR; PG8_WAIT_L(0); PG8_MMA(1, 0, At, B0); PG8_BAR; PG8_SCHED;
            PG8_STAGE(PG8_SB(1, 1), b3 + hstepB, voffB);
            PG8_WAIT_V(6); PG8_BAR; PG8_MMA(1, 1, At, B1); PG8_BAR;
            }
        }
        if constexpr (ALIGN_EPI) { if (wr == 0) PG8_BAR; }
        if constexpr (!Epi::AFTER_DRAIN) { E(acc, cur, wr, wc, fr, fq); S.done(cur); }
        if (!has_next) break;
#pragma unroll
        for (int a = 0; a < 2; ++a)
#pragma unroll
            for (int b = 0; b < 2; ++b)
#pragma unroll
                for (int m = 0; m < 4; ++m)
#pragma unroll
                    for (int n = 0; n < 2; ++n) acc[a][b][m][n] = (f32x4){0.f, 0.f, 0.f, 0.f};
        cur = nxt; cA = nA; cB = nB; ++ui;
        if constexpr (ALIGN_EPI) { if (wr == 1) PG8_BAR; }
    }
    PG8_WAIT_V(0);
    if constexpr (!ALIGN_EPI) { if (wr == 0) PG8_BAR; }
    PG8_BAR;
    if constexpr (Epi::AFTER_DRAIN) { E.fused(acc, cur, wr, wc, fr, fq, lds, wid, lane); S.done(cur); }
#undef PG8_ABASE
#undef PG8_BBASE
#undef PG8_SA
#undef PG8_SB
#undef PG8_STAGE
#undef PG8_LDA
#undef PG8_LDB
#undef PG8_MMA
#undef PG8_WAIT_V
#undef PG8_WAIT_L
#undef PG8_BAR
#undef PG8_SCHED
}
typedef int i32x4 __attribute__((ext_vector_type(4)));
template <class Epi, class Sched, bool ALIGN_EPI = false, bool SP2 = false>
__device__ __forceinline__ void gemm_phase_i8(PG8_LAS unsigned char* lds, const Gemm g, const Sched& S, const Epi& E, const int tid) {
    const int wid = __builtin_amdgcn_readfirstlane(tid >> 6), lane = tid & 63, wr = wid >> 2, wc = wid & 3, fr = lane & 15, fq = lane >> 4;
    const int K = g.K, nt = K / BK;
    unsigned voffA[2], voffB[2];
#pragma unroll
    for (int i = 0; i < 2; ++i) { int R, C; stage_rc(tid * 16 + i * 8192, R, C); const int Rb = Epi::WIDE ? (64 * (R >> 5) + perm32(R & 31)) : (Epi::PERM ? ((R & ~31) + perm32(R & 31)) : R);
        voffA[i] = (unsigned)(R * g.lda + C) * 2u; voffB[i] = (unsigned)(Rb * g.ldb + C) * 2u; }
    const size_t kstepA = g.kstepA, kstepB = g.kstepB;
    const size_t hstepA = (size_t)HALF * g.lda * 2, hstepB = (size_t)(Epi::WIDE ? 32 : HALF) * g.ldb * 2;
#define PG8_ABASE(u) ((const char*)g.A + ((size_t)(u).pm * BM * g.lda + (size_t)((u).pn / g.npg) * K) * 2)
#define PG8_BBASE(u) ((const char*)g.Bt + (size_t)(u).pn * BM * g.ldb * 2)
    const unsigned ldsw = (unsigned)wid * 1024u;
    const int aoff = lds_byte(wr * 64 + fr, fq * 8), boff = lds_byte(wc * 32 + fr, fq * 8);
#define PG8_SA(b, h) (((b) * 2 + (h)) * HTB)
#define PG8_SB(b, h) ((4 + (b) * 2 + (h)) * HTB)
#define PG8_STAGE(bufoff, gbase, voff) do { _Pragma("unroll") for (int _i = 0; _i < 2; ++_i) \
        __builtin_amdgcn_global_load_lds((const unsigned*)((const char*)(gbase) + (voff)[_i]), (PG8_LAS unsigned*)(lds + (bufoff) + ldsw + _i * 8192), 16, 0, 0); } while (0)
#define PG8_LDA(dst, b, h) do { _Pragma("unroll") for (int m = 0; m < 4; ++m) _Pragma("unroll") for (int k = 0; k < 2; ++k) dst[m][k] = *(const PG8_LAS bf16x8*)(lds + PG8_SA(b, h) + aoff + m * 2048 + k * 1024); } while (0)
#define PG8_LDB(dst, b, h) do { _Pragma("unroll") for (int n = 0; n < 2; ++n) _Pragma("unroll") for (int k = 0; k < 2; ++k) dst[n][k] = *(const PG8_LAS bf16x8*)(lds + PG8_SB(b, h) + boff + n * 2048 + k * 1024); } while (0)
#define PG8_MMA(ai, bj, At, Bt) do { __builtin_amdgcn_s_setprio(1); _Pragma("unroll") for (int m = 0; m < 4; ++m) _Pragma("unroll") for (int n = 0; n < 2; ++n) _Pragma("unroll") for (int k = 0; k < 2; ++k) \
        acc[ai][bj][m][n] = __builtin_amdgcn_mfma_i32_16x16x64_i8(__builtin_bit_cast(i32x4, Bt[n][k]), __builtin_bit_cast(i32x4, At[m][k]), acc[ai][bj][m][n], 0, 0, 0); __builtin_amdgcn_s_setprio(0); } while (0)
#define PG8_WAIT_V(n) asm volatile("s_waitcnt vmcnt(" #n ")" ::: "memory")
#define PG8_WAIT_L(n) asm volatile("s_waitcnt lgkmcnt(" #n ")" ::: "memory")
#define PG8_BAR __builtin_amdgcn_s_barrier()
#define PG8_SCHED __builtin_amdgcn_sched_barrier(0)
    Unit cur, nxt; int ui = 0;
    if (!S.next(0, cur)) return;
    i32x4 acc[2][2][4][2];
#pragma unroll
    for (int a = 0; a < 2; ++a)
#pragma unroll
        for (int b = 0; b < 2; ++b)
#pragma unroll
            for (int m = 0; m < 4; ++m)
#pragma unroll
                for (int n = 0; n < 2; ++n) acc[a][b][m][n] = (i32x4){0, 0, 0, 0};
    bf16x8 At[4][2], B0[2][2], B1[2][2];
    const char* cA = PG8_ABASE(cur); const char* cB = PG8_BBASE(cur);
    S.a_ready(cur);
    if constexpr (SP2) {
        PG8_STAGE(PG8_SB(0, 0), cB, voffB); PG8_STAGE(PG8_SB(0, 1), cB + hstepB, voffB); PG8_STAGE(PG8_SA(0, 0), cA, voffA); PG8_STAGE(PG8_SA(0, 1), cA + hstepA, voffA);
        if (wr == 1) PG8_BAR;
        PG8_WAIT_V(2); PG8_BAR;
        PG8_STAGE(PG8_SB(1, 0), cB + kstepB, voffB); PG8_STAGE(PG8_SA(1, 0), cA + kstepA, voffA); PG8_STAGE(PG8_SB(1, 1), cB + hstepB + kstepB, voffB);
        PG8_WAIT_V(6); PG8_BAR;
    } else {
        PG8_STAGE(PG8_SB(0, 0), cB, voffB); PG8_STAGE(PG8_SA(0, 0), cA, voffA); PG8_STAGE(PG8_SB(0, 1), cB + hstepB, voffB); PG8_STAGE(PG8_SA(0, 1), cA + hstepA, voffA);
        if (wr == 1) PG8_BAR;
        PG8_WAIT_V(4); PG8_BAR;
        PG8_STAGE(PG8_SB(1, 0), cB + kstepB, voffB); PG8_STAGE(PG8_SA(1, 0), cA + kstepA, voffA); PG8_STAGE(PG8_SB(1, 1), cB + hstepB + kstepB, voffB);
        PG8_WAIT_V(6); PG8_BAR;
    }
    for (;;) {
        const bool has_next = S.next(ui + 1, nxt);
        const char* nA = has_next ? PG8_ABASE(nxt) : cA; const char* nB = has_next ? PG8_BBASE(nxt) : cB;
        for (int t = 0; t < nt; t += 2) {
            const bool last = (t == nt - 2);
            const char* a1 = cA + (size_t)(t + 1) * kstepA;
            const char* a2 = last ? nA : cA + (size_t)(t + 2) * kstepA; const char* b2 = last ? nB : cB + (size_t)(t + 2) * kstepB;
            const char* a3 = a2 + kstepA; const char* b3 = b2 + kstepB;
            if (last && has_next) S.a_ready(nxt);
            if constexpr (SP2) {
            PG8_LDB(B0, 0, 0); PG8_LDB(B1, 0, 1); PG8_SCHED; PG8_LDA(At, 0, 0); PG8_STAGE(PG8_SA(1, 1), a1 + hstepA, voffA);
            PG8_WAIT_V(8); PG8_WAIT_L(0); PG8_BAR; PG8_MMA(0, 0, At, B0); PG8_MMA(0, 1, At, B1); PG8_BAR; PG8_SCHED;
            PG8_LDA(At, 0, 1); PG8_STAGE(PG8_SB(0, 0), b2, voffB); PG8_STAGE(PG8_SB(0, 1), b2 + hstepB, voffB); PG8_STAGE(PG8_SA(0, 0), a2, voffA);
            PG8_WAIT_V(8); PG8_WAIT_L(0); PG8_BAR; PG8_MMA(1, 0, At, B0); PG8_MMA(1, 1, At, B1); PG8_BAR; PG8_SCHED;
            PG8_LDB(B0, 1, 0); PG8_LDB(B1, 1, 1); PG8_SCHED; PG8_LDA(At, 1, 0); PG8_STAGE(PG8_SA(0, 1), a2 + hstepA, voffA);
            PG8_WAIT_V(8); PG8_WAIT_L(0); PG8_BAR; PG8_MMA(0, 0, At, B0); PG8_MMA(0, 1, At, B1); PG8_BAR; PG8_SCHED;
            PG8_LDA(At, 1, 1); PG8_STAGE(PG8_SB(1, 0), b3, voffB); PG8_STAGE(PG8_SB(1, 1), b3 + hstepB, voffB); PG8_STAGE(PG8_SA(1, 0), a3, voffA);
            PG8_WAIT_V(8); PG8_WAIT_L(0); PG8_BAR; PG8_MMA(1, 0, At, B0); PG8_MMA(1, 1, At, B1); PG8_BAR; PG8_SCHED;
            } else {
            PG8_LDB(B0, 0, 0); PG8_SCHED; PG8_LDA(At, 0, 0); PG8_STAGE(PG8_SA(1, 1), a1 + hstepA, voffA);
            PG8_WAIT_L(8); PG8_BAR; PG8_WAIT_L(0); PG8_MMA(0, 0, At, B0); PG8_BAR; PG8_SCHED;
            PG8_LDB(B1, 0, 1); PG8_STAGE(PG8_SB(0, 0), b2, voffB);
            PG8_BAR; PG8_WAIT_L(0); PG8_MMA(0, 1, At, B1); PG8_BAR;
            PG8_LDA(At, 0, 1); PG8_STAGE(PG8_SA(0, 0), a2, voffA);
            PG8_BAR; PG8_WAIT_L(0); PG8_MMA(1, 0, At, B0); PG8_BAR; PG8_SCHED;
            PG8_STAGE(PG8_SB(0, 1), b2 + hstepB, voffB);
            PG8_WAIT_V(6); PG8_BAR; PG8_MMA(1, 1, At, B1); PG8_BAR;
            PG8_LDB(B0, 1, 0); PG8_SCHED; PG8_LDA(At, 1, 0); PG8_STAGE(PG8_SA(0, 1), a2 + hstepA, voffA);
            PG8_WAIT_L(8); PG8_BAR; PG8_WAIT_L(0); PG8_MMA(0, 0, At, B0); PG8_BAR; PG8_SCHED;
            PG8_LDB(B1, 1, 1); PG8_STAGE(PG8_SB(1, 0), b3, voffB);
            PG8_BAR; PG8_WAIT_L(0); PG8_MMA(0, 1, At, B1); PG8_BAR;
            PG8_LDA(At, 1, 1); PG8_STAGE(PG8_SA(1, 0), a3, voffA);
            PG8_BAR; PG8_WAIT_L(0); PG8_MMA(1, 0, At, B0); PG8_BAR; PG8_SCHED;
            PG8_STAGE(PG8_SB(1, 1), b3 + hstepB, voffB);
            PG8_WAIT_V(6); PG8_BAR; PG8_MMA(1, 1, At, B1); PG8_BAR;
            }
        }
        if constexpr (ALIGN_EPI) { if (wr == 0) PG8_BAR; }
        if constexpr (!Epi::AFTER_DRAIN) { E(acc, cur, wr, wc, fr, fq); S.done(cur); }
        if (!has_next) break;
#pragma unroll
        for (int a = 0; a < 2; ++a)
#pragma unroll
            for (int b = 0; b < 2; ++b)
#pragma unroll
                for (int m = 0; m < 4; ++m)
#pragma unroll
                    for (int n = 0; n < 2; ++n) acc[a][b][m][n] = (i32x4){0, 0, 0, 0};
        cur = nxt; cA = nA; cB = nB; ++ui;
        if constexpr (ALIGN_EPI) { if (wr == 1) PG8_BAR; }
    }
    PG8_WAIT_V(0);
    if constexpr (!ALIGN_EPI) { if (wr == 0) PG8_BAR; }
    PG8_BAR;
    if constexpr (Epi::AFTER_DRAIN) { E.fused(acc, cur, wr, wc, fr, fq, lds, wid, lane); S.done(cur); }
#undef PG8_ABASE
#undef PG8_BBASE
#undef PG8_SA
#undef PG8_SB
#undef PG8_STAGE
#undef PG8_LDA
#undef PG8_LDB
#undef PG8_MMA
#undef PG8_WAIT_V
#undef PG8_WAIT_L
#undef PG8_BAR
#undef PG8_SCHED
}
}

constexpr int T = 8192, D = 2048, FF = 8192, DEPTH = 4;
constexpr int NH = 16, HD = 128, NKV = 4, TOPK = 256;
constexpr int A_IN = 5264, A_INP = 5376;
constexpr int C_Q = 0, C_K = 2048, C_V = 2560, C_IQ = 3072, C_IK = 5120, C_IW = 5248;
constexpr float EPS = 1e-6f;
constexpr int NWAVES = 8, NTHR = NWAVES * 64;

constexpr size_t MiB = 1u << 20;
constexpr size_t WS_CTL = 0, CTL_ZERO_BYTES = 1 * MiB;
constexpr size_t WS_COS128 = 1 * MiB, WS_SIN128 = 3 * MiB, WS_COS64 = 5 * MiB, WS_SIN64 = 6 * MiB;
constexpr size_t WS_IW = 7 * MiB;
constexpr size_t WS_AGGA = 724 * MiB, WS_AGGB = 726 * MiB, WS_CARRY = 728 * MiB;
constexpr size_t WS_WINA = 10 * MiB;
constexpr size_t WS_WOUTA = 52 * MiB;
constexpr size_t WS_WINR = 68 * MiB;
constexpr size_t WS_WGR = 84 * MiB;
constexpr size_t WS_WOUTR = 86 * MiB;
constexpr size_t WS_WPOOL = 94 * MiB;
constexpr size_t WS_WUP = 96 * MiB;
constexpr size_t WS_WDOWN = 224 * MiB;
constexpr size_t WS_BA = 352 * MiB;
constexpr size_t BA_SC = 0;
constexpr int SC_LD = T + 64;
constexpr size_t BA_O16 = 0;
constexpr size_t BA_U = 0;
constexpr size_t BA_AF = 0, BA_BF = 64 * MiB;
constexpr size_t BA_H16 = 128 * MiB;
constexpr size_t BA_PROJ = 160 * MiB;
constexpr size_t BA_XC = 224 * MiB;
constexpr size_t WS_QH = 616 * MiB, WS_KH = 632 * MiB, WS_VH = 636 * MiB, WS_IK = 640 * MiB, WS_SEL = 642 * MiB, WS_IQ = 650 * MiB, WS_PARTA = 686 * MiB, WS_PARTB = 687 * MiB, WS_BLKMAXD = 688 * MiB, WS_X16 = 692 * MiB, WS_END = 730 * MiB;
constexpr int CW_BAR = 4096;
constexpr size_t WS_BLKMAX = 682 * MiB;
constexpr size_t WS_RS = 7 * MiB + 512 * 1024, WS_CS = WS_RS + 64 * 1024;
constexpr size_t WS_RS2 = WS_RS + 128 * 1024, WS_CS2 = WS_RS + 192 * 1024, WS_CSUM = WS_RS + 208 * 1024;
constexpr size_t BA_U8 = 192 * MiB, BA_W8D = 176 * MiB;
constexpr size_t BA_A8 = 160 * MiB, BA_W8 = 176 * MiB;
constexpr size_t WS_ROWSQ = 256 * 1024;

constexpr int RING_BYTES = 131072;
constexpr int LDSCTL_OFF = RING_BYTES, MISC_OFF = LDSCTL_OFF + 320;
constexpr int LDS_BYTES = 155648;

#define GAS __attribute__((address_space(1)))
#define LAS __attribute__((address_space(3)))
typedef _Float16 h16;
typedef _Float16 h16x2 __attribute__((ext_vector_type(2)));
typedef _Float16 h16x4 __attribute__((ext_vector_type(4)));
typedef _Float16 h16x8 __attribute__((ext_vector_type(8)));
typedef unsigned v4u __attribute__((ext_vector_type(4)));
typedef unsigned v2u __attribute__((ext_vector_type(2)));
typedef float f32x4 __attribute__((ext_vector_type(4)));
typedef float f32x2 __attribute__((ext_vector_type(2)));
#define LDS_WAIT() asm volatile("s_waitcnt lgkmcnt(0)" ::: "memory")
#define VM_WAIT() asm volatile("s_waitcnt vmcnt(0)" ::: "memory")
__device__ __forceinline__ unsigned pkh(float lo, float hi) { h16x2 v = {(h16)lo, (h16)hi}; return __builtin_bit_cast(unsigned, v); }
__device__ __forceinline__ float wave_sum(float v) {
#pragma unroll
    for (int o = 1; o < 64; o <<= 1) v += __shfl_xor(v, o);
    return v;
}
__device__ __forceinline__ float wave_max(float v) {
#pragma unroll
    for (int o = 1; o < 64; o <<= 1) v = fmaxf(v, __shfl_xor(v, o));
    return v;
}

#define XB_TMO      128
#define XB_XCNT(j)  (256  + 64 * (j))
#define XB_XSUB(j)  (1280 + 64 * (j))
#define XB_XGEN(j)  (2304 + 64 * (j))
#define XB_TOP      3328
#define XB_TOPGEN   3392
#define XCD_BAR_WORDS 3456
#define XB_SPIN_CAP (1u << 18)

__device__ __forceinline__ unsigned xb_ld(unsigned* p)              { return __hip_atomic_load(p, __ATOMIC_RELAXED, __HIP_MEMORY_SCOPE_AGENT); }
__device__ __forceinline__ unsigned xb_add(unsigned* p, unsigned v) { return __hip_atomic_fetch_add(p, v, __ATOMIC_RELAXED, __HIP_MEMORY_SCOPE_AGENT); }
__device__ __forceinline__ unsigned xb_xcc_id() { return (unsigned)__builtin_amdgcn_s_getreg((3 << 11) | 20) & 0xFu; }
#define XB_SPIN(cond, bar) do { unsigned _sp = 0; while (cond) { __builtin_amdgcn_s_sleep(1); \
    if ((++_sp & 255u) == 0u) { if (xb_ld(&(bar)[XB_TMO])) break; if (_sp > XB_SPIN_CAP) { atomicAdd(&(bar)[XB_TMO], 1u); break; } } } } while (0)

struct XcdBarrier { unsigned* bar; unsigned x; volatile LAS unsigned* st; };

__device__ __forceinline__ XcdBarrier xcd_barrier_post(unsigned* bar, volatile LAS unsigned* st) {
    XcdBarrier b; b.bar = bar; b.x = xb_xcc_id(); b.st = st;
    if (threadIdx.x == 0) (void)xb_add(&bar[XB_XCNT(b.x)], 1u);
    return b;
}
__device__ __forceinline__ void xcd_barrier_complete(unsigned* bar, unsigned x, unsigned& nloc, unsigned& nx) {
    const unsigned G = gridDim.x * gridDim.y * gridDim.z;
    unsigned sum, cnt, mine, sp = 0u;
    for (;;) {
        sum = 0u; cnt = 0u; mine = 0u;
#pragma unroll
        for (unsigned j = 0; j < 16; ++j) { const unsigned c = xb_ld(&bar[XB_XCNT(j)]); sum += c; cnt += (c > 0u) ? 1u : 0u; mine = (j == x) ? c : mine; }
        if (sum == G) break;
        __builtin_amdgcn_s_sleep(1);
        if ((++sp & 255u) == 0u) { if (xb_ld(&bar[XB_TMO])) break; if (sp > XB_SPIN_CAP) { atomicAdd(&bar[XB_TMO], 1u); break; } }
    }
    nloc = mine > 0u ? mine : 1u; nx = cnt > 0u ? cnt : 1u;
}
__device__ __forceinline__ void xcd_barrier(const XcdBarrier& b) {
    asm volatile("s_waitcnt vmcnt(0)" ::: "memory");
    __syncthreads();
    if (threadIdx.x == 0) {
        unsigned* bar = b.bar;
        __builtin_amdgcn_s_waitcnt(0);
        unsigned nloc = b.st[0], nx = b.st[1];
        if (nloc == 0u) { xcd_barrier_complete(bar, b.x, nloc, nx); b.st[0] = nloc; b.st[1] = nx; }
        const unsigned old = xb_add(&bar[XB_XSUB(b.x)], 1u);
        const unsigned gen = old / nloc;
        if (old + 1u == (gen + 1u) * nloc) {
            __builtin_amdgcn_fence(__ATOMIC_RELEASE, "agent");
            asm volatile("s_waitcnt vmcnt(0)" ::: "memory");
            const unsigned og = xb_add(&bar[XB_TOP], 1u);
            const unsigned tg = og / nx;
            if (og + 1u == (tg + 1u) * nx) xb_add(&bar[XB_TOPGEN], 1u);
            else XB_SPIN(xb_ld(&bar[XB_TOPGEN]) == tg, bar);
            __builtin_amdgcn_fence(__ATOMIC_ACQUIRE, "agent");
            xb_add(&bar[XB_XGEN(b.x)], 1u);
            asm volatile("s_waitcnt vmcnt(0)" ::: "memory");
        } else {
            XB_SPIN(xb_ld(&bar[XB_XGEN(b.x)]) == gen, bar);
            __builtin_amdgcn_fence(__ATOMIC_ACQUIRE, "agent");
            asm volatile("s_waitcnt vmcnt(0)" ::: "memory");
        }
    }
    __syncthreads();
}

__device__ __forceinline__ void tr_item(const float* src, int ldw, int nvalid, h16* dst, int ldd, LAS float* scr, int lane, unsigned* colmax = nullptr, const float* gk = nullptr) {
    const int nn = lane & 31; float v[32];
#pragma unroll
    for (int i = 0; i < 32; ++i) { const int kk = 2 * i + (lane >> 5); v[i] = (nn < nvalid) ? src[(size_t)kk * ldw + nn] * (gk ? gk[kk] : 1.0f) : 0.f; }
    __builtin_amdgcn_sched_barrier(0);
#pragma unroll
    for (int i = 0; i < 32; ++i) { const int kk = 2 * i + (lane >> 5); scr[kk * 33 + nn] = v[i]; }
    LDS_WAIT();
    const int c = lane & 7;
#pragma unroll
    for (int j = 0; j < 4; ++j) { const int n = (lane >> 3) + 8 * j; const LAS float* s = scr + (8 * c) * 33 + n;
        v4u o; o.x = pkh(s[0 * 33], s[1 * 33]); o.y = pkh(s[2 * 33], s[3 * 33]); o.z = pkh(s[4 * 33], s[5 * 33]); o.w = pkh(s[6 * 33], s[7 * 33]);
        *(v4u*)(dst + (size_t)n * ldd + 8 * c) = o;
        if (colmax) {
            float mx = fmaxf(fmaxf(fmaxf(fabsf(s[0 * 33]), fabsf(s[1 * 33])), fmaxf(fabsf(s[2 * 33]), fabsf(s[3 * 33]))), fmaxf(fmaxf(fabsf(s[4 * 33]), fabsf(s[5 * 33])), fmaxf(fabsf(s[6 * 33]), fabsf(s[7 * 33]))));
            mx = fmaxf(mx, __shfl_xor(mx, 1)); mx = fmaxf(mx, __shfl_xor(mx, 2)); mx = fmaxf(mx, __shfl_xor(mx, 4));
            if (c == 0) colmax[n] = __float_as_uint(mx); } }
    LDS_WAIT();
}

struct Ptrs {
    const float* x; const int* pos;
    const float *attn_norm, *attn_w_in, *attn_qn, *attn_kn, *attn_w_out;
    const float *rnn_norm, *rnn_w_in, *conv_w, *conv_b, *ga_w, *ga_b, *gx_w, *gx_b, *lam, *rnn_w_out;
    const float *pool_norm, *pool_w, *pool_b, *pool_scale;
    const float *mlp_norm, *mlp_w_up, *mlp_w_down;
    float* out; unsigned char* ws;
    int ph_lo, ph_hi;
};

#define CAS __attribute__((address_space(4)))
__device__ __forceinline__ const CAS Ptrs* kargs() { const CAS Ptrs* p = (const CAS Ptrs*)__builtin_amdgcn_kernarg_segment_ptr(); asm volatile("" : "+s"(p)); return p; }
__device__ __forceinline__ void p0_prologue(const CAS Ptrs* PP, LAS unsigned char* lds, int gw, int NGW, int wave, int lane, int gtid, int NGT) {
    LAS float* scr = (LAS float*)(lds + wave * 16384);
    unsigned char* ws = PP->ws;
    constexpr int I_WINA = 32 * 165, I_WOUTA = 32 * 64, I_WINR = 32 * 128, I_G = 4 * 8, I_WOUTR = 32 * 64, I_POOL = 8 * 16, I_UP = 32 * 256, I_DN = 128 * 64, I_Z = 384;
    constexpr int NITEMS = 2 * I_WINA + 2 * I_WOUTA + I_WINR + 16 * I_G + I_WOUTR + 4 * I_POOL + 4 * I_UP + 4 * I_DN + 2 * I_Z;
    for (int it = gw; it < NITEMS; it += NGW) {
        int r = it;
        if (r < 2 * I_WINA) { const int j = r / I_WINA; r -= j * I_WINA; const int kb = r / 165, nb = r % 165, n0 = 32 * nb; const int nv = (A_IN - n0) < 32 ? (A_IN - n0) : 32;
            tr_item(PP->attn_w_in + (size_t)j * D * A_IN + (size_t)(64 * kb) * A_IN + n0, A_IN, nv, (h16*)(ws + WS_WINA) + (size_t)j * A_INP * D + (size_t)n0 * D + 64 * kb, D, scr, lane, nullptr, PP->attn_norm + (size_t)j * D + 64 * kb); continue; }
        r -= 2 * I_WINA;
        if (r < 2 * I_WOUTA) { const int j = r / I_WOUTA; r -= j * I_WOUTA; const int kb = r / 64, nb = r % 64;
            tr_item(PP->attn_w_out + (size_t)j * D * D + (size_t)(64 * kb) * D + 32 * nb, D, 32, (h16*)(ws + WS_WOUTA) + (size_t)j * D * D + (size_t)(32 * nb) * D + 64 * kb, D, scr, lane); continue; }
        r -= 2 * I_WOUTA;
        if (r < I_WINR) { const int kb = r / 128, nb = r % 128;
            tr_item(PP->rnn_w_in + (size_t)(64 * kb) * 4096 + 32 * nb, 4096, 32, (h16*)(ws + WS_WINR) + (size_t)(32 * nb) * D + 64 * kb, D, scr, lane, nullptr, PP->rnn_norm + 64 * kb); continue; }
        r -= I_WINR;
        if (r < 16 * I_G) { const int mi = r / I_G; r -= mi * I_G; const int which = mi >> 3, blk = mi & 7, kb = r / 8, nb = r % 8, d0 = 32 * nb;
            const float* src = (which ? PP->gx_w : PP->ga_w) + (size_t)blk * 65536 + (size_t)(64 * kb) * 256 + d0;
            const int drow = 256 * (2 * blk + (d0 >> 7)) + 128 * which + (d0 & 127);
            tr_item(src, 256, 32, (h16*)(ws + WS_WGR) + (size_t)drow * 256 + 64 * kb, 256, scr, lane); continue; }
        r -= 16 * I_G;
        if (r < I_WOUTR) { const int kb = r / 64, nb = r % 64;
            tr_item(PP->rnn_w_out + (size_t)(64 * kb) * D + 32 * nb, D, 32, (h16*)(ws + WS_WOUTR) + (size_t)(32 * nb) * D + 64 * kb, D, scr, lane); continue; }
        r -= I_WOUTR;
        if (r < 4 * I_POOL) { const int g = r / I_POOL; r -= g * I_POOL; const int kb = r / 16, nb = r % 16;
            tr_item(PP->pool_w + (size_t)g * 262144 + (size_t)(64 * kb) * 512 + 32 * nb, 512, 32, (h16*)(ws + WS_WPOOL) + (size_t)(512 * g + 32 * nb) * 512 + 64 * kb, 512, scr, lane); continue; }
        r -= 4 * I_POOL;
        if (r < 4 * I_UP) { const int i = r / I_UP; r -= i * I_UP; const int kb = r / 256, nb = r % 256;
            tr_item(PP->mlp_w_up + (size_t)i * D * FF + (size_t)(64 * kb) * FF + 32 * nb, FF, 32, (h16*)(ws + WS_WUP) + (size_t)i * D * FF + (size_t)(32 * nb) * D + 64 * kb, D, scr, lane, (unsigned*)(ws + WS_BLKMAX) + ((size_t)i * 32 + kb) * FF + 32 * nb, PP->mlp_norm + (size_t)i * D + 64 * kb); continue; }
        r -= 4 * I_UP;
        if (r < 4 * I_DN) { const int i = r / I_DN; r -= i * I_DN; const int kb = r / 64, nb = r % 64;
            tr_item(PP->mlp_w_down + (size_t)i * D * FF + (size_t)(64 * kb) * D + 32 * nb, D, 32, (h16*)(ws + WS_WDOWN) + (size_t)i * D * FF + ((size_t)kb * D + 32 * nb) * 64, 64, scr, lane, (unsigned*)(ws + WS_BLKMAXD) + ((size_t)i * 128 + kb) * D + 32 * nb); continue; }
        r -= 4 * I_DN;
        { const int j = r / I_Z; r -= j * I_Z;
            v4u* z = (v4u*)((h16*)(ws + WS_WINA) + (size_t)j * A_INP * D + (size_t)5280 * D); z[(size_t)r * 64 + lane] = (v4u){0u, 0u, 0u, 0u}; }
    }
    for (int e = gtid; e < T * 96; e += NGT) {
        const int t = e / 96, i = e % 96; const bool big = i < 64; const int fi = big ? i : i - 64;
        const double base = big ? 0.8659643233600653 : 0.7498942093324559;
        double inv = 1.0; for (int k = 0; k < fi; ++k) inv *= base;
        const double ang = (double)PP->pos[t] * inv;
        const double n = __builtin_rint(ang * 0.15915494309189535); const double rr = ang - n * 6.283185307179586 - n * 2.4492935982947064e-16;
        const double r2 = rr * rr; double sn = 1.0, cs = 1.0;
#pragma unroll
        for (int k = 14; k >= 1; --k) { sn = 1.0 - sn * r2 * (1.0 / (double)((2 * k) * (2 * k + 1))); cs = 1.0 - cs * r2 * (1.0 / (double)((2 * k - 1) * (2 * k))); }
        sn *= rr;
        if (big) { ((float*)(ws + WS_COS128))[t * 64 + fi] = (float)cs; ((float*)(ws + WS_SIN128))[t * 64 + fi] = (float)sn; }
        else { ((float*)(ws + WS_COS64))[t * 32 + fi] = (float)cs; ((float*)(ws + WS_SIN64))[t * 32 + fi] = (float)sn; }
    }
}

__device__ __forceinline__ void quant_rows(const h16* src, int nrows, signed char* dst, float* scale_out, const float* rowsq, const unsigned* colmax, int gw, int NGW, int lane) {
    h16x8 vn[4]; float cmn = 0.f;
    if (gw < nrows) {
#pragma unroll
        for (int j = 0; j < 4; ++j) vn[j] = *(const h16x8*)(src + (size_t)gw * D + 512 * j + 8 * lane);
        if (colmax) cmn = lane < 32 ? __uint_as_float(colmax[(size_t)lane * FF + gw]) : 0.f; }
    for (int r = gw; r < nrows; r += NGW) {
        h16x8 v[4]; const float cm = cmn;
#pragma unroll
        for (int j = 0; j < 4; ++j) v[j] = vn[j];
        const int rn = r + NGW;
        if (rn < nrows) {
#pragma unroll
            for (int j = 0; j < 4; ++j) vn[j] = *(const h16x8*)(src + (size_t)rn * D + 512 * j + 8 * lane);
            if (colmax) cmn = lane < 32 ? __uint_as_float(colmax[(size_t)lane * FF + rn]) : 0.f; }
        float mx;
        if (colmax) mx = wave_max(cm);
        else { mx = 0.f;
#pragma unroll
            for (int j = 0; j < 4; ++j)
#pragma unroll
                for (int e = 0; e < 8; ++e) mx = fmaxf(mx, fabsf((float)v[j][e]));
            mx = wave_max(mx); }
        const float step = mx > 0.f ? mx * (1.0f / 127.0f) : 1.0f, inv = 1.0f / step;
        if (lane == 0) { float sc = step;
            if (rowsq) { const f32x4* pp = (const f32x4*)(rowsq + (size_t)r * 32); f32x4 a4 = pp[0];
#pragma unroll
                for (int q = 1; q < 8; ++q) a4 += pp[q];
                sc = step / sqrtf(((a4[0] + a4[1]) + (a4[2] + a4[3])) * (1.0f / D) + EPS); }
            scale_out[r] = sc; }
#pragma unroll
        for (int j = 0; j < 4; ++j) { unsigned w[2];
#pragma unroll
            for (int hh = 0; hh < 2; ++hh) { unsigned p = 0u;
#pragma unroll
                for (int e = 0; e < 4; ++e) { int qv = (int)rintf((float)v[j][4 * hh + e] * inv); qv = qv > 127 ? 127 : (qv < -127 ? -127 : qv); p |= ((unsigned)qv & 255u) << (8 * e); }
                w[hh] = p; }
            *(v2u*)(dst + (size_t)r * D + 512 * j + 8 * lane) = (v2u){w[0], w[1]}; }
    }
}
template <bool UNSIGNED>
__device__ __forceinline__ void quant_kblk(const h16* src, int R, signed char* dst, float* scale_out, float* csum, const unsigned* blkmax, int gw, int NGW, int lane) {
    const int bsub = lane >> 3, c8 = (lane & 7) * 8;
    h16x8 vn[16]; float cmn = 0.f;
#define QK_LOAD(r_) do { _Pragma("unroll") for (int i = 0; i < 16; ++i) vn[i] = *(const h16x8*)(src + ((size_t)(8 * i + bsub) * R + (r_)) * 64 + c8); \
        if (!UNSIGNED) cmn = fmaxf(__uint_as_float(blkmax[(size_t)lane * R + (r_)]), __uint_as_float(blkmax[(size_t)(64 + lane) * R + (r_)])); } while (0)
    if (gw < R) QK_LOAD(gw);
    for (int r = gw; r < R; r += NGW) {
        h16x8 v[16]; const float cm = cmn;
#pragma unroll
        for (int i = 0; i < 16; ++i) v[i] = vn[i];
        if (r + NGW < R) QK_LOAD(r + NGW);
        float mx;
        if (UNSIGNED) { mx = 0.f;
#pragma unroll
            for (int i = 0; i < 16; ++i)
#pragma unroll
                for (int e = 0; e < 8; ++e) mx = fmaxf(mx, (float)v[i][e]);
            mx = wave_max(mx); }
        else mx = wave_max(cm);
        const float step = mx > 0.f ? mx * (UNSIGNED ? 1.0f / 255.0f : 1.0f / 127.0f) : 1.0f, inv = 1.0f / step;
        int ssum = 0;
#pragma unroll
        for (int i = 0; i < 16; ++i) { unsigned w[2];
#pragma unroll
            for (int hh = 0; hh < 2; ++hh) { unsigned p = 0u;
#pragma unroll
                for (int e = 0; e < 4; ++e) { int qv = (int)rintf((float)v[i][4 * hh + e] * inv);
                    if (UNSIGNED) { qv = qv > 255 ? 255 : (qv < 0 ? 0 : qv); qv -= 128; } else { qv = qv > 127 ? 127 : (qv < -127 ? -127 : qv); ssum += qv; }
                    p |= ((unsigned)qv & 255u) << (8 * e); }
                w[hh] = p; }
            const int b = 8 * i + bsub;
            *(v2u*)(dst + ((size_t)(b >> 1) * R + r) * 128 + 64 * (b & 1) + c8) = (v2u){w[0], w[1]}; }
        if (!UNSIGNED) { float fs = (float)ssum; fs = wave_sum(fs); if (lane == 0) csum[r] = fs; }
        if (lane == 0) scale_out[r] = step;
    }
#undef QK_LOAD
}
__device__ __forceinline__ void norm0_phase(const float* src, h16* dst, float* rowsq, int gw, int NGW, int lane) {
    for (int m = gw; m < T; m += NGW) {
        const f32x4* xr = (const f32x4*)(src + (size_t)m * D) + lane;
        f32x4 v[8]; float s = 0.f;
#pragma unroll
        for (int j = 0; j < 8; ++j) { v[j] = xr[64 * j]; s += (v[j].x * v[j].x + v[j].y * v[j].y) + (v[j].z * v[j].z + v[j].w * v[j].w); }
        s = wave_sum(s); if (lane == 0) rowsq[m] = s;
        v2u* o = (v2u*)(dst + (size_t)m * D) + lane;
#pragma unroll
        for (int j = 0; j < 8; ++j) { v2u w; w.x = pkh(v[j].x, v[j].y); w.y = pkh(v[j].z, v[j].w); o[64 * j] = w; }
    }
}

__device__ __forceinline__ unsigned char f8(float x) { return (unsigned char)(__builtin_amdgcn_cvt_pk_fp8_f32(x, x, 0, false) & 0xFF); }
__device__ __forceinline__ float sum16(float v) { v += __shfl_xor(v, 1); v += __shfl_xor(v, 2); v += __shfl_xor(v, 4); v += __shfl_xor(v, 8); return v; }
__device__ __forceinline__ unsigned f8x4(float a, float b, float c, float d) { int p = __builtin_amdgcn_cvt_pk_fp8_f32(a, b, 0, false); p = __builtin_amdgcn_cvt_pk_fp8_f32(c, d, p, true); return (unsigned)p; }
__device__ __forceinline__ void dsa_post_phase(const h16* PROJ, const float* qn, const float* kn, const float* c128, const float* s128, const float* c64, const float* s64,
                                               unsigned char* Q8, unsigned char* K8, unsigned char* V8, h16* IQ, h16* IK, float* IW, int gw, int NGW, int lane) {
    const int hh = lane >> 4, m = lane & 15;
    const f32x4 gqa = *(const f32x4*)(qn + 4 * m), gqb = *(const f32x4*)(qn + 64 + 4 * m), gka = *(const f32x4*)(kn + 4 * m), gkb = *(const f32x4*)(kn + 64 + 4 * m);
    const bool rot = m < 8; const int ioa = rot ? 4 * m : 32 + 4 * m, iob = ioa + 32;
    for (int t = gw; t < T; t += NGW) {
        const h16* pr = PROJ + (size_t)t * A_INP;
        const f32x4 c = *(const f32x4*)(c128 + t * 64 + 4 * m), s = *(const f32x4*)(s128 + t * 64 + 4 * m);
        f32x4 ci = {1.f, 1.f, 1.f, 1.f}, si = {0.f, 0.f, 0.f, 0.f};
        if (rot) { ci = *(const f32x4*)(c64 + t * 32 + 4 * m); si = *(const f32x4*)(s64 + t * 32 + 4 * m); }
#pragma unroll
        for (int p = 0; p < 5; ++p) {
            const int cb = (p < 4 ? C_Q + (4 * p + hh) * HD : C_K + hh * HD) + 4 * m;
            const h16x4 a4 = *(const h16x4*)(pr + cb), b4 = *(const h16x4*)(pr + cb + 64);
            float a[4], b[4], ss = 0.f;
#pragma unroll
            for (int e = 0; e < 4; ++e) { a[e] = (float)a4[e]; b[e] = (float)b4[e]; ss += a[e] * a[e] + b[e] * b[e]; }
            const float rstd = 1.0f / sqrtf(sum16(ss) * (1.0f / HD) + EPS);
            float oa[4], ob[4];
#pragma unroll
            for (int e = 0; e < 4; ++e) { const float ya = a[e] * rstd * (p < 4 ? gqa[e] : gka[e]), yb = b[e] * rstd * (p < 4 ? gqb[e] : gkb[e]); oa[e] = ya * c[e] - yb * s[e]; ob[e] = yb * c[e] + ya * s[e]; }
            unsigned char* o8 = (p < 4 ? Q8 + (size_t)t * D + (4 * p + hh) * HD : K8 + (size_t)t * 512 + hh * HD) + 4 * m;
            *(unsigned*)o8 = f8x4(oa[0], oa[1], oa[2], oa[3]); *(unsigned*)(o8 + 64) = f8x4(ob[0], ob[1], ob[2], ob[3]);
        }
        { const h16x8 vv = *(const h16x8*)(pr + C_V + lane * 8);
          *(v2u*)(V8 + (size_t)t * 512 + lane * 8) = (v2u){f8x4((float)vv[0], (float)vv[1], (float)vv[2], (float)vv[3]), f8x4((float)vv[4], (float)vv[5], (float)vv[6], (float)vv[7])}; }
#pragma unroll
        for (int p = 0; p < 5; ++p) {
            const int hd = p < 4 ? 4 * p + hh : 0; const int cb = p < 4 ? C_IQ + hd * HD : C_IK;
            const h16x4 a4 = *(const h16x4*)(pr + cb + ioa), b4 = *(const h16x4*)(pr + cb + iob);
            h16x4 oa, ob;
#pragma unroll
            for (int e = 0; e < 4; ++e) { const float av = (float)a4[e], bv = (float)b4[e]; oa[e] = (h16)(av * ci[e] - bv * si[e]); ob[e] = (h16)(bv * ci[e] + av * si[e]); }
            if (p < 4) { *(h16x4*)(IQ + (size_t)t * D + hd * HD + ioa) = oa; *(h16x4*)(IQ + (size_t)t * D + hd * HD + iob) = ob; }
            else if (hh == 0) { *(h16x4*)(IK + (size_t)t * HD + ioa) = oa; *(h16x4*)(IK + (size_t)t * HD + iob) = ob; }
        }
        if (lane < 16) IW[t * 16 + lane] = (float)pr[C_IW + lane] * 0.02209708691207961f;
    }
}

__device__ __forceinline__ float relu_i(float x) { const int b = __float_as_int(x); return __int_as_float(b > 0 ? b : 0); }
constexpr int IDX_ITEMS = 8320, IDX_ROWB = 272, IDX_TILEB = 128 * IDX_ROWB;
__device__ __forceinline__ void idx_decode(int L, int& qb, int& kc) {
    int m = (int)((sqrtf(1.0f + 2.0f * (float)L) - 1.0f) * 0.5f);
    while (2 * (m + 1) * (m + 2) <= L) ++m;
    while (2 * m * (m + 1) > L) --m;
    const int rem = L - 2 * m * (m + 1); qb = 4 * m + rem / (m + 1); kc = rem % (m + 1);
}
constexpr int IDX_HDR = 2, IDX_WKT = 4;
__device__ __forceinline__ int idx_cut(int v) {
    int m = (int)((sqrtf((float)((1 + 2 * IDX_HDR) * (1 + 2 * IDX_HDR)) + 2.0f * (float)v) - (float)(1 + 2 * IDX_HDR)) * 0.5f);
    while (2 * (m + 1) * (m + 2) + 4 * IDX_HDR * (m + 1) <= v) ++m;
    while (2 * m * (m + 1) + 4 * IDX_HDR * m > v) --m;
    const int rem = v - (2 * m * (m + 1) + 4 * IDX_HDR * m), j = rem / (m + 1 + IDX_HDR), slot = rem % (m + 1 + IDX_HDR);
    return 2 * m * (m + 1) + j * (m + 1) + (slot < IDX_HDR ? 0 : slot - IDX_HDR);
}
__device__ __forceinline__ void idx_scores_phase(const h16* IQ, const h16* IK, const float* IW, h16* SC, LAS unsigned char* lds, int wg, int G, int tid, int wave, int lane) {
    const int L0 = idx_cut((int)(((long)(IDX_ITEMS + 256 * IDX_HDR) * wg) / G)), L1 = idx_cut((int)(((long)(IDX_ITEMS + 256 * IDX_HDR) * (wg + 1)) / G));
    if (L0 >= L1) return;
    int qb, kc; idx_decode(L0, qb, kc);
    const int fr = lane & 15, fq = lane >> 4;
    h16x8 st[4];
#define IDX_LOAD(kc_) do { _Pragma("unroll") for (int i = 0; i < 4; ++i) { const int p = tid + 512 * i; st[i] = *(const h16x8*)(IK + (size_t)((kc_) * 128 + (p >> 4)) * HD + (p & 15) * 8); } } while (0)
#define IDX_WRITE(buf_) do { _Pragma("unroll") for (int i = 0; i < 4; ++i) { const int p = tid + 512 * i; *(LAS h16x8*)(lds + (buf_) * IDX_TILEB + (p >> 4) * IDX_ROWB + (p & 15) * 16) = st[i]; } } while (0)
    IDX_LOAD(kc); IDX_WRITE(0);
    __syncthreads();
    int par = 0, L = L0;
#if TPROBE
    unsigned long long tp_acc = 0;
#define TP_T() ({ __builtin_amdgcn_sched_barrier(0); asm volatile("" ::: "memory"); unsigned long long t_ = __builtin_amdgcn_s_memrealtime(); asm volatile("s_waitcnt lgkmcnt(0)" ::: "memory"); __builtin_amdgcn_sched_barrier(0); t_; })
#define TP_BEG(n) unsigned long long tp0_##n = 0; if (TPROBE == n) tp0_##n = TP_T();
#define TP_END(n) if (TPROBE == n) tp_acc += TP_T() - tp0_##n;
#else
#define TP_BEG(n)
#define TP_END(n)
#endif
#pragma unroll 1
    while (L < L1) {
        int kend = kc + (L1 - L) - 1; if (kend > (qb >> 2)) kend = (qb >> 2);
        h16x8 a[4][4]; v4u A2[4][2];
        TP_BEG(3)
        { const int tq = 32 * qb + 4 * wave; f32x4 w4[4];
#pragma unroll
            for (int q = 0; q < 4; ++q) {
#pragma unroll
                for (int ks = 0; ks < 4; ++ks) a[q][ks] = *(const h16x8*)(IQ + (size_t)(tq + q) * D + fr * HD + ks * 32 + fq * 8);
                w4[q] = *(const f32x4*)(IW + (size_t)(tq + q) * 16 + 4 * fq); }
            __builtin_amdgcn_s_waitcnt(0x0F70);
            unsigned wp[4][2];
#pragma unroll
            for (int q = 0; q < 4; ++q) { wp[q][0] = pg8::pk_h2(w4[q][0], w4[q][1]); wp[q][1] = pg8::pk_h2(w4[q][2], w4[q][3]); }
#pragma unroll
            for (int r = 0; r < 4; ++r)
#pragma unroll
                for (int p = 0; p < 2; ++p) { const int i0 = 4 * r + 2 * p; const bool e0 = (fr == i0), e1 = (fr == i0 + 1);
                    A2[r][p] = (v4u){e0 ? wp[2 * p][0] : 0u, e0 ? wp[2 * p][1] : 0u, e1 ? wp[2 * p + 1][0] : 0u, e1 ? wp[2 * p + 1][1] : 0u}; } }
        __builtin_amdgcn_sched_barrier(0);
        TP_END(3)
#pragma unroll 1
        for (; kc <= kend; ++kc, ++L) {
            TP_BEG(2)
            const bool more = (L + 1 < L1);
            { const int kcp = more ? (kc < (qb >> 2) ? kc + 1 : 0) : kc; IDX_LOAD(kcp); }
            const LAS unsigned char* bb = lds + par * IDX_TILEB + fr * IDX_ROWB + fq * 16;
            h16x8 bq[2][4];
#pragma unroll
            for (int ks = 0; ks < 4; ++ks) bq[0][ks] = *(const LAS h16x8*)(bb + ks * 64);
            f32x4 d2 = {0.f, 0.f, 0.f, 0.f};
#pragma unroll
            for (int kt = 0; kt < 8; ++kt) {
                if (kt + 1 < 8) {
#pragma unroll
                    for (int ks = 0; ks < 4; ++ks) bq[(kt + 1) & 1][ks] = *(const LAS h16x8*)(bb + (kt + 1) * 16 * IDX_ROWB + ks * 64);
                    __builtin_amdgcn_sched_barrier(0); }
                const h16x8 (&b)[4] = bq[kt & 1];
#pragma unroll
                for (int p = 0; p < 2; ++p) { f32x4 s0 = {0.f, 0.f, 0.f, 0.f}, s1 = {0.f, 0.f, 0.f, 0.f};
#pragma unroll
                    for (int ks = 0; ks < 4; ++ks) { s0 = __builtin_amdgcn_mfma_f32_16x16x32_f16(a[2 * p][ks], b[ks], s0, 0, 0, 0); s1 = __builtin_amdgcn_mfma_f32_16x16x32_f16(a[2 * p + 1][ks], b[ks], s1, 0, 0, 0); }
                    const h16x2 z2 = {(h16)0.f, (h16)0.f};
                    h16x2 r0 = {(h16)s0[0], (h16)s0[1]}, r1 = {(h16)s0[2], (h16)s0[3]}, r2 = {(h16)s1[0], (h16)s1[1]}, r3 = {(h16)s1[2], (h16)s1[3]};
                    r0 = __builtin_elementwise_max(r0, z2); r1 = __builtin_elementwise_max(r1, z2); r2 = __builtin_elementwise_max(r2, z2); r3 = __builtin_elementwise_max(r3, z2);
                    const h16x8 b2 = {r0[0], r0[1], r1[0], r1[1], r2[0], r2[1], r3[0], r3[1]};
                    d2 = __builtin_amdgcn_mfma_f32_16x16x32_f16(__builtin_bit_cast(h16x8, A2[kt & 3][p]), b2, d2, 0, 0, 0); }
                if ((kt & 3) == 3) { const int tq = 32 * qb + 4 * wave;
#pragma unroll
                    for (int q = 0; q < 4; ++q) SC[(size_t)(tq + q) * SC_LD + kc * 128 + 64 * (kt >> 2) + lane] = (h16)d2[q];
                    d2 = (f32x4){0.f, 0.f, 0.f, 0.f}; }
                if (kt == IDX_WKT) { IDX_WRITE(par ^ 1); }
            }
            TP_BEG(1) TP_BEG(5)
            asm volatile("s_waitcnt lgkmcnt(0)" ::: "memory"); __builtin_amdgcn_s_barrier(); asm volatile("" ::: "memory");
            TP_END(5) TP_END(1) TP_END(2)
            par ^= 1;
        }
        ++qb; kc = 0;
    }
#if TPROBE
    { const unsigned long long t0 = __builtin_amdgcn_s_memrealtime(); while (__builtin_amdgcn_s_memrealtime() - t0 < (unsigned long long)TP_MULT * tp_acc) __builtin_amdgcn_s_sleep(2); }
#endif
#undef IDX_LOAD
#undef IDX_WRITE
}

template <int NR>
__device__ __forceinline__ unsigned kth_largest(const unsigned (&u)[NR], int K) {
    unsigned prefix = 0u;
#pragma unroll 1
    for (int bit = 15; bit >= 0; --bit) { const unsigned cand = prefix | (1u << bit); int cnt = 0;
#pragma unroll
        for (int i = 0; i < NR; ++i) { cnt += __builtin_popcountll(__ballot(u[i] >= cand)); if ((i & 31) == 31) __builtin_amdgcn_sched_barrier(0); }
        if (cnt >= K) prefix = cand; }
    return prefix;
}
template <int NR, bool ARR>
__device__ __forceinline__ void emit_topk(const unsigned (&u)[NR], unsigned thr_in, int* sel, const int (&keys)[ARR ? NR : 1], int lane) {
    unsigned thr = thr_in; int cgt = 0;
#pragma unroll
    for (int i = 0; i < NR; ++i) { cgt += __builtin_popcountll(__ballot(u[i] > thr)); if ((i & 7) == 7) __builtin_amdgcn_sched_barrier(0); }
    const int need = TOPK - cgt;
    asm volatile("" : "+s"(thr));
    int base = 0, eqseen = 0;
#pragma unroll
    for (int i = 0; i < NR; ++i) {
        const bool gt = u[i] > thr, eq = u[i] == thr;
        const unsigned long long eb = __ballot(eq);
        const int erank = eqseen + (int)__builtin_amdgcn_mbcnt_hi((unsigned)(eb >> 32), __builtin_amdgcn_mbcnt_lo((unsigned)eb, 0u));
        const bool take = gt || (eq && erank < need);
        const unsigned long long tb = __ballot(take);
        const int pos = base + (int)__builtin_amdgcn_mbcnt_hi((unsigned)(tb >> 32), __builtin_amdgcn_mbcnt_lo((unsigned)tb, 0u));
        if (take) sel[pos] = ARR ? keys[ARR ? i : 0] : 64 * i + lane;
        base += __builtin_popcountll(tb); eqseen += __builtin_popcountll(eb);
        __builtin_amdgcn_sched_barrier(0);
    }
}
constexpr int TK_CAP = 768, TK_TARGET = 448;
template <int NREG>
__device__ __forceinline__ void topk_load_row(unsigned (&u)[NREG], const h16* sc_in, int t_in, int lane) {
    static_assert(NREG % 16 == 0, "chunks of 16 registers");
#pragma unroll
    for (int c = 0; c < NREG / 16; ++c) {
        const GAS unsigned short* pc = (const GAS unsigned short*)(sc_in + 1024 * c); asm volatile("" : "+s"(pc));
#pragma unroll
        for (int k = 0; k < 16; ++k) u[16 * c + k] = (unsigned)pc[64 * k + lane];
    }
#pragma unroll
    for (int c = 0; c < NREG / 16; ++c) {
        int tl = t_in - 1024 * c; asm volatile("" : "+s"(tl));
#pragma unroll
        for (int k = 0; k < 16; ++k) { const unsigned b = u[16 * c + k]; const unsigned mk = (b >> 15) ? 0xFFFFu : 0x8000u; u[16 * c + k] = (lane <= tl - 64 * k) ? (b ^ mk) : 0u; }
        __builtin_amdgcn_sched_barrier(0);
    }
}
template <int NREG>
__device__ __forceinline__ void topk_row(const h16* sc_in, int t_in, int* sel, int lane_in, LAS unsigned long long* cand) {
    int lane = lane_in; asm volatile("" : "+v"(lane));
    if constexpr (NREG >= 64) {
        int cn = 0;
        {   unsigned u[NREG];
            topk_load_row<NREG>(u, sc_in, t_in, lane);
            constexpr int NS = NREG / 8;
            unsigned us[NS]; int nsv = 0;
#pragma unroll
            for (int s = 0; s < NS; ++s) { us[s] = u[8 * s]; const int rem = t_in + 1 - 512 * s; nsv += rem < 0 ? 0 : (rem > 64 ? 64 : rem); }
            int Ks = (TK_TARGET * nsv) / (t_in + 1); Ks = Ks < 1 ? 1 : Ks;
            unsigned tau = kth_largest<NS>(us, Ks);
            asm volatile("" : "+s"(tau));
#pragma unroll
            for (int c = 0; c < NREG / 16; ++c) {
                int kb = 1024 * c + lane; asm volatile("" : "+v"(kb));
#pragma unroll
                for (int k = 0; k < 16; ++k) { const int i = 16 * c + k; const bool m = u[i] >= tau && tau != 0u; const unsigned long long mb = __ballot(m);
                    const int pos = cn + (int)__builtin_amdgcn_mbcnt_hi((unsigned)(mb >> 32), __builtin_amdgcn_mbcnt_lo((unsigned)mb, 0u));
                    if (m && pos < TK_CAP) cand[pos] = ((unsigned long long)u[i] << 32) | (unsigned)(kb + 64 * k);
                    cn += __builtin_popcountll(mb); if ((k & 3) == 3) __builtin_amdgcn_sched_barrier(0); }
            }
        }
        asm volatile("" : "+s"(cn));
        if (cn >= TOPK && cn <= TK_CAP) {
            LDS_WAIT();
            unsigned cu[TK_CAP / 64]; int ck[TK_CAP / 64];
#pragma unroll
            for (int k = 0; k < TK_CAP / 64; ++k) { const int ix = 64 * k + lane; const unsigned long long v = cand[ix]; cu[k] = ix < cn ? (unsigned)(v >> 32) : 0u; ck[k] = (int)(unsigned)v; }
            const unsigned thr = kth_largest<TK_CAP / 64>(cu, TOPK);
            emit_topk<TK_CAP / 64, true>(cu, thr, sel, ck, lane);
            LDS_WAIT();
            return;
        }
    }
    {   unsigned u[NREG];
        topk_load_row<NREG>(u, sc_in, t_in, lane);
        const unsigned thr = kth_largest<NREG>(u, TOPK);
        const int nokeys[1] = {0}; emit_topk<NREG, false>(u, thr, sel, nokeys, lane); }
}
__device__ __forceinline__ void topk_phase(const h16* SC, int* SEL, LAS unsigned char* lds, int gw, int NGW, int wave, int lane) {
    LAS unsigned long long* cand = (LAS unsigned long long*)(lds + wave * (TK_CAP * 8));
    for (int t = gw; t < T; t += NGW) {
        const h16* sc = SC + (size_t)t * SC_LD; int* sel = SEL + (size_t)t * TOPK;
        if (t < TOPK) {
#pragma unroll
            for (int j = 0; j < 4; ++j) { const int k = lane + 64 * j; sel[k] = (k <= t) ? k : -1; }
        } else if (t < 2048) topk_row<32>(sc, t, sel, lane, cand);
        else if (t < 4096) topk_row<64>(sc, t, sel, lane, cand);
        else if (t < 6144) topk_row<96>(sc, t, sel, lane, cand);
        else topk_row<128>(sc, t, sel, lane, cand);
    }
}

__device__ __forceinline__ float dot8(h16x8 a, h16x8 b, float c) {
#if __has_builtin(__builtin_amdgcn_fdot2)
    c = __builtin_amdgcn_fdot2((h16x2){a[0], a[1]}, (h16x2){b[0], b[1]}, c, false); c = __builtin_amdgcn_fdot2((h16x2){a[2], a[3]}, (h16x2){b[2], b[3]}, c, false);
    c = __builtin_amdgcn_fdot2((h16x2){a[4], a[5]}, (h16x2){b[4], b[5]}, c, false); c = __builtin_amdgcn_fdot2((h16x2){a[6], a[7]}, (h16x2){b[6], b[7]}, c, false);
#else
#pragma unroll
    for (int e = 0; e < 8; ++e) c += (float)a[e] * (float)b[e];
#endif
    return c;
}
__device__ __forceinline__ void attn_phase(const h16* QH, const h16* KH, const h16* VH, const int* SEL, h16* O, LAS unsigned char* lds, int wg, int G, int wave, int lane) {
    LAS h16* qs = (LAS h16*)(lds + wave * 6144);
    LAS float* ps = (LAS float*)(lds + wave * 6144 + 1024);
    LAS int* is = (LAS int*)(lds + wave * 6144 + 5120);
    const int grp = lane >> 4, c = lane & 15;
    for (int L = wg; L < (T / 8) * NKV; L += G) {
        const int g = L & 3, t = 8 * (L >> 2) + wave;
        int idx[4];
#pragma unroll
        for (int j = 0; j < 4; ++j) idx[j] = SEL[(size_t)t * TOPK + lane + 64 * j];
        *(LAS h16x8*)(qs + lane * 8) = *(const h16x8*)(QH + (size_t)t * D + g * 512 + lane * 8);
#pragma unroll
        for (int j = 0; j < 4; ++j) is[lane + 64 * j] = idx[j] < 0 ? 0 : idx[j];
        LDS_WAIT();
        float sc[4][4];
#pragma unroll
        for (int j = 0; j < 4; ++j) { const h16* krow = KH + (size_t)(idx[j] < 0 ? 0 : idx[j]) * 512 + g * HD; h16x8 kf[16];
#pragma unroll
            for (int cc = 0; cc < 16; ++cc) kf[cc] = *(const h16x8*)(krow + 8 * cc);
#pragma unroll
            for (int hh = 0; hh < 4; ++hh) { float s = 0.f;
#pragma unroll
                for (int cc = 0; cc < 16; ++cc) s = dot8(kf[cc], *(const LAS h16x8*)(qs + hh * HD + 8 * cc), s);
                sc[j][hh] = (idx[j] < 0) ? -__builtin_inff() : s * 0.08838834764831845f; }
            __builtin_amdgcn_sched_barrier(0); }
#pragma unroll
        for (int hh = 0; hh < 4; ++hh) {
            const float mx = wave_max(fmaxf(fmaxf(sc[0][hh], sc[1][hh]), fmaxf(sc[2][hh], sc[3][hh])));
            float e0 = __expf(sc[0][hh] - mx), e1 = __expf(sc[1][hh] - mx), e2 = __expf(sc[2][hh] - mx), e3 = __expf(sc[3][hh] - mx);
            const float inv = 1.0f / wave_sum((e0 + e1) + (e2 + e3));
            sc[0][hh] = e0 * inv; sc[1][hh] = e1 * inv; sc[2][hh] = e2 * inv; sc[3][hh] = e3 * inv; }
#pragma unroll
        for (int j = 0; j < 4; ++j) *(LAS f32x4*)(ps + 4 * (lane + 64 * j)) = (f32x4){sc[j][0], sc[j][1], sc[j][2], sc[j][3]};
        LDS_WAIT();
        float acc[4][8];
#pragma unroll
        for (int hh = 0; hh < 4; ++hh)
#pragma unroll
            for (int e = 0; e < 8; ++e) acc[hh][e] = 0.f;
#pragma unroll 4
        for (int it = 0; it < 64; ++it) { const int kk = 4 * it + grp; const int ik = is[kk]; const f32x4 p4 = *(const LAS f32x4*)(ps + 4 * kk);
            const h16x8 v8 = *(const h16x8*)(VH + (size_t)ik * 512 + g * HD + 8 * c);
#pragma unroll
            for (int hh = 0; hh < 4; ++hh)
#pragma unroll
                for (int e = 0; e < 8; ++e) acc[hh][e] += p4[hh] * (float)v8[e];
            if ((it & 3) == 3) __builtin_amdgcn_sched_barrier(0); }
#pragma unroll
        for (int hh = 0; hh < 4; ++hh)
#pragma unroll
            for (int e = 0; e < 8; ++e) { float v = acc[hh][e]; v += __shfl_xor(v, 16); v += __shfl_xor(v, 32); acc[hh][e] = v; }
        float o8[8];
#pragma unroll
        for (int e = 0; e < 8; ++e) o8[e] = grp == 0 ? acc[0][e] : grp == 1 ? acc[1][e] : grp == 2 ? acc[2][e] : acc[3][e];
        v4u w; w.x = pkh(o8[0], o8[1]); w.y = pkh(o8[2], o8[3]); w.z = pkh(o8[4], o8[5]); w.w = pkh(o8[6], o8[7]);
        *(v4u*)(O + (size_t)t * D + (4 * g + grp) * HD + 8 * c) = w;
        LDS_WAIT();
    }
}

__device__ __forceinline__ void conv_phase(const h16* PROJ, const float* cw, const float* cb, h16* XC, int gtid, int NGT) {
    h16x8 xn[4];
#define CONV_LOAD(i_) do { const int c8_ = ((i_) & 255) * 8, t_ = (i_) >> 8; _Pragma("unroll") for (int j = 0; j < 4; ++j) { const int tt = t_ - 3 + j; xn[j] = *(const h16x8*)(PROJ + (size_t)(tt < 0 ? 0 : tt) * 4096 + 2048 + c8_); } } while (0)
    if (gtid < T * 256) CONV_LOAD(gtid);
    for (int i = gtid; i < T * 256; i += NGT) { const int c8 = (i & 255) * 8, t = i >> 8;
        h16x8 xv[4];
#pragma unroll
        for (int j = 0; j < 4; ++j) xv[j] = xn[j];
        if (i + NGT < T * 256) CONV_LOAD(i + NGT);
        float acc[8];
#pragma unroll
        for (int e = 0; e < 8; ++e) acc[e] = cb[c8 + e];
#pragma unroll
        for (int j = 0; j < 4; ++j) { const int tt = t - 3 + j; if (tt >= 0) {
            const f32x4 w0 = *(const f32x4*)(cw + j * 2048 + c8), w1 = *(const f32x4*)(cw + j * 2048 + c8 + 4);
#pragma unroll
            for (int e = 0; e < 4; ++e) { acc[e] += (float)xv[j][e] * w0[e]; acc[4 + e] += (float)xv[j][4 + e] * w1[e]; } } }
        v4u w; w.x = pkh(acc[0], acc[1]); w.y = pkh(acc[2], acc[3]); w.z = pkh(acc[4], acc[5]); w.w = pkh(acc[6], acc[7]);
        *(v4u*)(XC + (size_t)t * 2048 + c8) = w; }
#undef CONV_LOAD
}
constexpr int SCAN_LC = 32, SCAN_NCH = T / SCAN_LC;
__device__ __forceinline__ f32x4 ld_a4(const h16* LA, size_t o) { const h16x4 v = *(const h16x4*)(LA + o); return (f32x4){__expf((float)v[0]), __expf((float)v[1]), __expf((float)v[2]), __expf((float)v[3])}; }
__device__ __forceinline__ f32x4 ld_b4(const h16* BF, size_t o) { const h16x4 v = *(const h16x4*)(BF + o); return (f32x4){(float)v[0], (float)v[1], (float)v[2], (float)v[3]}; }
__device__ __forceinline__ void scan_agg_phase(const h16* AF, const h16* BF, float* AGGA, float* AGGB, int gtid, int NGT) {
    for (int i = gtid; i < SCAN_NCH * 512; i += NGT) { const int cg = (i & 511) * 4, k = i >> 9;
        f32x4 Pr = {1.f, 1.f, 1.f, 1.f}, H = {0.f, 0.f, 0.f, 0.f};
#pragma unroll 16
        for (int r = 0; r < SCAN_LC; ++r) { const size_t o = (size_t)(k * SCAN_LC + r) * 2048 + cg; const f32x4 a = ld_a4(AF, o), b = ld_b4(BF, o); H = a * H + b; Pr = Pr * a; }
        *(f32x4*)(AGGA + (size_t)k * 2048 + cg) = Pr; *(f32x4*)(AGGB + (size_t)k * 2048 + cg) = H; }
}
__device__ __forceinline__ void scan_carry_phase(const float* AGGA, const float* AGGB, float* CARRY, int vcu, int wave, int lane) {
    if (wave != 0 || vcu >= 16) return;
    const int c = (vcu * 64 + lane) * 2; f32x2 H = {0.f, 0.f};
#pragma unroll 1
    for (int k0 = 0; k0 < SCAN_NCH; k0 += 32) { f32x2 a[32], b[32];
#pragma unroll
        for (int j = 0; j < 32; ++j) { a[j] = *(const f32x2*)(AGGA + (size_t)(k0 + j) * 2048 + c); b[j] = *(const f32x2*)(AGGB + (size_t)(k0 + j) * 2048 + c); }
        __builtin_amdgcn_sched_barrier(0);
#pragma unroll
        for (int j = 0; j < 32; ++j) { *(f32x2*)(CARRY + (size_t)(k0 + j) * 2048 + c) = H; H = a[j] * H + b[j]; } }
}
__device__ __forceinline__ float gelu_tanh(float x) { const float u = 0.7978845608028654f * (x + 0.044715f * x * x * x); const float e = __expf(2.0f * u); const float th = 1.0f - 2.0f / (e + 1.0f); return 0.5f * x * (1.0f + th); }
__device__ __forceinline__ void scan_final_phase(const h16* AF, const h16* BF, const float* CARRY, const h16* PROJ, h16* Y, int gtid, int NGT) {
    for (int i = gtid; i < SCAN_NCH * 512; i += NGT) { const int cg = (i & 511) * 4, k = i >> 9;
        f32x4 H = *(const f32x4*)(CARRY + (size_t)k * 2048 + cg);
#pragma unroll 8
        for (int r = 0; r < SCAN_LC; ++r) { const int t = k * SCAN_LC + r; const size_t o = (size_t)t * 2048 + cg; const f32x4 a = ld_a4(AF, o), b = ld_b4(BF, o); H = a * H + b;
            const h16x4 gt = *(const h16x4*)(PROJ + (size_t)t * 4096 + cg);
            v2u w; w.x = pkh(H[0] * gelu_tanh((float)gt[0]), H[1] * gelu_tanh((float)gt[1])); w.y = pkh(H[2] * gelu_tanh((float)gt[2]), H[3] * gelu_tanh((float)gt[3]));
            *(v2u*)(Y + o) = w; } }
}
__device__ __forceinline__ f32x4 ldx4(const h16* p) { const h16x4 v = *(const h16x4*)p; return (f32x4){(float)v[0], (float)v[1], (float)v[2], (float)v[3]}; }
__device__ __forceinline__ void pool_phase(const h16* X, const float* gain, h16* Y, LAS unsigned char* lds, int wg, int G, int tid, int wave, int lane) {
    LAS float* rs = (LAS float*)lds;
    const int c4 = tid * 4; const int w = 2 << (tid >> 7);
    const f32x4 gn = *(const f32x4*)(gain + c4);
    for (int u = wg; u < T / 32; u += G) { const int t0 = 32 * u;
        __syncthreads();
        for (int r = wave; r < 47; r += NWAVES) { const int t = t0 - 15 + r;
            if (t >= 0) { const h16* xr = X + (size_t)t * D + 4 * lane; float s = 0.f;
#pragma unroll
                for (int j = 0; j < 8; ++j) { const f32x4 v = ldx4(xr + 256 * j); s += (v.x * v.x + v.y * v.y) + (v.z * v.z + v.w * v.w); }
                s = wave_sum(s); if (lane == 0) rs[r] = 1.0f / sqrtf(s * (1.0f / D) + EPS); } }
        __syncthreads();
        f32x4 sum = {0.f, 0.f, 0.f, 0.f};
        { const int n0 = (t0 + 1) < w ? (t0 + 1) : w;
          for (int j = 1; j < n0; ++j) sum += ldx4(X + (size_t)(t0 - j) * D + c4) * rs[15 - j]; }
#pragma unroll 8
        for (int r = 0; r < 32; ++r) { const int t = t0 + r; const int n = (t + 1) < w ? (t + 1) : w;
            const f32x4 h0 = ldx4(X + (size_t)t * D + c4) * rs[15 + r];
            sum += h0;
            const float invn = 1.0f / (float)n;
            const f32x4 y = (sum * invn - h0) * gn;
            v2u o; o.x = pkh(y.x, y.y); o.y = pkh(y.z, y.w); *(v2u*)(Y + (size_t)t * D + c4) = o;
            if (t + 1 >= w) sum -= ldx4(X + (size_t)(t + 1 - w) * D + c4) * rs[15 + r + 1 - w]; }
    }
}

__device__ __forceinline__ h16x8 f8x8_to_h(unsigned d0, unsigned d1) {
    const h16x2 a = __builtin_amdgcn_cvt_scalef32_pk_f16_fp8((int)d0, 1.0f, false), b = __builtin_amdgcn_cvt_scalef32_pk_f16_fp8((int)d0, 1.0f, true);
    const h16x2 c = __builtin_amdgcn_cvt_scalef32_pk_f16_fp8((int)d1, 1.0f, false), d = __builtin_amdgcn_cvt_scalef32_pk_f16_fp8((int)d1, 1.0f, true);
    return (h16x8){a[0], a[1], b[0], b[1], c[0], c[1], d[0], d[1]};
}
__device__ __forceinline__ unsigned attn_off_b(unsigned row, unsigned ch) { return 256u * row + 16u * (ch ^ (((row & 3u) << 2) | ((row >> 2) & 3u))); }
__device__ __forceinline__ void attn_mfma_phase(const unsigned char* Q8, const unsigned char* K8, const unsigned char* V8, const int* SEL, h16* O, LAS unsigned char* lds, int wg, int G, int wave, int lane_in) {
    typedef int i32x4 __attribute__((ext_vector_type(4)));
    typedef int i32x2 __attribute__((ext_vector_type(2)));
    typedef long i64x2 __attribute__((ext_vector_type(2)));
    i32x4 svn = {0, 0, 0, 0}; i64x2 qfn[2] = {{0, 0}, {0, 0}};
#define AT_PREF(L_) do { const int g_ = (L_) & 3, t_ = 8 * ((L_) >> 2) + wave; svn = *(const i32x4*)(SEL + (size_t)t_ * TOPK + 4 * lane_in); \
        _Pragma("unroll") for (int pp = 0; pp < 2; ++pp) qfn[pp] = *(const i64x2*)(Q8 + (size_t)t_ * D + (4 * g_ + (lane_in & 3)) * HD + 64 * pp + 16 * (lane_in >> 4)); } while (0)
    v4u kga[4], kgb[4];
#define AT_LOADK2(buf, G_, selk_, kbase_) do { const i32x2 i0 = *(const LAS i32x2*)((selk_) + 2 * (G_)), i1 = *(const LAS i32x2*)((selk_) + 128 + 2 * (G_)); \
            buf[0] = *(const v4u*)((kbase_) + (size_t)(i0.x < 0 ? 0 : i0.x) * 512); buf[1] = *(const v4u*)((kbase_) + (size_t)(i1.x < 0 ? 0 : i1.x) * 512); \
            buf[2] = *(const v4u*)((kbase_) + (size_t)(i0.y < 0 ? 0 : i0.y) * 512); buf[3] = *(const v4u*)((kbase_) + (size_t)(i1.y < 0 ? 0 : i1.y) * 512); } while (0)
#define AT_PREP(L_, par_) do { LAS int* sst_ = (LAS int*)(lds + LDSCTL_OFF + 1024 + wave * 2048 + (par_) * 1024); *(LAS i32x4*)(sst_ + 4 * lane_in) = svn; \
        asm volatile("s_waitcnt lgkmcnt(0)" ::: "memory"); \
        const LAS int* selk_ = sst_ + 16 * (lane_in >> 3); const unsigned char* kbase_ = K8 + ((L_) & 3) * HD + 16 * (lane_in & 7); \
        AT_LOADK2(kga, 0, selk_, kbase_); AT_LOADK2(kgb, 1, selk_, kbase_); } while (0)
    if (wg < (T / 8) * NKV) { AT_PREF(wg); AT_PREP(wg, 0); }
    int itpar = 0;
    for (int L = wg; L < (T / 8) * NKV; L += G, itpar ^= 1) {
        int lane = lane_in; asm volatile("" : "+v"(lane));
        const int jl = lane & 15, gi = lane >> 4;
        const int g = L & 3, t = 8 * (L >> 2) + wave;
        const int* sel = SEL + (size_t)t * TOPK; (void)sel;
        const int nvalid = (t + 1) < TOPK ? (t + 1) : TOPK;
        LAS int* sst = (LAS int*)(lds + LDSCTL_OFF + 1024 + wave * 2048 + itpar * 1024);
        i64x2 qf[2];
#pragma unroll
        for (int pp = 0; pp < 2; ++pp) qf[pp] = qfn[pp];
        LAS unsigned char* vimg = lds + wave * 16384;
        const LAS int* selk = sst + 16 * (lane >> 3);
        const unsigned char* kbase = K8 + g * HD + 16 * (lane & 7);
        const unsigned kwr = 136u * (unsigned)(lane >> 3) + 16u * (unsigned)(lane & 7), krd = 136u * (unsigned)jl + 16u * (unsigned)gi;
        f32x4 s[16];
#define AT_LOADK(buf, G_) AT_LOADK2(buf, G_, selk, kbase)
#define AT_KSTEP(buf, G_) do { LAS unsigned char* kb_ = vimg + ((G_) & 1) * 8192; \
            _Pragma("unroll") for (int j = 0; j < 4; ++j) { *(LAS v2u*)(kb_ + kwr + 1088 * j) = (v2u){buf[j].x, buf[j].y}; *(LAS v2u*)(kb_ + kwr + 1088 * j + 8) = (v2u){buf[j].z, buf[j].w}; } \
            if ((G_) + 2 < 8) AT_LOADK(buf, (G_) + 2); \
            _Pragma("unroll") for (int tt = 0; tt < 2; ++tt) { f32x4 acc = {0.f, 0.f, 0.f, 0.f}; \
                _Pragma("unroll") for (int pp = 0; pp < 2; ++pp) { const long a0 = *(const LAS long*)(kb_ + krd + 2176 * tt + 64 * pp), a1 = *(const LAS long*)(kb_ + krd + 2176 * tt + 64 * pp + 8); \
                    acc = __builtin_amdgcn_mfma_f32_16x16x32_fp8_fp8(a0, qf[pp].x, acc, 0, 0, 0); acc = __builtin_amdgcn_mfma_f32_16x16x32_fp8_fp8(a1, qf[pp].y, acc, 0, 0, 0); } \
                s[2 * (G_) + tt] = acc; } } while (0)
        if (L + G < (T / 8) * NKV) AT_PREF(L + G);
        AT_KSTEP(kga, 0); AT_KSTEP(kgb, 1); AT_KSTEP(kga, 2); AT_KSTEP(kgb, 3); AT_KSTEP(kga, 4); AT_KSTEP(kgb, 5); AT_KSTEP(kga, 6); AT_KSTEP(kgb, 7);
#undef AT_LOADK
#undef AT_KSTEP
        const LAS int* selv = sst + ((lane >> 5) & 1) + 16 * ((lane >> 3) & 3);
        const unsigned char* vbase = V8 + g * HD + 16 * (lane & 7);
        v4u vsa[4], vsb[4];
#define AT_LOADV(vst, Tt) do { _Pragma("unroll") for (int i = 0; i < 4; ++i) { const int ix = selv[2 * (Tt) + 64 * i]; vst[i] = *(const v4u*)(vbase + (size_t)(ix < 0 ? 0 : ix) * 512); } } while (0)
        AT_LOADV(vsa, 0); AT_LOADV(vsb, 1);
        __builtin_amdgcn_sched_barrier(0);
        if (nvalid < TOPK) {
#pragma unroll
            for (int kt = 0; kt < 16; ++kt)
#pragma unroll
                for (int r = 0; r < 4; ++r) if (kt + 64 * gi + 16 * r >= nvalid) s[kt][r] = -__builtin_inff();
        }
        float mx = -__builtin_inff();
#pragma unroll
        for (int kt = 0; kt < 16; ++kt) mx = fmaxf(mx, fmaxf(fmaxf(s[kt][0], s[kt][1]), fmaxf(s[kt][2], s[kt][3])));
        mx = fmaxf(mx, __shfl_xor(mx, 16)); mx = fmaxf(mx, __shfl_xor(mx, 32));
        constexpr float C2 = 0.08838834764831845f * 1.4426950408889634f;
        const float mb = -mx * C2; float sum = 0.f;
        h16x8 pf[8];
#pragma unroll
        for (int Tt = 0; Tt < 8; ++Tt) { float p[8];
#pragma unroll
            for (int r = 0; r < 4; ++r) { p[r] = __builtin_amdgcn_exp2f(fmaf(s[2 * Tt][r], C2, mb)); p[4 + r] = __builtin_amdgcn_exp2f(fmaf(s[2 * Tt + 1][r], C2, mb)); }
            sum += ((p[0] + p[1]) + (p[2] + p[3])) + ((p[4] + p[5]) + (p[6] + p[7]));
            pf[Tt] = (h16x8){(h16)p[0], (h16)p[1], (h16)p[2], (h16)p[3], (h16)p[4], (h16)p[5], (h16)p[6], (h16)p[7]}; }
        sum += __shfl_xor(sum, 16); sum += __shfl_xor(sum, 32);
        const float linv = 1.0f / sum;
        const unsigned q4 = (unsigned)jl >> 2, p4 = (unsigned)jl & 3u;
        unsigned wr_off[8], rd_off[2];
#pragma unroll
        for (int i = 0; i < 4; ++i) { wr_off[2 * i] = attn_off_b((unsigned)((lane >> 3) + 8 * i), 2u * (lane & 7)); wr_off[2 * i + 1] = attn_off_b((unsigned)((lane >> 3) + 8 * i), 2u * (lane & 7) + 1u); }
#pragma unroll
        for (int tt = 0; tt < 2; ++tt) { const unsigned row = 8u * gi + 4u * tt + q4; const unsigned x = ((row & 3u) << 2) | ((row >> 2) & 3u);
            rd_off[tt] = 256u * row + 16u * ((p4 >> 1) ^ (x & 1u)) + 8u * (p4 & 1u) + 32u * (x >> 1); }
        f32x4 o[8];
#pragma unroll
        for (int c = 0; c < 8; ++c) o[c] = (f32x4){0.f, 0.f, 0.f, 0.f};
#define AT_STEP(vst, Tt) do { \
            _Pragma("unroll") for (int i = 0; i < 4; ++i) {     \
                *(LAS h16x8*)(vimg + ((Tt) & 1) * 8192 + wr_off[2 * i]) = f8x8_to_h(vst[i].x, vst[i].y); *(LAS h16x8*)(vimg + ((Tt) & 1) * 8192 + wr_off[2 * i + 1]) = f8x8_to_h(vst[i].z, vst[i].w); } \
            if ((Tt) + 2 < 8) AT_LOADV(vst, (Tt) + 2); \
            const unsigned ib = (unsigned)(size_t)(vimg + ((Tt) & 1) * 8192); \
            h16x4 lo[8], hi[8]; \
            asm volatile("s_waitcnt lgkmcnt(0)" ::: "memory"); \
            _Pragma("unroll") for (int c = 0; c < 8; ++c) { \
                asm volatile("ds_read_b64_tr_b16 %0, %1" : "=&v"(lo[c]) : "v"(ib + (rd_off[0] ^ ((unsigned)c << 5))) : "memory"); \
                asm volatile("ds_read_b64_tr_b16 %0, %1" : "=&v"(hi[c]) : "v"(ib + (rd_off[1] ^ ((unsigned)c << 5))) : "memory"); } \
            asm volatile("s_waitcnt lgkmcnt(0)" ::: "memory"); __builtin_amdgcn_sched_barrier(0); \
            _Pragma("unroll") for (int c = 0; c < 8; ++c) o[c] = __builtin_amdgcn_mfma_f32_16x16x32_f16(pf[Tt], (h16x8){lo[c][0], lo[c][1], lo[c][2], lo[c][3], hi[c][0], hi[c][1], hi[c][2], hi[c][3]}, o[c], 0, 0, 0); \
        } while (0)
        AT_STEP(vsa, 0); AT_STEP(vsb, 1); AT_STEP(vsa, 2); AT_STEP(vsb, 3); AT_STEP(vsa, 4); AT_STEP(vsb, 5); AT_STEP(vsa, 6); AT_STEP(vsb, 7);
#undef AT_STEP
#undef AT_LOADV
        const float li = __shfl(linv, gi);
        h16* orow = O + (size_t)t * D + (4 * g + gi) * HD + jl;
#pragma unroll
        for (int c = 0; c < 8; ++c) { const float v = gi == 0 ? o[c][0] : gi == 1 ? o[c][1] : gi == 2 ? o[c][2] : o[c][3]; orow[16 * c] = (h16)(v * li); }
        asm volatile("s_waitcnt lgkmcnt(0)" ::: "memory");
        if (L + G < (T / 8) * NKV) AT_PREP(L + G, itpar ^ 1);
    }
#undef AT_PREF
#undef AT_PREP
#undef AT_LOADK2
}

constexpr int NPH = 38;
__global__ void __launch_bounds__(NTHR, 2) fwd_kernel(Ptrs P_unused) {
    extern __shared__ __attribute__((aligned(16))) unsigned char lds_raw[];
    LAS unsigned char* lds = (LAS unsigned char*)lds_raw;
    volatile LAS unsigned* MISC = (volatile LAS unsigned*)(lds + MISC_OFF);
    for (int u = threadIdx.x; u < (LDS_BYTES - LDSCTL_OFF) / 4; u += NTHR) ((LAS unsigned*)(lds + LDSCTL_OFF))[u] = 0u;
    __syncthreads();
    int lo, hi;
    XcdBarrier bar;
    { const CAS Ptrs* PP = kargs(); lo = PP->ph_lo; hi = PP->ph_hi; unsigned* bw = (unsigned*)(PP->ws + WS_CTL) + CW_BAR;
      bar.bar = bw; bar.x = 0; bar.st = nullptr; if (hi - lo > 1) bar = xcd_barrier_post(bw, MISC + 8); }
    int seq = 0;
#define PH_BEGIN(S_) if (seq >= lo && seq < hi) { const int site_ = (S_); unsigned long long tph0_ = 0; if (TPH_SITE == site_) tph0_ = __builtin_amdgcn_s_memrealtime(); const CAS Ptrs* PP = kargs(); unsigned char* const ws = PP->ws; float* const X = PP->out; (void)X; \
        int tid = threadIdx.x, bx = blockIdx.x, G = gridDim.x; asm volatile("" : "+v"(tid), "+s"(bx), "+s"(G)); \
        const int lane = tid & 63, wave = __builtin_amdgcn_readfirstlane(tid >> 6); const int vcu = (G % 8 == 0) ? (bx % 8) * (G / 8) + bx / 8 : bx; \
        const int gw = vcu * NWAVES + wave, NGW = G * NWAVES, gtid = vcu * NTHR + tid, NGT = G * NTHR; (void)lane; (void)gw; (void)NGW; (void)gtid; (void)NGT; \
        for (int rep_ = 0; rep_ < 1 + (int)((REP_MASK >> (S_)) & 1u); ++rep_) { if (rep_) __syncthreads(); \
        h16* const X16 = (h16*)(ws + WS_X16); h16* const PROJ = (h16*)(ws + WS_BA + BA_PROJ); h16* const U16 = (h16*)(ws + WS_BA + BA_U); (void)X16; (void)PROJ; (void)U16;
#define PH_END   } if (TPH_SITE == site_) { const unsigned long long t1_ = __builtin_amdgcn_s_memrealtime(), d_ = (unsigned long long)TPH_MULT * (t1_ - tph0_); while (__builtin_amdgcn_s_memrealtime() - t1_ < d_) __builtin_amdgcn_s_sleep(2); } \
                 if (seq + 1 < hi) xcd_barrier(bar); } ++seq;
#define RSQ(i_) ((float*)(ws + WS_CTL + WS_ROWSQ) + (size_t)(i_) * T)
#define PARTA ((float*)(ws + WS_PARTA))
#define PARTB ((float*)(ws + WS_PARTB))

    PH_BEGIN(0) p0_prologue(PP, lds, gw, NGW, wave, lane, gtid, NGT); norm0_phase(PP->x, X16, RSQ(0), gw, NGW, lane); PH_END

#pragma unroll 1
    for (int layer = 0; layer < DEPTH; ++layer) {
        const int kind = layer % 3, j = layer / 3;
        if (kind == 0) {
            PH_BEGIN(2) { pg8::Gemm g{X16, (const h16*)(ws + WS_WINA) + (size_t)j * A_INP * D, T, A_INP, D, D, 1 << 20, D, 128, 128}; pg8::StaticOrder S; S.init(T, A_INP, G, bx);
                       pg8::EpiF16<0> E{PROJ, A_INP, layer == 0 ? RSQ(0) : PARTB, 0, layer == 0 ? 0 : 32}; pg8::gemm_phase<pg8::EpiF16<0>, pg8::StaticOrder, true, true>(lds, g, S, E, tid); } PH_END
            PH_BEGIN(3) dsa_post_phase(PROJ, PP->attn_qn + j * HD, PP->attn_kn + j * HD, (const float*)(ws + WS_COS128), (const float*)(ws + WS_SIN128), (const float*)(ws + WS_COS64), (const float*)(ws + WS_SIN64),
                                    (unsigned char*)(ws + WS_QH), (unsigned char*)(ws + WS_KH), (unsigned char*)(ws + WS_VH), (h16*)(ws + WS_IQ), (h16*)(ws + WS_IK), (float*)(ws + WS_IW), gw, NGW, lane); PH_END
            PH_BEGIN(4) idx_scores_phase((const h16*)(ws + WS_IQ), (const h16*)(ws + WS_IK), (const float*)(ws + WS_IW), (h16*)(ws + WS_BA + BA_SC), lds, vcu, G, tid, wave, lane); PH_END
            PH_BEGIN(5) topk_phase((const h16*)(ws + WS_BA + BA_SC), (int*)(ws + WS_SEL), lds, gw, NGW, wave, lane); PH_END
            PH_BEGIN(6) attn_mfma_phase((const unsigned char*)(ws + WS_QH), (const unsigned char*)(ws + WS_KH), (const unsigned char*)(ws + WS_VH), (const int*)(ws + WS_SEL), (h16*)(ws + WS_BA + BA_O16), lds, bx, G, wave, lane); PH_END
            PH_BEGIN(7) { pg8::Gemm g{(const h16*)(ws + WS_BA + BA_O16), (const h16*)(ws + WS_WOUTA) + (size_t)j * D * D, T, D, D, D, 1 << 20, D, 128, 128}; pg8::StaticOrder S; S.init(T, D, G, bx);
                       pg8::EpiResid E{X16, X16, nullptr, D, nullptr, nullptr, PARTA}; pg8::gemm_phase<pg8::EpiResid, pg8::StaticOrder, true, true>(lds, g, S, E, tid); } PH_END
        } else if (kind == 1) {
            PH_BEGIN(9) { pg8::Gemm g{X16, (const h16*)(ws + WS_WINR), T, 4096, D, D, 1 << 20, D, 128, 128}; pg8::StaticOrder S; S.init(T, 4096, G, bx);
                       pg8::EpiF16<0> E{PROJ, 4096, layer == 0 ? RSQ(0) : PARTB, 0, layer == 0 ? 0 : 32}; pg8::gemm_phase<pg8::EpiF16<0>, pg8::StaticOrder, true, true>(lds, g, S, E, tid); } PH_END
            PH_BEGIN(10) conv_phase(PROJ, PP->conv_w, PP->conv_b, (h16*)(ws + WS_BA + BA_XC), gtid, NGT); PH_END
            PH_BEGIN(11) { int kg = 256; asm volatile("" : "+s"(kg));
                       pg8::Gemm g{(const h16*)(ws + WS_BA + BA_XC), (const h16*)(ws + WS_WGR), T, 4096, kg, D, 2, kg, 128, 128}; pg8::StaticOrder S; S.init(T, 4096, G, bx);
                       pg8::EpiGates E{(const h16*)(ws + WS_BA + BA_XC), PP->ga_b, PP->gx_b, PP->lam, (h16*)(ws + WS_BA + BA_AF), (h16*)(ws + WS_BA + BA_BF)};
                       pg8::gemm_phase<pg8::EpiGates, pg8::StaticOrder, true, true>(lds, g, S, E, tid); } PH_END
            PH_BEGIN(12) scan_agg_phase((const h16*)(ws + WS_BA + BA_AF), (const h16*)(ws + WS_BA + BA_BF), (float*)(ws + WS_AGGA), (float*)(ws + WS_AGGB), gtid, NGT); PH_END
            PH_BEGIN(21) scan_carry_phase((const float*)(ws + WS_AGGA), (const float*)(ws + WS_AGGB), (float*)(ws + WS_CARRY), vcu, wave, lane); PH_END
            PH_BEGIN(13) scan_final_phase((const h16*)(ws + WS_BA + BA_AF), (const h16*)(ws + WS_BA + BA_BF), (const float*)(ws + WS_CARRY), PROJ, (h16*)(ws + WS_BA + BA_XC), gtid, NGT); PH_END
            PH_BEGIN(14) { pg8::Gemm g{(const h16*)(ws + WS_BA + BA_XC), (const h16*)(ws + WS_WOUTR), T, D, D, D, 1 << 20, D, 128, 128}; pg8::StaticOrder S; S.init(T, D, G, bx);
                       pg8::EpiResid E{X16, X16, nullptr, D, nullptr, nullptr, PARTA}; pg8::gemm_phase<pg8::EpiResid, pg8::StaticOrder, true, true>(lds, g, S, E, tid); } PH_END
        } else {
            PH_BEGIN(15) pool_phase(X16, PP->pool_norm, (h16*)(ws + WS_BA + BA_XC), lds, vcu, G, tid, wave, lane); PH_END
            PH_BEGIN(16) { pg8::Gemm g{(const h16*)(ws + WS_BA + BA_XC), (const h16*)(ws + WS_WPOOL), T, D, 512, D, 2, 512, 128, 128}; pg8::StaticOrder S; S.init(T, D, G, bx);
                       pg8::EpiResid E{X16, X16, nullptr, D, PP->pool_b, PP->pool_scale, PARTA}; pg8::gemm_phase<pg8::EpiResid, pg8::StaticOrder, true, true>(lds, g, S, E, tid); } PH_END
        }
        PH_BEGIN(17) quant_rows(X16, T, (signed char*)(ws + WS_BA + BA_A8), (float*)(ws + WS_RS), PARTA, nullptr, gw, NGW, lane);
                     quant_rows((const h16*)(ws + WS_WUP) + (size_t)layer * D * FF, FF, (signed char*)(ws + WS_BA + BA_W8), (float*)(ws + WS_CS), nullptr, (const unsigned*)(ws + WS_BLKMAX) + (size_t)layer * 32 * FF, gw, NGW, lane); PH_END
        PH_BEGIN(18) { pg8::Gemm g{(const h16*)(ws + WS_BA + BA_A8), (const h16*)(ws + WS_BA + BA_W8), T, FF, D / 2, D / 2, 1 << 20, D / 2, 128, 128}; pg8::StaticOrder S; S.init(T, FF, G, bx);
                   pg8::EpiQRelu2<pg8::i32x4> E{U16, (const float*)(ws + WS_RS), (const float*)(ws + WS_CS), T}; pg8::gemm_phase_i8<pg8::EpiQRelu2<pg8::i32x4>, pg8::StaticOrder, true, true>(lds, g, S, E, tid); } PH_END
        PH_BEGIN(19) quant_kblk<true>(U16, T, (signed char*)(ws + WS_BA + BA_U8), (float*)(ws + WS_RS2), nullptr, nullptr, gw, NGW, lane);
                     quant_kblk<false>((const h16*)(ws + WS_WDOWN) + (size_t)layer * D * FF, D, (signed char*)(ws + WS_BA + BA_W8D), (float*)(ws + WS_CS2), (float*)(ws + WS_CSUM), (const unsigned*)(ws + WS_BLKMAXD) + (size_t)layer * 128 * D, gw, NGW, lane); PH_END
        PH_BEGIN(20) { pg8::Gemm g{(const h16*)(ws + WS_BA + BA_U8), (const h16*)(ws + WS_BA + BA_W8D), T, D, FF / 2, 64, 1 << 20, 64, (size_t)T * 128, (size_t)D * 128}; pg8::StaticOrder S; S.init(T, D, G, bx);
                   const bool lastl = layer + 1 >= DEPTH, needsq = !lastl && (layer + 1) % 3 != 2;
                   pg8::EpiResidQ E{X16, X16, lastl ? X : nullptr, D, (const float*)(ws + WS_RS2), (const float*)(ws + WS_CS2), (const float*)(ws + WS_CSUM), needsq ? PARTB : nullptr};
                   pg8::gemm_phase_i8<pg8::EpiResidQ, pg8::StaticOrder, true, true>(lds, g, S, E, tid); } PH_END
    }
#undef PH_BEGIN
#undef PH_END
#undef RSQ
#undef PARTA
#undef PARTB
}

extern "C" void kernel_launch(void* const* d_in, const int* in_sizes, int n_in, void* d_out, int out_size, void* d_ws, size_t ws_size, hipStream_t stream) {
    static int grid = 0;
    if (grid == 0) {
        if (n_in != 24 || in_sizes[0] != T * D || out_size != T * D || ws_size < WS_END) { fprintf(stderr, "kernel_launch: unexpected shapes / workspace (n_in %d, in0 %d, out %d, ws %zu, need %zu); nothing launched\n", n_in, n_in > 0 ? in_sizes[0] : -1, out_size, ws_size, (size_t)WS_END); grid = -1; return; }
        int dev = 0, cus = 0, per_cu = 0;
        if (hipGetDevice(&dev) != hipSuccess || hipDeviceGetAttribute(&cus, hipDeviceAttributeMultiprocessorCount, dev) != hipSuccess) { grid = -1; return; }
        if (hipFuncSetAttribute((const void*)fwd_kernel, hipFuncAttributeMaxDynamicSharedMemorySize, LDS_BYTES) != hipSuccess) { fprintf(stderr, "kernel_launch: hipFuncSetAttribute failed\n"); grid = -1; return; }
        if (hipOccupancyMaxActiveBlocksPerMultiprocessor(&per_cu, (const void*)fwd_kernel, NTHR, LDS_BYTES) != hipSuccess || per_cu < 1) { fprintf(stderr, "kernel_launch: occupancy query reports %d workgroups per CU\n", per_cu); }
        (void)hipGetLastError();
        grid = cus;
    }
    if (grid < 0) return;
    if (hipMemsetAsync((char*)d_ws + WS_CTL, 0, CTL_ZERO_BYTES, stream) != hipSuccess) return;
    Ptrs p{};
    p.x = (const float*)d_in[0]; p.pos = (const int*)d_in[1];
    p.attn_norm = (const float*)d_in[2]; p.attn_w_in = (const float*)d_in[3]; p.attn_qn = (const float*)d_in[4]; p.attn_kn = (const float*)d_in[5]; p.attn_w_out = (const float*)d_in[6];
    p.rnn_norm = (const float*)d_in[7]; p.rnn_w_in = (const float*)d_in[8]; p.conv_w = (const float*)d_in[9]; p.conv_b = (const float*)d_in[10]; p.ga_w = (const float*)d_in[11]; p.ga_b = (const float*)d_in[12];
    p.gx_w = (const float*)d_in[13]; p.gx_b = (const float*)d_in[14]; p.lam = (const float*)d_in[15]; p.rnn_w_out = (const float*)d_in[16];
    p.pool_norm = (const float*)d_in[17]; p.pool_w = (const float*)d_in[18]; p.pool_b = (const float*)d_in[19]; p.pool_scale = (const float*)d_in[20];
    p.mlp_norm = (const float*)d_in[21]; p.mlp_w_up = (const float*)d_in[22]; p.mlp_w_down = (const float*)d_in[23];
    p.out = (float*)d_out; p.ws = (unsigned char*)d_ws;
#if MK_SPLIT
    for (int ph = 0; ph < NPH; ++ph) { p.ph_lo = ph; p.ph_hi = ph + 1; hipLaunchKernelGGL(fwd_kernel, dim3(grid), dim3(NTHR), LDS_BYTES, stream, p); }
#else
    p.ph_lo = 0; p.ph_hi = NPH; hipLaunchKernelGGL(fwd_kernel, dim3(grid), dim3(NTHR), LDS_BYTES, stream, p);
#endif
}
```

```cpp
#include <hip/hip_runtime.h>
#include <cstdio>
#include <cstdint>

#ifndef REP_MASK
#define REP_MASK 0u
#ifndef TPROBE
#define TPROBE 0
#endif
#ifndef TP_MULT
#define TP_MULT 4
#endif
#ifndef TPH_SITE
#define TPH_SITE (-1)
#define TPH_MULT 1
#endif
#endif
#ifndef MK_SPLIT
#define MK_SPLIT 0
#endif

namespace pg8 {
#define PG8_LAS __attribute__((address_space(3)))
typedef _Float16 bf16_t;
typedef _Float16 bf16x8 __attribute__((ext_vector_type(8)));
typedef float f32x4 __attribute__((ext_vector_type(4)));
typedef unsigned u32x4 __attribute__((ext_vector_type(4)));
typedef unsigned u32x2 __attribute__((ext_vector_type(2)));
typedef _Float16 h16x2 __attribute__((ext_vector_type(2)));
typedef _Float16 h16x4 __attribute__((ext_vector_type(4)));
typedef _Float16 h16x8e __attribute__((ext_vector_type(8)));
constexpr int BM = 256, BK = 64, HALF = 128, HTB = HALF * BK * 2  , STAGE_BYTES = 8 * HTB, NXCD = 8, WGM = 8;

__host__ __device__ __forceinline__ int lds_byte(int r, int c) { const int st = (r >> 4) * 2 + (c >> 5), rr = r & 15, cc = c & 31, ob = rr * 64 + cc * 2; return st * 1024 + (ob ^ (((ob >> 9) & 1) << 5)); }
__host__ __device__ __forceinline__ void stage_rc(int b, int& R, int& C) { const int st = b / 1024, sb = b % 1024, swz = sb ^ (((sb >> 9) & 1) << 5); R = (st >> 1) * 16 + swz / 64; C = (st & 1) * 32 + (swz % 64) / 2; }
__host__ __device__ __forceinline__ int perm32(int rho) { const int n = rho >> 4, i = rho & 15; return 8 * (i >> 2) + 4 * n + (i & 3); }

struct Unit { int pm, pn; };
struct Gemm { const bf16_t* A; const bf16_t* Bt; int M, N, K, lda, npg, ldb; size_t kstepA, kstepB; };

struct StaticOrder {
    int nM, nN, nwg, G, c;
    __host__ __device__ void init(int M, int N, int G_, int c_) { nM = M / BM; nN = N / BM; nwg = nM * nN; G = G_; c = c_; }
    __host__ __device__ bool next(int i, Unit& u) const {
        const long L = (long)i * G + c; if (L >= nwg) return false;
        int wgid = (int)L; { const int q = nwg / NXCD, r = nwg % NXCD, xcd = wgid % NXCD, off = wgid / NXCD; wgid = (xcd < r ? xcd * (q + 1) : r * (q + 1) + (xcd - r) * q) + off; }
        const int nig = WGM * nN, gid = wgid / nig, fm = gid * WGM, gsz = (nM - fm) < WGM ? (nM - fm) : WGM;
        u.pm = fm + ((wgid % nig) % gsz); u.pn = (wgid % nig) / gsz; return true;
    }
    __device__ __forceinline__ void a_ready(const Unit&) const {}
    __device__ __forceinline__ void done(const Unit&) const {}
};

__device__ __forceinline__ unsigned pk_h2(float lo, float hi) { h16x2 v = {(_Float16)lo, (_Float16)hi}; return __builtin_bit_cast(unsigned, v); }

template <int ACT> struct EpiF16 {
    static constexpr bool PERM = true, WIDE = true, AFTER_DRAIN = false;
    bf16_t* O; int ldc; const float* rowsq; int kblk_rows; int npart;
    __device__ __forceinline__ void operator()(const f32x4 (&acc)[2][2][4][2], const Unit& u, int wr, int wc, int fr, int fq) const {
        const int row0 = u.pm * BM + wr * 64 + fr, col0 = u.pn * BM + wc * 64 + 8 * fq;
#pragma unroll
        for (int ai = 0; ai < 2; ++ai)
#pragma unroll
            for (int m = 0; m < 4; ++m) { const int row = row0 + ai * HALF + m * 16;
                bf16_t* rowp = kblk_rows ? O + ((size_t)(col0 >> 6) * kblk_rows + row) * 64 + (col0 & 63) : O + (size_t)row * ldc + col0;
                const size_t bjstep = 32;
                float rs = 1.0f; if (rowsq) { float ssq;
                    if (npart) { const f32x4* pp = (const f32x4*)(rowsq + (size_t)row * 32); f32x4 a4 = pp[0];
#pragma unroll
                        for (int q = 1; q < 8; ++q) a4 += pp[q];
                        ssq = (a4[0] + a4[1]) + (a4[2] + a4[3]); }
                    else ssq = rowsq[row];
                    rs = 1.0f / sqrtf(ssq * (1.0f / 2048.0f) + 1e-6f); if (ACT == 1) rs = rs * rs; }
#pragma unroll
                for (int bj = 0; bj < 2; ++bj) { f32x4 v0 = acc[ai][bj][m][0], v1 = acc[ai][bj][m][1];
                    if (ACT == 1) {
#pragma unroll
                        for (int j = 0; j < 4; ++j) { const float a = fmaxf(v0[j], 0.f), b = fmaxf(v1[j], 0.f); v0[j] = a * a; v1[j] = b * b; } }
                    v0 = v0 * rs; v1 = v1 * rs;
                    u32x4 w; w.x = pk_h2(v0[0], v0[1]); w.y = pk_h2(v0[2], v0[3]); w.z = pk_h2(v1[0], v1[1]); w.w = pk_h2(v1[2], v1[3]);
                    *(u32x4*)(rowp + bj * bjstep) = w; } }
    }
};
typedef int i32x4e __attribute__((ext_vector_type(4)));
template <class AccV> struct EpiQRelu2;
template <class AccV> struct EpiQRelu2 {
    static constexpr bool PERM = true, WIDE = true, AFTER_DRAIN = false;
    bf16_t* O; const float* rs; const float* cs; int kblk_rows;
    __device__ __forceinline__ void operator()(const AccV (&acc)[2][2][4][2], const Unit& u, int wr, int wc, int fr, int fq) const {
        const int row0 = u.pm * BM + wr * 64 + fr, col0 = u.pn * BM + wc * 64 + 8 * fq;
        f32x4 cv[2][2];
#pragma unroll
        for (int bj = 0; bj < 2; ++bj)
#pragma unroll
            for (int n = 0; n < 2; ++n) cv[bj][n] = *(const f32x4*)(cs + col0 + bj * 32 + 4 * n);
#pragma unroll
        for (int ai = 0; ai < 2; ++ai)
#pragma unroll
            for (int m = 0; m < 4; ++m) { const int row = row0 + ai * HALF + m * 16; const float r = rs[row];
                bf16_t* rowp = O + ((size_t)(col0 >> 6) * kblk_rows + row) * 64 + (col0 & 63); const size_t bjstep = 32;
#pragma unroll
                for (int bj = 0; bj < 2; ++bj) { f32x4 v0, v1;
#pragma unroll
                    for (int j = 0; j < 4; ++j) { const float a = fmaxf((float)acc[ai][bj][m][0][j] * (r * cv[bj][0][j]), 0.f), b = fmaxf((float)acc[ai][bj][m][1][j] * (r * cv[bj][1][j]), 0.f); v0[j] = a * a; v1[j] = b * b; }
                    u32x4 w; w.x = pk_h2(v0[0], v0[1]); w.y = pk_h2(v0[2], v0[3]); w.z = pk_h2(v1[0], v1[1]); w.w = pk_h2(v1[2], v1[3]);
                    *(u32x4*)(rowp + bj * bjstep) = w; } }
    }
};
struct EpiResid {
    static constexpr bool PERM = true, WIDE = true, AFTER_DRAIN = false;
    const bf16_t* res; bf16_t* out; float* out32; int ldc; const float* bias; const float* scale; float* rowsq;
    __device__ __forceinline__ void operator()(const f32x4 (&acc)[2][2][4][2], const Unit& u, int wr, int wc, int fr, int fq) const {
        const int row0 = u.pm * BM + wr * 64 + fr, col0 = u.pn * BM + wc * 64 + 8 * fq;
#pragma unroll
        for (int ai = 0; ai < 2; ++ai)
#pragma unroll
            for (int m = 0; m < 4; ++m) { const int row = row0 + ai * HALF + m * 16; const size_t off = (size_t)row * ldc + col0; float sq = 0.f;
#pragma unroll
                for (int bj = 0; bj < 2; ++bj) { const int cc = bj * 32; const h16x8e rh = *(const h16x8e*)(res + off + cc); float o[8];
#pragma unroll
                    for (int n = 0; n < 2; ++n) { const f32x4 bv = bias ? *(const f32x4*)(bias + col0 + cc + 4 * n) : (f32x4){0.f, 0.f, 0.f, 0.f}, sv = scale ? *(const f32x4*)(scale + col0 + cc + 4 * n) : (f32x4){1.f, 1.f, 1.f, 1.f};
#pragma unroll
                        for (int j = 0; j < 4; ++j) { o[4 * n + j] = (float)rh[4 * n + j] + (acc[ai][bj][m][n][j] + bv[j]) * sv[j]; sq += o[4 * n + j] * o[4 * n + j]; } }
                    if (out32) { *(f32x4*)(out32 + off + cc) = (f32x4){o[0], o[1], o[2], o[3]}; *(f32x4*)(out32 + off + cc + 4) = (f32x4){o[4], o[5], o[6], o[7]}; }
                    else { u32x4 w; w.x = pk_h2(o[0], o[1]); w.y = pk_h2(o[2], o[3]); w.z = pk_h2(o[4], o[5]); w.w = pk_h2(o[6], o[7]); *(u32x4*)(out + off + cc) = w; } }
                if (rowsq) { sq += __shfl_xor(sq, 16); sq += __shfl_xor(sq, 32); if (fq == 0) rowsq[(size_t)row * 32 + u.pn * 4 + wc] = sq; }
                asm volatile("" ::: "memory"); }
    }
};
struct EpiResidQ {
    static constexpr bool PERM = true, WIDE = true, AFTER_DRAIN = false;
    const bf16_t* res; bf16_t* out; float* out32; int ldc; const float* rs; const float* cs; const float* csum; float* rowsq;
    __device__ __forceinline__ void operator()(const i32x4e (&acc)[2][2][4][2], const Unit& u, int wr, int wc, int fr, int fq) const {
        const int row0 = u.pm * BM + wr * 64 + fr, col0 = u.pn * BM + wc * 64 + 8 * fq;
#pragma unroll
        for (int ai = 0; ai < 2; ++ai)
#pragma unroll
            for (int m = 0; m < 4; ++m) { const int row = row0 + ai * HALF + m * 16; const size_t off = (size_t)row * ldc + col0; float sq = 0.f; const float rsv = rs[row];
#pragma unroll
                for (int bj = 0; bj < 2; ++bj) { const int cc = bj * 32; const h16x8e rh = *(const h16x8e*)(res + off + cc); float o[8];
#pragma unroll
                    for (int n = 0; n < 2; ++n) { const f32x4 cv = *(const f32x4*)(cs + col0 + cc + 4 * n), zv = *(const f32x4*)(csum + col0 + cc + 4 * n);
#pragma unroll
                        for (int j = 0; j < 4; ++j) { o[4 * n + j] = (float)rh[4 * n + j] + (rsv * cv[j]) * ((float)acc[ai][bj][m][n][j] + 128.0f * zv[j]); sq += o[4 * n + j] * o[4 * n + j]; } }
                    if (out32) { *(f32x4*)(out32 + off + cc) = (f32x4){o[0], o[1], o[2], o[3]}; *(f32x4*)(out32 + off + cc + 4) = (f32x4){o[4], o[5], o[6], o[7]}; }
                    else { u32x4 w; w.x = pk_h2(o[0], o[1]); w.y = pk_h2(o[2], o[3]); w.z = pk_h2(o[4], o[5]); w.w = pk_h2(o[6], o[7]); *(u32x4*)(out + off + cc) = w; } }
                if (rowsq) { sq += __shfl_xor(sq, 16); sq += __shfl_xor(sq, 32); if (fq == 0) rowsq[(size_t)row * 32 + u.pn * 4 + wc] = sq; }
                asm volatile("" ::: "memory"); }
    }
};
struct EpiGates {
    static constexpr bool PERM = false, WIDE = false, AFTER_DRAIN = false;
    const bf16_t* XC; const float* ba; const float* bx; const float* lam; bf16_t* AF; bf16_t* BF;
    __device__ __forceinline__ void operator()(const f32x4 (&acc)[2][2][4][2], const Unit& u, int wr, int wc, int fr, int fq) const {
        const int row0 = u.pm * BM + wr * 64 + fr, ch0 = (u.pn >> 1) * 256 + (u.pn & 1) * 128 + wc * 32 + 4 * fq;
#pragma unroll
        for (int n = 0; n < 2; ++n) {
            const f32x4 bav = *(const f32x4*)(ba + ch0 + n * 16), bxv = *(const f32x4*)(bx + ch0 + n * 16), l = *(const f32x4*)(lam + ch0 + n * 16); f32x4 spv;
#pragma unroll
            for (int j = 0; j < 4; ++j) spv[j] = -8.0f * log1pf(__expf(-l[j]));
#pragma unroll
            for (int ai = 0; ai < 2; ++ai)
#pragma unroll
                for (int m = 0; m < 4; ++m) { const size_t off = (size_t)(row0 + ai * HALF + m * 16) * 2048 + ch0 + n * 16;
                    const h16x4 xh = *(const h16x4*)(XC + off); f32x4 av, bv;
#pragma unroll
                    for (int j = 0; j < 4; ++j) { const float r = __builtin_amdgcn_rcpf(1.0f + __expf(-(acc[ai][0][m][n][j] + bav[j]))), ig = __builtin_amdgcn_rcpf(1.0f + __expf(-(acc[ai][1][m][n][j] + bxv[j])));
                        const float la = r * spv[j]; av[j] = la;
                        const float y = 2.0f * la;
                        const float em = y * (1.0f + y * 0.5f * (1.0f + y * (1.0f / 3.0f) * (1.0f + y * 0.25f * (1.0f + y * 0.2f * (1.0f + y * (1.0f / 6.0f) * (1.0f + y * (1.0f / 7.0f)))))));
                        const float om = (y > -0.5f) ? -em : 1.0f - __expf(y);
                        bv[j] = (float)xh[j] * ig * __builtin_amdgcn_sqrtf(fmaxf(om, 0.f)); }
                    { u32x2 w; w.x = pk_h2(av[0], av[1]); w.y = pk_h2(av[2], av[3]); *(u32x2*)(AF + off) = w; w.x = pk_h2(bv[0], bv[1]); w.y = pk_h2(bv[2], bv[3]); *(u32x2*)(BF + off) = w; }
                    asm volatile("" ::: "memory"); }
        }
    }
};

template <class Epi, class Sched, bool ALIGN_EPI = false, bool SP2 = false>
__device__ __forceinline__ void gemm_phase(PG8_LAS unsigned char* lds, const Gemm g, const Sched& S, const Epi& E, const int tid) {
    const int wid = __builtin_amdgcn_readfirstlane(tid >> 6), lane = tid & 63, wr = wid >> 2, wc = wid & 3, fr = lane & 15, fq = lane >> 4;
    const int K = g.K, nt = K / BK;
    unsigned voffA[2], voffB[2];
#pragma unroll
    for (int i = 0; i < 2; ++i) { int R, C; stage_rc(tid * 16 + i * 8192, R, C); const int Rb = Epi::WIDE ? (64 * (R >> 5) + perm32(R & 31)) : (Epi::PERM ? ((R & ~31) + perm32(R & 31)) : R);
        voffA[i] = (unsigned)(R * g.lda + C) * 2u; voffB[i] = (unsigned)(Rb * g.ldb + C) * 2u; }
    const size_t kstepA = g.kstepA, kstepB = g.kstepB;
    const size_t hstepA = (size_t)HALF * g.lda * 2, hstepB = (size_t)(Epi::WIDE ? 32 : HALF) * g.ldb * 2;
#define PG8_ABASE(u) ((const char*)g.A + ((size_t)(u).pm * BM * g.lda + (size_t)((u).pn / g.npg) * K) * 2)
#define PG8_BBASE(u) ((const char*)g.Bt + (size_t)(u).pn * BM * g.ldb * 2)
    const unsigned ldsw = (unsigned)wid * 1024u;
    const int aoff = lds_byte(wr * 64 + fr, fq * 8), boff = lds_byte(wc * 32 + fr, fq * 8);
#define PG8_SA(b, h) (((b) * 2 + (h)) * HTB)
#define PG8_SB(b, h) ((4 + (b) * 2 + (h)) * HTB)
#define PG8_STAGE(bufoff, gbase, voff) do { _Pragma("unroll") for (int _i = 0; _i < 2; ++_i) \
        __builtin_amdgcn_global_load_lds((const unsigned*)((const char*)(gbase) + (voff)[_i]), (PG8_LAS unsigned*)(lds + (bufoff) + ldsw + _i * 8192), 16, 0, 0); } while (0)
#define PG8_LDA(dst, b, h) do { _Pragma("unroll") for (int m = 0; m < 4; ++m) _Pragma("unroll") for (int k = 0; k < 2; ++k) dst[m][k] = *(const PG8_LAS bf16x8*)(lds + PG8_SA(b, h) + aoff + m * 2048 + k * 1024); } while (0)
#define PG8_LDB(dst, b, h) do { _Pragma("unroll") for (int n = 0; n < 2; ++n) _Pragma("unroll") for (int k = 0; k < 2; ++k) dst[n][k] = *(const PG8_LAS bf16x8*)(lds + PG8_SB(b, h) + boff + n * 2048 + k * 1024); } while (0)
#define PG8_MMA(ai, bj, At, Bt) do { __builtin_amdgcn_s_setprio(1); _Pragma("unroll") for (int m = 0; m < 4; ++m) _Pragma("unroll") for (int n = 0; n < 2; ++n) _Pragma("unroll") for (int k = 0; k < 2; ++k) \
        acc[ai][bj][m][n] = __builtin_amdgcn_mfma_f32_16x16x32_f16(Bt[n][k], At[m][k], acc[ai][bj][m][n], 0, 0, 0); __builtin_amdgcn_s_setprio(0); } while (0)
#define PG8_WAIT_V(n) asm volatile("s_waitcnt vmcnt(" #n ")" ::: "memory")
#define PG8_WAIT_L(n) asm volatile("s_waitcnt lgkmcnt(" #n ")" ::: "memory")
#define PG8_BAR __builtin_amdgcn_s_barrier()
#define PG8_SCHED __builtin_amdgcn_sched_barrier(0)
    Unit cur, nxt; int ui = 0;
    if (!S.next(0, cur)) return;
    f32x4 acc[2][2][4][2];
#pragma unroll
    for (int a = 0; a < 2; ++a)
#pragma unroll
        for (int b = 0; b < 2; ++b)
#pragma unroll
            for (int m = 0; m < 4; ++m)
#pragma unroll
                for (int n = 0; n < 2; ++n) acc[a][b][m][n] = (f32x4){0.f, 0.f, 0.f, 0.f};
    bf16x8 At[4][2], B0[2][2], B1[2][2];
    const char* cA = PG8_ABASE(cur); const char* cB = PG8_BBASE(cur);
    S.a_ready(cur);
    if constexpr (SP2) {
        PG8_STAGE(PG8_SB(0, 0), cB, voffB); PG8_STAGE(PG8_SB(0, 1), cB + hstepB, voffB); PG8_STAGE(PG8_SA(0, 0), cA, voffA); PG8_STAGE(PG8_SA(0, 1), cA + hstepA, voffA);
        if (wr == 1) PG8_BAR;
        PG8_WAIT_V(2); PG8_BAR;
        PG8_STAGE(PG8_SB(1, 0), cB + kstepB, voffB); PG8_STAGE(PG8_SA(1, 0), cA + kstepA, voffA); PG8_STAGE(PG8_SB(1, 1), cB + hstepB + kstepB, voffB);
        PG8_WAIT_V(6); PG8_BAR;
    } else {
        PG8_STAGE(PG8_SB(0, 0), cB, voffB); PG8_STAGE(PG8_SA(0, 0), cA, voffA); PG8_STAGE(PG8_SB(0, 1), cB + hstepB, voffB); PG8_STAGE(PG8_SA(0, 1), cA + hstepA, voffA);
        if (wr == 1) PG8_BAR;
        PG8_WAIT_V(4); PG8_BAR;
        PG8_STAGE(PG8_SB(1, 0), cB + kstepB, voffB); PG8_STAGE(PG8_SA(1, 0), cA + kstepA, voffA); PG8_STAGE(PG8_SB(1, 1), cB + hstepB + kstepB, voffB);
        PG8_WAIT_V(6); PG8_BAR;
    }
    for (;;) {
        const bool has_next = S.next(ui + 1, nxt);
        const char* nA = has_next ? PG8_ABASE(nxt) : cA; const char* nB = has_next ? PG8_BBASE(nxt) : cB;
        for (int t = 0; t < nt; t += 2) {
            const bool last = (t == nt - 2);
            const char* a1 = cA + (size_t)(t + 1) * kstepA;
            const char* a2 = last ? nA : cA + (size_t)(t + 2) * kstepA; const char* b2 = last ? nB : cB + (size_t)(t + 2) * kstepB;
            const char* a3 = a2 + kstepA; const char* b3 = b2 + kstepB;
            if (last && has_next) S.a_ready(nxt);
            if constexpr (SP2) {
            PG8_LDB(B0, 0, 0); PG8_LDB(B1, 0, 1); PG8_SCHED; PG8_LDA(At, 0, 0); PG8_STAGE(PG8_SA(1, 1), a1 + hstepA, voffA);
            PG8_WAIT_V(8); PG8_WAIT_L(0); PG8_BAR; PG8_MMA(0, 0, At, B0); PG8_MMA(0, 1, At, B1); PG8_BAR; PG8_SCHED;
            PG8_LDA(At, 0, 1); PG8_STAGE(PG8_SB(0, 0), b2, voffB); PG8_STAGE(PG8_SB(0, 1), b2 + hstepB, voffB); PG8_STAGE(PG8_SA(0, 0), a2, voffA);
            PG8_WAIT_V(8); PG8_WAIT_L(0); PG8_BAR; PG8_MMA(1, 0, At, B0); PG8_MMA(1, 1, At, B1); PG8_BAR; PG8_SCHED;
            PG8_LDB(B0, 1, 0); PG8_LDB(B1, 1, 1); PG8_SCHED; PG8_LDA(At, 1, 0); PG8_STAGE(PG8_SA(0, 1), a2 + hstepA, voffA);
            PG8_WAIT_V(8); PG8_WAIT_L(0); PG8_BAR; PG8_MMA(0, 0, At, B0); PG8_MMA(0, 1, At, B1); PG8_BAR; PG8_SCHED;
            PG8_LDA(At, 1, 1); PG8_STAGE(PG8_SB(1, 0), b3, voffB); PG8_STAGE(PG8_SB(1, 1), b3 + hstepB, voffB); PG8_STAGE(PG8_SA(1, 0), a3, voffA);
            PG8_WAIT_V(8); PG8_WAIT_L(0); PG8_BAR; PG8_MMA(1, 0, At, B0); PG8_MMA(1, 1, At, B1); PG8_BAR; PG8_SCHED;
            } else {
            PG8_LDB(B0, 0, 0); PG8_SCHED; PG8_LDA(At, 0, 0); PG8_STAGE(PG8_SA(1, 1), a1 + hstepA, voffA);
            PG8_WAIT_L(8); PG8_BAR; PG8_WAIT_L(0); PG8_MMA(0, 0, At, B0); PG8_BAR; PG8_SCHED;
            PG8_LDB(B1, 0, 1); PG8_STAGE(PG8_SB(0, 0), b2, voffB);
            PG8_BAR; PG8_WAIT_L(0); PG8_MMA(0, 1, At, B1); PG8_BAR;
            PG8_LDA(At, 0, 1); PG8_STAGE(PG8_SA(0, 0), a2, voffA);
            PG8_BAR; PG8_WAIT_L(0); PG8_MMA(1, 0, At, B0); PG8_BAR; PG8_SCHED;
            PG8_STAGE(PG8_SB(0, 1), b2 + hstepB, voffB);
            PG8_WAIT_V(6); PG8_BAR; PG8_MMA(1, 1, At, B1); PG8_BAR;
            PG8_LDB(B0, 1, 0); PG8_SCHED; PG8_LDA(At, 1, 0); PG8_STAGE(PG8_SA(0, 1), a2 + hstepA, voffA);
            PG8_WAIT_L(8); PG8_BAR; PG8_WAIT_L(0); PG8_MMA(0, 0, At, B0); PG8_BAR; PG8_SCHED;
            PG8_LDB(B1, 1, 1); PG8_STAGE(PG8_SB(1, 0), b3, voffB);
            PG8_BAR; PG8_WAIT_L(0); PG8_MMA(0, 1, At, B1); PG8_BAR;
            PG8_LDA(At, 1, 1); PG8_STAGE(PG8_SA(1, 0), a3, voffA);
            PG8_BAR; PG8_WAIT_L(0); PG8_MMA(1, 0, At, B0); PG8_BAR; PG8_SCHED;
            PG8_STAGE(PG8_SB(1, 1), b3 + hstepB, voffB);
            PG8_WAIT_V(6); PG8_BAR; PG8_MMA(1, 1, At, B1); PG8_BAR;
            }
        }
        if constexpr (ALIGN_EPI) { if (wr == 0) PG8_BAR; }
        if constexpr (!Epi::AFTER_DRAIN) { E(acc, cur, wr, wc, fr, fq); S.done(cur); }
        if (!has_next) break;
#pragma unroll
        for (int a = 0; a < 2; ++a)
#pragma unroll
            for (int b = 0; b < 2; ++b)
#pragma unroll
                for (int m = 0; m < 4; ++m)
#pragma unroll
                    for (int n = 0; n < 2; ++n) acc[a][b][m][n] = (f32x4){0.f, 0.f, 0.f, 0.f};
        cur = nxt; cA = nA; cB = nB; ++ui;
        if constexpr (ALIGN_EPI) { if (wr == 1) PG8_BAR; }
    }
    PG8_WAIT_V(0);
    if constexpr (!ALIGN_EPI) { if (wr == 0) PG8_BAR; }
    PG8_BAR;
    if constexpr (Epi::AFTER_DRAIN) { E.fused(acc, cur, wr, wc, fr, fq, lds, wid, lane); S.done(cur); }
#undef PG8_ABASE
#undef PG8_BBASE
#undef PG8_SA
#undef PG8_SB
#undef PG8_STAGE
#undef PG8_LDA
#undef PG8_LDB
#undef PG8_MMA
#undef PG8_WAIT_V
#undef PG8_WAIT_L
#undef PG8_BAR
#undef PG8_SCHED
}
typedef int i32x4 __attribute__((ext_vector_type(4)));
template <class Epi, class Sched, bool ALIGN_EPI = false, bool SP2 = false>
__device__ __forceinline__ void gemm_phase_i8(PG8_LAS unsigned char* lds, const Gemm g, const Sched& S, const Epi& E, const int tid) {
    const int wid = __builtin_amdgcn_readfirstlane(tid >> 6), lane = tid & 63, wr = wid >> 2, wc = wid & 3, fr = lane & 15, fq = lane >> 4;
    const int K = g.K, nt = K / BK;
    unsigned voffA[2], voffB[2];
#pragma unroll
    for (int i = 0; i < 2; ++i) { int R, C; stage_rc(tid * 16 + i * 8192, R, C); const int Rb = Epi::WIDE ? (64 * (R >> 5) + perm32(R & 31)) : (Epi::PERM ? ((R & ~31) + perm32(R & 31)) : R);
        voffA[i] = (unsigned)(R * g.lda + C) * 2u; voffB[i] = (unsigned)(Rb * g.ldb + C) * 2u; }
    const size_t kstepA = g.kstepA, kstepB = g.kstepB;
    const size_t hstepA = (size_t)HALF * g.lda * 2, hstepB = (size_t)(Epi::WIDE ? 32 : HALF) * g.ldb * 2;
#define PG8_ABASE(u) ((const char*)g.A + ((size_t)(u).pm * BM * g.lda + (size_t)((u).pn / g.npg) * K) * 2)
#define PG8_BBASE(u) ((const char*)g.Bt + (size_t)(u).pn * BM * g.ldb * 2)
    const unsigned ldsw = (unsigned)wid * 1024u;
    const int aoff = lds_byte(wr * 64 + fr, fq * 8), boff = lds_byte(wc * 32 + fr, fq * 8);
#define PG8_SA(b, h) (((b) * 2 + (h)) * HTB)
#define PG8_SB(b, h) ((4 + (b) * 2 + (h)) * HTB)
#define PG8_STAGE(bufoff, gbase, voff) do { _Pragma("unroll") for (int _i = 0; _i < 2; ++_i) \
        __builtin_amdgcn_global_load_lds((const unsigned*)((const char*)(gbase) + (voff)[_i]), (PG8_LAS unsigned*)(lds + (bufoff) + ldsw + _i * 8192), 16, 0, 0); } while (0)
#define PG8_LDA(dst, b, h) do { _Pragma("unroll") for (int m = 0; m < 4; ++m) _Pragma("unroll") for (int k = 0; k < 2; ++k) dst[m][k] = *(const PG8_LAS bf16x8*)(lds + PG8_SA(b, h) + aoff + m * 2048 + k * 1024); } while (0)
#define PG8_LDB(dst, b, h) do { _Pragma("unroll") for (int n = 0; n < 2; ++n) _Pragma("unroll") for (int k = 0; k < 2; ++k) dst[n][k] = *(const PG8_LAS bf16x8*)(lds + PG8_SB(b, h) + boff + n * 2048 + k * 1024); } while (0)
#define PG8_MMA(ai, bj, At, Bt) do { __builtin_amdgcn_s_setprio(1); _Pragma("unroll") for (int m = 0; m < 4; ++m) _Pragma("unroll") for (int n = 0; n < 2; ++n) _Pragma("unroll") for (int k = 0; k < 2; ++k) \
        acc[ai][bj][m][n] = __builtin_amdgcn_mfma_i32_16x16x64_i8(__builtin_bit_cast(i32x4, Bt[n][k]), __builtin_bit_cast(i32x4, At[m][k]), acc[ai][bj][m][n], 0, 0, 0); __builtin_amdgcn_s_setprio(0); } while (0)
#define PG8_WAIT_V(n) asm volatile("s_waitcnt vmcnt(" #n ")" ::: "memory")
#define PG8_WAIT_L(n) asm volatile("s_waitcnt lgkmcnt(" #n ")" ::: "memory")
#define PG8_BAR __builtin_amdgcn_s_barrier()
#define PG8_SCHED __builtin_amdgcn_sched_barrier(0)
    Unit cur, nxt; int ui = 0;
    if (!S.next(0, cur)) return;
    i32x4 acc[2][2][4][2];
#pragma unroll
    for (int a = 0; a < 2; ++a)
#pragma unroll
        for (int b = 0; b < 2; ++b)
#pragma unroll
            for (int m = 0; m < 4; ++m)
#pragma unroll
                for (int n = 0; n < 2; ++n) acc[a][b][m][n] = (i32x4){0, 0, 0, 0};
    bf16x8 At[4][2], B0[2][2], B1[2][2];
    const char* cA = PG8_ABASE(cur); const char* cB = PG8_BBASE(cur);
    S.a_ready(cur);
    if constexpr (SP2) {
        PG8_STAGE(PG8_SB(0, 0), cB, voffB); PG8_STAGE(PG8_SB(0, 1), cB + hstepB, voffB); PG8_STAGE(PG8_SA(0, 0), cA, voffA); PG8_STAGE(PG8_SA(0, 1), cA + hstepA, voffA);
        if (wr == 1) PG8_BAR;
        PG8_WAIT_V(2); PG8_BAR;
        PG8_STAGE(PG8_SB(1, 0), cB + kstepB, voffB); PG8_STAGE(PG8_SA(1, 0), cA + kstepA, voffA); PG8_STAGE(PG8_SB(1, 1), cB + hstepB + kstepB, voffB);
        PG8_WAIT_V(6); PG8_BAR;
    } else {
        PG8_STAGE(PG8_SB(0, 0), cB, voffB); PG8_STAGE(PG8_SA(0, 0), cA, voffA); PG8_STAGE(PG8_SB(0, 1), cB + hstepB, voffB); PG8_STAGE(PG8_SA(0, 1), cA + hstepA, voffA);
        if (wr == 1) PG8_BAR;
        PG8_WAIT_V(4); PG8_BAR;
        PG8_STAGE(PG8_SB(1, 0), cB + kstepB, voffB); PG8_STAGE(PG8_SA(1, 0), cA + kstepA, voffA); PG8_STAGE(PG8_SB(1, 1), cB + hstepB + kstepB, voffB);
        PG8_WAIT_V(6); PG8_BAR;
    }
    for (;;) {
        const bool has_next = S.next(ui + 1, nxt);
        const char* nA = has_next ? PG8_ABASE(nxt) : cA; const char* nB = has_next ? PG8_BBASE(nxt) : cB;
        for (int t = 0; t < nt; t += 2) {
            const bool last = (t == nt - 2);
            const char* a1 = cA + (size_t)(t + 1) * kstepA;
            const char* a2 = last ? nA : cA + (size_t)(t + 2) * kstepA; const char* b2 = last ? nB : cB + (size_t)(t + 2) * kstepB;
            const char* a3 = a2 + kstepA; const char* b3 = b2 + kstepB;
            if (last && has_next) S.a_ready(nxt);
            if constexpr (SP2) {
            PG8_LDB(B0, 0, 0); PG8_LDB(B1, 0, 1); PG8_SCHED; PG8_LDA(At, 0, 0); PG8_STAGE(PG8_SA(1, 1), a1 + hstepA, voffA);
            PG8_WAIT_V(8); PG8_WAIT_L(0); PG8_BAR; PG8_MMA(0, 0, At, B0); PG8_MMA(0, 1, At, B1); PG8_BAR; PG8_SCHED;
            PG8_LDA(At, 0, 1); PG8_STAGE(PG8_SB(0, 0), b2, voffB); PG8_STAGE(PG8_SB(0, 1), b2 + hstepB, voffB); PG8_STAGE(PG8_SA(0, 0), a2, voffA);
            PG8_WAIT_V(8); PG8_WAIT_L(0); PG8_BAR; PG8_MMA(1, 0, At, B0); PG8_MMA(1, 1, At, B1); PG8_BAR; PG8_SCHED;
            PG8_LDB(B0, 1, 0); PG8_LDB(B1, 1, 1); PG8_SCHED; PG8_LDA(At, 1, 0); PG8_STAGE(PG8_SA(0, 1), a2 + hstepA, voffA);
            PG8_WAIT_V(8); PG8_WAIT_L(0); PG8_BAR; PG8_MMA(0, 0, At, B0); PG8_MMA(0, 1, At, B1); PG8_BAR; PG8_SCHED;
            PG8_LDA(At, 1, 1); PG8_STAGE(PG8_SB(1, 0), b3, voffB); PG8_STAGE(PG8_SB(1, 1), b3 + hstepB, voffB); PG8_STAGE(PG8_SA(1, 0), a3, voffA);
            PG8_WAIT_V(8); PG8_WAIT_L(0); PG8_BAR; PG8_MMA(1, 0, At, B0); PG8_MMA(1, 1, At, B1); PG8_BAR; PG8_SCHED;
            } else {
            PG8_LDB(B0, 0, 0); PG8_SCHED; PG8_LDA(At, 0, 0); PG8_STAGE(PG8_SA(1, 1), a1 + hstepA, voffA);
            PG8_WAIT_L(8); PG8_BAR; PG8_WAIT_L(0); PG8_MMA(0, 0, At, B0); PG8_BAR; PG8_SCHED;
            PG8_LDB(B1, 0, 1); PG8_STAGE(PG8_SB(0, 0), b2, voffB);
            PG8_BAR; PG8_WAIT_L(0); PG8_MMA(0, 1, At, B1); PG8_BAR;
            PG8_LDA(At, 0, 1); PG8_STAGE(PG8_SA(0, 0), a2, voffA);
            PG8_BAR; PG8_WAIT_L(0); PG8_MMA(1, 0, At, B0); PG8_BAR; PG8_SCHED;
            PG8_STAGE(PG8_SB(0, 1), b2 + hstepB, voffB);
            PG8_WAIT_V(6); PG8_BAR; PG8_MMA(1, 1, At, B1); PG8_BAR;
            PG8_LDB(B0, 1, 0); PG8_SCHED; PG8_LDA(At, 1, 0); PG8_STAGE(PG8_SA(0, 1), a2 + hstepA, voffA);
            PG8_WAIT_L(8); PG8_BAR; PG8_WAIT_L(0); PG8_MMA(0, 0, At, B0); PG8_BAR; PG8_SCHED;
            PG8_LDB(B1, 1, 1); PG8_STAGE(PG8_SB(1, 0), b3, voffB);
            PG8_BAR; PG8_WAIT_L(0); PG8_MMA(0, 1, At, B1); PG8_BAR;
            PG8_LDA(At, 1, 1); PG8_STAGE(PG8_SA(1, 0), a3, voffA);
            PG8_BAR; PG8_WAIT_L(0); PG8_MMA(1, 0, At, B0); PG8_BAR; PG8_SCHED;
            PG8_STAGE(PG8_SB(1, 1), b3 + hstepB, voffB);
            PG8_WAIT_V(6); PG8_BAR; PG8_MMA(1, 1, At, B1); PG8_BAR;
            }
        }
        if constexpr (ALIGN_EPI) { if (wr == 0) PG8_BAR; }
        if constexpr (!Epi::AFTER_DRAIN) { E(acc, cur, wr, wc, fr, fq); S.done(cur); }
        if (!has_next) break;
#pragma unroll
        for (int a = 0; a < 2; ++a)
#pragma unroll
            for (int b = 0; b < 2; ++b)
#pragma unroll
                for (int m = 0; m < 4; ++m)
#pragma unroll
                    for (int n = 0; n < 2; ++n) acc[a][b][m][n] = (i32x4){0, 0, 0, 0};
        cur = nxt; cA = nA; cB = nB; ++ui;
        if constexpr (ALIGN_EPI) { if (wr == 1) PG8_BAR; }
    }
    PG8_WAIT_V(0);
    if constexpr (!ALIGN_EPI) { if (wr == 0) PG8_BAR; }
    PG8_BAR;
    if constexpr (Epi::AFTER_DRAIN) { E.fused(acc, cur, wr, wc, fr, fq, lds, wid, lane); S.done(cur); }
#undef PG8_ABASE
#undef PG8_BBASE
#undef PG8_SA
#undef PG8_SB
#undef PG8_STAGE
#undef PG8_LDA
#undef PG8_LDB
#undef PG8_MMA
#undef PG8_WAIT_V
#undef PG8_WAIT_L
#undef PG8_BAR
#undef PG8_SCHED
}
}

constexpr int T = 8192, D = 2048, FF = 8192, DEPTH = 4;
constexpr int NH = 16, HD = 128, NKV = 4, TOPK = 256;
constexpr int A_IN = 5264, A_INP = 5376;
constexpr int C_Q = 0, C_K = 2048, C_V = 2560, C_IQ = 3072, C_IK = 5120, C_IW = 5248;
constexpr float EPS = 1e-6f;
constexpr int NWAVES = 8, NTHR = NWAVES * 64;

constexpr size_t MiB = 1u << 20;
constexpr size_t WS_CTL = 0, CTL_ZERO_BYTES = 1 * MiB;
constexpr size_t WS_COS128 = 1 * MiB, WS_SIN128 = 3 * MiB, WS_COS64 = 5 * MiB, WS_SIN64 = 6 * MiB;
constexpr size_t WS_IW = 7 * MiB;
constexpr size_t WS_AGGA = 724 * MiB, WS_AGGB = 726 * MiB, WS_CARRY = 728 * MiB;
constexpr size_t WS_WINA = 10 * MiB;
constexpr size_t WS_WOUTA = 52 * MiB;
constexpr size_t WS_WINR = 68 * MiB;
constexpr size_t WS_WGR = 84 * MiB;
constexpr size_t WS_WOUTR = 86 * MiB;
constexpr size_t WS_WPOOL = 94 * MiB;
constexpr size_t WS_WUP = 96 * MiB;
constexpr size_t WS_WDOWN = 224 * MiB;
constexpr size_t WS_BA = 352 * MiB;
constexpr size_t BA_SC = 0;
constexpr int SC_LD = T + 64;
constexpr size_t BA_O16 = 0;
constexpr size_t BA_U = 0;
constexpr size_t BA_AF = 0, BA_BF = 64 * MiB;
constexpr size_t BA_H16 = 128 * MiB;
constexpr size_t BA_PROJ = 160 * MiB;
constexpr size_t BA_XC = 224 * MiB;
constexpr size_t WS_QH = 616 * MiB, WS_KH = 632 * MiB, WS_VH = 636 * MiB, WS_IK = 640 * MiB, WS_SEL = 642 * MiB, WS_IQ = 650 * MiB, WS_PARTA = 686 * MiB, WS_PARTB = 687 * MiB, WS_BLKMAXD = 688 * MiB, WS_X16 = 692 * MiB, WS_END = 730 * MiB;
constexpr int CW_BAR = 4096;
constexpr size_t WS_BLKMAX = 682 * MiB;
constexpr size_t WS_RS = 7 * MiB + 512 * 1024, WS_CS = WS_RS + 64 * 1024;
constexpr size_t WS_RS2 = WS_RS + 128 * 1024, WS_CS2 = WS_RS + 192 * 1024, WS_CSUM = WS_RS + 208 * 1024;
constexpr size_t BA_U8 = 192 * MiB, BA_W8D = 176 * MiB;
constexpr size_t BA_A8 = 160 * MiB, BA_W8 = 176 * MiB;
constexpr size_t WS_ROWSQ = 256 * 1024;

constexpr int RING_BYTES = 131072;
constexpr int LDSCTL_OFF = RING_BYTES, MISC_OFF = LDSCTL_OFF + 320;
constexpr int LDS_BYTES = 155648;

#define GAS __attribute__((address_space(1)))
#define LAS __attribute__((address_space(3)))
typedef _Float16 h16;
typedef _Float16 h16x2 __attribute__((ext_vector_type(2)));
typedef _Float16 h16x4 __attribute__((ext_vector_type(4)));
typedef _Float16 h16x8 __attribute__((ext_vector_type(8)));
typedef unsigned v4u __attribute__((ext_vector_type(4)));
typedef unsigned v2u __attribute__((ext_vector_type(2)));
typedef float f32x4 __attribute__((ext_vector_type(4)));
typedef float f32x2 __attribute__((ext_vector_type(2)));
#define LDS_WAIT() asm volatile("s_waitcnt lgkmcnt(0)" ::: "memory")
#define VM_WAIT() asm volatile("s_waitcnt vmcnt(0)" ::: "memory")
__device__ __forceinline__ unsigned pkh(float lo, float hi) { h16x2 v = {(h16)lo, (h16)hi}; return __builtin_bit_cast(unsigned, v); }
__device__ __forceinline__ float wave_sum(float v) {
#pragma unroll
    for (int o = 1; o < 64; o <<= 1) v += __shfl_xor(v, o);
    return v;
}
__device__ __forceinline__ float wave_max(float v) {
#pragma unroll
    for (int o = 1; o < 64; o <<= 1) v = fmaxf(v, __shfl_xor(v, o));
    return v;
}

#define XB_TMO      128
#define XB_XCNT(j)  (256  + 64 * (j))
#define XB_XSUB(j)  (1280 + 64 * (j))
#define XB_XGEN(j)  (2304 + 64 * (j))
#define XB_TOP      3328
#define XB_TOPGEN   3392
#define XCD_BAR_WORDS 3456
#define XB_SPIN_CAP (1u << 18)

__device__ __forceinline__ unsigned xb_ld(unsigned* p)              { return __hip_atomic_load(p, __ATOMIC_RELAXED, __HIP_MEMORY_SCOPE_AGENT); }
__device__ __forceinline__ unsigned xb_add(unsigned* p, unsigned v) { return __hip_atomic_fetch_add(p, v, __ATOMIC_RELAXED, __HIP_MEMORY_SCOPE_AGENT); }
__device__ __forceinline__ unsigned xb_xcc_id() { return (unsigned)__builtin_amdgcn_s_getreg((3 << 11) | 20) & 0xFu; }
#define XB_SPIN(cond, bar) do { unsigned _sp = 0; while (cond) { __builtin_amdgcn_s_sleep(1); \
    if ((++_sp & 255u) == 0u) { if (xb_ld(&(bar)[XB_TMO])) break; if (_sp > XB_SPIN_CAP) { atomicAdd(&(bar)[XB_TMO], 1u); break; } } } } while (0)

struct XcdBarrier { unsigned* bar; unsigned x; volatile LAS unsigned* st; };

__device__ __forceinline__ XcdBarrier xcd_barrier_post(unsigned* bar, volatile LAS unsigned* st) {
    XcdBarrier b; b.bar = bar; b.x = xb_xcc_id(); b.st = st;
    if (threadIdx.x == 0) (void)xb_add(&bar[XB_XCNT(b.x)], 1u);
    return b;
}
__device__ __forceinline__ void xcd_barrier_complete(unsigned* bar, unsigned x, unsigned& nloc, unsigned& nx) {
    const unsigned G = gridDim.x * gridDim.y * gridDim.z;
    unsigned sum, cnt, mine, sp = 0u;
    for (;;) {
        sum = 0u; cnt = 0u; mine = 0u;
#pragma unroll
        for (unsigned j = 0; j < 16; ++j) { const unsigned c = xb_ld(&bar[XB_XCNT(j)]); sum += c; cnt += (c > 0u) ? 1u : 0u; mine = (j == x) ? c : mine; }
        if (sum == G) break;
        __builtin_amdgcn_s_sleep(1);
        if ((++sp & 255u) == 0u) { if (xb_ld(&bar[XB_TMO])) break; if (sp > XB_SPIN_CAP) { atomicAdd(&bar[XB_TMO], 1u); break; } }
    }
    nloc = mine > 0u ? mine : 1u; nx = cnt > 0u ? cnt : 1u;
}
__device__ __forceinline__ void xcd_barrier(const XcdBarrier& b) {
    asm volatile("s_waitcnt vmcnt(0)" ::: "memory");
    __syncthreads();
    if (threadIdx.x == 0) {
        unsigned* bar = b.bar;
        __builtin_amdgcn_s_waitcnt(0);
        unsigned nloc = b.st[0], nx = b.st[1];
        if (nloc == 0u) { xcd_barrier_complete(bar, b.x, nloc, nx); b.st[0] = nloc; b.st[1] = nx; }
        const unsigned old = xb_add(&bar[XB_XSUB(b.x)], 1u);
        const unsigned gen = old / nloc;
        if (old + 1u == (gen + 1u) * nloc) {
            __builtin_amdgcn_fence(__ATOMIC_RELEASE, "agent");
            asm volatile("s_waitcnt vmcnt(0)" ::: "memory");
            const unsigned og = xb_add(&bar[XB_TOP], 1u);
            const unsigned tg = og / nx;
            if (og + 1u == (tg + 1u) * nx) xb_add(&bar[XB_TOPGEN], 1u);
            else XB_SPIN(xb_ld(&bar[XB_TOPGEN]) == tg, bar);
            __builtin_amdgcn_fence(__ATOMIC_ACQUIRE, "agent");
            xb_add(&bar[XB_XGEN(b.x)], 1u);
            asm volatile("s_waitcnt vmcnt(0)" ::: "memory");
        } else {
            XB_SPIN(xb_ld(&bar[XB_XGEN(b.x)]) == gen, bar);
            __builtin_amdgcn_fence(__ATOMIC_ACQUIRE, "agent");
            asm volatile("s_waitcnt vmcnt(0)" ::: "memory");
        }
    }
    __syncthreads();
}

__device__ __forceinline__ void tr_item(const float* src, int ldw, int nvalid, h16* dst, int ldd, LAS float* scr, int lane, unsigned* colmax = nullptr, const float* gk = nullptr) {
    const int nn = lane & 31; float v[32];
#pragma unroll
    for (int i = 0; i < 32; ++i) { const int kk = 2 * i + (lane >> 5); v[i] = (nn < nvalid) ? src[(size_t)kk * ldw + nn] * (gk ? gk[kk] : 1.0f) : 0.f; }
    __builtin_amdgcn_sched_barrier(0);
#pragma unroll
    for (int i = 0; i < 32; ++i) { const int kk = 2 * i + (lane >> 5); scr[kk * 33 + nn] = v[i]; }
    LDS_WAIT();
    const int c = lane & 7;
#pragma unroll
    for (int j = 0; j < 4; ++j) { const int n = (lane >> 3) + 8 * j; const LAS float* s = scr + (8 * c) * 33 + n;
        v4u o; o.x = pkh(s[0 * 33], s[1 * 33]); o.y = pkh(s[2 * 33], s[3 * 33]); o.z = pkh(s[4 * 33], s[5 * 33]); o.w = pkh(s[6 * 33], s[7 * 33]);
        *(v4u*)(dst + (size_t)n * ldd + 8 * c) = o;
        if (colmax) {
            float mx = fmaxf(fmaxf(fmaxf(fabsf(s[0 * 33]), fabsf(s[1 * 33])), fmaxf(fabsf(s[2 * 33]), fabsf(s[3 * 33]))), fmaxf(fmaxf(fabsf(s[4 * 33]), fabsf(s[5 * 33])), fmaxf(fabsf(s[6 * 33]), fabsf(s[7 * 33]))));
            mx = fmaxf(mx, __shfl_xor(mx, 1)); mx = fmaxf(mx, __shfl_xor(mx, 2)); mx = fmaxf(mx, __shfl_xor(mx, 4));
            if (c == 0) colmax[n] = __float_as_uint(mx); } }
    LDS_WAIT();
}

struct Ptrs {
    const float* x; const int* pos;
    const float *attn_norm, *attn_w_in, *attn_qn, *attn_kn, *attn_w_out;
    const float *rnn_norm, *rnn_w_in, *conv_w, *conv_b, *ga_w, *ga_b, *gx_w, *gx_b, *lam, *rnn_w_out;
    const float *pool_norm, *pool_w, *pool_b, *pool_scale;
    const float *mlp_norm, *mlp_w_up, *mlp_w_down;
    float* out; unsigned char* ws;
    int ph_lo, ph_hi;
};

#define CAS __attribute__((address_space(4)))
__device__ __forceinline__ const CAS Ptrs* kargs() { const CAS Ptrs* p = (const CAS Ptrs*)__builtin_amdgcn_kernarg_segment_ptr(); asm volatile("" : "+s"(p)); return p; }
__device__ __forceinline__ void p0_prologue(const CAS Ptrs* PP, LAS unsigned char* lds, int gw, int NGW, int wave, int lane, int gtid, int NGT) {
    LAS float* scr = (LAS float*)(lds + wave * 16384);
    unsigned char* ws = PP->ws;
    constexpr int I_WINA = 32 * 165, I_WOUTA = 32 * 64, I_WINR = 32 * 128, I_G = 4 * 8, I_WOUTR = 32 * 64, I_POOL = 8 * 16, I_UP = 32 * 256, I_DN = 128 * 64, I_Z = 384;
    constexpr int NITEMS = 2 * I_WINA + 2 * I_WOUTA + I_WINR + 16 * I_G + I_WOUTR + 4 * I_POOL + 4 * I_UP + 4 * I_DN + 2 * I_Z;
    for (int it = gw; it < NITEMS; it += NGW) {
        int r = it;
        if (r < 2 * I_WINA) { const int j = r / I_WINA; r -= j * I_WINA; const int kb = r / 165, nb = r % 165, n0 = 32 * nb; const int nv = (A_IN - n0) < 32 ? (A_IN - n0) : 32;
            tr_item(PP->attn_w_in + (size_t)j * D * A_IN + (size_t)(64 * kb) * A_IN + n0, A_IN, nv, (h16*)(ws + WS_WINA) + (size_t)j * A_INP * D + (size_t)n0 * D + 64 * kb, D, scr, lane, nullptr, PP->attn_norm + (size_t)j * D + 64 * kb); continue; }
        r -= 2 * I_WINA;
        if (r < 2 * I_WOUTA) { const int j = r / I_WOUTA; r -= j * I_WOUTA; const int kb = r / 64, nb = r % 64;
            tr_item(PP->attn_w_out + (size_t)j * D * D + (size_t)(64 * kb) * D + 32 * nb, D, 32, (h16*)(ws + WS_WOUTA) + (size_t)j * D * D + (size_t)(32 * nb) * D + 64 * kb, D, scr, lane); continue; }
        r -= 2 * I_WOUTA;
        if (r < I_WINR) { const int kb = r / 128, nb = r % 128;
            tr_item(PP->rnn_w_in + (size_t)(64 * kb) * 4096 + 32 * nb, 4096, 32, (h16*)(ws + WS_WINR) + (size_t)(32 * nb) * D + 64 * kb, D, scr, lane, nullptr, PP->rnn_norm + 64 * kb); continue; }
        r -= I_WINR;
        if (r < 16 * I_G) { const int mi = r / I_G; r -= mi * I_G; const int which = mi >> 3, blk = mi & 7, kb = r / 8, nb = r % 8, d0 = 32 * nb;
            const float* src = (which ? PP->gx_w : PP->ga_w) + (size_t)blk * 65536 + (size_t)(64 * kb) * 256 + d0;
            const int drow = 256 * (2 * blk + (d0 >> 7)) + 128 * which + (d0 & 127);
            tr_item(src, 256, 32, (h16*)(ws + WS_WGR) + (size_t)drow * 256 + 64 * kb, 256, scr, lane); continue; }
        r -= 16 * I_G;
        if (r < I_WOUTR) { const int kb = r / 64, nb = r % 64;
            tr_item(PP->rnn_w_out + (size_t)(64 * kb) * D + 32 * nb, D, 32, (h16*)(ws + WS_WOUTR) + (size_t)(32 * nb) * D + 64 * kb, D, scr, lane); continue; }
        r -= I_WOUTR;
        if (r < 4 * I_POOL) { const int g = r / I_POOL; r -= g * I_POOL; const int kb = r / 16, nb = r % 16;
            tr_item(PP->pool_w + (size_t)g * 262144 + (size_t)(64 * kb) * 512 + 32 * nb, 512, 32, (h16*)(ws + WS_WPOOL) + (size_t)(512 * g + 32 * nb) * 512 + 64 * kb, 512, scr, lane); continue; }
        r -= 4 * I_POOL;
        if (r < 4 * I_UP) { const int i = r / I_UP; r -= i * I_UP; const int kb = r / 256, nb = r % 256;
            tr_item(PP->mlp_w_up + (size_t)i * D * FF + (size_t)(64 * kb) * FF + 32 * nb, FF, 32, (h16*)(ws + WS_WUP) + (size_t)i * D * FF + (size_t)(32 * nb) * D + 64 * kb, D, scr, lane, (unsigned*)(ws + WS_BLKMAX) + ((size_t)i * 32 + kb) * FF + 32 * nb, PP->mlp_norm + (size_t)i * D + 64 * kb); continue; }
        r -= 4 * I_UP;
        if (r < 4 * I_DN) { const int i = r / I_DN; r -= i * I_DN; const int kb = r / 64, nb = r % 64;
            tr_item(PP->mlp_w_down + (size_t)i * D * FF + (size_t)(64 * kb) * D + 32 * nb, D, 32, (h16*)(ws + WS_WDOWN) + (size_t)i * D * FF + ((size_t)kb * D + 32 * nb) * 64, 64, scr, lane, (unsigned*)(ws + WS_BLKMAXD) + ((size_t)i * 128 + kb) * D + 32 * nb); continue; }
        r -= 4 * I_DN;
        { const int j = r / I_Z; r -= j * I_Z;
            v4u* z = (v4u*)((h16*)(ws + WS_WINA) + (size_t)j * A_INP * D + (size_t)5280 * D); z[(size_t)r * 64 + lane] = (v4u){0u, 0u, 0u, 0u}; }
    }
    for (int e = gtid; e < T * 96; e += NGT) {
        const int t = e / 96, i = e % 96; const bool big = i < 64; const int fi = big ? i : i - 64;
        const double base = big ? 0.8659643233600653 : 0.7498942093324559;
        double inv = 1.0; for (int k = 0; k < fi; ++k) inv *= base;
        const double ang = (double)PP->pos[t] * inv;
        const double n = __builtin_rint(ang * 0.15915494309189535); const double rr = ang - n * 6.283185307179586 - n * 2.4492935982947064e-16;
        const double r2 = rr * rr; double sn = 1.0, cs = 1.0;
#pragma unroll
        for (int k = 14; k >= 1; --k) { sn = 1.0 - sn * r2 * (1.0 / (double)((2 * k) * (2 * k + 1))); cs = 1.0 - cs * r2 * (1.0 / (double)((2 * k - 1) * (2 * k))); }
        sn *= rr;
        if (big) { ((float*)(ws + WS_COS128))[t * 64 + fi] = (float)cs; ((float*)(ws + WS_SIN128))[t * 64 + fi] = (float)sn; }
        else { ((float*)(ws + WS_COS64))[t * 32 + fi] = (float)cs; ((float*)(ws + WS_SIN64))[t * 32 + fi] = (float)sn; }
    }
}

__device__ __forceinline__ void quant_rows(const h16* src, int nrows, signed char* dst, float* scale_out, const float* rowsq, const unsigned* colmax, int gw, int NGW, int lane) {
    h16x8 vn[4]; float cmn = 0.f;
    if (gw < nrows) {
#pragma unroll
        for (int j = 0; j < 4; ++j) vn[j] = *(const h16x8*)(src + (size_t)gw * D + 512 * j + 8 * lane);
        if (colmax) cmn = lane < 32 ? __uint_as_float(colmax[(size_t)lane * FF + gw]) : 0.f; }
    for (int r = gw; r < nrows; r += NGW) {
        h16x8 v[4]; const float cm = cmn;
#pragma unroll
        for (int j = 0; j < 4; ++j) v[j] = vn[j];
        const int rn = r + NGW;
        if (rn < nrows) {
#pragma unroll
            for (int j = 0; j < 4; ++j) vn[j] = *(const h16x8*)(src + (size_t)rn * D + 512 * j + 8 * lane);
            if (colmax) cmn = lane < 32 ? __uint_as_float(colmax[(size_t)lane * FF + rn]) : 0.f; }
        float mx;
        if (colmax) mx = wave_max(cm);
        else { mx = 0.f;
#pragma unroll
            for (int j = 0; j < 4; ++j)
#pragma unroll
                for (int e = 0; e < 8; ++e) mx = fmaxf(mx, fabsf((float)v[j][e]));
            mx = wave_max(mx); }
        const float step = mx > 0.f ? mx * (1.0f / 127.0f) : 1.0f, inv = 1.0f / step;
        if (lane == 0) { float sc = step;
            if (rowsq) { const f32x4* pp = (const f32x4*)(rowsq + (size_t)r * 32); f32x4 a4 = pp[0];
#pragma unroll
                for (int q = 1; q < 8; ++q) a4 += pp[q];
                sc = step / sqrtf(((a4[0] + a4[1]) + (a4[2] + a4[3])) * (1.0f / D) + EPS); }
            scale_out[r] = sc; }
#pragma unroll
        for (int j = 0; j < 4; ++j) { unsigned w[2];
#pragma unroll
            for (int hh = 0; hh < 2; ++hh) { unsigned p = 0u;
#pragma unroll
                for (int e = 0; e < 4; ++e) { int qv = (int)rintf((float)v[j][4 * hh + e] * inv); qv = qv > 127 ? 127 : (qv < -127 ? -127 : qv); p |= ((unsigned)qv & 255u) << (8 * e); }
                w[hh] = p; }
            *(v2u*)(dst + (size_t)r * D + 512 * j + 8 * lane) = (v2u){w[0], w[1]}; }
    }
}
template <bool UNSIGNED>
__device__ __forceinline__ void quant_kblk(const h16* src, int R, signed char* dst, float* scale_out, float* csum, const unsigned* blkmax, int gw, int NGW, int lane) {
    const int bsub = lane >> 3, c8 = (lane & 7) * 8;
    h16x8 vn[16]; float cmn = 0.f;
#define QK_LOAD(r_) do { _Pragma("unroll") for (int i = 0; i < 16; ++i) vn[i] = *(const h16x8*)(src + ((size_t)(8 * i + bsub) * R + (r_)) * 64 + c8); \
        if (!UNSIGNED) cmn = fmaxf(__uint_as_float(blkmax[(size_t)lane * R + (r_)]), __uint_as_float(blkmax[(size_t)(64 + lane) * R + (r_)])); } while (0)
    if (gw < R) QK_LOAD(gw);
    for (int r = gw; r < R; r += NGW) {
        h16x8 v[16]; const float cm = cmn;
#pragma unroll
        for (int i = 0; i < 16; ++i) v[i] = vn[i];
        if (r + NGW < R) QK_LOAD(r + NGW);
        float mx;
        if (UNSIGNED) { mx = 0.f;
#pragma unroll
            for (int i = 0; i < 16; ++i)
#pragma unroll
                for (int e = 0; e < 8; ++e) mx = fmaxf(mx, (float)v[i][e]);
            mx = wave_max(mx); }
        else mx = wave_max(cm);
        const float step = mx > 0.f ? mx * (UNSIGNED ? 1.0f / 255.0f : 1.0f / 127.0f) : 1.0f, inv = 1.0f / step;
        int ssum = 0;
#pragma unroll
        for (int i = 0; i < 16; ++i) { unsigned w[2];
#pragma unroll
            for (int hh = 0; hh < 2; ++hh) { unsigned p = 0u;
#pragma unroll
                for (int e = 0; e < 4; ++e) { int qv = (int)rintf((float)v[i][4 * hh + e] * inv);
                    if (UNSIGNED) { qv = qv > 255 ? 255 : (qv < 0 ? 0 : qv); qv -= 128; } else { qv = qv > 127 ? 127 : (qv < -127 ? -127 : qv); ssum += qv; }
                    p |= ((unsigned)qv & 255u) << (8 * e); }
                w[hh] = p; }
            const int b = 8 * i + bsub;
            *(v2u*)(dst + ((size_t)(b >> 1) * R + r) * 128 + 64 * (b & 1) + c8) = (v2u){w[0], w[1]}; }
        if (!UNSIGNED) { float fs = (float)ssum; fs = wave_sum(fs); if (lane == 0) csum[r] = fs; }
        if (lane == 0) scale_out[r] = step;
    }
#undef QK_LOAD
}
__device__ __forceinline__ void norm0_phase(const float* src, h16* dst, float* rowsq, int gw, int NGW, int lane) {
    for (int m = gw; m < T; m += NGW) {
        const f32x4* xr = (const f32x4*)(src + (size_t)m * D) + lane;
        f32x4 v[8]; float s = 0.f;
#pragma unroll
        for (int j = 0; j < 8; ++j) { v[j] = xr[64 * j]; s += (v[j].x * v[j].x + v[j].y * v[j].y) + (v[j].z * v[j].z + v[j].w * v[j].w); }
        s = wave_sum(s); if (lane == 0) rowsq[m] = s;
        v2u* o = (v2u*)(dst + (size_t)m * D) + lane;
#pragma unroll
        for (int j = 0; j < 8; ++j) { v2u w; w.x = pkh(v[j].x, v[j].y); w.y = pkh(v[j].z, v[j].w); o[64 * j] = w; }
    }
}

__device__ __forceinline__ unsigned char f8(float x) { return (unsigned char)(__builtin_amdgcn_cvt_pk_fp8_f32(x, x, 0, false) & 0xFF); }
__device__ __forceinline__ float sum16(float v) { v += __shfl_xor(v, 1); v += __shfl_xor(v, 2); v += __shfl_xor(v, 4); v += __shfl_xor(v, 8); return v; }
__device__ __forceinline__ unsigned f8x4(float a, float b, float c, float d) { int p = __builtin_amdgcn_cvt_pk_fp8_f32(a, b, 0, false); p = __builtin_amdgcn_cvt_pk_fp8_f32(c, d, p, true); return (unsigned)p; }
__device__ __forceinline__ void dsa_post_phase(const h16* PROJ, const float* qn, const float* kn, const float* c128, const float* s128, const float* c64, const float* s64,
                                               unsigned char* Q8, unsigned char* K8, unsigned char* V8, h16* IQ, h16* IK, float* IW, int gw, int NGW, int lane) {
    const int hh = lane >> 4, m = lane & 15;
    const f32x4 gqa = *(const f32x4*)(qn + 4 * m), gqb = *(const f32x4*)(qn + 64 + 4 * m), gka = *(const f32x4*)(kn + 4 * m), gkb = *(const f32x4*)(kn + 64 + 4 * m);
    const bool rot = m < 8; const int ioa = rot ? 4 * m : 32 + 4 * m, iob = ioa + 32;
    for (int t = gw; t < T; t += NGW) {
        const h16* pr = PROJ + (size_t)t * A_INP;
        const f32x4 c = *(const f32x4*)(c128 + t * 64 + 4 * m), s = *(const f32x4*)(s128 + t * 64 + 4 * m);
        f32x4 ci = {1.f, 1.f, 1.f, 1.f}, si = {0.f, 0.f, 0.f, 0.f};
        if (rot) { ci = *(const f32x4*)(c64 + t * 32 + 4 * m); si = *(const f32x4*)(s64 + t * 32 + 4 * m); }
#pragma unroll
        for (int p = 0; p < 5; ++p) {
            const int cb = (p < 4 ? C_Q + (4 * p + hh) * HD : C_K + hh * HD) + 4 * m;
            const h16x4 a4 = *(const h16x4*)(pr + cb), b4 = *(const h16x4*)(pr + cb + 64);
            float a[4], b[4], ss = 0.f;
#pragma unroll
            for (int e = 0; e < 4; ++e) { a[e] = (float)a4[e]; b[e] = (float)b4[e]; ss += a[e] * a[e] + b[e] * b[e]; }
            const float rstd = 1.0f / sqrtf(sum16(ss) * (1.0f / HD) + EPS);
            float oa[4], ob[4];
#pragma unroll
            for (int e = 0; e < 4; ++e) { const float ya = a[e] * rstd * (p < 4 ? gqa[e] : gka[e]), yb = b[e] * rstd * (p < 4 ? gqb[e] : gkb[e]); oa[e] = ya * c[e] - yb * s[e]; ob[e] = yb * c[e] + ya * s[e]; }
            unsigned char* o8 = (p < 4 ? Q8 + (size_t)t * D + (4 * p + hh) * HD : K8 + (size_t)t * 512 + hh * HD) + 4 * m;
            *(unsigned*)o8 = f8x4(oa[0], oa[1], oa[2], oa[3]); *(unsigned*)(o8 + 64) = f8x4(ob[0], ob[1], ob[2], ob[3]);
        }
        { const h16x8 vv = *(const h16x8*)(pr + C_V + lane * 8);
          *(v2u*)(V8 + (size_t)t * 512 + lane * 8) = (v2u){f8x4((float)vv[0], (float)vv[1], (float)vv[2], (float)vv[3]), f8x4((float)vv[4], (float)vv[5], (float)vv[6], (float)vv[7])}; }
#pragma unroll
        for (int p = 0; p < 5; ++p) {
            const int hd = p < 4 ? 4 * p + hh : 0; const int cb = p < 4 ? C_IQ + hd * HD : C_IK;
            const h16x4 a4 = *(const h16x4*)(pr + cb + ioa), b4 = *(const h16x4*)(pr + cb + iob);
            h16x4 oa, ob;
#pragma unroll
            for (int e = 0; e < 4; ++e) { const float av = (float)a4[e], bv = (float)b4[e]; oa[e] = (h16)(av * ci[e] - bv * si[e]); ob[e] = (h16)(bv * ci[e] + av * si[e]); }
            if (p < 4) { *(h16x4*)(IQ + (size_t)t * D + hd * HD + ioa) = oa; *(h16x4*)(IQ + (size_t)t * D + hd * HD + iob) = ob; }
            else if (hh == 0) { *(h16x4*)(IK + (size_t)t * HD + ioa) = oa; *(h16x4*)(IK + (size_t)t * HD + iob) = ob; }
        }
        if (lane < 16) IW[t * 16 + lane] = (float)pr[C_IW + lane] * 0.02209708691207961f;
    }
}

__device__ __forceinline__ float relu_i(float x) { const int b = __float_as_int(x); return __int_as_float(b > 0 ? b : 0); }
constexpr int IDX_ITEMS = 8320, IDX_ROWB = 272, IDX_TILEB = 128 * IDX_ROWB;
__device__ __forceinline__ void idx_decode(int L, int& qb, int& kc) {
    int m = (int)((sqrtf(1.0f + 2.0f * (float)L) - 1.0f) * 0.5f);
    while (2 * (m + 1) * (m + 2) <= L) ++m;
    while (2 * m * (m + 1) > L) --m;
    const int rem = L - 2 * m * (m + 1); qb = 4 * m + rem / (m + 1); kc = rem % (m + 1);
}
constexpr int IDX_HDR = 2, IDX_WKT = 4;
__device__ __forceinline__ int idx_cut(int v) {
    int m = (int)((sqrtf((float)((1 + 2 * IDX_HDR) * (1 + 2 * IDX_HDR)) + 2.0f * (float)v) - (float)(1 + 2 * IDX_HDR)) * 0.5f);
    while (2 * (m + 1) * (m + 2) + 4 * IDX_HDR * (m + 1) <= v) ++m;
    while (2 * m * (m + 1) + 4 * IDX_HDR * m > v) --m;
    const int rem = v - (2 * m * (m + 1) + 4 * IDX_HDR * m), j = rem / (m + 1 + IDX_HDR), slot = rem % (m + 1 + IDX_HDR);
    return 2 * m * (m + 1) + j * (m + 1) + (slot < IDX_HDR ? 0 : slot - IDX_HDR);
}
__device__ __forceinline__ void idx_scores_phase(const h16* IQ, const h16* IK, const float* IW, h16* SC, LAS unsigned char* lds, int wg, int G, int tid, int wave, int lane) {
    const int L0 = idx_cut((int)(((long)(IDX_ITEMS + 256 * IDX_HDR) * wg) / G)), L1 = idx_cut((int)(((long)(IDX_ITEMS + 256 * IDX_HDR) * (wg + 1)) / G));
    if (L0 >= L1) return;
    int qb, kc; idx_decode(L0, qb, kc);
    const int fr = lane & 15, fq = lane >> 4;
    h16x8 st[4];
#define IDX_LOAD(kc_) do { _Pragma("unroll") for (int i = 0; i < 4; ++i) { const int p = tid + 512 * i; st[i] = *(const h16x8*)(IK + (size_t)((kc_) * 128 + (p >> 4)) * HD + (p & 15) * 8); } } while (0)
#define IDX_WRITE(buf_) do { _Pragma("unroll") for (int i = 0; i < 4; ++i) { const int p = tid + 512 * i; *(LAS h16x8*)(lds + (buf_) * IDX_TILEB + (p >> 4) * IDX_ROWB + (p & 15) * 16) = st[i]; } } while (0)
    IDX_LOAD(kc); IDX_WRITE(0);
    __syncthreads();
    int par = 0, L = L0;
#if TPROBE
    unsigned long long tp_acc = 0;
#define TP_T() ({ __builtin_amdgcn_sched_barrier(0); asm volatile("" ::: "memory"); unsigned long long t_ = __builtin_amdgcn_s_memrealtime(); asm volatile("s_waitcnt lgkmcnt(0)" ::: "memory"); __builtin_amdgcn_sched_barrier(0); t_; })
#define TP_BEG(n) unsigned long long tp0_##n = 0; if (TPROBE == n) tp0_##n = TP_T();
#define TP_END(n) if (TPROBE == n) tp_acc += TP_T() - tp0_##n;
#else
#define TP_BEG(n)
#define TP_END(n)
#endif
#pragma unroll 1
    while (L < L1) {
        int kend = kc + (L1 - L) - 1; if (kend > (qb >> 2)) kend = (qb >> 2);
        h16x8 a[4][4]; v4u A2[4][2];
        TP_BEG(3)
        { const int tq = 32 * qb + 4 * wave; f32x4 w4[4];
#pragma unroll
            for (int q = 0; q < 4; ++q) {
#pragma unroll
                for (int ks = 0; ks < 4; ++ks) a[q][ks] = *(const h16x8*)(IQ + (size_t)(tq + q) * D + fr * HD + ks * 32 + fq * 8);
                w4[q] = *(const f32x4*)(IW + (size_t)(tq + q) * 16 + 4 * fq); }
            __builtin_amdgcn_s_waitcnt(0x0F70);
            unsigned wp[4][2];
#pragma unroll
            for (int q = 0; q < 4; ++q) { wp[q][0] = pg8::pk_h2(w4[q][0], w4[q][1]); wp[q][1] = pg8::pk_h2(w4[q][2], w4[q][3]); }
#pragma unroll
            for (int r = 0; r < 4; ++r)
#pragma unroll
                for (int p = 0; p < 2; ++p) { const int i0 = 4 * r + 2 * p; const bool e0 = (fr == i0), e1 = (fr == i0 + 1);
                    A2[r][p] = (v4u){e0 ? wp[2 * p][0] : 0u, e0 ? wp[2 * p][1] : 0u, e1 ? wp[2 * p + 1][0] : 0u, e1 ? wp[2 * p + 1][1] : 0u}; } }
        __builtin_amdgcn_sched_barrier(0);
        TP_END(3)
#pragma unroll 1
        for (; kc <= kend; ++kc, ++L) {
            TP_BEG(2)
            const bool more = (L + 1 < L1);
            { const int kcp = more ? (kc < (qb >> 2) ? kc + 1 : 0) : kc; IDX_LOAD(kcp); }
            const LAS unsigned char* bb = lds + par * IDX_TILEB + fr * IDX_ROWB + fq * 16;
            h16x8 bq[2][4];
#pragma unroll
            for (int ks = 0; ks < 4; ++ks) bq[0][ks] = *(const LAS h16x8*)(bb + ks * 64);
            f32x4 d2 = {0.f, 0.f, 0.f, 0.f};
#pragma unroll
            for (int kt = 0; kt < 8; ++kt) {
                if (kt + 1 < 8) {
#pragma unroll
                    for (int ks = 0; ks < 4; ++ks) bq[(kt + 1) & 1][ks] = *(const LAS h16x8*)(bb + (kt + 1) * 16 * IDX_ROWB + ks * 64);
                    __builtin_amdgcn_sched_barrier(0); }
                const h16x8 (&b)[4] = bq[kt & 1];
#pragma unroll
                for (int p = 0; p < 2; ++p) { f32x4 s0 = {0.f, 0.f, 0.f, 0.f}, s1 = {0.f, 0.f, 0.f, 0.f};
#pragma unroll
                    for (int ks = 0; ks < 4; ++ks) { s0 = __builtin_amdgcn_mfma_f32_16x16x32_f16(a[2 * p][ks], b[ks], s0, 0, 0, 0); s1 = __builtin_amdgcn_mfma_f32_16x16x32_f16(a[2 * p + 1][ks], b[ks], s1, 0, 0, 0); }
                    const h16x2 z2 = {(h16)0.f, (h16)0.f};
                    h16x2 r0 = {(h16)s0[0], (h16)s0[1]}, r1 = {(h16)s0[2], (h16)s0[3]}, r2 = {(h16)s1[0], (h16)s1[1]}, r3 = {(h16)s1[2], (h16)s1[3]};
                    r0 = __builtin_elementwise_max(r0, z2); r1 = __builtin_elementwise_max(r1, z2); r2 = __builtin_elementwise_max(r2, z2); r3 = __builtin_elementwise_max(r3, z2);
                    const h16x8 b2 = {r0[0], r0[1], r1[0], r1[1], r2[0], r2[1], r3[0], r3[1]};
                    d2 = __builtin_amdgcn_mfma_f32_16x16x32_f16(__builtin_bit_cast(h16x8, A2[kt & 3][p]), b2, d2, 0, 0, 0); }
                if ((kt & 3) == 3) { const int tq = 32 * qb + 4 * wave;
#pragma unroll
                    for (int q = 0; q < 4; ++q) SC[(size_t)(tq + q) * SC_LD + kc * 128 + 64 * (kt >> 2) + lane] = (h16)d2[q];
                    d2 = (f32x4){0.f, 0.f, 0.f, 0.f}; }
                if (kt == IDX_WKT) { IDX_WRITE(par ^ 1); }
            }
            TP_BEG(1) TP_BEG(5)
            asm volatile("s_waitcnt lgkmcnt(0)" ::: "memory"); __builtin_amdgcn_s_barrier(); asm volatile("" ::: "memory");
            TP_END(5) TP_END(1) TP_END(2)
            par ^= 1;
        }
        ++qb; kc = 0;
    }
#if TPROBE
    { const unsigned long long t0 = __builtin_amdgcn_s_memrealtime(); while (__builtin_amdgcn_s_memrealtime() - t0 < (unsigned long long)TP_MULT * tp_acc) __builtin_amdgcn_s_sleep(2); }
#endif
#undef IDX_LOAD
#undef IDX_WRITE
}

template <int NR>
__device__ __forceinline__ unsigned kth_largest(const unsigned (&u)[NR], int K) {
    unsigned prefix = 0u;
#pragma unroll 1
    for (int bit = 15; bit >= 0; --bit) { const unsigned cand = prefix | (1u << bit); int cnt = 0;
#pragma unroll
        for (int i = 0; i < NR; ++i) { cnt += __builtin_popcountll(__ballot(u[i] >= cand)); if ((i & 31) == 31) __builtin_amdgcn_sched_barrier(0); }
        if (cnt >= K) prefix = cand; }
    return prefix;
}
template <int NR, bool ARR>
__device__ __forceinline__ void emit_topk(const unsigned (&u)[NR], unsigned thr_in, int* sel, const int (&keys)[ARR ? NR : 1], int lane) {
    unsigned thr = thr_in; int cgt = 0;
#pragma unroll
    for (int i = 0; i < NR; ++i) { cgt += __builtin_popcountll(__ballot(u[i] > thr)); if ((i & 7) == 7) __builtin_amdgcn_sched_barrier(0); }
    const int need = TOPK - cgt;
    asm volatile("" : "+s"(thr));
    int base = 0, eqseen = 0;
#pragma unroll
    for (int i = 0; i < NR; ++i) {
        const bool gt = u[i] > thr, eq = u[i] == thr;
        const unsigned long long eb = __ballot(eq);
        const int erank = eqseen + (int)__builtin_amdgcn_mbcnt_hi((unsigned)(eb >> 32), __builtin_amdgcn_mbcnt_lo((unsigned)eb, 0u));
        const bool take = gt || (eq && erank < need);
        const unsigned long long tb = __ballot(take);
        const int pos = base + (int)__builtin_amdgcn_mbcnt_hi((unsigned)(tb >> 32), __builtin_amdgcn_mbcnt_lo((unsigned)tb, 0u));
        if (take) sel[pos] = ARR ? keys[ARR ? i : 0] : 64 * i + lane;
        base += __builtin_popcountll(tb); eqseen += __builtin_popcountll(eb);
        __builtin_amdgcn_sched_barrier(0);
    }
}
constexpr int TK_CAP = 768, TK_TARGET = 448;
template <int NREG>
__device__ __forceinline__ void topk_load_row(unsigned (&u)[NREG], const h16* sc_in, int t_in, int lane) {
    static_assert(NREG % 16 == 0, "chunks of 16 registers");
#pragma unroll
    for (int c = 0; c < NREG / 16; ++c) {
        const GAS unsigned short* pc = (const GAS unsigned short*)(sc_in + 1024 * c); asm volatile("" : "+s"(pc));
#pragma unroll
        for (int k = 0; k < 16; ++k) u[16 * c + k] = (unsigned)pc[64 * k + lane];
    }
#pragma unroll
    for (int c = 0; c < NREG / 16; ++c) {
        int tl = t_in - 1024 * c; asm volatile("" : "+s"(tl));
#pragma unroll
        for (int k = 0; k < 16; ++k) { const unsigned b = u[16 * c + k]; const unsigned mk = (b >> 15) ? 0xFFFFu : 0x8000u; u[16 * c + k] = (lane <= tl - 64 * k) ? (b ^ mk) : 0u; }
        __builtin_amdgcn_sched_barrier(0);
    }
}
template <int NREG>
__device__ __forceinline__ void topk_row(const h16* sc_in, int t_in, int* sel, int lane_in, LAS unsigned long long* cand) {
    int lane = lane_in; asm volatile("" : "+v"(lane));
    if constexpr (NREG >= 64) {
        int cn = 0;
        {   unsigned u[NREG];
            topk_load_row<NREG>(u, sc_in, t_in, lane);
            constexpr int NS = NREG / 8;
            unsigned us[NS]; int nsv = 0;
#pragma unroll
            for (int s = 0; s < NS; ++s) { us[s] = u[8 * s]; const int rem = t_in + 1 - 512 * s; nsv += rem < 0 ? 0 : (rem > 64 ? 64 : rem); }
            int Ks = (TK_TARGET * nsv) / (t_in + 1); Ks = Ks < 1 ? 1 : Ks;
            unsigned tau = kth_largest<NS>(us, Ks);
            asm volatile("" : "+s"(tau));
#pragma unroll
            for (int c = 0; c < NREG / 16; ++c) {
                int kb = 1024 * c + lane; asm volatile("" : "+v"(kb));
#pragma unroll
                for (int k = 0; k < 16; ++k) { const int i = 16 * c + k; const bool m = u[i] >= tau && tau != 0u; const unsigned long long mb = __ballot(m);
                    const int pos = cn + (int)__builtin_amdgcn_mbcnt_hi((unsigned)(mb >> 32), __builtin_amdgcn_mbcnt_lo((unsigned)mb, 0u));
                    if (m && pos < TK_CAP) cand[pos] = ((unsigned long long)u[i] << 32) | (unsigned)(kb + 64 * k);
                    cn += __builtin_popcountll(mb); if ((k & 3) == 3) __builtin_amdgcn_sched_barrier(0); }
            }
        }
        asm volatile("" : "+s"(cn));
        if (cn >= TOPK && cn <= TK_CAP) {
            LDS_WAIT();
            unsigned cu[TK_CAP / 64]; int ck[TK_CAP / 64];
#pragma unroll
            for (int k = 0; k < TK_CAP / 64; ++k) { const int ix = 64 * k + lane; const unsigned long long v = cand[ix]; cu[k] = ix < cn ? (unsigned)(v >> 32) : 0u; ck[k] = (int)(unsigned)v; }
            const unsigned thr = kth_largest<TK_CAP / 64>(cu, TOPK);
            emit_topk<TK_CAP / 64, true>(cu, thr, sel, ck, lane);
            LDS_WAIT();
            return;
        }
    }
    {   unsigned u[NREG];
        topk_load_row<NREG>(u, sc_in, t_in, lane);
        const unsigned thr = kth_largest<NREG>(u, TOPK);
        const int nokeys[1] = {0}; emit_topk<NREG, false>(u, thr, sel, nokeys, lane); }
}
__device__ __forceinline__ void topk_phase(const h16* SC, int* SEL, LAS unsigned char* lds, int gw, int NGW, int wave, int lane) {
    LAS unsigned long long* cand = (LAS unsigned long long*)(lds + wave * (TK_CAP * 8));
    for (int t = gw; t < T; t += NGW) {
        const h16* sc = SC + (size_t)t * SC_LD; int* sel = SEL + (size_t)t * TOPK;
        if (t < TOPK) {
#pragma unroll
            for (int j = 0; j < 4; ++j) { const int k = lane + 64 * j; sel[k] = (k <= t) ? k : -1; }
        } else if (t < 2048) topk_row<32>(sc, t, sel, lane, cand);
        else if (t < 4096) topk_row<64>(sc, t, sel, lane, cand);
        else if (t < 6144) topk_row<96>(sc, t, sel, lane, cand);
        else topk_row<128>(sc, t, sel, lane, cand);
    }
}

__device__ __forceinline__ float dot8(h16x8 a, h16x8 b, float c) {
#if __has_builtin(__builtin_amdgcn_fdot2)
    c = __builtin_amdgcn_fdot2((h16x2){a[0], a[1]}, (h16x2){b[0], b[1]}, c, false); c = __builtin_amdgcn_fdot2((h16x2){a[2], a[3]}, (h16x2){b[2], b[3]}, c, false);
    c = __builtin_amdgcn_fdot2((h16x2){a[4], a[5]}, (h16x2){b[4], b[5]}, c, false); c = __builtin_amdgcn_fdot2((h16x2){a[6], a[7]}, (h16x2){b[6], b[7]}, c, false);
#else
#pragma unroll
    for (int e = 0; e < 8; ++e) c += (float)a[e] * (float)b[e];
#endif
    return c;
}
__device__ __forceinline__ void attn_phase(const h16* QH, const h16* KH, const h16* VH, const int* SEL, h16* O, LAS unsigned char* lds, int wg, int G, int wave, int lane) {
    LAS h16* qs = (LAS h16*)(lds + wave * 6144);
    LAS float* ps = (LAS float*)(lds + wave * 6144 + 1024);
    LAS int* is = (LAS int*)(lds + wave * 6144 + 5120);
    const int grp = lane >> 4, c = lane & 15;
    for (int L = wg; L < (T / 8) * NKV; L += G) {
        const int g = L & 3, t = 8 * (L >> 2) + wave;
        int idx[4];
#pragma unroll
        for (int j = 0; j < 4; ++j) idx[j] = SEL[(size_t)t * TOPK + lane + 64 * j];
        *(LAS h16x8*)(qs + lane * 8) = *(const h16x8*)(QH + (size_t)t * D + g * 512 + lane * 8);
#pragma unroll
        for (int j = 0; j < 4; ++j) is[lane + 64 * j] = idx[j] < 0 ? 0 : idx[j];
        LDS_WAIT();
        float sc[4][4];
#pragma unroll
        for (int j = 0; j < 4; ++j) { const h16* krow = KH + (size_t)(idx[j] < 0 ? 0 : idx[j]) * 512 + g * HD; h16x8 kf[16];
#pragma unroll
            for (int cc = 0; cc < 16; ++cc) kf[cc] = *(const h16x8*)(krow + 8 * cc);
#pragma unroll
            for (int hh = 0; hh < 4; ++hh) { float s = 0.f;
#pragma unroll
                for (int cc = 0; cc < 16; ++cc) s = dot8(kf[cc], *(const LAS h16x8*)(qs + hh * HD + 8 * cc), s);
                sc[j][hh] = (idx[j] < 0) ? -__builtin_inff() : s * 0.08838834764831845f; }
            __builtin_amdgcn_sched_barrier(0); }
#pragma unroll
        for (int hh = 0; hh < 4; ++hh) {
            const float mx = wave_max(fmaxf(fmaxf(sc[0][hh], sc[1][hh]), fmaxf(sc[2][hh], sc[3][hh])));
            float e0 = __expf(sc[0][hh] - mx), e1 = __expf(sc[1][hh] - mx), e2 = __expf(sc[2][hh] - mx), e3 = __expf(sc[3][hh] - mx);
            const float inv = 1.0f / wave_sum((e0 + e1) + (e2 + e3));
            sc[0][hh] = e0 * inv; sc[1][hh] = e1 * inv; sc[2][hh] = e2 * inv; sc[3][hh] = e3 * inv; }
#pragma unroll
        for (int j = 0; j < 4; ++j) *(LAS f32x4*)(ps + 4 * (lane + 64 * j)) = (f32x4){sc[j][0], sc[j][1], sc[j][2], sc[j][3]};
        LDS_WAIT();
        float acc[4][8];
#pragma unroll
        for (int hh = 0; hh < 4; ++hh)
#pragma unroll
            for (int e = 0; e < 8; ++e) acc[hh][e] = 0.f;
#pragma unroll 4
        for (int it = 0; it < 64; ++it) { const int kk = 4 * it + grp; const int ik = is[kk]; const f32x4 p4 = *(const LAS f32x4*)(ps + 4 * kk);
            const h16x8 v8 = *(const h16x8*)(VH + (size_t)ik * 512 + g * HD + 8 * c);
#pragma unroll
            for (int hh = 0; hh < 4; ++hh)
#pragma unroll
                for (int e = 0; e < 8; ++e) acc[hh][e] += p4[hh] * (float)v8[e];
            if ((it & 3) == 3) __builtin_amdgcn_sched_barrier(0); }
#pragma unroll
        for (int hh = 0; hh < 4; ++hh)
#pragma unroll
            for (int e = 0; e < 8; ++e) { float v = acc[hh][e]; v += __shfl_xor(v, 16); v += __shfl_xor(v, 32); acc[hh][e] = v; }
        float o8[8];
#pragma unroll
        for (int e = 0; e < 8; ++e) o8[e] = grp == 0 ? acc[0][e] : grp == 1 ? acc[1][e] : grp == 2 ? acc[2][e] : acc[3][e];
        v4u w; w.x = pkh(o8[0], o8[1]); w.y = pkh(o8[2], o8[3]); w.z = pkh(o8[4], o8[5]); w.w = pkh(o8[6], o8[7]);
        *(v4u*)(O + (size_t)t * D + (4 * g + grp) * HD + 8 * c) = w;
        LDS_WAIT();
    }
}

__device__ __forceinline__ void conv_phase(const h16* PROJ, const float* cw, const float* cb, h16* XC, int vcu, int G, int tid) {
    const int c8 = (tid & 255) * 8, half = tid >> 8;
    f32x4 w0[4], w1[4];
#pragma unroll
    for (int j = 0; j < 4; ++j) { w0[j] = *(const f32x4*)(cw + j * 2048 + c8); w1[j] = *(const f32x4*)(cw + j * 2048 + c8 + 4); }
    const f32x4 b0 = *(const f32x4*)(cb + c8), b1 = *(const f32x4*)(cb + c8 + 4);
#pragma unroll 1
    for (int u = vcu; u < T / 32; u += G) { const int t0 = 32 * u + 16 * half;
        h16x8 x[19];
#pragma unroll
        for (int r = 0; r < 19; ++r) { const int tt = t0 - 3 + r; x[r] = *(const h16x8*)(PROJ + (size_t)(tt < 0 ? 0 : tt) * 4096 + 2048 + c8); }
        __builtin_amdgcn_sched_barrier(0);
#pragma unroll
        for (int r = 0; r < 16; ++r) { const int t = t0 + r;
            float acc[8];
#pragma unroll
            for (int e = 0; e < 4; ++e) { acc[e] = b0[e]; acc[4 + e] = b1[e]; }
#pragma unroll
            for (int j = 0; j < 4; ++j) { if (t - 3 + j >= 0) {
#pragma unroll
                for (int e = 0; e < 4; ++e) { acc[e] += (float)x[r + j][e] * w0[j][e]; acc[4 + e] += (float)x[r + j][4 + e] * w1[j][e]; } } }
            v4u w; w.x = pkh(acc[0], acc[1]); w.y = pkh(acc[2], acc[3]); w.z = pkh(acc[4], acc[5]); w.w = pkh(acc[6], acc[7]);
            *(v4u*)(XC + (size_t)t * 2048 + c8) = w; } }
}
constexpr int SCAN_LC = 32, SCAN_NCH = T / SCAN_LC;
__device__ __forceinline__ f32x4 ld_a4(const h16* LA, size_t o) { const h16x4 v = *(const h16x4*)(LA + o); return (f32x4){__expf((float)v[0]), __expf((float)v[1]), __expf((float)v[2]), __expf((float)v[3])}; }
__device__ __forceinline__ f32x4 ld_b4(const h16* BF, size_t o) { const h16x4 v = *(const h16x4*)(BF + o); return (f32x4){(float)v[0], (float)v[1], (float)v[2], (float)v[3]}; }
__device__ __forceinline__ void scan_agg_phase(const h16* AF, const h16* BF, float* AGGA, float* AGGB, int gtid, int NGT) {
    for (int i = gtid; i < SCAN_NCH * 512; i += NGT) { const int cg = (i & 511) * 4, k = i >> 9;
        f32x4 Pr = {1.f, 1.f, 1.f, 1.f}, H = {0.f, 0.f, 0.f, 0.f};
#pragma unroll 16
        for (int r = 0; r < SCAN_LC; ++r) { const size_t o = (size_t)(k * SCAN_LC + r) * 2048 + cg; const f32x4 a = ld_a4(AF, o), b = ld_b4(BF, o); H = a * H + b; Pr = Pr * a; }
        *(f32x4*)(AGGA + (size_t)k * 2048 + cg) = Pr; *(f32x4*)(AGGB + (size_t)k * 2048 + cg) = H; }
}
__device__ __forceinline__ void scan_carry_phase(const float* AGGA, const float* AGGB, float* CARRY, int vcu, int wave, int lane) {
    if (wave != 0 || vcu >= 16) return;
    const int c = (vcu * 64 + lane) * 2; f32x2 H = {0.f, 0.f};
#pragma unroll 1
    for (int k0 = 0; k0 < SCAN_NCH; k0 += 32) { f32x2 a[32], b[32];
#pragma unroll
        for (int j = 0; j < 32; ++j) { a[j] = *(const f32x2*)(AGGA + (size_t)(k0 + j) * 2048 + c); b[j] = *(const f32x2*)(AGGB + (size_t)(k0 + j) * 2048 + c); }
        __builtin_amdgcn_sched_barrier(0);
#pragma unroll
        for (int j = 0; j < 32; ++j) { *(f32x2*)(CARRY + (size_t)(k0 + j) * 2048 + c) = H; H = a[j] * H + b[j]; } }
}
__device__ __forceinline__ float gelu_tanh(float x) { const float u = 0.7978845608028654f * (x + 0.044715f * x * x * x); const float e = __expf(2.0f * u); const float th = 1.0f - 2.0f / (e + 1.0f); return 0.5f * x * (1.0f + th); }
__device__ __forceinline__ void scan_final_phase(const h16* AF, const h16* BF, const float* CARRY, const h16* PROJ, h16* Y, int gtid, int NGT) {
    for (int i = gtid; i < SCAN_NCH * 512; i += NGT) { const int cg = (i & 511) * 4, k = i >> 9;
        f32x4 H = *(const f32x4*)(CARRY + (size_t)k * 2048 + cg);
#pragma unroll 1
        for (int r0 = 0; r0 < SCAN_LC; r0 += 16) {
            h16x4 av[16], bv[16], gv[16];
#pragma unroll
            for (int j = 0; j < 16; ++j) { const int t = k * SCAN_LC + r0 + j; const size_t o = (size_t)t * 2048 + cg;
                av[j] = *(const h16x4*)(AF + o); bv[j] = *(const h16x4*)(BF + o); gv[j] = *(const h16x4*)(PROJ + (size_t)t * 4096 + cg); }
            __builtin_amdgcn_sched_barrier(0);
#pragma unroll
            for (int j = 0; j < 16; ++j) { const int t = k * SCAN_LC + r0 + j; const size_t o = (size_t)t * 2048 + cg;
                const f32x4 a = {__expf((float)av[j][0]), __expf((float)av[j][1]), __expf((float)av[j][2]), __expf((float)av[j][3])};
                const f32x4 b = {(float)bv[j][0], (float)bv[j][1], (float)bv[j][2], (float)bv[j][3]};
                H = a * H + b;
                v2u w; w.x = pkh(H[0] * gelu_tanh((float)gv[j][0]), H[1] * gelu_tanh((float)gv[j][1])); w.y = pkh(H[2] * gelu_tanh((float)gv[j][2]), H[3] * gelu_tanh((float)gv[j][3]));
                *(v2u*)(Y + o) = w; } } }
}
__device__ __forceinline__ f32x4 ldx4(const h16* p) { const h16x4 v = *(const h16x4*)p; return (f32x4){(float)v[0], (float)v[1], (float)v[2], (float)v[3]}; }
template <int W>
__device__ __forceinline__ void pool_window(const h16x4 (&x)[47], const LAS float* rs, f32x4 gn, h16* Y, int t0, int c4) {
    f32x4 sum = {0.f, 0.f, 0.f, 0.f};
#pragma unroll
    for (int j = 1; j < W; ++j) if (t0 - j >= 0) { const h16x4 v = x[15 - j]; sum += (f32x4){(float)v[0], (float)v[1], (float)v[2], (float)v[3]} * rs[15 - j]; }
#pragma unroll
    for (int r = 0; r < 32; ++r) { const int t = t0 + r; const int n = (t + 1) < W ? (t + 1) : W;
        const h16x4 v = x[15 + r]; const f32x4 h0 = (f32x4){(float)v[0], (float)v[1], (float)v[2], (float)v[3]} * rs[15 + r];
        sum += h0;
        const float invn = 1.0f / (float)n;
        const f32x4 y = (sum * invn - h0) * gn;
        v2u o; o.x = pkh(y.x, y.y); o.y = pkh(y.z, y.w); *(v2u*)(Y + (size_t)t * D + c4) = o;
        if (t + 1 >= W) { const h16x4 q = x[15 + r + 1 - W]; sum -= (f32x4){(float)q[0], (float)q[1], (float)q[2], (float)q[3]} * rs[15 + r + 1 - W]; }
        if ((r & 3) == 3) __builtin_amdgcn_sched_barrier(0); }
}
__device__ __forceinline__ void pool_phase(const h16* X, const float* gain, h16* Y, LAS unsigned char* lds, int wg, int G, int tid, int wave, int lane) {
    LAS float* rs = (LAS float*)lds;
    LAS float* part = rs + 64;
    const int c4 = tid * 4; const int wsel = tid >> 7;
    const f32x4 gn = *(const f32x4*)(gain + c4);
#pragma unroll 1
    for (int u = wg; u < T / 32; u += G) { const int t0 = 32 * u;
        h16x4 x[47];
#pragma unroll
        for (int r = 0; r < 47; ++r) { const int t = t0 - 15 + r; x[r] = *(const h16x4*)(X + (size_t)(t < 0 ? 0 : t) * D + c4); }
        __builtin_amdgcn_sched_barrier(0);
        __syncthreads();
#pragma unroll
        for (int r = 0; r < 47; ++r) { const h16x4 v = x[r]; const float a0 = (float)v[0], a1 = (float)v[1], a2 = (float)v[2], a3 = (float)v[3];
            float s = (a0 * a0 + a1 * a1) + (a2 * a2 + a3 * a3); s = wave_sum(s); if (lane == 0) part[wave * 48 + r] = s; if ((r & 3) == 3) __builtin_amdgcn_sched_barrier(0); }
        __syncthreads();
        if (tid < 47) { float s = 0.f;
#pragma unroll
            for (int wv = 0; wv < NWAVES; ++wv) s += part[wv * 48 + tid];
            rs[tid] = 1.0f / sqrtf(s * (1.0f / D) + EPS); }
        __syncthreads();
        if (wsel == 0) pool_window<2>(x, rs, gn, Y, t0, c4); else if (wsel == 1) pool_window<4>(x, rs, gn, Y, t0, c4); else if (wsel == 2) pool_window<8>(x, rs, gn, Y, t0, c4); else pool_window<16>(x, rs, gn, Y, t0, c4);
    }
}

__device__ __forceinline__ h16x8 f8x8_to_h(unsigned d0, unsigned d1) {
    const h16x2 a = __builtin_amdgcn_cvt_scalef32_pk_f16_fp8((int)d0, 1.0f, false), b = __builtin_amdgcn_cvt_scalef32_pk_f16_fp8((int)d0, 1.0f, true);
    const h16x2 c = __builtin_amdgcn_cvt_scalef32_pk_f16_fp8((int)d1, 1.0f, false), d = __builtin_amdgcn_cvt_scalef32_pk_f16_fp8((int)d1, 1.0f, true);
    return (h16x8){a[0], a[1], b[0], b[1], c[0], c[1], d[0], d[1]};
}
__device__ __forceinline__ unsigned attn_off_b(unsigned row, unsigned ch) { return 256u * row + 16u * (ch ^ (((row & 3u) << 2) | ((row >> 2) & 3u))); }
__device__ __forceinline__ void attn_mfma_phase(const unsigned char* Q8, const unsigned char* K8, const unsigned char* V8, const int* SEL, h16* O, LAS unsigned char* lds, int wg, int G, int wave, int lane_in) {
    typedef int i32x4 __attribute__((ext_vector_type(4)));
    typedef int i32x2 __attribute__((ext_vector_type(2)));
    typedef long i64x2 __attribute__((ext_vector_type(2)));
    i32x4 svn = {0, 0, 0, 0}; i64x2 qfn[2] = {{0, 0}, {0, 0}};
#define AT_PREF(L_) do { const int g_ = (L_) & 3, t_ = 8 * ((L_) >> 2) + wave; svn = *(const i32x4*)(SEL + (size_t)t_ * TOPK + 4 * lane_in); \
        _Pragma("unroll") for (int pp = 0; pp < 2; ++pp) qfn[pp] = *(const i64x2*)(Q8 + (size_t)t_ * D + (4 * g_ + (lane_in & 3)) * HD + 64 * pp + 16 * (lane_in >> 4)); } while (0)
    v4u kga[4], kgb[4];
#define AT_LOADK2(buf, G_, selk_, kbase_) do { const i32x2 i0 = *(const LAS i32x2*)((selk_) + 2 * (G_)), i1 = *(const LAS i32x2*)((selk_) + 128 + 2 * (G_)); \
            buf[0] = *(const v4u*)((kbase_) + (size_t)(i0.x < 0 ? 0 : i0.x) * 512); buf[1] = *(const v4u*)((kbase_) + (size_t)(i1.x < 0 ? 0 : i1.x) * 512); \
            buf[2] = *(const v4u*)((kbase_) + (size_t)(i0.y < 0 ? 0 : i0.y) * 512); buf[3] = *(const v4u*)((kbase_) + (size_t)(i1.y < 0 ? 0 : i1.y) * 512); } while (0)
#define AT_PREP(L_, par_) do { LAS int* sst_ = (LAS int*)(lds + LDSCTL_OFF + 1024 + wave * 2048 + (par_) * 1024); *(LAS i32x4*)(sst_ + 4 * lane_in) = svn; \
        asm volatile("s_waitcnt lgkmcnt(0)" ::: "memory"); \
        const LAS int* selk_ = sst_ + 16 * (lane_in >> 3); const unsigned char* kbase_ = K8 + ((L_) & 3) * HD + 16 * (lane_in & 7); \
        AT_LOADK2(kga, 0, selk_, kbase_); AT_LOADK2(kgb, 1, selk_, kbase_); } while (0)
    if (wg < (T / 8) * NKV) { AT_PREF(wg); AT_PREP(wg, 0); }
    int itpar = 0;
    for (int L = wg; L < (T / 8) * NKV; L += G, itpar ^= 1) {
        int lane = lane_in; asm volatile("" : "+v"(lane));
        const int jl = lane & 15, gi = lane >> 4;
        const int g = L & 3, t = 8 * (L >> 2) + wave;
        const int* sel = SEL + (size_t)t * TOPK; (void)sel;
        const int nvalid = (t + 1) < TOPK ? (t + 1) : TOPK;
        LAS int* sst = (LAS int*)(lds + LDSCTL_OFF + 1024 + wave * 2048 + itpar * 1024);
        i64x2 qf[2];
#pragma unroll
        for (int pp = 0; pp < 2; ++pp) qf[pp] = qfn[pp];
        LAS unsigned char* vimg = lds + wave * 16384;
        const LAS int* selk = sst + 16 * (lane >> 3);
        const unsigned char* kbase = K8 + g * HD + 16 * (lane & 7);
        const unsigned kwr = 136u * (unsigned)(lane >> 3) + 16u * (unsigned)(lane & 7), krd = 136u * (unsigned)jl + 16u * (unsigned)gi;
        f32x4 s[16];
#define AT_LOADK(buf, G_) AT_LOADK2(buf, G_, selk, kbase)
#define AT_KSTEP(buf, G_) do { LAS unsigned char* kb_ = vimg + ((G_) & 1) * 8192; \
            _Pragma("unroll") for (int j = 0; j < 4; ++j) { *(LAS v2u*)(kb_ + kwr + 1088 * j) = (v2u){buf[j].x, buf[j].y}; *(LAS v2u*)(kb_ + kwr + 1088 * j + 8) = (v2u){buf[j].z, buf[j].w}; } \
            if ((G_) + 2 < 8) AT_LOADK(buf, (G_) + 2); \
            _Pragma("unroll") for (int tt = 0; tt < 2; ++tt) { f32x4 acc = {0.f, 0.f, 0.f, 0.f}; \
                _Pragma("unroll") for (int pp = 0; pp < 2; ++pp) { const long a0 = *(const LAS long*)(kb_ + krd + 2176 * tt + 64 * pp), a1 = *(const LAS long*)(kb_ + krd + 2176 * tt + 64 * pp + 8); \
                    acc = __builtin_amdgcn_mfma_f32_16x16x32_fp8_fp8(a0, qf[pp].x, acc, 0, 0, 0); acc = __builtin_amdgcn_mfma_f32_16x16x32_fp8_fp8(a1, qf[pp].y, acc, 0, 0, 0); } \
                s[2 * (G_) + tt] = acc; } } while (0)
        if (L + G < (T / 8) * NKV) AT_PREF(L + G);
        AT_KSTEP(kga, 0); AT_KSTEP(kgb, 1); AT_KSTEP(kga, 2); AT_KSTEP(kgb, 3); AT_KSTEP(kga, 4); AT_KSTEP(kgb, 5); AT_KSTEP(kga, 6); AT_KSTEP(kgb, 7);
#undef AT_LOADK
#undef AT_KSTEP
        const LAS int* selv = sst + ((lane >> 5) & 1) + 16 * ((lane >> 3) & 3);
        const unsigned char* vbase = V8 + g * HD + 16 * (lane & 7);
        v4u vsa[4], vsb[4];
#define AT_LOADV(vst, Tt) do { _Pragma("unroll") for (int i = 0; i < 4; ++i) { const int ix = selv[2 * (Tt) + 64 * i]; vst[i] = *(const v4u*)(vbase + (size_t)(ix < 0 ? 0 : ix) * 512); } } while (0)
        AT_LOADV(vsa, 0); AT_LOADV(vsb, 1);
        __builtin_amdgcn_sched_barrier(0);
        if (nvalid < TOPK) {
#pragma unroll
            for (int kt = 0; kt < 16; ++kt)
#pragma unroll
                for (int r = 0; r < 4; ++r) if (kt + 64 * gi + 16 * r >= nvalid) s[kt][r] = -__builtin_inff();
        }
        float mx = -__builtin_inff();
#pragma unroll
        for (int kt = 0; kt < 16; ++kt) mx = fmaxf(mx, fmaxf(fmaxf(s[kt][0], s[kt][1]), fmaxf(s[kt][2], s[kt][3])));
        mx = fmaxf(mx, __shfl_xor(mx, 16)); mx = fmaxf(mx, __shfl_xor(mx, 32));
        constexpr float C2 = 0.08838834764831845f * 1.4426950408889634f;
        const float mb = -mx * C2; float sum = 0.f;
        h16x8 pf[8];
#pragma unroll
        for (int Tt = 0; Tt < 8; ++Tt) { float p[8];
#pragma unroll
            for (int r = 0; r < 4; ++r) { p[r] = __builtin_amdgcn_exp2f(fmaf(s[2 * Tt][r], C2, mb)); p[4 + r] = __builtin_amdgcn_exp2f(fmaf(s[2 * Tt + 1][r], C2, mb)); }
            sum += ((p[0] + p[1]) + (p[2] + p[3])) + ((p[4] + p[5]) + (p[6] + p[7]));
            pf[Tt] = (h16x8){(h16)p[0], (h16)p[1], (h16)p[2], (h16)p[3], (h16)p[4], (h16)p[5], (h16)p[6], (h16)p[7]}; }
        sum += __shfl_xor(sum, 16); sum += __shfl_xor(sum, 32);
        const float linv = 1.0f / sum;
        const unsigned q4 = (unsigned)jl >> 2, p4 = (unsigned)jl & 3u;
        unsigned wr_off[8], rd_off[2];
#pragma unroll
        for (int i = 0; i < 4; ++i) { wr_off[2 * i] = attn_off_b((unsigned)((lane >> 3) + 8 * i), 2u * (lane & 7)); wr_off[2 * i + 1] = attn_off_b((unsigned)((lane >> 3) + 8 * i), 2u * (lane & 7) + 1u); }
#pragma unroll
        for (int tt = 0; tt < 2; ++tt) { const unsigned row = 8u * gi + 4u * tt + q4; const unsigned x = ((row & 3u) << 2) | ((row >> 2) & 3u);
            rd_off[tt] = 256u * row + 16u * ((p4 >> 1) ^ (x & 1u)) + 8u * (p4 & 1u) + 32u * (x >> 1); }
        f32x4 o[8];
#pragma unroll
        for (int c = 0; c < 8; ++c) o[c] = (f32x4){0.f, 0.f, 0.f, 0.f};
#define AT_STEP(vst, Tt) do { \
            _Pragma("unroll") for (int i = 0; i < 4; ++i) {     \
                *(LAS h16x8*)(vimg + ((Tt) & 1) * 8192 + wr_off[2 * i]) = f8x8_to_h(vst[i].x, vst[i].y); *(LAS h16x8*)(vimg + ((Tt) & 1) * 8192 + wr_off[2 * i + 1]) = f8x8_to_h(vst[i].z, vst[i].w); } \
            if ((Tt) + 2 < 8) AT_LOADV(vst, (Tt) + 2); \
            const unsigned ib = (unsigned)(size_t)(vimg + ((Tt) & 1) * 8192); \
            h16x4 lo[8], hi[8]; \
            asm volatile("s_waitcnt lgkmcnt(0)" ::: "memory"); \
            _Pragma("unroll") for (int c = 0; c < 8; ++c) { \
                asm volatile("ds_read_b64_tr_b16 %0, %1" : "=&v"(lo[c]) : "v"(ib + (rd_off[0] ^ ((unsigned)c << 5))) : "memory"); \
                asm volatile("ds_read_b64_tr_b16 %0, %1" : "=&v"(hi[c]) : "v"(ib + (rd_off[1] ^ ((unsigned)c << 5))) : "memory"); } \
            asm volatile("s_waitcnt lgkmcnt(0)" ::: "memory"); __builtin_amdgcn_sched_barrier(0); \
            _Pragma("unroll") for (int c = 0; c < 8; ++c) o[c] = __builtin_amdgcn_mfma_f32_16x16x32_f16(pf[Tt], (h16x8){lo[c][0], lo[c][1], lo[c][2], lo[c][3], hi[c][0], hi[c][1], hi[c][2], hi[c][3]}, o[c], 0, 0, 0); \
        } while (0)
        AT_STEP(vsa, 0); AT_STEP(vsb, 1); AT_STEP(vsa, 2); AT_STEP(vsb, 3); AT_STEP(vsa, 4); AT_STEP(vsb, 5); AT_STEP(vsa, 6); AT_STEP(vsb, 7);
#undef AT_STEP
#undef AT_LOADV
        const float li = __shfl(linv, gi);
        h16* orow = O + (size_t)t * D + (4 * g + gi) * HD + jl;
#pragma unroll
        for (int c = 0; c < 8; ++c) { const float v = gi == 0 ? o[c][0] : gi == 1 ? o[c][1] : gi == 2 ? o[c][2] : o[c][3]; orow[16 * c] = (h16)(v * li); }
        asm volatile("s_waitcnt lgkmcnt(0)" ::: "memory");
        if (L + G < (T / 8) * NKV) AT_PREP(L + G, itpar ^ 1);
    }
#undef AT_PREF
#undef AT_PREP
#undef AT_LOADK2
}

constexpr int NPH = 38;
__global__ void __launch_bounds__(NTHR, 2) fwd_kernel(Ptrs P_unused) {
    extern __shared__ __attribute__((aligned(16))) unsigned char lds_raw[];
    LAS unsigned char* lds = (LAS unsigned char*)lds_raw;
    volatile LAS unsigned* MISC = (volatile LAS unsigned*)(lds + MISC_OFF);
    for (int u = threadIdx.x; u < (LDS_BYTES - LDSCTL_OFF) / 4; u += NTHR) ((LAS unsigned*)(lds + LDSCTL_OFF))[u] = 0u;
    __syncthreads();
    int lo, hi;
    XcdBarrier bar;
    { const CAS Ptrs* PP = kargs(); lo = PP->ph_lo; hi = PP->ph_hi; unsigned* bw = (unsigned*)(PP->ws + WS_CTL) + CW_BAR;
      bar.bar = bw; bar.x = 0; bar.st = nullptr; if (hi - lo > 1) bar = xcd_barrier_post(bw, MISC + 8); }
    int seq = 0;
#define PH_BEGIN(S_) if (seq >= lo && seq < hi) { const int site_ = (S_); unsigned long long tph0_ = 0; if (TPH_SITE == site_) tph0_ = __builtin_amdgcn_s_memrealtime(); const CAS Ptrs* PP = kargs(); unsigned char* const ws = PP->ws; float* const X = PP->out; (void)X; \
        int tid = threadIdx.x, bx = blockIdx.x, G = gridDim.x; asm volatile("" : "+v"(tid), "+s"(bx), "+s"(G)); \
        const int lane = tid & 63, wave = __builtin_amdgcn_readfirstlane(tid >> 6); const int vcu = (G % 8 == 0) ? (bx % 8) * (G / 8) + bx / 8 : bx; \
        const int gw = vcu * NWAVES + wave, NGW = G * NWAVES, gtid = vcu * NTHR + tid, NGT = G * NTHR; (void)lane; (void)gw; (void)NGW; (void)gtid; (void)NGT; \
        for (int rep_ = 0; rep_ < 1 + (int)((REP_MASK >> (S_)) & 1u); ++rep_) { if (rep_) __syncthreads(); \
        h16* const X16 = (h16*)(ws + WS_X16); h16* const PROJ = (h16*)(ws + WS_BA + BA_PROJ); h16* const U16 = (h16*)(ws + WS_BA + BA_U); (void)X16; (void)PROJ; (void)U16;
#define PH_END   } if (TPH_SITE == site_) { const unsigned long long t1_ = __builtin_amdgcn_s_memrealtime(), d_ = (unsigned long long)TPH_MULT * (t1_ - tph0_); while (__builtin_amdgcn_s_memrealtime() - t1_ < d_) __builtin_amdgcn_s_sleep(2); } \
                 if (seq + 1 < hi) xcd_barrier(bar); } ++seq;
#define RSQ(i_) ((float*)(ws + WS_CTL + WS_ROWSQ) + (size_t)(i_) * T)
#define PARTA ((float*)(ws + WS_PARTA))
#define PARTB ((float*)(ws + WS_PARTB))

    PH_BEGIN(0) p0_prologue(PP, lds, gw, NGW, wave, lane, gtid, NGT); norm0_phase(PP->x, X16, RSQ(0), gw, NGW, lane); PH_END

#pragma unroll 1
    for (int layer = 0; layer < DEPTH; ++layer) {
        const int kind = layer % 3, j = layer / 3;
        if (kind == 0) {
            PH_BEGIN(2) { pg8::Gemm g{X16, (const h16*)(ws + WS_WINA) + (size_t)j * A_INP * D, T, A_INP, D, D, 1 << 20, D, 128, 128}; pg8::StaticOrder S; S.init(T, A_INP, G, bx);
                       pg8::EpiF16<0> E{PROJ, A_INP, layer == 0 ? RSQ(0) : PARTB, 0, layer == 0 ? 0 : 32}; pg8::gemm_phase<pg8::EpiF16<0>, pg8::StaticOrder, true, true>(lds, g, S, E, tid); } PH_END
            PH_BEGIN(3) dsa_post_phase(PROJ, PP->attn_qn + j * HD, PP->attn_kn + j * HD, (const float*)(ws + WS_COS128), (const float*)(ws + WS_SIN128), (const float*)(ws + WS_COS64), (const float*)(ws + WS_SIN64),
                                    (unsigned char*)(ws + WS_QH), (unsigned char*)(ws + WS_KH), (unsigned char*)(ws + WS_VH), (h16*)(ws + WS_IQ), (h16*)(ws + WS_IK), (float*)(ws + WS_IW), gw, NGW, lane); PH_END
            PH_BEGIN(4) idx_scores_phase((const h16*)(ws + WS_IQ), (const h16*)(ws + WS_IK), (const float*)(ws + WS_IW), (h16*)(ws + WS_BA + BA_SC), lds, vcu, G, tid, wave, lane); PH_END
            PH_BEGIN(5) topk_phase((const h16*)(ws + WS_BA + BA_SC), (int*)(ws + WS_SEL), lds, gw, NGW, wave, lane); PH_END
            PH_BEGIN(6) attn_mfma_phase((const unsigned char*)(ws + WS_QH), (const unsigned char*)(ws + WS_KH), (const unsigned char*)(ws + WS_VH), (const int*)(ws + WS_SEL), (h16*)(ws + WS_BA + BA_O16), lds, bx, G, wave, lane); PH_END
            PH_BEGIN(7) { pg8::Gemm g{(const h16*)(ws + WS_BA + BA_O16), (const h16*)(ws + WS_WOUTA) + (size_t)j * D * D, T, D, D, D, 1 << 20, D, 128, 128}; pg8::StaticOrder S; S.init(T, D, G, bx);
                       pg8::EpiResid E{X16, X16, nullptr, D, nullptr, nullptr, PARTA}; pg8::gemm_phase<pg8::EpiResid, pg8::StaticOrder, true, true>(lds, g, S, E, tid); } PH_END
        } else if (kind == 1) {
            PH_BEGIN(9) { pg8::Gemm g{X16, (const h16*)(ws + WS_WINR), T, 4096, D, D, 1 << 20, D, 128, 128}; pg8::StaticOrder S; S.init(T, 4096, G, bx);
                       pg8::EpiF16<0> E{PROJ, 4096, layer == 0 ? RSQ(0) : PARTB, 0, layer == 0 ? 0 : 32}; pg8::gemm_phase<pg8::EpiF16<0>, pg8::StaticOrder, true, true>(lds, g, S, E, tid); } PH_END
            PH_BEGIN(10) conv_phase(PROJ, PP->conv_w, PP->conv_b, (h16*)(ws + WS_BA + BA_XC), vcu, G, tid); PH_END
            PH_BEGIN(11) { int kg = 256; asm volatile("" : "+s"(kg));
                       pg8::Gemm g{(const h16*)(ws + WS_BA + BA_XC), (const h16*)(ws + WS_WGR), T, 4096, kg, D, 2, kg, 128, 128}; pg8::StaticOrder S; S.init(T, 4096, G, bx);
                       pg8::EpiGates E{(const h16*)(ws + WS_BA + BA_XC), PP->ga_b, PP->gx_b, PP->lam, (h16*)(ws + WS_BA + BA_AF), (h16*)(ws + WS_BA + BA_BF)};
                       pg8::gemm_phase<pg8::EpiGates, pg8::StaticOrder, true, true>(lds, g, S, E, tid); } PH_END
            PH_BEGIN(12) scan_agg_phase((const h16*)(ws + WS_BA + BA_AF), (const h16*)(ws + WS_BA + BA_BF), (float*)(ws + WS_AGGA), (float*)(ws + WS_AGGB), gtid, NGT); PH_END
            PH_BEGIN(21) scan_carry_phase((const float*)(ws + WS_AGGA), (const float*)(ws + WS_AGGB), (float*)(ws + WS_CARRY), vcu, wave, lane); PH_END
            PH_BEGIN(13) scan_final_phase((const h16*)(ws + WS_BA + BA_AF), (const h16*)(ws + WS_BA + BA_BF), (const float*)(ws + WS_CARRY), PROJ, (h16*)(ws + WS_BA + BA_XC), gtid, NGT); PH_END
            PH_BEGIN(14) { pg8::Gemm g{(const h16*)(ws + WS_BA + BA_XC), (const h16*)(ws + WS_WOUTR), T, D, D, D, 1 << 20, D, 128, 128}; pg8::StaticOrder S; S.init(T, D, G, bx);
                       pg8::EpiResid E{X16, X16, nullptr, D, nullptr, nullptr, PARTA}; pg8::gemm_phase<pg8::EpiResid, pg8::StaticOrder, true, true>(lds, g, S, E, tid); } PH_END
        } else {
            PH_BEGIN(15) pool_phase(X16, PP->pool_norm, (h16*)(ws + WS_BA + BA_XC), lds, vcu, G, tid, wave, lane); PH_END
            PH_BEGIN(16) { pg8::Gemm g{(const h16*)(ws + WS_BA + BA_XC), (const h16*)(ws + WS_WPOOL), T, D, 512, D, 2, 512, 128, 128}; pg8::StaticOrder S; S.init(T, D, G, bx);
                       pg8::EpiResid E{X16, X16, nullptr, D, PP->pool_b, PP->pool_scale, PARTA}; pg8::gemm_phase<pg8::EpiResid, pg8::StaticOrder, true, true>(lds, g, S, E, tid); } PH_END
        }
        PH_BEGIN(17) quant_rows(X16, T, (signed char*)(ws + WS_BA + BA_A8), (float*)(ws + WS_RS), PARTA, nullptr, gw, NGW, lane);
                     quant_rows((const h16*)(ws + WS_WUP) + (size_t)layer * D * FF, FF, (signed char*)(ws + WS_BA + BA_W8), (float*)(ws + WS_CS), nullptr, (const unsigned*)(ws + WS_BLKMAX) + (size_t)layer * 32 * FF, gw, NGW, lane); PH_END
        PH_BEGIN(18) { pg8::Gemm g{(const h16*)(ws + WS_BA + BA_A8), (const h16*)(ws + WS_BA + BA_W8), T, FF, D / 2, D / 2, 1 << 20, D / 2, 128, 128}; pg8::StaticOrder S; S.init(T, FF, G, bx);
                   pg8::EpiQRelu2<pg8::i32x4> E{U16, (const float*)(ws + WS_RS), (const float*)(ws + WS_CS), T}; pg8::gemm_phase_i8<pg8::EpiQRelu2<pg8::i32x4>, pg8::StaticOrder, true, true>(lds, g, S, E, tid); } PH_END
        PH_BEGIN(19) quant_kblk<true>(U16, T, (signed char*)(ws + WS_BA + BA_U8), (float*)(ws + WS_RS2), nullptr, nullptr, gw, NGW, lane);
                     quant_kblk<false>((const h16*)(ws + WS_WDOWN) + (size_t)layer * D * FF, D, (signed char*)(ws + WS_BA + BA_W8D), (float*)(ws + WS_CS2), (float*)(ws + WS_CSUM), (const unsigned*)(ws + WS_BLKMAXD) + (size_t)layer * 128 * D, gw, NGW, lane); PH_END
        PH_BEGIN(20) { pg8::Gemm g{(const h16*)(ws + WS_BA + BA_U8), (const h16*)(ws + WS_BA + BA_W8D), T, D, FF / 2, 64, 1 << 20, 64, (size_t)T * 128, (size_t)D * 128}; pg8::StaticOrder S; S.init(T, D, G, bx);
                   const bool lastl = layer + 1 >= DEPTH, needsq = !lastl && (layer + 1) % 3 != 2;
                   pg8::EpiResidQ E{X16, X16, lastl ? X : nullptr, D, (const float*)(ws + WS_RS2), (const float*)(ws + WS_CS2), (const float*)(ws + WS_CSUM), needsq ? PARTB : nullptr};
                   pg8::gemm_phase_i8<pg8::EpiResidQ, pg8::StaticOrder, true, true>(lds, g, S, E, tid); } PH_END
    }
#undef PH_BEGIN
#undef PH_END
#undef RSQ
#undef PARTA
#undef PARTB
}

extern "C" void kernel_launch(void* const* d_in, const int* in_sizes, int n_in, void* d_out, int out_size, void* d_ws, size_t ws_size, hipStream_t stream) {
    static int grid = 0;
    if (grid == 0) {
        if (n_in != 24 || in_sizes[0] != T * D || out_size != T * D || ws_size < WS_END) { fprintf(stderr, "kernel_launch: unexpected shapes / workspace (n_in %d, in0 %d, out %d, ws %zu, need %zu); nothing launched\n", n_in, n_in > 0 ? in_sizes[0] : -1, out_size, ws_size, (size_t)WS_END); grid = -1; return; }
        int dev = 0, cus = 0, per_cu = 0;
        if (hipGetDevice(&dev) != hipSuccess || hipDeviceGetAttribute(&cus, hipDeviceAttributeMultiprocessorCount, dev) != hipSuccess) { grid = -1; return; }
        if (hipFuncSetAttribute((const void*)fwd_kernel, hipFuncAttributeMaxDynamicSharedMemorySize, LDS_BYTES) != hipSuccess) { fprintf(stderr, "kernel_launch: hipFuncSetAttribute failed\n"); grid = -1; return; }
        if (hipOccupancyMaxActiveBlocksPerMultiprocessor(&per_cu, (const void*)fwd_kernel, NTHR, LDS_BYTES) != hipSuccess || per_cu < 1) { fprintf(stderr, "kernel_launch: occupancy query reports %d workgroups per CU\n", per_cu); }
        (void)hipGetLastError();
        grid = cus;
    }
    if (grid < 0) return;
    if (hipMemsetAsync((char*)d_ws + WS_CTL, 0, CTL_ZERO_BYTES, stream) != hipSuccess) return;
    Ptrs p{};
    p.x = (const float*)d_in[0]; p.pos = (const int*)d_in[1];
    p.attn_norm = (const float*)d_in[2]; p.attn_w_in = (const float*)d_in[3]; p.attn_qn = (const float*)d_in[4]; p.attn_kn = (const float*)d_in[5]; p.attn_w_out = (const float*)d_in[6];
    p.rnn_norm = (const float*)d_in[7]; p.rnn_w_in = (const float*)d_in[8]; p.conv_w = (const float*)d_in[9]; p.conv_b = (const float*)d_in[10]; p.ga_w = (const float*)d_in[11]; p.ga_b = (const float*)d_in[12];
    p.gx_w = (const float*)d_in[13]; p.gx_b = (const float*)d_in[14]; p.lam = (const float*)d_in[15]; p.rnn_w_out = (const float*)d_in[16];
    p.pool_norm = (const float*)d_in[17]; p.pool_w = (const float*)d_in[18]; p.pool_b = (const float*)d_in[19]; p.pool_scale = (const float*)d_in[20];
    p.mlp_norm = (const float*)d_in[21]; p.mlp_w_up = (const float*)d_in[22]; p.mlp_w_down = (const float*)d_in[23];
    p.out = (float*)d_out; p.ws = (unsigned char*)d_ws;
#if MK_SPLIT
    for (int ph = 0; ph < NPH; ++ph) { p.ph_lo = ph; p.ph_hi = ph + 1; hipLaunchKernelGGL(fwd_kernel, dim3(grid), dim3(NTHR), LDS_BYTES, stream, p); }
#else
    p.ph_lo = 0; p.ph_hi = NPH; hipLaunchKernelGGL(fwd_kernel, dim3(grid), dim3(NTHR), LDS_BYTES, stream, p);
#endif
}
```

```cpp
#include <hip/hip_runtime.h>
#include <cstdio>
#include <cstdint>

#ifndef REP_MASK
#define REP_MASK 0u
#ifndef TPROBE
#define TPROBE 0
#endif
#ifndef TP_MULT
#define TP_MULT 4
#endif
#ifndef TPH_SITE
#define TPH_SITE (-1)
#define TPH_MULT 1
#endif
#endif
#ifndef MK_SPLIT
#define MK_SPLIT 0
#endif

namespace pg8 {
#define PG8_LAS __attribute__((address_space(3)))
typedef _Float16 bf16_t;
typedef _Float16 bf16x8 __attribute__((ext_vector_type(8)));
typedef float f32x4 __attribute__((ext_vector_type(4)));
typedef unsigned u32x4 __attribute__((ext_vector_type(4)));
typedef unsigned u32x2 __attribute__((ext_vector_type(2)));
typedef _Float16 h16x2 __attribute__((ext_vector_type(2)));
typedef _Float16 h16x4 __attribute__((ext_vector_type(4)));
typedef _Float16 h16x8e __attribute__((ext_vector_type(8)));
constexpr int BM = 256, BK = 64, HALF = 128, HTB = HALF * BK * 2  , STAGE_BYTES = 8 * HTB, NXCD = 8, WGM = 8;

__host__ __device__ __forceinline__ int lds_byte(int r, int c) { const int st = (r >> 4) * 2 + (c >> 5), rr = r & 15, cc = c & 31, ob = rr * 64 + cc * 2; return st * 1024 + (ob ^ (((ob >> 9) & 1) << 5)); }
__host__ __device__ __forceinline__ void stage_rc(int b, int& R, int& C) { const int st = b / 1024, sb = b % 1024, swz = sb ^ (((sb >> 9) & 1) << 5); R = (st >> 1) * 16 + swz / 64; C = (st & 1) * 32 + (swz % 64) / 2; }
__host__ __device__ __forceinline__ int perm32(int rho) { const int n = rho >> 4, i = rho & 15; return 8 * (i >> 2) + 4 * n + (i & 3); }

struct Unit { int pm, pn; };
struct Gemm { const bf16_t* A; const bf16_t* Bt; int M, N, K, lda, npg, ldb; size_t kstepA, kstepB; };

struct StaticOrder {
    int nM, nN, nwg, G, c;
    __host__ __device__ void init(int M, int N, int G_, int c_) { nM = M / BM; nN = N / BM; nwg = nM * nN; G = G_; c = c_; }
    __host__ __device__ bool next(int i, Unit& u) const {
        const long L = (long)i * G + c; if (L >= nwg) return false;
        int wgid = (int)L; { const int q = nwg / NXCD, r = nwg % NXCD, xcd = wgid % NXCD, off = wgid / NXCD; wgid = (xcd < r ? xcd * (q + 1) : r * (q + 1) + (xcd - r) * q) + off; }
        const int nig = WGM * nN, gid = wgid / nig, fm = gid * WGM, gsz = (nM - fm) < WGM ? (nM - fm) : WGM;
        u.pm = fm + ((wgid % nig) % gsz); u.pn = (wgid % nig) / gsz; return true;
    }
    __device__ __forceinline__ void a_ready(const Unit&) const {}
    __device__ __forceinline__ void done(const Unit&) const {}
};

__device__ __forceinline__ unsigned pk_h2(float lo, float hi) { h16x2 v = {(_Float16)lo, (_Float16)hi}; return __builtin_bit_cast(unsigned, v); }

template <int ACT> struct EpiF16 {
    static constexpr bool PERM = true, WIDE = true, AFTER_DRAIN = false;
    bf16_t* O; int ldc; const float* rowsq; int kblk_rows; int npart;
    __device__ __forceinline__ void operator()(const f32x4 (&acc)[2][2][4][2], const Unit& u, int wr, int wc, int fr, int fq) const {
        const int row0 = u.pm * BM + wr * 64 + fr, col0 = u.pn * BM + wc * 64 + 8 * fq;
        f32x4 pn0 = {0.f, 0.f, 0.f, 0.f}, pn1 = {0.f, 0.f, 0.f, 0.f}; float sn = 0.f;
#define EPI_LOADP(row_) do { if (npart) { const f32x4* pp_ = (const f32x4*)(rowsq + (size_t)(row_) * 32) + 2 * fq; pn0 = pp_[0]; pn1 = pp_[1]; } else sn = rowsq[row_]; } while (0)
        if (rowsq) EPI_LOADP(row0);
#pragma unroll
        for (int ai = 0; ai < 2; ++ai)
#pragma unroll
            for (int m = 0; m < 4; ++m) { const int row = row0 + ai * HALF + m * 16;
                bf16_t* rowp = kblk_rows ? O + ((size_t)(col0 >> 6) * kblk_rows + row) * 64 + (col0 & 63) : O + (size_t)row * ldc + col0;
                const size_t bjstep = 32;
                float rs = 1.0f; if (rowsq) { float ssq; const f32x4 c0 = pn0, c1 = pn1; const float cs_ = sn;
                    if (ai * 4 + m < 7) EPI_LOADP(row0 + ((ai * 4 + m + 1) >> 2) * HALF + ((ai * 4 + m + 1) & 3) * 16);
                    __builtin_amdgcn_sched_barrier(0);
                    if (npart) { const f32x4 a4 = c0 + c1; float p = (a4[0] + a4[1]) + (a4[2] + a4[3]); p += __shfl_xor(p, 16); p += __shfl_xor(p, 32); ssq = p; }
                    else ssq = cs_;
                    rs = 1.0f / sqrtf(ssq * (1.0f / 2048.0f) + 1e-6f); if (ACT == 1) rs = rs * rs; }
#pragma unroll
                for (int bj = 0; bj < 2; ++bj) { f32x4 v0 = acc[ai][bj][m][0], v1 = acc[ai][bj][m][1];
                    if (ACT == 1) {
#pragma unroll
                        for (int j = 0; j < 4; ++j) { const float a = fmaxf(v0[j], 0.f), b = fmaxf(v1[j], 0.f); v0[j] = a * a; v1[j] = b * b; } }
                    v0 = v0 * rs; v1 = v1 * rs;
                    u32x4 w; w.x = pk_h2(v0[0], v0[1]); w.y = pk_h2(v0[2], v0[3]); w.z = pk_h2(v1[0], v1[1]); w.w = pk_h2(v1[2], v1[3]);
                    *(u32x4*)(rowp + bj * bjstep) = w; } }
#undef EPI_LOADP
    }
};
typedef int i32x4e __attribute__((ext_vector_type(4)));
template <class AccV> struct EpiQRelu2;
template <class AccV> struct EpiQRelu2 {
    static constexpr bool PERM = true, WIDE = true, AFTER_DRAIN = false;
    bf16_t* O; const float* rs; const float* cs; int kblk_rows;
    __device__ __forceinline__ void operator()(const AccV (&acc)[2][2][4][2], const Unit& u, int wr, int wc, int fr, int fq) const {
        const int row0 = u.pm * BM + wr * 64 + fr, col0 = u.pn * BM + wc * 64 + 8 * fq;
        f32x4 cv[2][2];
#pragma unroll
        for (int bj = 0; bj < 2; ++bj)
#pragma unroll
            for (int n = 0; n < 2; ++n) cv[bj][n] = *(const f32x4*)(cs + col0 + bj * 32 + 4 * n);
        float rv[2][4];
#pragma unroll
        for (int ai = 0; ai < 2; ++ai)
#pragma unroll
            for (int m = 0; m < 4; ++m) rv[ai][m] = rs[row0 + ai * HALF + m * 16];
#pragma unroll
        for (int ai = 0; ai < 2; ++ai)
#pragma unroll
            for (int m = 0; m < 4; ++m) { const int row = row0 + ai * HALF + m * 16; const float r = rv[ai][m];
                bf16_t* rowp = O + ((size_t)(col0 >> 6) * kblk_rows + row) * 64 + (col0 & 63); const size_t bjstep = 32;
#pragma unroll
                for (int bj = 0; bj < 2; ++bj) { f32x4 v0, v1;
#pragma unroll
                    for (int j = 0; j < 4; ++j) { const float a = fmaxf((float)acc[ai][bj][m][0][j] * (r * cv[bj][0][j]), 0.f), b = fmaxf((float)acc[ai][bj][m][1][j] * (r * cv[bj][1][j]), 0.f); v0[j] = a * a; v1[j] = b * b; }
                    u32x4 w; w.x = pk_h2(v0[0], v0[1]); w.y = pk_h2(v0[2], v0[3]); w.z = pk_h2(v1[0], v1[1]); w.w = pk_h2(v1[2], v1[3]);
                    *(u32x4*)(rowp + bj * bjstep) = w; } }
    }
};
template <class AccV> struct EpiQRelu2B {
    static constexpr bool PERM = true, WIDE = true, AFTER_DRAIN = false;
    unsigned char* O; float* SB; const float* rs; const float* cs; int rows;
    __device__ __forceinline__ void operator()(const AccV (&acc)[2][2][4][2], const Unit& u, int wr, int wc, int fr, int fq) const {
        const int row0 = u.pm * BM + wr * 64 + fr, col0 = u.pn * BM + wc * 64 + 8 * fq;
        f32x4 cv[2][2];
#pragma unroll
        for (int bj = 0; bj < 2; ++bj)
#pragma unroll
            for (int n = 0; n < 2; ++n) cv[bj][n] = *(const f32x4*)(cs + col0 + bj * 32 + 4 * n);
        float rv[2][4];
#pragma unroll
        for (int ai = 0; ai < 2; ++ai)
#pragma unroll
            for (int m = 0; m < 4; ++m) rv[ai][m] = rs[row0 + ai * HALF + m * 16];
#pragma unroll
        for (int ai = 0; ai < 2; ++ai)
#pragma unroll
            for (int m = 0; m < 4; ++m) { const int row = row0 + ai * HALF + m * 16; const float r = rv[ai][m];
                float uu[2][8]; float bm = 0.f;
#pragma unroll
                for (int bj = 0; bj < 2; ++bj)
#pragma unroll
                    for (int n = 0; n < 2; ++n)
#pragma unroll
                        for (int j = 0; j < 4; ++j) { const float a = fmaxf((float)acc[ai][bj][m][n][j] * (r * cv[bj][n][j]), 0.f); const float q = a * a; uu[bj][4 * n + j] = q; bm = fmaxf(bm, q); }
                bm = fmaxf(bm, __shfl_xor(bm, 16)); bm = fmaxf(bm, __shfl_xor(bm, 32));
                const float inv = bm > 0.f ? 255.0f / bm : 0.f;
                unsigned char* rowp = O + ((size_t)(col0 >> 6) * rows + row) * 64 + (col0 & 63);
#pragma unroll
                for (int bj = 0; bj < 2; ++bj) { unsigned w0 = 0u, w1 = 0u;
#pragma unroll
                    for (int e = 0; e < 4; ++e) { w0 = __builtin_amdgcn_cvt_pk_u8_f32(__builtin_rintf(uu[bj][e] * inv), e, w0); w1 = __builtin_amdgcn_cvt_pk_u8_f32(__builtin_rintf(uu[bj][4 + e] * inv), e, w1); }
                    u32x2 w; w.x = w0; w.y = w1; *(u32x2*)(rowp + bj * 32) = w; }
                if (fq == 0) SB[((size_t)(col0 >> 8) * rows + row) * 4 + ((col0 >> 6) & 3)] = bm * (1.0f / 255.0f); }
    }
};
struct EpiResid {
    static constexpr bool PERM = true, WIDE = true, AFTER_DRAIN = false;
    const bf16_t* res; bf16_t* out; float* out32; int ldc; const float* bias; const float* scale; float* rowsq;
    __device__ __forceinline__ void operator()(const f32x4 (&acc)[2][2][4][2], const Unit& u, int wr, int wc, int fr, int fq) const {
        const int row0 = u.pm * BM + wr * 64 + fr, col0 = u.pn * BM + wc * 64 + 8 * fq;
        h16x8e rn[2];
#pragma unroll
        for (int bj = 0; bj < 2; ++bj) rn[bj] = *(const h16x8e*)(res + (size_t)row0 * ldc + col0 + bj * 32);
#pragma unroll
        for (int ai = 0; ai < 2; ++ai)
#pragma unroll
            for (int m = 0; m < 4; ++m) { const int row = row0 + ai * HALF + m * 16; const size_t off = (size_t)row * ldc + col0; float sq = 0.f;
                const h16x8e r0 = rn[0], r1 = rn[1];
                if (ai * 4 + m < 7) { const int rown = row0 + ((ai * 4 + m + 1) >> 2) * HALF + ((ai * 4 + m + 1) & 3) * 16;
#pragma unroll
                    for (int bj = 0; bj < 2; ++bj) rn[bj] = *(const h16x8e*)(res + (size_t)rown * ldc + col0 + bj * 32); }
                __builtin_amdgcn_sched_barrier(0);
#pragma unroll
                for (int bj = 0; bj < 2; ++bj) { const int cc = bj * 32; const h16x8e rh = bj ? r1 : r0; float o[8];
#pragma unroll
                    for (int n = 0; n < 2; ++n) { const f32x4 bv = bias ? *(const f32x4*)(bias + col0 + cc + 4 * n) : (f32x4){0.f, 0.f, 0.f, 0.f}, sv = scale ? *(const f32x4*)(scale + col0 + cc + 4 * n) : (f32x4){1.f, 1.f, 1.f, 1.f};
#pragma unroll
                        for (int j = 0; j < 4; ++j) { o[4 * n + j] = (float)rh[4 * n + j] + (acc[ai][bj][m][n][j] + bv[j]) * sv[j]; sq += o[4 * n + j] * o[4 * n + j]; } }
                    if (out32) { *(f32x4*)(out32 + off + cc) = (f32x4){o[0], o[1], o[2], o[3]}; *(f32x4*)(out32 + off + cc + 4) = (f32x4){o[4], o[5], o[6], o[7]}; }
                    else { u32x4 w; w.x = pk_h2(o[0], o[1]); w.y = pk_h2(o[2], o[3]); w.z = pk_h2(o[4], o[5]); w.w = pk_h2(o[6], o[7]); *(u32x4*)(out + off + cc) = w; } }
                if (rowsq) { sq += __shfl_xor(sq, 16); sq += __shfl_xor(sq, 32); if (fq == 0) rowsq[(size_t)row * 32 + u.pn * 4 + wc] = sq; }
                asm volatile("" ::: "memory"); }
    }
};
struct EpiResidB {
    static constexpr bool PERM = true, WIDE = true, AFTER_DRAIN = false;
    const bf16_t* res; bf16_t* out; float* out32; int ldc; const float* bias; const float* scale; float* rowsq;
    __device__ __forceinline__ void operator()(const f32x4 (&acc)[2][2][4][2], const Unit& u, int wr, int wc, int fr, int fq) const {
        const int row0 = u.pm * BM + wr * 64 + fr, col0 = u.pn * BM + wc * 64 + 8 * fq;
        h16x8e rn[2]; f32x4 bvv[2][2], svv[2][2];
#pragma unroll
        for (int bj = 0; bj < 2; ++bj)
#pragma unroll
            for (int n = 0; n < 2; ++n) { bvv[bj][n] = *(const f32x4*)(bias + col0 + bj * 32 + 4 * n); svv[bj][n] = *(const f32x4*)(scale + col0 + bj * 32 + 4 * n); }
#pragma unroll
        for (int bj = 0; bj < 2; ++bj) rn[bj] = *(const h16x8e*)(res + (size_t)row0 * ldc + col0 + bj * 32);
#pragma unroll
        for (int ai = 0; ai < 2; ++ai)
#pragma unroll
            for (int m = 0; m < 4; ++m) { const int row = row0 + ai * HALF + m * 16; const size_t off = (size_t)row * ldc + col0; float sq = 0.f;
                const h16x8e r0 = rn[0], r1 = rn[1];
                if (ai * 4 + m < 7) { const int rown = row0 + ((ai * 4 + m + 1) >> 2) * HALF + ((ai * 4 + m + 1) & 3) * 16;
#pragma unroll
                    for (int bj = 0; bj < 2; ++bj) rn[bj] = *(const h16x8e*)(res + (size_t)rown * ldc + col0 + bj * 32); }
                __builtin_amdgcn_sched_barrier(0);
#pragma unroll
                for (int bj = 0; bj < 2; ++bj) { const int cc = bj * 32; const h16x8e rh = bj ? r1 : r0; float o[8];
#pragma unroll
                    for (int n = 0; n < 2; ++n) { const f32x4 bv = bvv[bj][n], sv = svv[bj][n];
#pragma unroll
                        for (int j = 0; j < 4; ++j) { o[4 * n + j] = (float)rh[4 * n + j] + (acc[ai][bj][m][n][j] + bv[j]) * sv[j]; sq += o[4 * n + j] * o[4 * n + j]; } }
                    if (out32) { *(f32x4*)(out32 + off + cc) = (f32x4){o[0], o[1], o[2], o[3]}; *(f32x4*)(out32 + off + cc + 4) = (f32x4){o[4], o[5], o[6], o[7]}; }
                    else { u32x4 w; w.x = pk_h2(o[0], o[1]); w.y = pk_h2(o[2], o[3]); w.z = pk_h2(o[4], o[5]); w.w = pk_h2(o[6], o[7]); *(u32x4*)(out + off + cc) = w; } }
                if (rowsq) { sq += __shfl_xor(sq, 16); sq += __shfl_xor(sq, 32); if (fq == 0) rowsq[(size_t)row * 32 + u.pn * 4 + wc] = sq; }
                asm volatile("" ::: "memory"); }
    }
};
struct EpiResidQ {
    static constexpr bool PERM = true, WIDE = true, AFTER_DRAIN = false;
    const bf16_t* res; bf16_t* out; float* out32; int ldc; const float* rs; const float* cs; const float* csum; float* rowsq;
    __device__ __forceinline__ void operator()(const i32x4e (&acc)[2][2][4][2], const Unit& u, int wr, int wc, int fr, int fq) const {
        const int row0 = u.pm * BM + wr * 64 + fr, col0 = u.pn * BM + wc * 64 + 8 * fq;
        i32x4e (&accw)[2][2][4][2] = const_cast<i32x4e (&)[2][2][4][2]>(acc);
        f32x4 cvv[2][2];
#pragma unroll
        for (int bj = 0; bj < 2; ++bj)
#pragma unroll
            for (int n = 0; n < 2; ++n) { cvv[bj][n] = *(const f32x4*)(cs + col0 + bj * 32 + 4 * n); const f32x4 zf = *(const f32x4*)(csum + col0 + bj * 32 + 4 * n);
                const i32x4e zi = {128 * (int)zf[0], 128 * (int)zf[1], 128 * (int)zf[2], 128 * (int)zf[3]};
#pragma unroll
                for (int ai = 0; ai < 2; ++ai)
#pragma unroll
                    for (int m = 0; m < 4; ++m) accw[ai][bj][m][n] += zi; }
        h16x8e rn[2]; float rsn;
#pragma unroll
        for (int bj = 0; bj < 2; ++bj) rn[bj] = *(const h16x8e*)(res + (size_t)row0 * ldc + col0 + bj * 32);
        rsn = rs[row0];
#pragma unroll
        for (int ai = 0; ai < 2; ++ai)
#pragma unroll
            for (int m = 0; m < 4; ++m) { const int row = row0 + ai * HALF + m * 16; const size_t off = (size_t)row * ldc + col0; float sq = 0.f; const float rsv = rsn;
                const h16x8e r0 = rn[0], r1 = rn[1];
                if (ai * 4 + m < 7) { const int rown = row0 + ((ai * 4 + m + 1) >> 2) * HALF + ((ai * 4 + m + 1) & 3) * 16;
#pragma unroll
                    for (int bj = 0; bj < 2; ++bj) rn[bj] = *(const h16x8e*)(res + (size_t)rown * ldc + col0 + bj * 32);
                    rsn = rs[rown]; }
                __builtin_amdgcn_sched_barrier(0);
#pragma unroll
                for (int bj = 0; bj < 2; ++bj) { const int cc = bj * 32; const h16x8e rh = bj ? r1 : r0; float o[8];
#pragma unroll
                    for (int n = 0; n < 2; ++n) { const f32x4 cv = cvv[bj][n];
#pragma unroll
                        for (int j = 0; j < 4; ++j) { o[4 * n + j] = (float)rh[4 * n + j] + (rsv * cv[j]) * (float)accw[ai][bj][m][n][j]; sq += o[4 * n + j] * o[4 * n + j]; } }
                    if (out32) { *(f32x4*)(out32 + off + cc) = (f32x4){o[0], o[1], o[2], o[3]}; *(f32x4*)(out32 + off + cc + 4) = (f32x4){o[4], o[5], o[6], o[7]}; }
                    else { u32x4 w; w.x = pk_h2(o[0], o[1]); w.y = pk_h2(o[2], o[3]); w.z = pk_h2(o[4], o[5]); w.w = pk_h2(o[6], o[7]); *(u32x4*)(out + off + cc) = w; } }
                if (rowsq) { sq += __shfl_xor(sq, 16); sq += __shfl_xor(sq, 32); if (fq == 0) rowsq[(size_t)row * 32 + u.pn * 4 + wc] = sq; }
                asm volatile("" ::: "memory"); }
    }
};
struct EpiGates {
    static constexpr bool PERM = false, WIDE = false, AFTER_DRAIN = false;
    const bf16_t* XC; const float* ba; const float* bx; const float* lam; bf16_t* AF; bf16_t* BF;
    __device__ __forceinline__ void operator()(const f32x4 (&acc)[2][2][4][2], const Unit& u, int wr, int wc, int fr, int fq) const {
        const int row0 = u.pm * BM + wr * 64 + fr, ch0 = (u.pn >> 1) * 256 + (u.pn & 1) * 128 + wc * 32 + 4 * fq;
#pragma unroll
        for (int n = 0; n < 2; ++n) {
            const f32x4 bav = *(const f32x4*)(ba + ch0 + n * 16), bxv = *(const f32x4*)(bx + ch0 + n * 16), l = *(const f32x4*)(lam + ch0 + n * 16); f32x4 spv;
#pragma unroll
            for (int j = 0; j < 4; ++j) spv[j] = -8.0f * log1pf(__expf(-l[j]));
            const f32x4 nba = bav * -1.4426950408889634f, nbx = bxv * -1.4426950408889634f;
#pragma unroll
            for (int ai = 0; ai < 2; ++ai) {
                h16x4 xhv[4];
#pragma unroll
                for (int m = 0; m < 4; ++m) xhv[m] = *(const h16x4*)(XC + (size_t)(row0 + ai * HALF + m * 16) * 2048 + ch0 + n * 16);
                __builtin_amdgcn_sched_barrier(0);
#pragma unroll
                for (int m = 0; m < 4; ++m) { const size_t off = (size_t)(row0 + ai * HALF + m * 16) * 2048 + ch0 + n * 16;
                    const h16x4 xh = xhv[m]; f32x4 av, bv;
#pragma unroll
                    for (int j = 0; j < 4; ++j) { const float r = __builtin_amdgcn_rcpf(1.0f + __builtin_amdgcn_exp2f(fmaf(acc[ai][0][m][n][j], -1.4426950408889634f, nba[j]))), ig = __builtin_amdgcn_rcpf(1.0f + __builtin_amdgcn_exp2f(fmaf(acc[ai][1][m][n][j], -1.4426950408889634f, nbx[j])));
                        const float la = r * spv[j]; av[j] = la;
                        const float y = 2.0f * la;
                        const float ser = -y * (1.0f + y * (0.5f + y * (1.0f / 6.0f))), dir = 1.0f - __expf(y);
                        const float om = (y > -1e-3f) ? ser : dir;
                        bv[j] = (float)xh[j] * ig * __builtin_amdgcn_sqrtf(fmaxf(om, 0.f)); }
                    { u32x2 w; w.x = pk_h2(av[0], av[1]); w.y = pk_h2(av[2], av[3]); *(u32x2*)(AF + off) = w; w.x = pk_h2(bv[0], bv[1]); w.y = pk_h2(bv[2], bv[3]); *(u32x2*)(BF + off) = w; }
                    asm volatile("" ::: "memory"); } }
        }
    }
};

template <class Epi, class Sched, bool ALIGN_EPI = false, bool SP2 = false>
__device__ __forceinline__ void gemm_phase(PG8_LAS unsigned char* lds, const Gemm g, const Sched& S, const Epi& E, const int tid) {
    const int wid = __builtin_amdgcn_readfirstlane(tid >> 6), lane = tid & 63, wr = wid >> 2, wc = wid & 3, fr = lane & 15, fq = lane >> 4;
    const int K = g.K, nt = K / BK;
    unsigned voffA[2], voffB[2];
#pragma unroll
    for (int i = 0; i < 2; ++i) { int R, C; stage_rc(tid * 16 + i * 8192, R, C); const int Rb = Epi::WIDE ? (64 * (R >> 5) + perm32(R & 31)) : (Epi::PERM ? ((R & ~31) + perm32(R & 31)) : R);
        voffA[i] = (unsigned)(R * g.lda + C) * 2u; voffB[i] = (unsigned)(Rb * g.ldb + C) * 2u; }
    const size_t kstepA = g.kstepA, kstepB = g.kstepB;
    const size_t hstepA = (size_t)HALF * g.lda * 2, hstepB = (size_t)(Epi::WIDE ? 32 : HALF) * g.ldb * 2;
#define PG8_ABASE(u) ((const char*)g.A + ((size_t)(u).pm * BM * g.lda + (size_t)((u).pn / g.npg) * K) * 2)
#define PG8_BBASE(u) ((const char*)g.Bt + (size_t)(u).pn * BM * g.ldb * 2)
    const unsigned ldsw = (unsigned)wid * 1024u;
    const int aoff = lds_byte(wr * 64 + fr, fq * 8), boff = lds_byte(wc * 32 + fr, fq * 8);
#define PG8_SA(b, h) (((b) * 2 + (h)) * HTB)
#define PG8_SB(b, h) ((4 + (b) * 2 + (h)) * HTB)
#define PG8_STAGE(bufoff, gbase, voff) do { _Pragma("unroll") for (int _i = 0; _i < 2; ++_i) \
        __builtin_amdgcn_global_load_lds((const unsigned*)((const char*)(gbase) + (voff)[_i]), (PG8_LAS unsigned*)(lds + (bufoff) + ldsw + _i * 8192), 16, 0, 0); } while (0)
#define PG8_LDA(dst, b, h) do { _Pragma("unroll") for (int m = 0; m < 4; ++m) _Pragma("unroll") for (int k = 0; k < 2; ++k) dst[m][k] = *(const PG8_LAS bf16x8*)(lds + PG8_SA(b, h) + aoff + m * 2048 + k * 1024); } while (0)
#define PG8_LDB(dst, b, h) do { _Pragma("unroll") for (int n = 0; n < 2; ++n) _Pragma("unroll") for (int k = 0; k < 2; ++k) dst[n][k] = *(const PG8_LAS bf16x8*)(lds + PG8_SB(b, h) + boff + n * 2048 + k * 1024); } while (0)
#define PG8_MMA(ai, bj, At, Bt) do { __builtin_amdgcn_s_setprio(1); _Pragma("unroll") for (int m = 0; m < 4; ++m) _Pragma("unroll") for (int n = 0; n < 2; ++n) _Pragma("unroll") for (int k = 0; k < 2; ++k) \
        acc[ai][bj][m][n] = __builtin_amdgcn_mfma_f32_16x16x32_f16(Bt[n][k], At[m][k], acc[ai][bj][m][n], 0, 0, 0); __builtin_amdgcn_s_setprio(0); } while (0)
#define PG8_WAIT_V(n) asm volatile("s_waitcnt vmcnt(" #n ")" ::: "memory")
#define PG8_WAIT_L(n) asm volatile("s_waitcnt lgkmcnt(" #n ")" ::: "memory")
#define PG8_BAR __builtin_amdgcn_s_barrier()
#define PG8_SCHED __builtin_amdgcn_sched_barrier(0)
    Unit cur, nxt; int ui = 0;
    if (!S.next(0, cur)) return;
    f32x4 acc[2][2][4][2];
#pragma unroll
    for (int a = 0; a < 2; ++a)
#pragma unroll
        for (int b = 0; b < 2; ++b)
#pragma unroll
            for (int m = 0; m < 4; ++m)
#pragma unroll
                for (int n = 0; n < 2; ++n) acc[a][b][m][n] = (f32x4){0.f, 0.f, 0.f, 0.f};
    bf16x8 At[4][2], B0[2][2], B1[2][2];
    const char* cA = PG8_ABASE(cur); const char* cB = PG8_BBASE(cur);
    S.a_ready(cur);
    if constexpr (SP2) {
        PG8_STAGE(PG8_SB(0, 0), cB, voffB); PG8_STAGE(PG8_SB(0, 1), cB + hstepB, voffB); PG8_STAGE(PG8_SA(0, 0), cA, voffA); PG8_STAGE(PG8_SA(0, 1), cA + hstepA, voffA);
        if (wr == 1) PG8_BAR;
        PG8_WAIT_V(2); PG8_BAR;
        PG8_STAGE(PG8_SB(1, 0), cB + kstepB, voffB); PG8_STAGE(PG8_SA(1, 0), cA + kstepA, voffA); PG8_STAGE(PG8_SB(1, 1), cB + hstepB + kstepB, voffB);
        PG8_WAIT_V(6); PG8_BAR;
    } else {
        PG8_STAGE(PG8_SB(0, 0), cB, voffB); PG8_STAGE(PG8_SA(0, 0), cA, voffA); PG8_STAGE(PG8_SB(0, 1), cB + hstepB, voffB); PG8_STAGE(PG8_SA(0, 1), cA + hstepA, voffA);
        if (wr == 1) PG8_BAR;
        PG8_WAIT_V(4); PG8_BAR;
        PG8_STAGE(PG8_SB(1, 0), cB + kstepB, voffB); PG8_STAGE(PG8_SA(1, 0), cA + kstepA, voffA); PG8_STAGE(PG8_SB(1, 1), cB + hstepB + kstepB, voffB);
        PG8_WAIT_V(6); PG8_BAR;
    }
    for (;;) {
        const bool has_next = S.next(ui + 1, nxt);
        const char* nA = has_next ? PG8_ABASE(nxt) : cA; const char* nB = has_next ? PG8_BBASE(nxt) : cB;
        for (int t = 0; t < nt; t += 2) {
            const bool last = (t == nt - 2);
            const char* a1 = cA + (size_t)(t + 1) * kstepA;
            const char* a2 = last ? nA : cA + (size_t)(t + 2) * kstepA; const char* b2 = last ? nB : cB + (size_t)(t + 2) * kstepB;
            const char* a3 = a2 + kstepA; const char* b3 = b2 + kstepB;
            if (last && has_next) S.a_ready(nxt);
            if constexpr (SP2) {
            PG8_LDB(B0, 0, 0); PG8_LDB(B1, 0, 1); PG8_SCHED; PG8_LDA(At, 0, 0); PG8_STAGE(PG8_SA(1, 1), a1 + hstepA, voffA);
            PG8_WAIT_V(8); PG8_WAIT_L(0); PG8_BAR; PG8_MMA(0, 0, At, B0); PG8_MMA(0, 1, At, B1); PG8_BAR; PG8_SCHED;
            PG8_LDA(At, 0, 1); PG8_STAGE(PG8_SB(0, 0), b2, voffB); PG8_STAGE(PG8_SB(0, 1), b2 + hstepB, voffB); PG8_STAGE(PG8_SA(0, 0), a2, voffA);
            PG8_WAIT_V(8); PG8_WAIT_L(0); PG8_BAR; PG8_MMA(1, 0, At, B0); PG8_MMA(1, 1, At, B1); PG8_BAR; PG8_SCHED;
            PG8_LDB(B0, 1, 0); PG8_LDB(B1, 1, 1); PG8_SCHED; PG8_LDA(At, 1, 0); PG8_STAGE(PG8_SA(0, 1), a2 + hstepA, voffA);
            PG8_WAIT_V(8); PG8_WAIT_L(0); PG8_BAR; PG8_MMA(0, 0, At, B0); PG8_MMA(0, 1, At, B1); PG8_BAR; PG8_SCHED;
            PG8_LDA(At, 1, 1); PG8_STAGE(PG8_SB(1, 0), b3, voffB); PG8_STAGE(PG8_SB(1, 1), b3 + hstepB, voffB); PG8_STAGE(PG8_SA(1, 0), a3, voffA);
            PG8_WAIT_V(8); PG8_WAIT_L(0); PG8_BAR; PG8_MMA(1, 0, At, B0); PG8_MMA(1, 1, At, B1); PG8_BAR; PG8_SCHED;
            } else {
            PG8_LDB(B0, 0, 0); PG8_SCHED; PG8_LDA(At, 0, 0); PG8_STAGE(PG8_SA(1, 1), a1 + hstepA, voffA);
            PG8_WAIT_L(8); PG8_BAR; PG8_WAIT_L(0); PG8_MMA(0, 0, At, B0); PG8_BAR; PG8_SCHED;
            PG8_LDB(B1, 0, 1); PG8_STAGE(PG8_SB(0, 0), b2, voffB);
            PG8_BAR; PG8_WAIT_L(0); PG8_MMA(0, 1, At, B1); PG8_BAR;
            PG8_LDA(At, 0, 1); PG8_STAGE(PG8_SA(0, 0), a2, voffA);
            PG8_BAR; PG8_WAIT_L(0); PG8_MMA(1, 0, At, B0); PG8_BAR; PG8_SCHED;
            PG8_STAGE(PG8_SB(0, 1), b2 + hstepB, voffB);
            PG8_WAIT_V(6); PG8_BAR; PG8_MMA(1, 1, At, B1); PG8_BAR;
            PG8_LDB(B0, 1, 0); PG8_SCHED; PG8_LDA(At, 1, 0); PG8_STAGE(PG8_SA(0, 1), a2 + hstepA, voffA);
            PG8_WAIT_L(8); PG8_BAR; PG8_WAIT_L(0); PG8_MMA(0, 0, At, B0); PG8_BAR; PG8_SCHED;
            PG8_LDB(B1, 1, 1); PG8_STAGE(PG8_SB(1, 0), b3, voffB);
            PG8_BAR; PG8_WAIT_L(0); PG8_MMA(0, 1, At, B1); PG8_BAR;
            PG8_LDA(At, 1, 1); PG8_STAGE(PG8_SA(1, 0), a3, voffA);
            PG8_BAR; PG8_WAIT_L(0); PG8_MMA(1, 0, At, B0); PG8_BAR; PG8_SCHED;
            PG8_STAGE(PG8_SB(1, 1), b3 + hstepB, voffB);
            PG8_WAIT_V(6); PG8_BAR; PG8_MMA(1, 1, At, B1); PG8_BAR;
            }
        }
        if constexpr (ALIGN_EPI) { if (wr == 0) PG8_BAR; }
        if constexpr (!Epi::AFTER_DRAIN) { E(acc, cur, wr, wc, fr, fq); S.done(cur); }
        if (!has_next) break;
#pragma unroll
        for (int a = 0; a < 2; ++a)
#pragma unroll
            for (int b = 0; b < 2; ++b)
#pragma unroll
                for (int m = 0; m < 4; ++m)
#pragma unroll
                    for (int n = 0; n < 2; ++n) acc[a][b][m][n] = (f32x4){0.f, 0.f, 0.f, 0.f};
        cur = nxt; cA = nA; cB = nB; ++ui;
        if constexpr (ALIGN_EPI) { if (wr == 1) PG8_BAR; }
    }
    PG8_WAIT_V(0);
    if constexpr (!ALIGN_EPI) { if (wr == 0) PG8_BAR; }
    PG8_BAR;
    if constexpr (Epi::AFTER_DRAIN) { E.fused(acc, cur, wr, wc, fr, fq, lds, wid, lane); S.done(cur); }
#undef PG8_ABASE
#undef PG8_BBASE
#undef PG8_SA
#undef PG8_SB
#undef PG8_STAGE
#undef PG8_LDA
#undef PG8_LDB
#undef PG8_MMA
#undef PG8_WAIT_V
#undef PG8_WAIT_L
#undef PG8_BAR
#undef PG8_SCHED
}
typedef int i32x4 __attribute__((ext_vector_type(4)));
template <class Epi, class Sched, bool ALIGN_EPI = false, bool SP2 = false>
__device__ __forceinline__ void gemm_phase_i8(PG8_LAS unsigned char* lds, const Gemm g, const Sched& S, const Epi& E, const int tid) {
    const int wid = __builtin_amdgcn_readfirstlane(tid >> 6), lane = tid & 63, wr = wid >> 2, wc = wid & 3, fr = lane & 15, fq = lane >> 4;
    const int K = g.K, nt = K / BK;
    unsigned voffA[2], voffB[2];
#pragma unroll
    for (int i = 0; i < 2; ++i) { int R, C; stage_rc(tid * 16 + i * 8192, R, C); const int Rb = Epi::WIDE ? (64 * (R >> 5) + perm32(R & 31)) : (Epi::PERM ? ((R & ~31) + perm32(R & 31)) : R);
        voffA[i] = (unsigned)(R * g.lda + C) * 2u; voffB[i] = (unsigned)(Rb * g.ldb + C) * 2u; }
    const size_t kstepA = g.kstepA, kstepB = g.kstepB;
    const size_t hstepA = (size_t)HALF * g.lda * 2, hstepB = (size_t)(Epi::WIDE ? 32 : HALF) * g.ldb * 2;
#define PG8_ABASE(u) ((const char*)g.A + ((size_t)(u).pm * BM * g.lda + (size_t)((u).pn / g.npg) * K) * 2)
#define PG8_BBASE(u) ((const char*)g.Bt + (size_t)(u).pn * BM * g.ldb * 2)
    const unsigned ldsw = (unsigned)wid * 1024u;
    const int aoff = lds_byte(wr * 64 + fr, fq * 8), boff = lds_byte(wc * 32 + fr, fq * 8);
#define PG8_SA(b, h) (((b) * 2 + (h)) * HTB)
#define PG8_SB(b, h) ((4 + (b) * 2 + (h)) * HTB)
#define PG8_STAGE(bufoff, gbase, voff) do { _Pragma("unroll") for (int _i = 0; _i < 2; ++_i) \
        __builtin_amdgcn_global_load_lds((const unsigned*)((const char*)(gbase) + (voff)[_i]), (PG8_LAS unsigned*)(lds + (bufoff) + ldsw + _i * 8192), 16, 0, 0); } while (0)
#define PG8_LDA(dst, b, h) do { _Pragma("unroll") for (int m = 0; m < 4; ++m) _Pragma("unroll") for (int k = 0; k < 2; ++k) dst[m][k] = *(const PG8_LAS bf16x8*)(lds + PG8_SA(b, h) + aoff + m * 2048 + k * 1024); } while (0)
#define PG8_LDB(dst, b, h) do { _Pragma("unroll") for (int n = 0; n < 2; ++n) _Pragma("unroll") for (int k = 0; k < 2; ++k) dst[n][k] = *(const PG8_LAS bf16x8*)(lds + PG8_SB(b, h) + boff + n * 2048 + k * 1024); } while (0)
#define PG8_MMA(ai, bj, At, Bt) do { __builtin_amdgcn_s_setprio(1); _Pragma("unroll") for (int m = 0; m < 4; ++m) _Pragma("unroll") for (int n = 0; n < 2; ++n) _Pragma("unroll") for (int k = 0; k < 2; ++k) \
        acc[ai][bj][m][n] = __builtin_amdgcn_mfma_i32_16x16x64_i8(__builtin_bit_cast(i32x4, Bt[n][k]), __builtin_bit_cast(i32x4, At[m][k]), acc[ai][bj][m][n], 0, 0, 0); __builtin_amdgcn_s_setprio(0); } while (0)
#define PG8_WAIT_V(n) asm volatile("s_waitcnt vmcnt(" #n ")" ::: "memory")
#define PG8_WAIT_L(n) asm volatile("s_waitcnt lgkmcnt(" #n ")" ::: "memory")
#define PG8_BAR __builtin_amdgcn_s_barrier()
#define PG8_SCHED __builtin_amdgcn_sched_barrier(0)
    Unit cur, nxt; int ui = 0;
    if (!S.next(0, cur)) return;
    i32x4 acc[2][2][4][2];
#pragma unroll
    for (int a = 0; a < 2; ++a)
#pragma unroll
        for (int b = 0; b < 2; ++b)
#pragma unroll
            for (int m = 0; m < 4; ++m)
#pragma unroll
                for (int n = 0; n < 2; ++n) acc[a][b][m][n] = (i32x4){0, 0, 0, 0};
    bf16x8 At[4][2], B0[2][2], B1[2][2];
    const char* cA = PG8_ABASE(cur); const char* cB = PG8_BBASE(cur);
    S.a_ready(cur);
    if constexpr (SP2) {
        PG8_STAGE(PG8_SB(0, 0), cB, voffB); PG8_STAGE(PG8_SB(0, 1), cB + hstepB, voffB); PG8_STAGE(PG8_SA(0, 0), cA, voffA); PG8_STAGE(PG8_SA(0, 1), cA + hstepA, voffA);
        if (wr == 1) PG8_BAR;
        PG8_WAIT_V(2); PG8_BAR;
        PG8_STAGE(PG8_SB(1, 0), cB + kstepB, voffB); PG8_STAGE(PG8_SA(1, 0), cA + kstepA, voffA); PG8_STAGE(PG8_SB(1, 1), cB + hstepB + kstepB, voffB);
        PG8_WAIT_V(6); PG8_BAR;
    } else {
        PG8_STAGE(PG8_SB(0, 0), cB, voffB); PG8_STAGE(PG8_SA(0, 0), cA, voffA); PG8_STAGE(PG8_SB(0, 1), cB + hstepB, voffB); PG8_STAGE(PG8_SA(0, 1), cA + hstepA, voffA);
        if (wr == 1) PG8_BAR;
        PG8_WAIT_V(4); PG8_BAR;
        PG8_STAGE(PG8_SB(1, 0), cB + kstepB, voffB); PG8_STAGE(PG8_SA(1, 0), cA + kstepA, voffA); PG8_STAGE(PG8_SB(1, 1), cB + hstepB + kstepB, voffB);
        PG8_WAIT_V(6); PG8_BAR;
    }
    for (;;) {
        const bool has_next = S.next(ui + 1, nxt);
        const char* nA = has_next ? PG8_ABASE(nxt) : cA; const char* nB = has_next ? PG8_BBASE(nxt) : cB;
        for (int t = 0; t < nt; t += 2) {
            const bool last = (t == nt - 2);
            const char* a1 = cA + (size_t)(t + 1) * kstepA;
            const char* a2 = last ? nA : cA + (size_t)(t + 2) * kstepA; const char* b2 = last ? nB : cB + (size_t)(t + 2) * kstepB;
            const char* a3 = a2 + kstepA; const char* b3 = b2 + kstepB;
            if (last && has_next) S.a_ready(nxt);
            if constexpr (SP2) {
            PG8_LDB(B0, 0, 0); PG8_LDB(B1, 0, 1); PG8_SCHED; PG8_LDA(At, 0, 0); PG8_STAGE(PG8_SA(1, 1), a1 + hstepA, voffA);
            PG8_WAIT_V(8); PG8_WAIT_L(0); PG8_BAR; PG8_MMA(0, 0, At, B0); PG8_MMA(0, 1, At, B1); PG8_BAR; PG8_SCHED;
            PG8_LDA(At, 0, 1); PG8_STAGE(PG8_SB(0, 0), b2, voffB); PG8_STAGE(PG8_SB(0, 1), b2 + hstepB, voffB); PG8_STAGE(PG8_SA(0, 0), a2, voffA);
            PG8_WAIT_V(8); PG8_WAIT_L(0); PG8_BAR; PG8_MMA(1, 0, At, B0); PG8_MMA(1, 1, At, B1); PG8_BAR; PG8_SCHED;
            PG8_LDB(B0, 1, 0); PG8_LDB(B1, 1, 1); PG8_SCHED; PG8_LDA(At, 1, 0); PG8_STAGE(PG8_SA(0, 1), a2 + hstepA, voffA);
            PG8_WAIT_V(8); PG8_WAIT_L(0); PG8_BAR; PG8_MMA(0, 0, At, B0); PG8_MMA(0, 1, At, B1); PG8_BAR; PG8_SCHED;
            PG8_LDA(At, 1, 1); PG8_STAGE(PG8_SB(1, 0), b3, voffB); PG8_STAGE(PG8_SB(1, 1), b3 + hstepB, voffB); PG8_STAGE(PG8_SA(1, 0), a3, voffA);
            PG8_WAIT_V(8); PG8_WAIT_L(0); PG8_BAR; PG8_MMA(1, 0, At, B0); PG8_MMA(1, 1, At, B1); PG8_BAR; PG8_SCHED;
            } else {
            PG8_LDB(B0, 0, 0); PG8_SCHED; PG8_LDA(At, 0, 0); PG8_STAGE(PG8_SA(1, 1), a1 + hstepA, voffA);
            PG8_WAIT_L(8); PG8_BAR; PG8_WAIT_L(0); PG8_MMA(0, 0, At, B0); PG8_BAR; PG8_SCHED;
            PG8_LDB(B1, 0, 1); PG8_STAGE(PG8_SB(0, 0), b2, voffB);
            PG8_BAR; PG8_WAIT_L(0); PG8_MMA(0, 1, At, B1); PG8_BAR;
            PG8_LDA(At, 0, 1); PG8_STAGE(PG8_SA(0, 0), a2, voffA);
            PG8_BAR; PG8_WAIT_L(0); PG8_MMA(1, 0, At, B0); PG8_BAR; PG8_SCHED;
            PG8_STAGE(PG8_SB(0, 1), b2 + hstepB, voffB);
            PG8_WAIT_V(6); PG8_BAR; PG8_MMA(1, 1, At, B1); PG8_BAR;
            PG8_LDB(B0, 1, 0); PG8_SCHED; PG8_LDA(At, 1, 0); PG8_STAGE(PG8_SA(0, 1), a2 + hstepA, voffA);
            PG8_WAIT_L(8); PG8_BAR; PG8_WAIT_L(0); PG8_MMA(0, 0, At, B0); PG8_BAR; PG8_SCHED;
            PG8_LDB(B1, 1, 1); PG8_STAGE(PG8_SB(1, 0), b3, voffB);
            PG8_BAR; PG8_WAIT_L(0); PG8_MMA(0, 1, At, B1); PG8_BAR;
            PG8_LDA(At, 1, 1); PG8_STAGE(PG8_SA(1, 0), a3, voffA);
            PG8_BAR; PG8_WAIT_L(0); PG8_MMA(1, 0, At, B0); PG8_BAR; PG8_SCHED;
            PG8_STAGE(PG8_SB(1, 1), b3 + hstepB, voffB);
            PG8_WAIT_V(6); PG8_BAR; PG8_MMA(1, 1, At, B1); PG8_BAR;
            }
        }
        if constexpr (ALIGN_EPI) { if (wr == 0) PG8_BAR; }
        if constexpr (!Epi::AFTER_DRAIN) { E(acc, cur, wr, wc, fr, fq); S.done(cur); }
        if (!has_next) break;
#pragma unroll
        for (int a = 0; a < 2; ++a)
#pragma unroll
            for (int b = 0; b < 2; ++b)
#pragma unroll
                for (int m = 0; m < 4; ++m)
#pragma unroll
                    for (int n = 0; n < 2; ++n) acc[a][b][m][n] = (i32x4){0, 0, 0, 0};
        cur = nxt; cA = nA; cB = nB; ++ui;
        if constexpr (ALIGN_EPI) { if (wr == 1) PG8_BAR; }
    }
    PG8_WAIT_V(0);
    if constexpr (!ALIGN_EPI) { if (wr == 0) PG8_BAR; }
    PG8_BAR;
    if constexpr (Epi::AFTER_DRAIN) { E.fused(acc, cur, wr, wc, fr, fq, lds, wid, lane); S.done(cur); }
#undef PG8_ABASE
#undef PG8_BBASE
#undef PG8_SA
#undef PG8_SB
#undef PG8_STAGE
#undef PG8_LDA
#undef PG8_LDB
#undef PG8_MMA
#undef PG8_WAIT_V
#undef PG8_WAIT_L
#undef PG8_BAR
#undef PG8_SCHED
}
}

constexpr int T = 8192, D = 2048, FF = 8192, DEPTH = 4;
constexpr int NH = 16, HD = 128, NKV = 4, TOPK = 256;
constexpr int A_IN = 5264, A_INP = 5376;
constexpr int C_Q = 0, C_K = 2048, C_V = 2560, C_IQ = 3072, C_IK = 5120, C_IW = 5248;
constexpr float EPS = 1e-6f;
constexpr int NWAVES = 8, NTHR = NWAVES * 64;

constexpr size_t MiB = 1u << 20;
constexpr size_t WS_CTL = 0, CTL_ZERO_BYTES = 1 * MiB;
constexpr size_t WS_COS128 = 1 * MiB, WS_SIN128 = 3 * MiB, WS_COS64 = 5 * MiB, WS_SIN64 = 6 * MiB;
constexpr size_t WS_IW = 7 * MiB;
constexpr size_t WS_AGGA = 724 * MiB, WS_AGGB = 726 * MiB, WS_CARRY = 728 * MiB;
constexpr size_t WS_WINA = 10 * MiB;
constexpr size_t WS_WOUTA = 52 * MiB;
constexpr size_t WS_WINR = 68 * MiB;
constexpr size_t WS_WGR = 84 * MiB;
constexpr size_t WS_WOUTR = 86 * MiB;
constexpr size_t WS_WPOOL = 94 * MiB;
constexpr size_t WS_WUP = 96 * MiB;
constexpr size_t WS_WDOWN = 224 * MiB;
constexpr size_t WS_BA = 352 * MiB;
constexpr size_t BA_SC = 0;
constexpr int SC_LD = T + 64;
constexpr size_t BA_O16 = 0;
constexpr size_t BA_U = 0, BA_SB = 64 * MiB;
constexpr size_t BA_AF = 0, BA_BF = 64 * MiB;
constexpr size_t BA_H16 = 128 * MiB;
constexpr size_t BA_PROJ = 160 * MiB;
constexpr size_t BA_XC = 224 * MiB;
constexpr size_t WS_QH = 616 * MiB, WS_KH = 632 * MiB, WS_VH = 636 * MiB, WS_IK = 640 * MiB, WS_SEL = 642 * MiB, WS_IQ = 650 * MiB, WS_PARTA = 686 * MiB, WS_PARTB = 687 * MiB, WS_BLKMAXD = 688 * MiB, WS_X16 = 692 * MiB, WS_END = 730 * MiB;
constexpr int CW_BAR = 4096;
constexpr size_t WS_BLKMAX = 682 * MiB;
constexpr size_t WS_RS = 7 * MiB + 512 * 1024, WS_CS = WS_RS + 64 * 1024;
constexpr size_t WS_RS2 = WS_RS + 128 * 1024, WS_CS2 = WS_RS + 192 * 1024, WS_CSUM = WS_RS + 208 * 1024;
constexpr size_t BA_U8 = 192 * MiB, BA_W8D = 176 * MiB;
constexpr size_t BA_A8 = 160 * MiB, BA_W8 = 176 * MiB;
constexpr size_t WS_ROWSQ = 256 * 1024;

constexpr int RING_BYTES = 131072;
constexpr int LDSCTL_OFF = RING_BYTES, MISC_OFF = LDSCTL_OFF + 320;
constexpr int LDS_BYTES = 155648;

#define GAS __attribute__((address_space(1)))
#define LAS __attribute__((address_space(3)))
typedef _Float16 h16;
typedef _Float16 h16x2 __attribute__((ext_vector_type(2)));
typedef _Float16 h16x4 __attribute__((ext_vector_type(4)));
typedef _Float16 h16x8 __attribute__((ext_vector_type(8)));
typedef unsigned v4u __attribute__((ext_vector_type(4)));
typedef unsigned v2u __attribute__((ext_vector_type(2)));
typedef float f32x4 __attribute__((ext_vector_type(4)));
typedef float f32x2 __attribute__((ext_vector_type(2)));
#define LDS_WAIT() asm volatile("s_waitcnt lgkmcnt(0)" ::: "memory")
#define VM_WAIT() asm volatile("s_waitcnt vmcnt(0)" ::: "memory")
__device__ __forceinline__ unsigned pkh(float lo, float hi) { h16x2 v = {(h16)lo, (h16)hi}; return __builtin_bit_cast(unsigned, v); }
__device__ __forceinline__ float wave_sum(float v) {
#pragma unroll
    for (int o = 1; o < 64; o <<= 1) v += __shfl_xor(v, o);
    return v;
}
__device__ __forceinline__ float wave_max(float v) {
#pragma unroll
    for (int o = 1; o < 64; o <<= 1) v = fmaxf(v, __shfl_xor(v, o));
    return v;
}

#define XB_TMO      128
#define XB_XCNT(j)  (256  + 64 * (j))
#define XB_XSUB(j)  (1280 + 64 * (j))
#define XB_XGEN(j)  (2304 + 64 * (j))
#define XB_TOP      3328
#define XB_TOPGEN   3392
#define XCD_BAR_WORDS 3456
#define XB_SPIN_CAP (1u << 18)

__device__ __forceinline__ unsigned xb_ld(unsigned* p)              { return __hip_atomic_load(p, __ATOMIC_RELAXED, __HIP_MEMORY_SCOPE_AGENT); }
__device__ __forceinline__ unsigned xb_add(unsigned* p, unsigned v) { return __hip_atomic_fetch_add(p, v, __ATOMIC_RELAXED, __HIP_MEMORY_SCOPE_AGENT); }
__device__ __forceinline__ unsigned xb_xcc_id() { return (unsigned)__builtin_amdgcn_s_getreg((3 << 11) | 20) & 0xFu; }
#define XB_SPIN(cond, bar) do { unsigned _sp = 0; while (cond) { __builtin_amdgcn_s_sleep(1); \
    if ((++_sp & 255u) == 0u) { if (xb_ld(&(bar)[XB_TMO])) break; if (_sp > XB_SPIN_CAP) { atomicAdd(&(bar)[XB_TMO], 1u); break; } } } } while (0)

struct XcdBarrier { unsigned* bar; unsigned x; volatile LAS unsigned* st; };

__device__ __forceinline__ XcdBarrier xcd_barrier_post(unsigned* bar, volatile LAS unsigned* st) {
    XcdBarrier b; b.bar = bar; b.x = xb_xcc_id(); b.st = st;
    if (threadIdx.x == 0) (void)xb_add(&bar[XB_XCNT(b.x)], 1u);
    return b;
}
__device__ __forceinline__ void xcd_barrier_complete(unsigned* bar, unsigned x, unsigned& nloc, unsigned& nx) {
    const unsigned G = gridDim.x * gridDim.y * gridDim.z;
    unsigned sum, cnt, mine, sp = 0u;
    for (;;) {
        sum = 0u; cnt = 0u; mine = 0u;
#pragma unroll
        for (unsigned j = 0; j < 16; ++j) { const unsigned c = xb_ld(&bar[XB_XCNT(j)]); sum += c; cnt += (c > 0u) ? 1u : 0u; mine = (j == x) ? c : mine; }
        if (sum == G) break;
        __builtin_amdgcn_s_sleep(1);
        if ((++sp & 255u) == 0u) { if (xb_ld(&bar[XB_TMO])) break; if (sp > XB_SPIN_CAP) { atomicAdd(&bar[XB_TMO], 1u); break; } }
    }
    nloc = mine > 0u ? mine : 1u; nx = cnt > 0u ? cnt : 1u;
}
__device__ __forceinline__ void xcd_barrier(const XcdBarrier& b) {
    asm volatile("s_waitcnt vmcnt(0)" ::: "memory");
    __syncthreads();
    if (threadIdx.x == 0) {
        unsigned* bar = b.bar;
        __builtin_amdgcn_s_waitcnt(0);
        unsigned nloc = b.st[0], nx = b.st[1];
        if (nloc == 0u) { xcd_barrier_complete(bar, b.x, nloc, nx); b.st[0] = nloc; b.st[1] = nx; }
        const unsigned old = xb_add(&bar[XB_XSUB(b.x)], 1u);
        const unsigned gen = old / nloc;
        if (old + 1u == (gen + 1u) * nloc) {
            __builtin_amdgcn_fence(__ATOMIC_RELEASE, "agent");
            asm volatile("s_waitcnt vmcnt(0)" ::: "memory");
            const unsigned og = xb_add(&bar[XB_TOP], 1u);
            const unsigned tg = og / nx;
            if (og + 1u == (tg + 1u) * nx) xb_add(&bar[XB_TOPGEN], 1u);
            else XB_SPIN(xb_ld(&bar[XB_TOPGEN]) == tg, bar);
            __builtin_amdgcn_fence(__ATOMIC_ACQUIRE, "agent");
            xb_add(&bar[XB_XGEN(b.x)], 1u);
            asm volatile("s_waitcnt vmcnt(0)" ::: "memory");
        } else {
            XB_SPIN(xb_ld(&bar[XB_XGEN(b.x)]) == gen, bar);
            __builtin_amdgcn_fence(__ATOMIC_ACQUIRE, "agent");
            asm volatile("s_waitcnt vmcnt(0)" ::: "memory");
        }
    }
    __syncthreads();
}

__device__ __forceinline__ void tr_item(const float* src, int ldw, int nvalid, h16* dst, int ldd, LAS float* scr, int lane, unsigned* colmax = nullptr, const float* gk = nullptr) {
    const int nn = lane & 31; float v[32];
#pragma unroll
    for (int i = 0; i < 32; ++i) { const int kk = 2 * i + (lane >> 5); v[i] = (nn < nvalid) ? src[(size_t)kk * ldw + nn] * (gk ? gk[kk] : 1.0f) : 0.f; }
    __builtin_amdgcn_sched_barrier(0);
#pragma unroll
    for (int i = 0; i < 32; ++i) { const int kk = 2 * i + (lane >> 5); scr[kk * 33 + nn] = v[i]; }
    LDS_WAIT();
    const int c = lane & 7;
#pragma unroll
    for (int j = 0; j < 4; ++j) { const int n = (lane >> 3) + 8 * j; const LAS float* s = scr + (8 * c) * 33 + n;
        v4u o; o.x = pkh(s[0 * 33], s[1 * 33]); o.y = pkh(s[2 * 33], s[3 * 33]); o.z = pkh(s[4 * 33], s[5 * 33]); o.w = pkh(s[6 * 33], s[7 * 33]);
        *(v4u*)(dst + (size_t)n * ldd + 8 * c) = o;
        if (colmax) {
            float mx = fmaxf(fmaxf(fmaxf(fabsf(s[0 * 33]), fabsf(s[1 * 33])), fmaxf(fabsf(s[2 * 33]), fabsf(s[3 * 33]))), fmaxf(fmaxf(fabsf(s[4 * 33]), fabsf(s[5 * 33])), fmaxf(fabsf(s[6 * 33]), fabsf(s[7 * 33]))));
            mx = fmaxf(mx, __shfl_xor(mx, 1)); mx = fmaxf(mx, __shfl_xor(mx, 2)); mx = fmaxf(mx, __shfl_xor(mx, 4));
            if (c == 0) colmax[n] = __float_as_uint(mx); } }
    LDS_WAIT();
}

struct Ptrs {
    const float* x; const int* pos;
    const float *attn_norm, *attn_w_in, *attn_qn, *attn_kn, *attn_w_out;
    const float *rnn_norm, *rnn_w_in, *conv_w, *conv_b, *ga_w, *ga_b, *gx_w, *gx_b, *lam, *rnn_w_out;
    const float *pool_norm, *pool_w, *pool_b, *pool_scale;
    const float *mlp_norm, *mlp_w_up, *mlp_w_down;
    float* out; unsigned char* ws;
    int ph_lo, ph_hi;
};

#define CAS __attribute__((address_space(4)))
__device__ __forceinline__ const CAS Ptrs* kargs() { const CAS Ptrs* p = (const CAS Ptrs*)__builtin_amdgcn_kernarg_segment_ptr(); asm volatile("" : "+s"(p)); return p; }
__device__ __forceinline__ void p0_prologue(const CAS Ptrs* PP, LAS unsigned char* lds, int gw, int NGW, int wave, int lane, int gtid, int NGT) {
    LAS float* scr = (LAS float*)(lds + wave * 16384);
    unsigned char* ws = PP->ws;
    constexpr int I_WINA = 32 * 165, I_WOUTA = 32 * 64, I_WINR = 32 * 128, I_G = 4 * 8, I_WOUTR = 32 * 64, I_POOL = 8 * 16, I_UP = 32 * 256, I_DN = 128 * 64, I_Z = 384;
    constexpr int NITEMS = 2 * I_WINA + 2 * I_WOUTA + I_WINR + 16 * I_G + I_WOUTR + 4 * I_POOL + 4 * I_UP + 4 * I_DN + 2 * I_Z;
    for (int it = gw; it < NITEMS; it += NGW) {
        int r = it;
        if (r < 2 * I_WINA) { const int j = r / I_WINA; r -= j * I_WINA; const int kb = r / 165, nb = r % 165, n0 = 32 * nb; const int nv = (A_IN - n0) < 32 ? (A_IN - n0) : 32;
            tr_item(PP->attn_w_in + (size_t)j * D * A_IN + (size_t)(64 * kb) * A_IN + n0, A_IN, nv, (h16*)(ws + WS_WINA) + (size_t)j * A_INP * D + (size_t)n0 * D + 64 * kb, D, scr, lane, nullptr, PP->attn_norm + (size_t)j * D + 64 * kb); continue; }
        r -= 2 * I_WINA;
        if (r < 2 * I_WOUTA) { const int j = r / I_WOUTA; r -= j * I_WOUTA; const int kb = r / 64, nb = r % 64;
            tr_item(PP->attn_w_out + (size_t)j * D * D + (size_t)(64 * kb) * D + 32 * nb, D, 32, (h16*)(ws + WS_WOUTA) + (size_t)j * D * D + (size_t)(32 * nb) * D + 64 * kb, D, scr, lane); continue; }
        r -= 2 * I_WOUTA;
        if (r < I_WINR) { const int kb = r / 128, nb = r % 128;
            tr_item(PP->rnn_w_in + (size_t)(64 * kb) * 4096 + 32 * nb, 4096, 32, (h16*)(ws + WS_WINR) + (size_t)(32 * nb) * D + 64 * kb, D, scr, lane, nullptr, PP->rnn_norm + 64 * kb); continue; }
        r -= I_WINR;
        if (r < 16 * I_G) { const int mi = r / I_G; r -= mi * I_G; const int which = mi >> 3, blk = mi & 7, kb = r / 8, nb = r % 8, d0 = 32 * nb;
            const float* src = (which ? PP->gx_w : PP->ga_w) + (size_t)blk * 65536 + (size_t)(64 * kb) * 256 + d0;
            const int drow = 256 * (2 * blk + (d0 >> 7)) + 128 * which + (d0 & 127);
            tr_item(src, 256, 32, (h16*)(ws + WS_WGR) + (size_t)drow * 256 + 64 * kb, 256, scr, lane); continue; }
        r -= 16 * I_G;
        if (r < I_WOUTR) { const int kb = r / 64, nb = r % 64;
            tr_item(PP->rnn_w_out + (size_t)(64 * kb) * D + 32 * nb, D, 32, (h16*)(ws + WS_WOUTR) + (size_t)(32 * nb) * D + 64 * kb, D, scr, lane); continue; }
        r -= I_WOUTR;
        if (r < 4 * I_POOL) { const int g = r / I_POOL; r -= g * I_POOL; const int kb = r / 16, nb = r % 16;
            tr_item(PP->pool_w + (size_t)g * 262144 + (size_t)(64 * kb) * 512 + 32 * nb, 512, 32, (h16*)(ws + WS_WPOOL) + (size_t)(512 * g + 32 * nb) * 512 + 64 * kb, 512, scr, lane); continue; }
        r -= 4 * I_POOL;
        if (r < 4 * I_UP) { const int i = r / I_UP; r -= i * I_UP; const int kb = r / 256, nb = r % 256;
            tr_item(PP->mlp_w_up + (size_t)i * D * FF + (size_t)(64 * kb) * FF + 32 * nb, FF, 32, (h16*)(ws + WS_WUP) + (size_t)i * D * FF + (size_t)(32 * nb) * D + 64 * kb, D, scr, lane, (unsigned*)(ws + WS_BLKMAX) + ((size_t)i * 32 + kb) * FF + 32 * nb, PP->mlp_norm + (size_t)i * D + 64 * kb); continue; }
        r -= 4 * I_UP;
        if (r < 4 * I_DN) { const int i = r / I_DN; r -= i * I_DN; const int kb = r / 64, nb = r % 64;
            tr_item(PP->mlp_w_down + (size_t)i * D * FF + (size_t)(64 * kb) * D + 32 * nb, D, 32, (h16*)(ws + WS_WDOWN) + (size_t)i * D * FF + ((size_t)kb * D + 32 * nb) * 64, 64, scr, lane, (unsigned*)(ws + WS_BLKMAXD) + ((size_t)i * 128 + kb) * D + 32 * nb); continue; }
        r -= 4 * I_DN;
        { const int j = r / I_Z; r -= j * I_Z;
            v4u* z = (v4u*)((h16*)(ws + WS_WINA) + (size_t)j * A_INP * D + (size_t)5280 * D); z[(size_t)r * 64 + lane] = (v4u){0u, 0u, 0u, 0u}; }
    }
    for (int e = gtid; e < T * 96; e += NGT) {
        const int t = e / 96, i = e % 96; const bool big = i < 64; const int fi = big ? i : i - 64;
        const double base = big ? 0.8659643233600653 : 0.7498942093324559;
        double inv = 1.0; for (int k = 0; k < fi; ++k) inv *= base;
        const double ang = (double)PP->pos[t] * inv;
        const double n = __builtin_rint(ang * 0.15915494309189535); const double rr = ang - n * 6.283185307179586 - n * 2.4492935982947064e-16;
        const double r2 = rr * rr; double sn = 1.0, cs = 1.0;
#pragma unroll
        for (int k = 14; k >= 1; --k) { sn = 1.0 - sn * r2 * (1.0 / (double)((2 * k) * (2 * k + 1))); cs = 1.0 - cs * r2 * (1.0 / (double)((2 * k - 1) * (2 * k))); }
        sn *= rr;
        if (big) { ((float*)(ws + WS_COS128))[t * 64 + fi] = (float)cs; ((float*)(ws + WS_SIN128))[t * 64 + fi] = (float)sn; }
        else { ((float*)(ws + WS_COS64))[t * 32 + fi] = (float)cs; ((float*)(ws + WS_SIN64))[t * 32 + fi] = (float)sn; }
    }
}

__device__ __forceinline__ void quant_rows(const h16* src, int nrows, signed char* dst, float* scale_out, const float* rowsq, const unsigned* colmax, int gw, int NGW, int lane) {
    h16x8 vn[4]; float cmn = 0.f; f32x4 pn = {0.f, 0.f, 0.f, 0.f};
    if (gw < nrows) {
#pragma unroll
        for (int j = 0; j < 4; ++j) vn[j] = *(const h16x8*)(src + (size_t)gw * D + 512 * j + 8 * lane);
        if (colmax) cmn = lane < 32 ? __uint_as_float(colmax[(size_t)lane * FF + gw]) : 0.f;
        if (rowsq && lane < 8) pn = *((const f32x4*)(rowsq + (size_t)gw * 32) + lane); }
    for (int r = gw; r < nrows; r += NGW) {
        h16x8 v[4]; const float cm = cmn; const f32x4 pc = pn;
#pragma unroll
        for (int j = 0; j < 4; ++j) v[j] = vn[j];
        const int rn = r + NGW;
        if (rn < nrows) {
#pragma unroll
            for (int j = 0; j < 4; ++j) vn[j] = *(const h16x8*)(src + (size_t)rn * D + 512 * j + 8 * lane);
            if (colmax) cmn = lane < 32 ? __uint_as_float(colmax[(size_t)lane * FF + rn]) : 0.f;
            if (rowsq && lane < 8) pn = *((const f32x4*)(rowsq + (size_t)rn * 32) + lane); }
        __builtin_amdgcn_sched_barrier(0);
        float mx;
        if (colmax) mx = wave_max(cm);
        else { mx = 0.f;
#pragma unroll
            for (int j = 0; j < 4; ++j)
#pragma unroll
                for (int e = 0; e < 8; ++e) mx = fmaxf(mx, fabsf((float)v[j][e]));
            mx = wave_max(mx); }
        const float step = mx > 0.f ? mx * (1.0f / 127.0f) : 1.0f, inv = 1.0f / step;
        float ssq = 0.f; if (rowsq) ssq = wave_sum((pc[0] + pc[1]) + (pc[2] + pc[3]));
        if (lane == 0) scale_out[r] = rowsq ? step / sqrtf(ssq * (1.0f / D) + EPS) : step;
#pragma unroll
        for (int j = 0; j < 4; ++j) { unsigned w[2];
#pragma unroll
            for (int hh = 0; hh < 2; ++hh) { unsigned p = 0u;
#pragma unroll
                for (int e = 0; e < 4; ++e) { int qv = (int)rintf((float)v[j][4 * hh + e] * inv); qv = qv > 127 ? 127 : (qv < -127 ? -127 : qv); p |= ((unsigned)qv & 255u) << (8 * e); }
                w[hh] = p; }
            *(v2u*)(dst + (size_t)r * D + 512 * j + 8 * lane) = (v2u){w[0], w[1]}; }
    }
}
template <bool UNSIGNED>
__device__ __forceinline__ void quant_kblk(const h16* src, int R, signed char* dst, float* scale_out, float* csum, const unsigned* blkmax, int gw, int NGW, int lane) {
    const int bsub = lane >> 3, c8 = (lane & 7) * 8;
    h16x8 vn[16]; float cmn = 0.f;
#define QK_LOAD(r_) do { _Pragma("unroll") for (int i = 0; i < 16; ++i) vn[i] = *(const h16x8*)(src + ((size_t)(8 * i + bsub) * R + (r_)) * 64 + c8); \
        if (!UNSIGNED) cmn = fmaxf(__uint_as_float(blkmax[(size_t)lane * R + (r_)]), __uint_as_float(blkmax[(size_t)(64 + lane) * R + (r_)])); } while (0)
    if (gw < R) QK_LOAD(gw);
    for (int r = gw; r < R; r += NGW) {
        h16x8 v[16]; const float cm = cmn;
#pragma unroll
        for (int i = 0; i < 16; ++i) v[i] = vn[i];
        if (r + NGW < R) QK_LOAD(r + NGW);
        float mx;
        if (UNSIGNED) { mx = 0.f;
#pragma unroll
            for (int i = 0; i < 16; ++i)
#pragma unroll
                for (int e = 0; e < 8; ++e) mx = fmaxf(mx, (float)v[i][e]);
            mx = wave_max(mx); }
        else mx = wave_max(cm);
        const float step = mx > 0.f ? mx * (UNSIGNED ? 1.0f / 255.0f : 1.0f / 127.0f) : 1.0f, inv = 1.0f / step;
        int ssum = 0;
#pragma unroll
        for (int i = 0; i < 16; ++i) { unsigned w[2];
#pragma unroll
            for (int hh = 0; hh < 2; ++hh) { unsigned p = 0u;
#pragma unroll
                for (int e = 0; e < 4; ++e) { int qv = (int)rintf((float)v[i][4 * hh + e] * inv);
                    if (UNSIGNED) { qv = qv > 255 ? 255 : (qv < 0 ? 0 : qv); qv -= 128; } else { qv = qv > 127 ? 127 : (qv < -127 ? -127 : qv); ssum += qv; }
                    p |= ((unsigned)qv & 255u) << (8 * e); }
                w[hh] = p; }
            const int b = 8 * i + bsub;
            *(v2u*)(dst + ((size_t)(b >> 1) * R + r) * 128 + 64 * (b & 1) + c8) = (v2u){w[0], w[1]}; }
        if (!UNSIGNED) { float fs = (float)ssum; fs = wave_sum(fs); if (lane == 0) csum[r] = fs; }
        if (lane == 0) scale_out[r] = step;
    }
#undef QK_LOAD
}
__device__ __forceinline__ void requant_u8(const unsigned char* src, const float* SB, signed char* dst, float* scale_out, int gw, int NGW, int lane) {
    const int bsub = lane >> 2, c16 = (lane & 3) * 16;
    v4u vn[8]; float sn[8];
#define RQ_LOAD(r_) do { _Pragma("unroll") for (int i = 0; i < 8; ++i) { const int b_ = 16 * i + bsub; vn[i] = *(const v4u*)(src + ((size_t)b_ * T + (r_)) * 64 + c16); sn[i] = SB[((size_t)(b_ >> 2) * T + (r_)) * 4 + (b_ & 3)]; } } while (0)
    if (gw < T) RQ_LOAD(gw);
    for (int r = gw; r < T; r += NGW) {
        v4u v[8]; float sc[8];
#pragma unroll
        for (int i = 0; i < 8; ++i) { v[i] = vn[i]; sc[i] = sn[i]; }
        if (r + NGW < T) RQ_LOAD(r + NGW);
        __builtin_amdgcn_sched_barrier(0);
        float mx = 0.f;
#pragma unroll
        for (int i = 0; i < 8; ++i) mx = fmaxf(mx, sc[i]);
        mx = wave_max(mx);
        const float step = mx > 0.f ? mx : 1.0f, inv = 1.0f / step;
#pragma unroll
        for (int i = 0; i < 8; ++i) { const float ratio = sc[i] * inv; unsigned w[4];
#pragma unroll
            for (int d = 0; d < 4; ++d) { const unsigned x = v[i][d]; unsigned p = 0u;
#pragma unroll
                for (int e = 0; e < 4; ++e) { const int qv = (int)__builtin_rintf((float)((x >> (8 * e)) & 255u) * ratio) - 128; p |= ((unsigned)qv & 255u) << (8 * e); }
                w[d] = p; }
            const int b = 16 * i + bsub;
            *(v4u*)(dst + ((size_t)(b >> 1) * T + r) * 128 + 64 * (b & 1) + c16) = (v4u){w[0], w[1], w[2], w[3]}; }
        if (lane == 0) scale_out[r] = step;
    }
#undef RQ_LOAD
}
__device__ __forceinline__ void norm0_phase(const float* src, h16* dst, float* rowsq, int gw, int NGW, int lane) {
    for (int m = gw; m < T; m += NGW) {
        const f32x4* xr = (const f32x4*)(src + (size_t)m * D) + lane;
        f32x4 v[8]; float s = 0.f;
#pragma unroll
        for (int j = 0; j < 8; ++j) { v[j] = xr[64 * j]; s += (v[j].x * v[j].x + v[j].y * v[j].y) + (v[j].z * v[j].z + v[j].w * v[j].w); }
        s = wave_sum(s); if (lane == 0) rowsq[m] = s;
        v2u* o = (v2u*)(dst + (size_t)m * D) + lane;
#pragma unroll
        for (int j = 0; j < 8; ++j) { v2u w; w.x = pkh(v[j].x, v[j].y); w.y = pkh(v[j].z, v[j].w); o[64 * j] = w; }
    }
}

__device__ __forceinline__ unsigned char f8(float x) { return (unsigned char)(__builtin_amdgcn_cvt_pk_fp8_f32(x, x, 0, false) & 0xFF); }
__device__ __forceinline__ float sum16(float v) { v += __shfl_xor(v, 1); v += __shfl_xor(v, 2); v += __shfl_xor(v, 4); v += __shfl_xor(v, 8); return v; }
__device__ __forceinline__ unsigned f8x4(float a, float b, float c, float d) { int p = __builtin_amdgcn_cvt_pk_fp8_f32(a, b, 0, false); p = __builtin_amdgcn_cvt_pk_fp8_f32(c, d, p, true); return (unsigned)p; }
__device__ __forceinline__ void dsa_post_phase(const h16* PROJ, const float* qn, const float* kn, const float* c128, const float* s128, const float* c64, const float* s64,
                                               unsigned char* Q8, unsigned char* K8, unsigned char* V8, h16* IQ, h16* IK, float* IW, int gw, int NGW, int lane) {
    const int hh = lane >> 4, m = lane & 15;
    const f32x4 gqa = *(const f32x4*)(qn + 4 * m), gqb = *(const f32x4*)(qn + 64 + 4 * m), gka = *(const f32x4*)(kn + 4 * m), gkb = *(const f32x4*)(kn + 64 + 4 * m);
    const bool rot = m < 8; const int ioa = rot ? 4 * m : 32 + 4 * m, iob = ioa + 32;
    h16x4 nqa[5], nqb[5], nia[5], nib[5]; h16x8 nvv; h16 nwv = (h16)0.f; f32x4 nc, ns, nci = {1.f, 1.f, 1.f, 1.f}, nsi = {0.f, 0.f, 0.f, 0.f};
#define POST_LOAD(t_) do { const h16* pr_ = PROJ + (size_t)(t_) * A_INP; \
        nc = *(const f32x4*)(c128 + (t_) * 64 + 4 * m); ns = *(const f32x4*)(s128 + (t_) * 64 + 4 * m); \
        if (rot) { nci = *(const f32x4*)(c64 + (t_) * 32 + 4 * m); nsi = *(const f32x4*)(s64 + (t_) * 32 + 4 * m); } \
        _Pragma("unroll") for (int p = 0; p < 5; ++p) { const int cb_ = (p < 4 ? C_Q + (4 * p + hh) * HD : C_K + hh * HD) + 4 * m; nqa[p] = *(const h16x4*)(pr_ + cb_); nqb[p] = *(const h16x4*)(pr_ + cb_ + 64); \
            const int ib_ = p < 4 ? C_IQ + (4 * p + hh) * HD : C_IK; nia[p] = *(const h16x4*)(pr_ + ib_ + ioa); nib[p] = *(const h16x4*)(pr_ + ib_ + iob); } \
        nvv = *(const h16x8*)(pr_ + C_V + lane * 8); if (lane < 16) nwv = pr_[C_IW + lane]; } while (0)
    if (gw < T) POST_LOAD(gw);
    for (int t = gw; t < T; t += NGW) {
        h16x4 qa[5], qb[5], ia[5], ib[5];
#pragma unroll
        for (int p = 0; p < 5; ++p) { qa[p] = nqa[p]; qb[p] = nqb[p]; ia[p] = nia[p]; ib[p] = nib[p]; }
        const h16x8 vv = nvv; const h16 wv = nwv; const f32x4 c = nc, s = ns, ci = nci, si = nsi;
        if (t + NGW < T) POST_LOAD(t + NGW);
        __builtin_amdgcn_sched_barrier(0);
#pragma unroll
        for (int p = 0; p < 5; ++p) {
            const h16x4 a4 = qa[p], b4 = qb[p];
            float a[4], b[4], ss = 0.f;
#pragma unroll
            for (int e = 0; e < 4; ++e) { a[e] = (float)a4[e]; b[e] = (float)b4[e]; ss += a[e] * a[e] + b[e] * b[e]; }
            const float rstd = 1.0f / sqrtf(sum16(ss) * (1.0f / HD) + EPS);
            float oa[4], ob[4];
#pragma unroll
            for (int e = 0; e < 4; ++e) { const float ya = a[e] * rstd * (p < 4 ? gqa[e] : gka[e]), yb = b[e] * rstd * (p < 4 ? gqb[e] : gkb[e]); oa[e] = ya * c[e] - yb * s[e]; ob[e] = yb * c[e] + ya * s[e]; }
            unsigned char* o8 = (p < 4 ? Q8 + (size_t)t * D + (4 * p + hh) * HD : K8 + (size_t)t * 512 + hh * HD) + 4 * m;
            *(unsigned*)o8 = f8x4(oa[0], oa[1], oa[2], oa[3]); *(unsigned*)(o8 + 64) = f8x4(ob[0], ob[1], ob[2], ob[3]);
        }
        *(v2u*)(V8 + (size_t)t * 512 + lane * 8) = (v2u){f8x4((float)vv[0], (float)vv[1], (float)vv[2], (float)vv[3]), f8x4((float)vv[4], (float)vv[5], (float)vv[6], (float)vv[7])};
#pragma unroll
        for (int p = 0; p < 5; ++p) {
            const int hd = p < 4 ? 4 * p + hh : 0;
            const h16x4 a4 = ia[p], b4 = ib[p];
            h16x4 oa, ob;
#pragma unroll
            for (int e = 0; e < 4; ++e) { const float av = (float)a4[e], bv = (float)b4[e]; oa[e] = (h16)(av * ci[e] - bv * si[e]); ob[e] = (h16)(bv * ci[e] + av * si[e]); }
            if (p < 4) { *(h16x4*)(IQ + (size_t)t * D + hd * HD + ioa) = oa; *(h16x4*)(IQ + (size_t)t * D + hd * HD + iob) = ob; }
            else if (hh == 0) { *(h16x4*)(IK + (size_t)t * HD + ioa) = oa; *(h16x4*)(IK + (size_t)t * HD + iob) = ob; }
        }
        if (lane < 16) IW[t * 16 + lane] = (float)wv * 0.02209708691207961f;
    }
#undef POST_LOAD
}

__device__ __forceinline__ float relu_i(float x) { const int b = __float_as_int(x); return __int_as_float(b > 0 ? b : 0); }
constexpr int IDX_ITEMS = 8320, IDX_ROWB = 272, IDX_TILEB = 128 * IDX_ROWB;
__device__ __forceinline__ void idx_decode(int L, int& qb, int& kc) {
    int m = (int)((sqrtf(1.0f + 2.0f * (float)L) - 1.0f) * 0.5f);
    while (2 * (m + 1) * (m + 2) <= L) ++m;
    while (2 * m * (m + 1) > L) --m;
    const int rem = L - 2 * m * (m + 1); qb = 4 * m + rem / (m + 1); kc = rem % (m + 1);
}
constexpr int IDX_HDR = 2, IDX_WKT = 4;
__device__ __forceinline__ int idx_cut(int v) {
    int m = (int)((sqrtf((float)((1 + 2 * IDX_HDR) * (1 + 2 * IDX_HDR)) + 2.0f * (float)v) - (float)(1 + 2 * IDX_HDR)) * 0.5f);
    while (2 * (m + 1) * (m + 2) + 4 * IDX_HDR * (m + 1) <= v) ++m;
    while (2 * m * (m + 1) + 4 * IDX_HDR * m > v) --m;
    const int rem = v - (2 * m * (m + 1) + 4 * IDX_HDR * m), j = rem / (m + 1 + IDX_HDR), slot = rem % (m + 1 + IDX_HDR);
    return 2 * m * (m + 1) + j * (m + 1) + (slot < IDX_HDR ? 0 : slot - IDX_HDR);
}
__device__ __forceinline__ void idx_scores_phase(const h16* IQ, const h16* IK, const float* IW, h16* SC, LAS unsigned char* lds, int wg, int G, int tid, int wave, int lane) {
    const int L0 = idx_cut((int)(((long)(IDX_ITEMS + 256 * IDX_HDR) * wg) / G)), L1 = idx_cut((int)(((long)(IDX_ITEMS + 256 * IDX_HDR) * (wg + 1)) / G));
    if (L0 >= L1) return;
    int qb, kc; idx_decode(L0, qb, kc);
    const int fr = lane & 15, fq = lane >> 4;
    h16x8 st[4];
#define IDX_LOAD(kc_) do { _Pragma("unroll") for (int i = 0; i < 4; ++i) { const int p = tid + 512 * i; st[i] = *(const h16x8*)(IK + (size_t)((kc_) * 128 + (p >> 4)) * HD + (p & 15) * 8); } } while (0)
#define IDX_WRITE(buf_) do { _Pragma("unroll") for (int i = 0; i < 4; ++i) { const int p = tid + 512 * i; *(LAS h16x8*)(lds + (buf_) * IDX_TILEB + (p >> 4) * IDX_ROWB + (p & 15) * 16) = st[i]; } } while (0)
    IDX_LOAD(kc); IDX_WRITE(0);
    __syncthreads();
    int par = 0, L = L0;
#if TPROBE
    unsigned long long tp_acc = 0;
#define TP_T() ({ __builtin_amdgcn_sched_barrier(0); asm volatile("" ::: "memory"); unsigned long long t_ = __builtin_amdgcn_s_memrealtime(); asm volatile("s_waitcnt lgkmcnt(0)" ::: "memory"); __builtin_amdgcn_sched_barrier(0); t_; })
#define TP_BEG(n) unsigned long long tp0_##n = 0; if (TPROBE == n) tp0_##n = TP_T();
#define TP_END(n) if (TPROBE == n) tp_acc += TP_T() - tp0_##n;
#else
#define TP_BEG(n)
#define TP_END(n)
#endif
#pragma unroll 1
    while (L < L1) {
        int kend = kc + (L1 - L) - 1; if (kend > (qb >> 2)) kend = (qb >> 2);
        h16x8 a[4][4]; v4u A2[4][2];
        TP_BEG(3)
        { const int tq = 32 * qb + 4 * wave; f32x4 w4[4];
#pragma unroll
            for (int q = 0; q < 4; ++q) {
#pragma unroll
                for (int ks = 0; ks < 4; ++ks) a[q][ks] = *(const h16x8*)(IQ + (size_t)(tq + q) * D + fr * HD + ks * 32 + fq * 8);
                w4[q] = *(const f32x4*)(IW + (size_t)(tq + q) * 16 + 4 * fq); }
            __builtin_amdgcn_s_waitcnt(0x0F70);
            unsigned wp[4][2];
#pragma unroll
            for (int q = 0; q < 4; ++q) { wp[q][0] = pg8::pk_h2(w4[q][0], w4[q][1]); wp[q][1] = pg8::pk_h2(w4[q][2], w4[q][3]); }
#pragma unroll
            for (int r = 0; r < 4; ++r)
#pragma unroll
                for (int p = 0; p < 2; ++p) { const int i0 = 4 * r + 2 * p; const bool e0 = (fr == i0), e1 = (fr == i0 + 1);
                    A2[r][p] = (v4u){e0 ? wp[2 * p][0] : 0u, e0 ? wp[2 * p][1] : 0u, e1 ? wp[2 * p + 1][0] : 0u, e1 ? wp[2 * p + 1][1] : 0u}; } }
        __builtin_amdgcn_sched_barrier(0);
        TP_END(3)
#pragma unroll 1
        for (; kc <= kend; ++kc, ++L) {
            TP_BEG(2)
            const bool more = (L + 1 < L1);
            { const int kcp = more ? (kc < (qb >> 2) ? kc + 1 : 0) : kc; IDX_LOAD(kcp); }
            const LAS unsigned char* bb = lds + par * IDX_TILEB + fr * IDX_ROWB + fq * 16;
            h16x8 bq[2][4];
#pragma unroll
            for (int ks = 0; ks < 4; ++ks) bq[0][ks] = *(const LAS h16x8*)(bb + ks * 64);
            f32x4 d2 = {0.f, 0.f, 0.f, 0.f};
            f32x4 ps0 = {0.f, 0.f, 0.f, 0.f}, ps1 = {0.f, 0.f, 0.f, 0.f};
#define IDX_STAGE2(q_) do { const int kt_ = (q_) >> 1, p_ = (q_) & 1; const h16x2 z2 = {(h16)0.f, (h16)0.f}; \
                h16x2 r0 = {(h16)ps0[0], (h16)ps0[1]}, r1 = {(h16)ps0[2], (h16)ps0[3]}, r2 = {(h16)ps1[0], (h16)ps1[1]}, r3 = {(h16)ps1[2], (h16)ps1[3]}; \
                r0 = __builtin_elementwise_max(r0, z2); r1 = __builtin_elementwise_max(r1, z2); r2 = __builtin_elementwise_max(r2, z2); r3 = __builtin_elementwise_max(r3, z2); \
                const h16x8 b2 = {r0[0], r0[1], r1[0], r1[1], r2[0], r2[1], r3[0], r3[1]};     \
                d2 = __builtin_amdgcn_mfma_f32_16x16x32_f16(__builtin_bit_cast(h16x8, A2[kt_ & 3][p_]), b2, d2, 0, 0, 0); \
                if ((q_) == 7 || (q_) == 15) { const int tq = 32 * qb + 4 * wave;        \
                    _Pragma("unroll") for (int qq = 0; qq < 4; ++qq) SC[(size_t)(tq + qq) * SC_LD + kc * 128 + 64 * (kt_ >> 2) + lane] = (h16)d2[qq];     \
                    d2 = (f32x4){0.f, 0.f, 0.f, 0.f}; } } while (0)
#pragma unroll
            for (int kt = 0; kt < 8; ++kt) {
                if (kt + 1 < 8) {
#pragma unroll
                    for (int ks = 0; ks < 4; ++ks) bq[(kt + 1) & 1][ks] = *(const LAS h16x8*)(bb + (kt + 1) * 16 * IDX_ROWB + ks * 64);
                    __builtin_amdgcn_sched_barrier(0); }
                const h16x8 (&b)[4] = bq[kt & 1];
#pragma unroll
                for (int p = 0; p < 2; ++p) { f32x4 s0 = {0.f, 0.f, 0.f, 0.f}, s1 = {0.f, 0.f, 0.f, 0.f};
#pragma unroll
                    for (int ks = 0; ks < 4; ++ks) { s0 = __builtin_amdgcn_mfma_f32_16x16x32_f16(a[2 * p][ks], b[ks], s0, 0, 0, 0); s1 = __builtin_amdgcn_mfma_f32_16x16x32_f16(a[2 * p + 1][ks], b[ks], s1, 0, 0, 0); }
                    if (2 * kt + p > 0) IDX_STAGE2(2 * kt + p - 1);
                    __builtin_amdgcn_sched_barrier(0);
                    ps0 = s0; ps1 = s1; }
                if (kt == IDX_WKT) { IDX_WRITE(par ^ 1); }
            }
            IDX_STAGE2(15);
#undef IDX_STAGE2
            TP_BEG(1) TP_BEG(5)
            asm volatile("s_waitcnt lgkmcnt(0)" ::: "memory"); __builtin_amdgcn_s_barrier(); asm volatile("" ::: "memory");
            TP_END(5) TP_END(1) TP_END(2)
            par ^= 1;
        }
        ++qb; kc = 0;
    }
#if TPROBE
    { const unsigned long long t0 = __builtin_amdgcn_s_memrealtime(); while (__builtin_amdgcn_s_memrealtime() - t0 < (unsigned long long)TP_MULT * tp_acc) __builtin_amdgcn_s_sleep(2); }
#endif
#undef IDX_LOAD
#undef IDX_WRITE
}

template <int NR>
__device__ __forceinline__ unsigned kth_largest(const unsigned (&u)[NR], int K) {
    unsigned prefix = 0u;
#pragma unroll 1
    for (int bit = 15; bit >= 0; --bit) { const unsigned cand = prefix | (1u << bit); int cnt = 0;
#pragma unroll
        for (int i = 0; i < NR; ++i) { cnt += __builtin_popcountll(__ballot(u[i] >= cand)); if ((i & 31) == 31) __builtin_amdgcn_sched_barrier(0); }
        if (cnt >= K) prefix = cand; }
    return prefix;
}
template <int NR, bool ARR>
__device__ __forceinline__ void emit_topk(const unsigned (&u)[NR], unsigned thr_in, int* sel, const int (&keys)[ARR ? NR : 1], int lane) {
    unsigned thr = thr_in; int cgt = 0;
#pragma unroll
    for (int i = 0; i < NR; ++i) { cgt += __builtin_popcountll(__ballot(u[i] > thr)); if ((i & 7) == 7) __builtin_amdgcn_sched_barrier(0); }
    const int need = TOPK - cgt;
    asm volatile("" : "+s"(thr));
    int base = 0, eqseen = 0;
#pragma unroll
    for (int i = 0; i < NR; ++i) {
        const bool gt = u[i] > thr, eq = u[i] == thr;
        const unsigned long long eb = __ballot(eq);
        const int erank = eqseen + (int)__builtin_amdgcn_mbcnt_hi((unsigned)(eb >> 32), __builtin_amdgcn_mbcnt_lo((unsigned)eb, 0u));
        const bool take = gt || (eq && erank < need);
        const unsigned long long tb = __ballot(take);
        const int pos = base + (int)__builtin_amdgcn_mbcnt_hi((unsigned)(tb >> 32), __builtin_amdgcn_mbcnt_lo((unsigned)tb, 0u));
        if (take) sel[pos] = ARR ? keys[ARR ? i : 0] : 64 * i + lane;
        base += __builtin_popcountll(tb); eqseen += __builtin_popcountll(eb);
        __builtin_amdgcn_sched_barrier(0);
    }
}
constexpr int TK_CAP = 768, TK_TARGET = 448;
template <int NREG>
__device__ __forceinline__ void topk_load_row(unsigned (&u)[NREG], const h16* sc_in, int t_in, int lane) {
    static_assert(NREG % 16 == 0, "chunks of 16 registers");
#pragma unroll
    for (int c = 0; c < NREG / 16; ++c) {
        const GAS unsigned short* pc = (const GAS unsigned short*)(sc_in + 1024 * c); asm volatile("" : "+s"(pc));
#pragma unroll
        for (int k = 0; k < 16; ++k) u[16 * c + k] = (unsigned)pc[64 * k + lane];
    }
#pragma unroll
    for (int c = 0; c < NREG / 16; ++c) {
        int tl = t_in - 1024 * c; asm volatile("" : "+s"(tl));
#pragma unroll
        for (int k = 0; k < 16; ++k) { const unsigned b = u[16 * c + k]; const unsigned mk = (b >> 15) ? 0xFFFFu : 0x8000u; u[16 * c + k] = (lane <= tl - 64 * k) ? (b ^ mk) : 0u; }
        __builtin_amdgcn_sched_barrier(0);
    }
}
template <int NREG>
__device__ __forceinline__ void topk_row(const h16* sc_in, int t_in, int* sel, int lane_in, LAS unsigned long long* cand) {
    int lane = lane_in; asm volatile("" : "+v"(lane));
    if constexpr (NREG >= 64) {
        int cn = 0;
        {   unsigned u[NREG];
            topk_load_row<NREG>(u, sc_in, t_in, lane);
            constexpr int NS = NREG / 8;
            unsigned us[NS]; int nsv = 0;
#pragma unroll
            for (int s = 0; s < NS; ++s) { us[s] = u[8 * s]; const int rem = t_in + 1 - 512 * s; nsv += rem < 0 ? 0 : (rem > 64 ? 64 : rem); }
            int Ks = (TK_TARGET * nsv) / (t_in + 1); Ks = Ks < 1 ? 1 : Ks;
            unsigned tau = kth_largest<NS>(us, Ks);
            asm volatile("" : "+s"(tau));
#pragma unroll
            for (int c = 0; c < NREG / 16; ++c) {
                int kb = 1024 * c + lane; asm volatile("" : "+v"(kb));
#pragma unroll
                for (int k = 0; k < 16; ++k) { const int i = 16 * c + k; const bool m = u[i] >= tau && tau != 0u; const unsigned long long mb = __ballot(m);
                    const int pos = cn + (int)__builtin_amdgcn_mbcnt_hi((unsigned)(mb >> 32), __builtin_amdgcn_mbcnt_lo((unsigned)mb, 0u));
                    if (m && pos < TK_CAP) cand[pos] = ((unsigned long long)u[i] << 32) | (unsigned)(kb + 64 * k);
                    cn += __builtin_popcountll(mb); if ((k & 3) == 3) __builtin_amdgcn_sched_barrier(0); }
            }
        }
        asm volatile("" : "+s"(cn));
        if (cn >= TOPK && cn <= TK_CAP) {
            LDS_WAIT();
            unsigned cu[TK_CAP / 64]; int ck[TK_CAP / 64];
#pragma unroll
            for (int k = 0; k < TK_CAP / 64; ++k) { const int ix = 64 * k + lane; const unsigned long long v = cand[ix]; cu[k] = ix < cn ? (unsigned)(v >> 32) : 0u; ck[k] = (int)(unsigned)v; }
            const unsigned thr = kth_largest<TK_CAP / 64>(cu, TOPK);
            emit_topk<TK_CAP / 64, true>(cu, thr, sel, ck, lane);
            LDS_WAIT();
            return;
        }
    }
    {   unsigned u[NREG];
        topk_load_row<NREG>(u, sc_in, t_in, lane);
        const unsigned thr = kth_largest<NREG>(u, TOPK);
        const int nokeys[1] = {0}; emit_topk<NREG, false>(u, thr, sel, nokeys, lane); }
}
__device__ __forceinline__ void topk_phase(const h16* SC, int* SEL, LAS unsigned char* lds, int gw, int NGW, int wave, int lane) {
    LAS unsigned long long* cand = (LAS unsigned long long*)(lds + wave * (TK_CAP * 8));
    for (int t = gw; t < T; t += NGW) {
        const h16* sc = SC + (size_t)t * SC_LD; int* sel = SEL + (size_t)t * TOPK;
        if (t < TOPK) {
#pragma unroll
            for (int j = 0; j < 4; ++j) { const int k = lane + 64 * j; sel[k] = (k <= t) ? k : -1; }
        } else if (t < 2048) topk_row<32>(sc, t, sel, lane, cand);
        else if (t < 4096) topk_row<64>(sc, t, sel, lane, cand);
        else if (t < 6144) topk_row<96>(sc, t, sel, lane, cand);
        else topk_row<128>(sc, t, sel, lane, cand);
    }
}

__device__ __forceinline__ float dot8(h16x8 a, h16x8 b, float c) {
#if __has_builtin(__builtin_amdgcn_fdot2)
    c = __builtin_amdgcn_fdot2((h16x2){a[0], a[1]}, (h16x2){b[0], b[1]}, c, false); c = __builtin_amdgcn_fdot2((h16x2){a[2], a[3]}, (h16x2){b[2], b[3]}, c, false);
    c = __builtin_amdgcn_fdot2((h16x2){a[4], a[5]}, (h16x2){b[4], b[5]}, c, false); c = __builtin_amdgcn_fdot2((h16x2){a[6], a[7]}, (h16x2){b[6], b[7]}, c, false);
#else
#pragma unroll
    for (int e = 0; e < 8; ++e) c += (float)a[e] * (float)b[e];
#endif
    return c;
}
__device__ __forceinline__ void attn_phase(const h16* QH, const h16* KH, const h16* VH, const int* SEL, h16* O, LAS unsigned char* lds, int wg, int G, int wave, int lane) {
    LAS h16* qs = (LAS h16*)(lds + wave * 6144);
    LAS float* ps = (LAS float*)(lds + wave * 6144 + 1024);
    LAS int* is = (LAS int*)(lds + wave * 6144 + 5120);
    const int grp = lane >> 4, c = lane & 15;
    for (int L = wg; L < (T / 8) * NKV; L += G) {
        const int g = L & 3, t = 8 * (L >> 2) + wave;
        int idx[4];
#pragma unroll
        for (int j = 0; j < 4; ++j) idx[j] = SEL[(size_t)t * TOPK + lane + 64 * j];
        *(LAS h16x8*)(qs + lane * 8) = *(const h16x8*)(QH + (size_t)t * D + g * 512 + lane * 8);
#pragma unroll
        for (int j = 0; j < 4; ++j) is[lane + 64 * j] = idx[j] < 0 ? 0 : idx[j];
        LDS_WAIT();
        float sc[4][4];
#pragma unroll
        for (int j = 0; j < 4; ++j) { const h16* krow = KH + (size_t)(idx[j] < 0 ? 0 : idx[j]) * 512 + g * HD; h16x8 kf[16];
#pragma unroll
            for (int cc = 0; cc < 16; ++cc) kf[cc] = *(const h16x8*)(krow + 8 * cc);
#pragma unroll
            for (int hh = 0; hh < 4; ++hh) { float s = 0.f;
#pragma unroll
                for (int cc = 0; cc < 16; ++cc) s = dot8(kf[cc], *(const LAS h16x8*)(qs + hh * HD + 8 * cc), s);
                sc[j][hh] = (idx[j] < 0) ? -__builtin_inff() : s * 0.08838834764831845f; }
            __builtin_amdgcn_sched_barrier(0); }
#pragma unroll
        for (int hh = 0; hh < 4; ++hh) {
            const float mx = wave_max(fmaxf(fmaxf(sc[0][hh], sc[1][hh]), fmaxf(sc[2][hh], sc[3][hh])));
            float e0 = __expf(sc[0][hh] - mx), e1 = __expf(sc[1][hh] - mx), e2 = __expf(sc[2][hh] - mx), e3 = __expf(sc[3][hh] - mx);
            const float inv = 1.0f / wave_sum((e0 + e1) + (e2 + e3));
            sc[0][hh] = e0 * inv; sc[1][hh] = e1 * inv; sc[2][hh] = e2 * inv; sc[3][hh] = e3 * inv; }
#pragma unroll
        for (int j = 0; j < 4; ++j) *(LAS f32x4*)(ps + 4 * (lane + 64 * j)) = (f32x4){sc[j][0], sc[j][1], sc[j][2], sc[j][3]};
        LDS_WAIT();
        float acc[4][8];
#pragma unroll
        for (int hh = 0; hh < 4; ++hh)
#pragma unroll
            for (int e = 0; e < 8; ++e) acc[hh][e] = 0.f;
#pragma unroll 4
        for (int it = 0; it < 64; ++it) { const int kk = 4 * it + grp; const int ik = is[kk]; const f32x4 p4 = *(const LAS f32x4*)(ps + 4 * kk);
            const h16x8 v8 = *(const h16x8*)(VH + (size_t)ik * 512 + g * HD + 8 * c);
#pragma unroll
            for (int hh = 0; hh < 4; ++hh)
#pragma unroll
                for (int e = 0; e < 8; ++e) acc[hh][e] += p4[hh] * (float)v8[e];
            if ((it & 3) == 3) __builtin_amdgcn_sched_barrier(0); }
#pragma unroll
        for (int hh = 0; hh < 4; ++hh)
#pragma unroll
            for (int e = 0; e < 8; ++e) { float v = acc[hh][e]; v += __shfl_xor(v, 16); v += __shfl_xor(v, 32); acc[hh][e] = v; }
        float o8[8];
#pragma unroll
        for (int e = 0; e < 8; ++e) o8[e] = grp == 0 ? acc[0][e] : grp == 1 ? acc[1][e] : grp == 2 ? acc[2][e] : acc[3][e];
        v4u w; w.x = pkh(o8[0], o8[1]); w.y = pkh(o8[2], o8[3]); w.z = pkh(o8[4], o8[5]); w.w = pkh(o8[6], o8[7]);
        *(v4u*)(O + (size_t)t * D + (4 * g + grp) * HD + 8 * c) = w;
        LDS_WAIT();
    }
}

__device__ __forceinline__ void conv_phase(const h16* PROJ, const float* cw, const float* cb, h16* XC, int vcu, int G, int tid) {
    const int c8 = (tid & 255) * 8, half = tid >> 8;
    f32x4 w0[4], w1[4];
#pragma unroll
    for (int j = 0; j < 4; ++j) { w0[j] = *(const f32x4*)(cw + j * 2048 + c8); w1[j] = *(const f32x4*)(cw + j * 2048 + c8 + 4); }
    const f32x4 b0 = *(const f32x4*)(cb + c8), b1 = *(const f32x4*)(cb + c8 + 4);
#pragma unroll 1
    for (int u = vcu; u < T / 32; u += G) { const int t0 = 32 * u + 16 * half;
        h16x8 x[19];
#pragma unroll
        for (int r = 0; r < 19; ++r) { const int tt = t0 - 3 + r; x[r] = *(const h16x8*)(PROJ + (size_t)(tt < 0 ? 0 : tt) * 4096 + 2048 + c8); }
        __builtin_amdgcn_sched_barrier(0);
#pragma unroll
        for (int r = 0; r < 16; ++r) { const int t = t0 + r;
            float acc[8];
#pragma unroll
            for (int e = 0; e < 4; ++e) { acc[e] = b0[e]; acc[4 + e] = b1[e]; }
#pragma unroll
            for (int j = 0; j < 4; ++j) { if (t - 3 + j >= 0) {
#pragma unroll
                for (int e = 0; e < 4; ++e) { acc[e] += (float)x[r + j][e] * w0[j][e]; acc[4 + e] += (float)x[r + j][4 + e] * w1[j][e]; } } }
            v4u w; w.x = pkh(acc[0], acc[1]); w.y = pkh(acc[2], acc[3]); w.z = pkh(acc[4], acc[5]); w.w = pkh(acc[6], acc[7]);
            *(v4u*)(XC + (size_t)t * 2048 + c8) = w; } }
}
constexpr int SCAN_LC = 32, SCAN_NCH = T / SCAN_LC;
__device__ __forceinline__ f32x4 ld_a4(const h16* LA, size_t o) { const h16x4 v = *(const h16x4*)(LA + o); return (f32x4){__expf((float)v[0]), __expf((float)v[1]), __expf((float)v[2]), __expf((float)v[3])}; }
__device__ __forceinline__ f32x4 ld_b4(const h16* BF, size_t o) { const h16x4 v = *(const h16x4*)(BF + o); return (f32x4){(float)v[0], (float)v[1], (float)v[2], (float)v[3]}; }
__device__ __forceinline__ void scan_agg_phase(const h16* AF, const h16* BF, float* AGGA, float* AGGB, int gtid, int NGT) {
    for (int i = gtid; i < SCAN_NCH * 512; i += NGT) { const int cg = (i & 511) * 4, k = i >> 9;
        f32x4 Pr = {1.f, 1.f, 1.f, 1.f}, H = {0.f, 0.f, 0.f, 0.f};
#pragma unroll 16
        for (int r = 0; r < SCAN_LC; ++r) { const size_t o = (size_t)(k * SCAN_LC + r) * 2048 + cg; const f32x4 a = ld_a4(AF, o), b = ld_b4(BF, o); H = a * H + b; Pr = Pr * a; }
        *(f32x4*)(AGGA + (size_t)k * 2048 + cg) = Pr; *(f32x4*)(AGGB + (size_t)k * 2048 + cg) = H; }
}
__device__ __forceinline__ void scan_carry_phase(const float* AGGA, const float* AGGB, float* CARRY, int vcu, int wave, int lane) {
    if (wave != 0 || vcu >= 16) return;
    const int c = (vcu * 64 + lane) * 2; f32x2 H = {0.f, 0.f};
#pragma unroll 1
    for (int k0 = 0; k0 < SCAN_NCH; k0 += 32) { f32x2 a[32], b[32];
#pragma unroll
        for (int j = 0; j < 32; ++j) { a[j] = *(const f32x2*)(AGGA + (size_t)(k0 + j) * 2048 + c); b[j] = *(const f32x2*)(AGGB + (size_t)(k0 + j) * 2048 + c); }
        __builtin_amdgcn_sched_barrier(0);
#pragma unroll
        for (int j = 0; j < 32; ++j) { *(f32x2*)(CARRY + (size_t)(k0 + j) * 2048 + c) = H; H = a[j] * H + b[j]; } }
}
__device__ __forceinline__ float gelu_tanh(float x) { const float w = x * fmaf(x * x, -2.3022082f * 0.044715f, -2.3022082f); return x * __builtin_amdgcn_rcpf(1.0f + __builtin_amdgcn_exp2f(w)); }
__device__ __forceinline__ void scan_final_phase(const h16* AF, const h16* BF, const float* CARRY, const h16* PROJ, h16* Y, int gtid, int NGT) {
    for (int i = gtid; i < SCAN_NCH * 512; i += NGT) { const int cg = (i & 511) * 4, k = i >> 9;
        f32x4 H = *(const f32x4*)(CARRY + (size_t)k * 2048 + cg);
#pragma unroll 1
        for (int r0 = 0; r0 < SCAN_LC; r0 += 16) {
            h16x4 av[16], bv[16], gv[16];
#pragma unroll
            for (int j = 0; j < 16; ++j) { const int t = k * SCAN_LC + r0 + j; const size_t o = (size_t)t * 2048 + cg;
                av[j] = *(const h16x4*)(AF + o); bv[j] = *(const h16x4*)(BF + o); gv[j] = *(const h16x4*)(PROJ + (size_t)t * 4096 + cg); }
            __builtin_amdgcn_sched_barrier(0);
#pragma unroll
            for (int j = 0; j < 16; ++j) { const int t = k * SCAN_LC + r0 + j; const size_t o = (size_t)t * 2048 + cg;
                const f32x4 a = {__expf((float)av[j][0]), __expf((float)av[j][1]), __expf((float)av[j][2]), __expf((float)av[j][3])};
                const f32x4 b = {(float)bv[j][0], (float)bv[j][1], (float)bv[j][2], (float)bv[j][3]};
                H = a * H + b;
                v2u w; w.x = pkh(H[0] * gelu_tanh((float)gv[j][0]), H[1] * gelu_tanh((float)gv[j][1])); w.y = pkh(H[2] * gelu_tanh((float)gv[j][2]), H[3] * gelu_tanh((float)gv[j][3]));
                *(v2u*)(Y + o) = w; } } }
}
__device__ __forceinline__ f32x4 ldx4(const h16* p) { const h16x4 v = *(const h16x4*)p; return (f32x4){(float)v[0], (float)v[1], (float)v[2], (float)v[3]}; }
template <int W>
__device__ __forceinline__ void pool_window(const h16x4 (&x)[47], const LAS float* rs, f32x4 gn, h16* Y, int t0, int c4) {
    f32x4 sum = {0.f, 0.f, 0.f, 0.f};
#pragma unroll
    for (int j = 1; j < W; ++j) if (t0 - j >= 0) { const h16x4 v = x[15 - j]; sum += (f32x4){(float)v[0], (float)v[1], (float)v[2], (float)v[3]} * rs[15 - j]; }
#pragma unroll
    for (int r = 0; r < 32; ++r) { const int t = t0 + r; const int n = (t + 1) < W ? (t + 1) : W;
        const h16x4 v = x[15 + r]; const f32x4 h0 = (f32x4){(float)v[0], (float)v[1], (float)v[2], (float)v[3]} * rs[15 + r];
        sum += h0;
        const float invn = 1.0f / (float)n;
        const f32x4 y = (sum * invn - h0) * gn;
        v2u o; o.x = pkh(y.x, y.y); o.y = pkh(y.z, y.w); *(v2u*)(Y + (size_t)t * D + c4) = o;
        if (t + 1 >= W) { const h16x4 q = x[15 + r + 1 - W]; sum -= (f32x4){(float)q[0], (float)q[1], (float)q[2], (float)q[3]} * rs[15 + r + 1 - W]; }
        if ((r & 3) == 3) __builtin_amdgcn_sched_barrier(0); }
}
__device__ __forceinline__ void pool_phase(const h16* X, const float* rowsq32, const float* gain, h16* Y, LAS unsigned char* lds, int wg, int G, int tid, int wave, int lane) {
    LAS float* rs = (LAS float*)lds;
    const int c4 = tid * 4; const int wsel = tid >> 7;
    const f32x4 gn = *(const f32x4*)(gain + c4);
#pragma unroll 1
    for (int u = wg; u < T / 32; u += G) { const int t0 = 32 * u;
        h16x4 x[47];
#pragma unroll
        for (int r = 0; r < 47; ++r) { const int t = t0 - 15 + r; x[r] = *(const h16x4*)(X + (size_t)(t < 0 ? 0 : t) * D + c4); }
        f32x4 pq[8];
        if (tid < 47) { const int t = t0 - 15 + tid; const f32x4* pp = (const f32x4*)(rowsq32 + (size_t)(t < 0 ? 0 : t) * 32);
#pragma unroll
            for (int q = 0; q < 8; ++q) pq[q] = pp[q]; }
        __builtin_amdgcn_sched_barrier(0);
        __syncthreads();
        if (tid < 47) { f32x4 a4 = pq[0];
#pragma unroll
            for (int q = 1; q < 8; ++q) a4 += pq[q];
            rs[tid] = 1.0f / sqrtf(((a4[0] + a4[1]) + (a4[2] + a4[3])) * (1.0f / D) + EPS); }
        __syncthreads();
        if (wsel == 0) pool_window<2>(x, rs, gn, Y, t0, c4); else if (wsel == 1) pool_window<4>(x, rs, gn, Y, t0, c4); else if (wsel == 2) pool_window<8>(x, rs, gn, Y, t0, c4); else pool_window<16>(x, rs, gn, Y, t0, c4);
    }
}

__device__ __forceinline__ h16x8 f8x8_to_h(unsigned d0, unsigned d1) {
    const h16x2 a = __builtin_amdgcn_cvt_scalef32_pk_f16_fp8((int)d0, 1.0f, false), b = __builtin_amdgcn_cvt_scalef32_pk_f16_fp8((int)d0, 1.0f, true);
    const h16x2 c = __builtin_amdgcn_cvt_scalef32_pk_f16_fp8((int)d1, 1.0f, false), d = __builtin_amdgcn_cvt_scalef32_pk_f16_fp8((int)d1, 1.0f, true);
    return (h16x8){a[0], a[1], b[0], b[1], c[0], c[1], d[0], d[1]};
}
__device__ __forceinline__ unsigned attn_off_b(unsigned row, unsigned ch) { return 256u * row + 16u * (ch ^ (((row & 3u) << 2) | ((row >> 2) & 3u))); }
__device__ __forceinline__ void attn_mfma_phase(const unsigned char* Q8, const unsigned char* K8, const unsigned char* V8, const int* SEL, h16* O, LAS unsigned char* lds, int wg, int G, int wave, int lane_in) {
    typedef int i32x4 __attribute__((ext_vector_type(4)));
    typedef int i32x2 __attribute__((ext_vector_type(2)));
    typedef long i64x2 __attribute__((ext_vector_type(2)));
    i32x4 svn = {0, 0, 0, 0}; i64x2 qfn[2] = {{0, 0}, {0, 0}};
#define AT_PREF(L_) do { const int g_ = (L_) & 3, t_ = 8 * ((L_) >> 2) + wave; svn = *(const i32x4*)(SEL + (size_t)t_ * TOPK + 4 * lane_in); \
        _Pragma("unroll") for (int pp = 0; pp < 2; ++pp) qfn[pp] = *(const i64x2*)(Q8 + (size_t)t_ * D + (4 * g_ + (lane_in & 3)) * HD + 64 * pp + 16 * (lane_in >> 4)); } while (0)
    v4u kga[4], kgb[4];
#define AT_LOADK2(buf, G_, selk_, kbase_) do { const i32x2 i0 = *(const LAS i32x2*)((selk_) + 2 * (G_)), i1 = *(const LAS i32x2*)((selk_) + 128 + 2 * (G_)); \
            buf[0] = *(const v4u*)((kbase_) + (size_t)(i0.x < 0 ? 0 : i0.x) * 512); buf[1] = *(const v4u*)((kbase_) + (size_t)(i1.x < 0 ? 0 : i1.x) * 512); \
            buf[2] = *(const v4u*)((kbase_) + (size_t)(i0.y < 0 ? 0 : i0.y) * 512); buf[3] = *(const v4u*)((kbase_) + (size_t)(i1.y < 0 ? 0 : i1.y) * 512); } while (0)
#define AT_PREP(L_, par_) do { LAS int* sst_ = (LAS int*)(lds + LDSCTL_OFF + 1024 + wave * 2048 + (par_) * 1024); *(LAS i32x4*)(sst_ + 4 * lane_in) = svn; \
        asm volatile("s_waitcnt lgkmcnt(0)" ::: "memory"); \
        const LAS int* selk_ = sst_ + 16 * (lane_in >> 3); const unsigned char* kbase_ = K8 + ((L_) & 3) * HD + 16 * (lane_in & 7); \
        AT_LOADK2(kga, 0, selk_, kbase_); AT_LOADK2(kgb, 1, selk_, kbase_); } while (0)
#define AT_PREP_A(L_, par_) do { LAS int* sst_ = (LAS int*)(lds + LDSCTL_OFF + 1024 + wave * 2048 + (par_) * 1024); *(LAS i32x4*)(sst_ + 4 * lane_in) = svn; \
        asm volatile("s_waitcnt lgkmcnt(0)" ::: "memory"); \
        const LAS int* selk_ = sst_ + 16 * (lane_in >> 3); const unsigned char* kbase_ = K8 + ((L_) & 3) * HD + 16 * (lane_in & 7); \
        AT_LOADK2(kga, 0, selk_, kbase_); } while (0)
#define AT_PREP_B(L_, par_) do { const LAS int* sst_ = (const LAS int*)(lds + LDSCTL_OFF + 1024 + wave * 2048 + (par_) * 1024); \
        const LAS int* selk_ = sst_ + 16 * (lane_in >> 3); const unsigned char* kbase_ = K8 + ((L_) & 3) * HD + 16 * (lane_in & 7); \
        AT_LOADK2(kgb, 1, selk_, kbase_); } while (0)
    if (wg < (T / 8) * NKV) { AT_PREF(wg); AT_PREP(wg, 0); }
    int itpar = 0;
    for (int L = wg; L < (T / 8) * NKV; L += G, itpar ^= 1) {
        int lane = lane_in; asm volatile("" : "+v"(lane));
        const int jl = lane & 15, gi = lane >> 4;
        const int g = L & 3, t = 8 * (L >> 2) + wave;
        const int* sel = SEL + (size_t)t * TOPK; (void)sel;
        const int nvalid = (t + 1) < TOPK ? (t + 1) : TOPK;
        LAS int* sst = (LAS int*)(lds + LDSCTL_OFF + 1024 + wave * 2048 + itpar * 1024);
        i64x2 qf[2];
#pragma unroll
        for (int pp = 0; pp < 2; ++pp) qf[pp] = qfn[pp];
        LAS unsigned char* vimg = lds + wave * 16384;
        const LAS int* selk = sst + 16 * (lane >> 3);
        const unsigned char* kbase = K8 + g * HD + 16 * (lane & 7);
        const unsigned kwr = 136u * (unsigned)(lane >> 3) + 16u * (unsigned)(lane & 7), krd = 136u * (unsigned)jl + 16u * (unsigned)gi;
        f32x4 s[16];
#define AT_LOADK(buf, G_) AT_LOADK2(buf, G_, selk, kbase)
#define AT_KSTEP(buf, G_) do { LAS unsigned char* kb_ = vimg + ((G_) & 1) * 8192; \
            _Pragma("unroll") for (int j = 0; j < 4; ++j) { *(LAS v2u*)(kb_ + kwr + 1088 * j) = (v2u){buf[j].x, buf[j].y}; *(LAS v2u*)(kb_ + kwr + 1088 * j + 8) = (v2u){buf[j].z, buf[j].w}; } \
            if ((G_) + 2 < 8) AT_LOADK(buf, (G_) + 2); \
            _Pragma("unroll") for (int tt = 0; tt < 2; ++tt) { f32x4 acc = {0.f, 0.f, 0.f, 0.f}; \
                _Pragma("unroll") for (int pp = 0; pp < 2; ++pp) { const long a0 = *(const LAS long*)(kb_ + krd + 2176 * tt + 64 * pp), a1 = *(const LAS long*)(kb_ + krd + 2176 * tt + 64 * pp + 8); \
                    acc = __builtin_amdgcn_mfma_f32_16x16x32_fp8_fp8(a0, qf[pp].x, acc, 0, 0, 0); acc = __builtin_amdgcn_mfma_f32_16x16x32_fp8_fp8(a1, qf[pp].y, acc, 0, 0, 0); } \
                s[2 * (G_) + tt] = acc; } } while (0)
        if (L + G < (T / 8) * NKV) AT_PREF(L + G);
        AT_KSTEP(kga, 0); AT_KSTEP(kgb, 1); AT_KSTEP(kga, 2); AT_KSTEP(kgb, 3); AT_KSTEP(kga, 4); AT_KSTEP(kgb, 5); AT_KSTEP(kga, 6); AT_KSTEP(kgb, 7);
#undef AT_LOADK
#undef AT_KSTEP
        if (L + G < (T / 8) * NKV) AT_PREP_A(L + G, itpar ^ 1);
        const LAS int* selv = sst + ((lane >> 5) & 1) + 16 * ((lane >> 3) & 3);
        const unsigned char* vbase = V8 + g * HD + 16 * (lane & 7);
        v4u vsa[4], vsb[4];
#define AT_LOADV(vst, Tt) do { _Pragma("unroll") for (int i = 0; i < 4; ++i) { const int ix = selv[2 * (Tt) + 64 * i]; vst[i] = *(const v4u*)(vbase + (size_t)(ix < 0 ? 0 : ix) * 512); } } while (0)
        AT_LOADV(vsa, 0); AT_LOADV(vsb, 1);
        __builtin_amdgcn_sched_barrier(0);
        if (nvalid < TOPK) {
#pragma unroll
            for (int kt = 0; kt < 16; ++kt)
#pragma unroll
                for (int r = 0; r < 4; ++r) if (kt + 64 * gi + 16 * r >= nvalid) s[kt][r] = -__builtin_inff();
        }
        float mx = -__builtin_inff();
#pragma unroll
        for (int kt = 0; kt < 16; ++kt) mx = fmaxf(mx, fmaxf(fmaxf(s[kt][0], s[kt][1]), fmaxf(s[kt][2], s[kt][3])));
        mx = fmaxf(mx, __shfl_xor(mx, 16)); mx = fmaxf(mx, __shfl_xor(mx, 32));
        constexpr float C2 = 0.08838834764831845f * 1.4426950408889634f;
        const float mb = -mx * C2; float sum = 0.f;
        h16x8 pf[8];
#pragma unroll
        for (int Tt = 0; Tt < 8; ++Tt) { float p[8];
#pragma unroll
            for (int r = 0; r < 4; ++r) { p[r] = __builtin_amdgcn_exp2f(fmaf(s[2 * Tt][r], C2, mb)); p[4 + r] = __builtin_amdgcn_exp2f(fmaf(s[2 * Tt + 1][r], C2, mb)); }
            sum += ((p[0] + p[1]) + (p[2] + p[3])) + ((p[4] + p[5]) + (p[6] + p[7]));
            pf[Tt] = (h16x8){(h16)p[0], (h16)p[1], (h16)p[2], (h16)p[3], (h16)p[4], (h16)p[5], (h16)p[6], (h16)p[7]}; }
        sum += __shfl_xor(sum, 16); sum += __shfl_xor(sum, 32);
        const float linv = 1.0f / sum;
        const unsigned q4 = (unsigned)jl >> 2, p4 = (unsigned)jl & 3u;
        unsigned wr_off[8], rd_off[2];
#pragma unroll
        for (int i = 0; i < 4; ++i) { wr_off[2 * i] = attn_off_b((unsigned)((lane >> 3) + 8 * i), 2u * (lane & 7)); wr_off[2 * i + 1] = attn_off_b((unsigned)((lane >> 3) + 8 * i), 2u * (lane & 7) + 1u); }
#pragma unroll
        for (int tt = 0; tt < 2; ++tt) { const unsigned row = 8u * gi + 4u * tt + q4; const unsigned x = ((row & 3u) << 2) | ((row >> 2) & 3u);
            rd_off[tt] = 256u * row + 16u * ((p4 >> 1) ^ (x & 1u)) + 8u * (p4 & 1u) + 32u * (x >> 1); }
        f32x4 o[8];
#pragma unroll
        for (int c = 0; c < 8; ++c) o[c] = (f32x4){0.f, 0.f, 0.f, 0.f};
#define AT_STEP(vst, Tt) do { \
            _Pragma("unroll") for (int i = 0; i < 4; ++i) {     \
                *(LAS h16x8*)(vimg + ((Tt) & 1) * 8192 + wr_off[2 * i]) = f8x8_to_h(vst[i].x, vst[i].y); *(LAS h16x8*)(vimg + ((Tt) & 1) * 8192 + wr_off[2 * i + 1]) = f8x8_to_h(vst[i].z, vst[i].w); } \
            if ((Tt) + 2 < 8) AT_LOADV(vst, (Tt) + 2); \
            const unsigned ib = (unsigned)(size_t)(vimg + ((Tt) & 1) * 8192); \
            h16x4 lo[8], hi[8]; \
            asm volatile("s_waitcnt lgkmcnt(0)" ::: "memory"); \
            _Pragma("unroll") for (int c = 0; c < 8; ++c) { \
                asm volatile("ds_read_b64_tr_b16 %0, %1" : "=&v"(lo[c]) : "v"(ib + (rd_off[0] ^ ((unsigned)c << 5))) : "memory"); \
                asm volatile("ds_read_b64_tr_b16 %0, %1" : "=&v"(hi[c]) : "v"(ib + (rd_off[1] ^ ((unsigned)c << 5))) : "memory"); } \
            asm volatile("s_waitcnt lgkmcnt(0)" ::: "memory"); __builtin_amdgcn_sched_barrier(0); \
            _Pragma("unroll") for (int c = 0; c < 8; ++c) o[c] = __builtin_amdgcn_mfma_f32_16x16x32_f16(pf[Tt], (h16x8){lo[c][0], lo[c][1], lo[c][2], lo[c][3], hi[c][0], hi[c][1], hi[c][2], hi[c][3]}, o[c], 0, 0, 0); \
        } while (0)
        AT_STEP(vsa, 0); AT_STEP(vsb, 1); AT_STEP(vsa, 2); AT_STEP(vsb, 3); AT_STEP(vsa, 4); AT_STEP(vsb, 5); AT_STEP(vsa, 6); AT_STEP(vsb, 7);
        if (L + G < (T / 8) * NKV) AT_PREP_B(L + G, itpar ^ 1);
#undef AT_STEP
#undef AT_LOADV
        const float li = __shfl(linv, gi);
        h16* orow = O + (size_t)t * D + (4 * g + gi) * HD + jl;
#pragma unroll
        for (int c = 0; c < 8; ++c) { const float v = gi == 0 ? o[c][0] : gi == 1 ? o[c][1] : gi == 2 ? o[c][2] : o[c][3]; orow[16 * c] = (h16)(v * li); }
        asm volatile("s_waitcnt lgkmcnt(0)" ::: "memory");
    }
#undef AT_PREF
#undef AT_PREP
#undef AT_PREP_A
#undef AT_PREP_B
#undef AT_LOADK2
}

constexpr int NPH = 38;
__global__ void __launch_bounds__(NTHR, 2) fwd_kernel(Ptrs P_unused) {
    extern __shared__ __attribute__((aligned(16))) unsigned char lds_raw[];
    LAS unsigned char* lds = (LAS unsigned char*)lds_raw;
    volatile LAS unsigned* MISC = (volatile LAS unsigned*)(lds + MISC_OFF);
    for (int u = threadIdx.x; u < (LDS_BYTES - LDSCTL_OFF) / 4; u += NTHR) ((LAS unsigned*)(lds + LDSCTL_OFF))[u] = 0u;
    __syncthreads();
    int lo, hi;
    XcdBarrier bar;
    { const CAS Ptrs* PP = kargs(); lo = PP->ph_lo; hi = PP->ph_hi; unsigned* bw = (unsigned*)(PP->ws + WS_CTL) + CW_BAR;
      bar.bar = bw; bar.x = 0; bar.st = nullptr; if (hi - lo > 1) bar = xcd_barrier_post(bw, MISC + 8); }
    int seq = 0;
#define PH_BEGIN(S_) if (seq >= lo && seq < hi) { const int site_ = (S_); unsigned long long tph0_ = 0; if (TPH_SITE == site_) tph0_ = __builtin_amdgcn_s_memrealtime(); const CAS Ptrs* PP = kargs(); unsigned char* const ws = PP->ws; float* const X = PP->out; (void)X; \
        int tid = threadIdx.x, bx = blockIdx.x, G = gridDim.x; asm volatile("" : "+v"(tid), "+s"(bx), "+s"(G)); \
        const int lane = tid & 63, wave = __builtin_amdgcn_readfirstlane(tid >> 6); const int vcu = (G % 8 == 0) ? (bx % 8) * (G / 8) + bx / 8 : bx; \
        const int gw = vcu * NWAVES + wave, NGW = G * NWAVES, gtid = vcu * NTHR + tid, NGT = G * NTHR; (void)lane; (void)gw; (void)NGW; (void)gtid; (void)NGT; \
        for (int rep_ = 0; rep_ < 1 + (int)((REP_MASK >> (S_)) & 1u); ++rep_) { if (rep_) __syncthreads(); \
        h16* const X16 = (h16*)(ws + WS_X16); h16* const PROJ = (h16*)(ws + WS_BA + BA_PROJ); h16* const U16 = (h16*)(ws + WS_BA + BA_U); (void)X16; (void)PROJ; (void)U16;
#define PH_END   } if (TPH_SITE == site_) { const unsigned long long t1_ = __builtin_amdgcn_s_memrealtime(), d_ = (unsigned long long)TPH_MULT * (t1_ - tph0_); while (__builtin_amdgcn_s_memrealtime() - t1_ < d_) __builtin_amdgcn_s_sleep(2); } \
                 if (seq + 1 < hi) xcd_barrier(bar); } ++seq;
#define RSQ(i_) ((float*)(ws + WS_CTL + WS_ROWSQ) + (size_t)(i_) * T)
#define PARTA ((float*)(ws + WS_PARTA))
#define PARTB ((float*)(ws + WS_PARTB))

    PH_BEGIN(0) p0_prologue(PP, lds, gw, NGW, wave, lane, gtid, NGT); norm0_phase(PP->x, X16, RSQ(0), gw, NGW, lane); PH_END

#pragma unroll 1
    for (int layer = 0; layer < DEPTH; ++layer) {
        const int kind = layer % 3, j = layer / 3;
        if (kind == 0) {
            PH_BEGIN(2) { pg8::Gemm g{X16, (const h16*)(ws + WS_WINA) + (size_t)j * A_INP * D, T, A_INP, D, D, 1 << 20, D, 128, 128}; pg8::StaticOrder S; S.init(T, A_INP, G, bx);
                       pg8::EpiF16<0> E{PROJ, A_INP, layer == 0 ? RSQ(0) : PARTB, 0, layer == 0 ? 0 : 32}; pg8::gemm_phase<pg8::EpiF16<0>, pg8::StaticOrder, true, true>(lds, g, S, E, tid); } PH_END
            PH_BEGIN(3) dsa_post_phase(PROJ, PP->attn_qn + j * HD, PP->attn_kn + j * HD, (const float*)(ws + WS_COS128), (const float*)(ws + WS_SIN128), (const float*)(ws + WS_COS64), (const float*)(ws + WS_SIN64),
                                    (unsigned char*)(ws + WS_QH), (unsigned char*)(ws + WS_KH), (unsigned char*)(ws + WS_VH), (h16*)(ws + WS_IQ), (h16*)(ws + WS_IK), (float*)(ws + WS_IW), gw, NGW, lane); PH_END
            PH_BEGIN(4) idx_scores_phase((const h16*)(ws + WS_IQ), (const h16*)(ws + WS_IK), (const float*)(ws + WS_IW), (h16*)(ws + WS_BA + BA_SC), lds, vcu, G, tid, wave, lane); PH_END
            PH_BEGIN(5) topk_phase((const h16*)(ws + WS_BA + BA_SC), (int*)(ws + WS_SEL), lds, gw, NGW, wave, lane); PH_END
            PH_BEGIN(6) attn_mfma_phase((const unsigned char*)(ws + WS_QH), (const unsigned char*)(ws + WS_KH), (const unsigned char*)(ws + WS_VH), (const int*)(ws + WS_SEL), (h16*)(ws + WS_BA + BA_O16), lds, bx, G, wave, lane); PH_END
            PH_BEGIN(7) { pg8::Gemm g{(const h16*)(ws + WS_BA + BA_O16), (const h16*)(ws + WS_WOUTA) + (size_t)j * D * D, T, D, D, D, 1 << 20, D, 128, 128}; pg8::StaticOrder S; S.init(T, D, G, bx);
                       pg8::EpiResid E{X16, X16, nullptr, D, nullptr, nullptr, PARTA}; pg8::gemm_phase<pg8::EpiResid, pg8::StaticOrder, true, true>(lds, g, S, E, tid); } PH_END
        } else if (kind == 1) {
            PH_BEGIN(9) { pg8::Gemm g{X16, (const h16*)(ws + WS_WINR), T, 4096, D, D, 1 << 20, D, 128, 128}; pg8::StaticOrder S; S.init(T, 4096, G, bx);
                       pg8::EpiF16<0> E{PROJ, 4096, layer == 0 ? RSQ(0) : PARTB, 0, layer == 0 ? 0 : 32}; pg8::gemm_phase<pg8::EpiF16<0>, pg8::StaticOrder, true, true>(lds, g, S, E, tid); } PH_END
            PH_BEGIN(10) conv_phase(PROJ, PP->conv_w, PP->conv_b, (h16*)(ws + WS_BA + BA_XC), vcu, G, tid); PH_END
            PH_BEGIN(11) { int kg = 256; asm volatile("" : "+s"(kg));
                       pg8::Gemm g{(const h16*)(ws + WS_BA + BA_XC), (const h16*)(ws + WS_WGR), T, 4096, kg, D, 2, kg, 128, 128}; pg8::StaticOrder S; S.init(T, 4096, G, bx);
                       pg8::EpiGates E{(const h16*)(ws + WS_BA + BA_XC), PP->ga_b, PP->gx_b, PP->lam, (h16*)(ws + WS_BA + BA_AF), (h16*)(ws + WS_BA + BA_BF)};
                       pg8::gemm_phase<pg8::EpiGates, pg8::StaticOrder, true, true>(lds, g, S, E, tid); } PH_END
            PH_BEGIN(12) scan_agg_phase((const h16*)(ws + WS_BA + BA_AF), (const h16*)(ws + WS_BA + BA_BF), (float*)(ws + WS_AGGA), (float*)(ws + WS_AGGB), gtid, NGT); PH_END
            PH_BEGIN(21) scan_carry_phase((const float*)(ws + WS_AGGA), (const float*)(ws + WS_AGGB), (float*)(ws + WS_CARRY), vcu, wave, lane); PH_END
            PH_BEGIN(13) scan_final_phase((const h16*)(ws + WS_BA + BA_AF), (const h16*)(ws + WS_BA + BA_BF), (const float*)(ws + WS_CARRY), PROJ, (h16*)(ws + WS_BA + BA_XC), gtid, NGT); PH_END
            PH_BEGIN(14) { pg8::Gemm g{(const h16*)(ws + WS_BA + BA_XC), (const h16*)(ws + WS_WOUTR), T, D, D, D, 1 << 20, D, 128, 128}; pg8::StaticOrder S; S.init(T, D, G, bx);
                       pg8::EpiResid E{X16, X16, nullptr, D, nullptr, nullptr, PARTA}; pg8::gemm_phase<pg8::EpiResid, pg8::StaticOrder, true, true>(lds, g, S, E, tid); } PH_END
        } else {
            PH_BEGIN(15) pool_phase(X16, PARTB, PP->pool_norm, (h16*)(ws + WS_BA + BA_XC), lds, vcu, G, tid, wave, lane); PH_END
            PH_BEGIN(16) { pg8::Gemm g{(const h16*)(ws + WS_BA + BA_XC), (const h16*)(ws + WS_WPOOL), T, D, 512, D, 2, 512, 128, 128}; pg8::StaticOrder S; S.init(T, D, G, bx);
                       pg8::EpiResidB E{X16, X16, nullptr, D, PP->pool_b, PP->pool_scale, PARTA}; pg8::gemm_phase<pg8::EpiResidB, pg8::StaticOrder, true, true>(lds, g, S, E, tid); } PH_END
        }
        PH_BEGIN(17) quant_rows(X16, T, (signed char*)(ws + WS_BA + BA_A8), (float*)(ws + WS_RS), PARTA, nullptr, gw, NGW, lane);
                     quant_rows((const h16*)(ws + WS_WUP) + (size_t)layer * D * FF, FF, (signed char*)(ws + WS_BA + BA_W8), (float*)(ws + WS_CS), nullptr, (const unsigned*)(ws + WS_BLKMAX) + (size_t)layer * 32 * FF, gw, NGW, lane); PH_END
        PH_BEGIN(18) { pg8::Gemm g{(const h16*)(ws + WS_BA + BA_A8), (const h16*)(ws + WS_BA + BA_W8), T, FF, D / 2, D / 2, 1 << 20, D / 2, 128, 128}; pg8::StaticOrder S; S.init(T, FF, G, bx);
                   pg8::EpiQRelu2B<pg8::i32x4> E{(unsigned char*)(ws + WS_BA + BA_U), (float*)(ws + WS_BA + BA_SB), (const float*)(ws + WS_RS), (const float*)(ws + WS_CS), T}; pg8::gemm_phase_i8<pg8::EpiQRelu2B<pg8::i32x4>, pg8::StaticOrder, true, true>(lds, g, S, E, tid); } PH_END
        PH_BEGIN(19) requant_u8((const unsigned char*)(ws + WS_BA + BA_U), (const float*)(ws + WS_BA + BA_SB), (signed char*)(ws + WS_BA + BA_U8), (float*)(ws + WS_RS2), gw, NGW, lane);
                     quant_kblk<false>((const h16*)(ws + WS_WDOWN) + (size_t)layer * D * FF, D, (signed char*)(ws + WS_BA + BA_W8D), (float*)(ws + WS_CS2), (float*)(ws + WS_CSUM), (const unsigned*)(ws + WS_BLKMAXD) + (size_t)layer * 128 * D, gw, NGW, lane); PH_END
        PH_BEGIN(20) { pg8::Gemm g{(const h16*)(ws + WS_BA + BA_U8), (const h16*)(ws + WS_BA + BA_W8D), T, D, FF / 2, 64, 1 << 20, 64, (size_t)T * 128, (size_t)D * 128}; pg8::StaticOrder S; S.init(T, D, G, bx);
                   const bool lastl = layer + 1 >= DEPTH, needsq = !lastl;
                   pg8::EpiResidQ E{X16, X16, lastl ? X : nullptr, D, (const float*)(ws + WS_RS2), (const float*)(ws + WS_CS2), (const float*)(ws + WS_CSUM), needsq ? PARTB : nullptr};
                   pg8::gemm_phase_i8<pg8::EpiResidQ, pg8::StaticOrder, true, true>(lds, g, S, E, tid); } PH_END
    }
#undef PH_BEGIN
#undef PH_END
#undef RSQ
#undef PARTA
#undef PARTB
}

extern "C" void kernel_launch(void* const* d_in, const int* in_sizes, int n_in, void* d_out, int out_size, void* d_ws, size_t ws_size, hipStream_t stream) {
    static int grid = 0;
    if (grid == 0) {
        if (n_in != 24 || in_sizes[0] != T * D || out_size != T * D || ws_size < WS_END) { fprintf(stderr, "kernel_launch: unexpected shapes / workspace (n_in %d, in0 %d, out %d, ws %zu, need %zu); nothing launched\n", n_in, n_in > 0 ? in_sizes[0] : -1, out_size, ws_size, (size_t)WS_END); grid = -1; return; }
        int dev = 0, cus = 0, per_cu = 0;
        if (hipGetDevice(&dev) != hipSuccess || hipDeviceGetAttribute(&cus, hipDeviceAttributeMultiprocessorCount, dev) != hipSuccess) { grid = -1; return; }
        if (hipFuncSetAttribute((const void*)fwd_kernel, hipFuncAttributeMaxDynamicSharedMemorySize, LDS_BYTES) != hipSuccess) { fprintf(stderr, "kernel_launch: hipFuncSetAttribute failed\n"); grid = -1; return; }
        if (hipOccupancyMaxActiveBlocksPerMultiprocessor(&per_cu, (const void*)fwd_kernel, NTHR, LDS_BYTES) != hipSuccess || per_cu < 1) { fprintf(stderr, "kernel_launch: occupancy query reports %d workgroups per CU\n", per_cu); }
        (void)hipGetLastError();
        grid = cus;
    }
    if (grid < 0) return;
    if (hipMemsetAsync((char*)d_ws + WS_CTL, 0, CTL_ZERO_BYTES, stream) != hipSuccess) return;
    Ptrs p{};
    p.x = (const float*)d_in[0]; p.pos = (const int*)d_in[1];
    p.attn_norm = (const float*)d_in[2]; p.attn_w_in = (const float*)d_in[3]; p.attn_qn = (const float*)d_in[4]; p.attn_kn = (const float*)d_in[5]; p.attn_w_out = (const float*)d_in[6];
    p.rnn_norm = (const float*)d_in[7]; p.rnn_w_in = (const float*)d_in[8]; p.conv_w = (const float*)d_in[9]; p.conv_b = (const float*)d_in[10]; p.ga_w = (const float*)d_in[11]; p.ga_b = (const float*)d_in[12];
    p.gx_w = (const float*)d_in[13]; p.gx_b = (const float*)d_in[14]; p.lam = (const float*)d_in[15]; p.rnn_w_out = (const float*)d_in[16];
    p.pool_norm = (const float*)d_in[17]; p.pool_w = (const float*)d_in[18]; p.pool_b = (const float*)d_in[19]; p.pool_scale = (const float*)d_in[20];
    p.mlp_norm = (const float*)d_in[21]; p.mlp_w_up = (const float*)d_in[22]; p.mlp_w_down = (const float*)d_in[23];
    p.out = (float*)d_out; p.ws = (unsigned char*)d_ws;
#if MK_SPLIT
    for (int ph = 0; ph < NPH; ++ph) { p.ph_lo = ph; p.ph_hi = ph + 1; hipLaunchKernelGGL(fwd_kernel, dim3(grid), dim3(NTHR), LDS_BYTES, stream, p); }
#else
    p.ph_lo = 0; p.ph_hi = NPH; hipLaunchKernelGGL(fwd_kernel, dim3(grid), dim3(NTHR), LDS_BYTES, stream, p);
#endif
}
```
